# Optimizing an MI355X kernel written in HIP

```python
import jax, jax.numpy as jnp
from jax import lax
import numpy as np

D_MODEL = 1024
BATCH = 8
SEQ = 4096
DEPTH = 4

D_MIX = D_MODEL
HG_HEADS = 4
HG_DK = 128
HG_DV = 128
HG_WIDTH = HG_HEADS * HG_DV
HG_CHUNK = 64
SA_HEADS = 4
SA_HEAD_DIM = 64
SA_WIDTH = SA_HEADS * SA_HEAD_DIM
IDX_HEADS = 8
IDX_DIM = 32
IDX_TOPK_MAX = 256
IDX_TOPK_DIV = 4
Q_BLOCK = 128
CV_WIDTH = D_MIX - HG_WIDTH - SA_WIDTH
CV_WIDTH_FILTER = 31
D_FF = 4 * D_MODEL
N_MOD = 6
EPS = 1e-6
NEG_BIG = -1e30
TINY = 1e-30

IN_SIZES = (
    HG_HEADS * HG_DK,
    HG_HEADS * HG_DK,
    HG_WIDTH,
    HG_WIDTH,
    SA_WIDTH,
    SA_WIDTH,
    SA_WIDTH,
    IDX_HEADS * IDX_DIM,
    IDX_DIM,
    IDX_HEADS,
    2 * CV_WIDTH,
)
D_IN = sum(IN_SIZES)

kernel_name = "hymba_hgrn2_dsa_conformer_trunk"


def rmsnorm(x, w):
    xf = x.astype(jnp.float32)
    y = xf * lax.rsqrt(jnp.mean(xf * xf, axis=-1, keepdims=True) + EPS)
    return (y * w.astype(jnp.float32)).astype(x.dtype)


def hgrn2_lower_bounds(lb_logits):
    p = jax.nn.softmax(lb_logits.astype(jnp.float32), axis=0)
    return jnp.cumsum(p, axis=0) - p[0]


def hgrn2_mixer(q_raw, f_raw, i_in, g_raw, lb, onorm_w):
    f32 = jnp.float32
    dt = q_raw.dtype
    bsz, L, _ = q_raw.shape
    lb = lb.astype(f32)
    fr = f_raw.astype(f32)
    q = jax.nn.silu(q_raw.astype(f32)) * (HG_DK ** -0.5)
    f = lb + (1.0 - lb) * jax.nn.sigmoid(fr)
    log_f = jnp.log(jnp.maximum(f, TINY))
    k = (1.0 - lb) * jax.nn.sigmoid(-fr)
    v = i_in.astype(f32)
    n_chunks = L // HG_CHUNK

    def to_chunks(t, d):
        return t.reshape(bsz, n_chunks, HG_CHUNK, HG_HEADS, d).transpose(1, 0, 3, 2, 4)

    causal = jnp.tril(jnp.ones((HG_CHUNK, HG_CHUNK), dtype=bool))

    def step(S, xs):
        qc, kc, gc, vc = xs
        G = jnp.cumsum(gc, axis=-2)
        o_inter = jnp.einsum('bhik,bhkv->bhiv', qc * jnp.exp(G), S)
        diff = G[:, :, :, None, :] - G[:, :, None, :, :]
        decay = jnp.exp(jnp.where(causal[:, :, None], diff, NEG_BIG))
        A = jnp.einsum('bhik,bhijk,bhjk->bhij', qc, decay, kc)
        o_intra = jnp.einsum('bhij,bhjv->bhiv', A, vc)
        G_last = G[:, :, -1:, :]
        S_new = jnp.exp(G_last[:, :, 0, :])[..., None] * S + jnp.einsum(
            'bhjk,bhjv->bhkv', kc * jnp.exp(G_last - G), vc)
        return S_new, o_inter + o_intra

    S0 = jnp.zeros((bsz, HG_HEADS, HG_DK, HG_DV), f32)
    _, o = lax.scan(step, S0, (to_chunks(q, HG_DK), to_chunks(k, HG_DK),
                               to_chunks(log_f, HG_DK), to_chunks(v, HG_DV)))
    o = o.transpose(1, 0, 3, 2, 4).reshape(bsz, L, HG_HEADS, HG_DV)
    o = o * lax.rsqrt(jnp.mean(o * o, axis=-1, keepdims=True) + EPS)
    o = o * onorm_w.astype(f32).reshape(HG_HEADS, HG_DV)
    o = o.reshape(bsz, L, HG_WIDTH) * jax.nn.silu(g_raw.astype(f32))
    return o.astype(dt)


def dsa_mixer(q, k, v, q_idx, k_idx, w_idx):
    f32 = jnp.float32
    dt = q.dtype
    bsz, L, _ = q.shape
    topk = min(IDX_TOPK_MAX, L // IDX_TOPK_DIV)
    n_blk = L // Q_BLOCK
    q = q.reshape(bsz, L, SA_HEADS, SA_HEAD_DIM)
    k = k.reshape(bsz, L, SA_HEADS, SA_HEAD_DIM)
    v = v.reshape(bsz, L, SA_HEADS, SA_HEAD_DIM)
    q_idx = q_idx.reshape(bsz, L, IDX_HEADS, IDX_DIM)
    w_idx = w_idx.astype(f32) * (IDX_HEADS ** -0.5)
    k_idx_f = k_idx.astype(f32)
    key_pos = jnp.arange(L, dtype=jnp.int32)

    def blocks(t):
        return t.reshape(bsz, n_blk, Q_BLOCK, *t.shape[2:]).swapaxes(0, 1)

    def one_block(xs):
        qb, qib, wb, t0 = xs
        qpos = t0 + jnp.arange(Q_BLOCK, dtype=jnp.int32)
        s = jnp.einsum('bqhd,bsd->bqhs', qib.astype(f32), k_idx_f) * (IDX_DIM ** -0.5)
        score = jnp.einsum('bqh,bqhs->bqs', wb, jax.nn.relu(s))
        admissible = key_pos[None, :] <= qpos[:, None]
        score = jnp.where(admissible[None], score, NEG_BIG)
        _, sel = lax.top_k(score, topk)
        valid = sel <= qpos[None, :, None]
        kg = jax.vmap(lambda kk, ii: kk[ii])(k, sel)
        vg = jax.vmap(lambda vv, ii: vv[ii])(v, sel)
        logits = jnp.einsum('bqhd,bqkhd->bqhk', qb.astype(f32), kg.astype(f32)) * (SA_HEAD_DIM ** -0.5)
        logits = jnp.where(valid[:, :, None, :], logits, NEG_BIG)
        p = jax.nn.softmax(logits, axis=-1)
        o = jnp.einsum('bqhk,bqkhd->bqhd', p, vg.astype(f32))
        return o.reshape(bsz, Q_BLOCK, SA_WIDTH).astype(dt)

    t0s = jnp.arange(n_blk, dtype=jnp.int32) * Q_BLOCK
    out = lax.map(one_block, (blocks(q), blocks(q_idx), blocks(w_idx), t0s))
    return out.swapaxes(0, 1).reshape(bsz, L, SA_WIDTH)


def conv_module(u, cv_w, cv_b, ln_w, ln_b):
    f32 = jnp.float32
    dt = u.dtype
    a, b = jnp.split(u, 2, axis=-1)
    h = a * jax.nn.sigmoid(b)
    h = lax.conv_general_dilated(
        h, cv_w[:, None, :], window_strides=(1,),
        padding=[(CV_WIDTH_FILTER - 1, 0)],
        dimension_numbers=('NWC', 'WIO', 'NWC'),
        feature_group_count=CV_WIDTH) + cv_b
    hf = h.astype(f32)
    mu = jnp.mean(hf, axis=-1, keepdims=True)
    var = jnp.mean(jnp.square(hf - mu), axis=-1, keepdims=True)
    hf = (hf - mu) * lax.rsqrt(var + EPS) * ln_w.astype(f32) + ln_b.astype(f32)
    return jax.nn.silu(hf).astype(dt)


def setup_inputs(seed: int = 0) -> dict:
    key = jax.random.key(seed)
    ks = jax.random.split(key, 17)
    f32 = jnp.float32
    n = lambda k, shape, s: jax.random.normal(k, shape, f32) * s
    return {
        "x": n(ks[0], (BATCH, SEQ, D_MODEL), 1.0),
        "c": n(ks[1], (BATCH, D_MODEL), 1.0),
        "ada_w": n(ks[2], (DEPTH, D_MODEL, N_MOD * D_MODEL), 0.5 * D_MODEL ** -0.5),
        "ada_b": n(ks[3], (DEPTH, N_MOD * D_MODEL), 0.02),
        "norm_mix_w": 1.0 + n(ks[4], (DEPTH, D_MODEL), 0.05),
        "norm_mlp_w": 1.0 + n(ks[5], (DEPTH, D_MODEL), 0.05),
        "w_in": n(ks[6], (DEPTH, D_MODEL, D_IN), D_MODEL ** -0.5),
        "hg_lb_logits": n(ks[7], (DEPTH, HG_HEADS * HG_DK), 1.0),
        "hg_onorm_w": 1.0 + n(ks[8], (DEPTH, HG_WIDTH), 0.05),
        "cv_w": n(ks[9], (DEPTH, CV_WIDTH_FILTER, CV_WIDTH), CV_WIDTH_FILTER ** -0.5),
        "cv_b": n(ks[10], (DEPTH, CV_WIDTH), 0.02),
        "cv_ln_w": 1.0 + n(ks[11], (DEPTH, CV_WIDTH), 0.05),
        "cv_ln_b": n(ks[12], (DEPTH, CV_WIDTH), 0.02),
        "w_out": n(ks[13], (DEPTH, D_MIX, D_MODEL), D_MIX ** -0.5),
        "mlp_w1": n(ks[14], (DEPTH, D_MODEL, D_FF), D_MODEL ** -0.5),
        "mlp_w2": n(ks[15], (DEPTH, D_FF, D_MODEL), D_FF ** -0.5),
        "final_norm_w": 1.0 + n(ks[16], (D_MODEL,), 0.05),
    }


def reference(x, c, ada_w, ada_b, norm_mix_w, norm_mlp_w, w_in, hg_lb_logits, hg_onorm_w,
              cv_w, cv_b, cv_ln_w, cv_ln_b, w_out, mlp_w1, mlp_w2, final_norm_w):
    offsets = np.cumsum(IN_SIZES)[:-1].tolist()
    lower_bounds = hgrn2_lower_bounds(hg_lb_logits)
    c_act = jax.nn.silu(c)
    for l in range(DEPTH):
        mod = c_act @ ada_w[l] + ada_b[l]
        sh1, sc1, g1, sh2, sc2, g2 = [m[:, None, :] for m in jnp.split(mod, N_MOD, axis=-1)]

        h = rmsnorm(x, norm_mix_w[l]) * (1.0 + sc1) + sh1
        proj = h @ w_in[l]
        (hq, hf, hi, hg, sq, sk, sv, iq, ik, iw, cu) = jnp.split(proj, offsets, axis=-1)
        o_a = hgrn2_mixer(hq, hf, hi, hg, lower_bounds[l], hg_onorm_w[l])
        o_b = dsa_mixer(sq, sk, sv, iq, ik, iw)
        o_c = conv_module(cu, cv_w[l], cv_b[l], cv_ln_w[l], cv_ln_b[l])
        mix = jnp.concatenate([o_a, o_b, o_c], axis=-1) @ w_out[l]
        x = x + g1 * mix

        h = rmsnorm(x, norm_mlp_w[l]) * (1.0 + sc2) + sh2
        ff = jnp.square(jax.nn.relu(h @ mlp_w1[l])) @ mlp_w2[l]
        x = x + g2 * ff
    return rmsnorm(x, final_norm_w)
```

```cpp
#include <hip/hip_runtime.h>
#include <hip/hip_cooperative_groups.h>
#include <cstdio>
#include <cstdint>
namespace cg = cooperative_groups;

#define LAS __attribute__((address_space(3)))
typedef unsigned short bf16_t;
typedef short bf16x8 __attribute__((ext_vector_type(8)));
typedef float f32x4 __attribute__((ext_vector_type(4)));
typedef unsigned u32x4 __attribute__((ext_vector_type(4)));
typedef unsigned u32x2 __attribute__((ext_vector_type(2)));

constexpr int DM = 1024, NB = 8, SEQ = 4096, DEPTH = 4, NTOK = NB * SEQ;
constexpr int DIN = 3624, DINP = 3840, DFF = 4096;
constexpr int OFF_HQ = 0, OFF_HF = 512, OFF_HI = 1024, OFF_HG = 1536, OFF_SQ = 2048, OFF_SK = 2304, OFF_SV = 2560, OFF_IQ = 2816, OFF_IK = 3072, OFF_IW = 3104, OFF_CU = 3112;
constexpr int TOPK = 256;
constexpr float EPS = 1e-6f;
constexpr int NTHREADS = 512;
constexpr int LDS_BYTES = 131072;

constexpr size_t WS_WIN = 0;
constexpr size_t WS_WOUT = WS_WIN + (size_t)DEPTH * DINP * DM * 2;
constexpr size_t WS_W1 = WS_WOUT + (size_t)DEPTH * DM * DM * 2;
constexpr size_t WS_W2 = WS_W1 + (size_t)DEPTH * DFF * DM * 2;
constexpr size_t WS_MOD = WS_W2 + (size_t)DEPTH * DM * DFF * 2;
constexpr size_t WS_LB = WS_MOD + (size_t)DEPTH * NB * 6 * DM * 4;
constexpr size_t WS_BIG = WS_LB + (size_t)DEPTH * 512 * 4;
constexpr size_t WS_HB = WS_BIG + (size_t)NTOK * DFF * 2;
constexpr size_t WS_ST = WS_HB + (size_t)NTOK * DM * 2;
constexpr size_t WS_DEC = WS_ST + (size_t)32 * 64 * 16384 * 2;
constexpr size_t WS_VT = WS_DEC + (size_t)32 * 64 * 128 * 4;
constexpr size_t WS_THRT = WS_VT + (size_t)NB * 4 * 64 * SEQ * 2;
constexpr size_t WS_THRC = WS_THRT + (size_t)NTOK * 4;
constexpr size_t WS_END = WS_THRC + (size_t)NTOK * 4;
static_assert(WS_END <= (size_t)512 * 1024 * 1024, "workspace map exceeds 512 MiB");

struct Params {
    const float* x; const float* c; const float* ada_w; const float* ada_b; const float* norm_mix_w; const float* norm_mlp_w;
    const float* w_in; const float* lb_logits; const float* onorm_w; const float* cv_w; const float* cv_b; const float* cv_ln_w; const float* cv_ln_b;
    const float* w_out; const float* w1; const float* w2; const float* final_w;
    float* out; unsigned char* ws;
    int ph_lo, ph_hi;
};

typedef float f32x2_t __attribute__((ext_vector_type(2)));
typedef __bf16 bf16x2_t __attribute__((ext_vector_type(2)));
__device__ __forceinline__ unsigned cvt_pk_bf16(float lo, float hi) { const f32x2_t v = {lo, hi}; return __builtin_bit_cast(unsigned, __builtin_convertvector(v, bf16x2_t)); }
__device__ __forceinline__ float bf2f(short h) { return __uint_as_float(((unsigned)(unsigned short)h) << 16); }
__device__ __forceinline__ float bflo(unsigned w) { return __uint_as_float(w << 16); }
__device__ __forceinline__ float bfhi(unsigned w) { return __uint_as_float(w & 0xffff0000u); }
__device__ __forceinline__ bf16_t f2bf(float f) { return (bf16_t)(cvt_pk_bf16(f, 0.f) & 0xffffu); }
__device__ __forceinline__ float wave_sum(float v) {
    v += __shfl_xor(v, 32); v += __shfl_xor(v, 16); v += __shfl_xor(v, 8); v += __shfl_xor(v, 4); v += __shfl_xor(v, 2); v += __shfl_xor(v, 1); return v;
}
__device__ __forceinline__ float sigmoidf_(float x) { return 1.f / (1.f + __expf(-x)); }
__device__ __forceinline__ float siluf_(float x) { return x / (1.f + __expf(-x)); }
__device__ __forceinline__ unsigned sortable(float f) { unsigned b = __float_as_uint(f); return b ^ ((b & 0x80000000u) ? 0xffffffffu : 0x80000000u); }
__device__ __forceinline__ f32x4 mfma16(bf16x8 a, bf16x8 b, f32x4 c) { return __builtin_amdgcn_mfma_f32_16x16x32_bf16(a, b, c, 0, 0, 0); }

namespace pg8 {
#define PG8_LAS __attribute__((address_space(3)))
constexpr int BM = 256, BK = 64, HALF = 128, HTB = HALF * BK * 2, STAGE_BYTES = 8 * HTB, NXCD = 8, WGM = 8;
__host__ __device__ __forceinline__ int lds_byte(int r, int c) { const int st = (r >> 4) * 2 + (c >> 5), rr = r & 15, cc = c & 31, ob = rr * 64 + cc * 2; return st * 1024 + (ob ^ (((ob >> 9) & 1) << 5)); }
__host__ __device__ __forceinline__ void stage_rc(int b, int& R, int& C) { const int st = b / 1024, sb = b % 1024, swz = sb ^ (((sb >> 9) & 1) << 5); R = (st >> 1) * 16 + swz / 64; C = (st & 1) * 32 + (swz % 64) / 2; }
__host__ __device__ __forceinline__ int perm32(int rho) { const int n = rho >> 4, i = rho & 15; return 8 * (i >> 2) + 4 * n + (i & 3); }
struct Unit { int pm, pn; };
struct Gemm { const bf16_t* A; const bf16_t* Bt; int M, N, K; };
struct StaticOrder {
    int nM, nN, nwg, G, c;
    __host__ __device__ void init(int M, int N, int G_, int c_) { nM = M / BM; nN = N / BM; nwg = nM * nN; G = G_; c = c_; }
    __host__ __device__ bool next(int i, Unit& u) const {
        const long L = (long)i * G + c; if (L >= nwg) return false;
        int wgid = (int)L; { const int q = nwg / NXCD, r = nwg % NXCD, xcd = wgid % NXCD, off = wgid / NXCD; wgid = (xcd < r ? xcd * (q + 1) : r * (q + 1) + (xcd - r) * q) + off; }
        const int nig = WGM * nN, gid = wgid / nig, fm = gid * WGM, gsz = (nM - fm) < WGM ? (nM - fm) : WGM;
        u.pm = fm + ((wgid % nig) % gsz); u.pn = (wgid % nig) / gsz; return true;
    }
    __device__ __forceinline__ void a_ready(const Unit&) const {}
    __device__ __forceinline__ void done(const Unit&) const {}
};

template <int ACT  > struct EpiBf16 {
    static constexpr bool PERM = true, AFTER_DRAIN = false;
    bf16_t* O; int ldc;
    __device__ __forceinline__ void operator()(const f32x4 (&acc)[2][2][4][2], const Unit& u, int wr, int wc, int fr, int fq) const {
        const int row0 = u.pm * BM + wr * 64 + fr, col0 = u.pn * BM + wc * 32 + 8 * fq;
#pragma unroll
        for (int ai = 0; ai < 2; ++ai)
#pragma unroll
            for (int m = 0; m < 4; ++m) { bf16_t* rowp = O + (size_t)(row0 + ai * HALF + m * 16) * ldc + col0;
#pragma unroll
                for (int bj = 0; bj < 2; ++bj) { f32x4 v0 = acc[ai][bj][m][0], v1 = acc[ai][bj][m][1];
                    if (ACT == 1) {
#pragma unroll
                        for (int j = 0; j < 4; ++j) { const float a = fmaxf(v0[j], 0.f), b = fmaxf(v1[j], 0.f); v0[j] = a * a; v1[j] = b * b; } }
                    u32x4 w; w.x = cvt_pk_bf16(v0[0], v0[1]); w.y = cvt_pk_bf16(v0[2], v0[3]); w.z = cvt_pk_bf16(v1[0], v1[1]); w.w = cvt_pk_bf16(v1[2], v1[3]);
                    *(u32x4*)(rowp + bj * HALF) = w; } }
    }
};
struct EpiResid {
    static constexpr bool PERM = true, AFTER_DRAIN = false;
    const float* xs; float* xd; const float* gate;
    __device__ __forceinline__ void operator()(const f32x4 (&acc)[2][2][4][2], const Unit& u, int wr, int wc, int fr, int fq) const {
        const int row0 = u.pm * BM + wr * 64 + fr, col0 = u.pn * BM + wc * 32 + 8 * fq;
        const float* gp = gate + (size_t)((u.pm * BM) >> 12) * 6144 + col0;
        f32x4 gv[2][2];
#pragma unroll
        for (int bj = 0; bj < 2; ++bj)
#pragma unroll
            for (int n = 0; n < 2; ++n) gv[bj][n] = *(const f32x4*)(gp + bj * HALF + 4 * n);
#pragma unroll
        for (int ai = 0; ai < 2; ++ai)
#pragma unroll
            for (int m = 0; m < 4; ++m) { const size_t off = (size_t)(row0 + ai * HALF + m * 16) * DM + col0;
#pragma unroll
                for (int bj = 0; bj < 2; ++bj)
#pragma unroll
                    for (int n = 0; n < 2; ++n) { const f32x4 xv = *(const f32x4*)(xs + off + bj * HALF + 4 * n);
                        *(f32x4*)(xd + off + bj * HALF + 4 * n) = xv + gv[bj][n] * acc[ai][bj][m][n]; } }
    }
};
template <class Epi, class Sched, bool ALIGN_EPI = false, bool SP2 = false>
__device__ __forceinline__ void gemm_phase(PG8_LAS unsigned char* lds, const Gemm g, const Sched& S, const Epi& E) {
    int tid_ = threadIdx.x; asm volatile("" : "+v"(tid_)); const int tid = tid_, wid = __builtin_amdgcn_readfirstlane(tid >> 6), lane = tid & 63, wr = wid >> 2, wc = wid & 3, fr = lane & 15, fq = lane >> 4;
    const int K = g.K, nt = K / BK;
    unsigned voffA[2], voffB[2];
#pragma unroll
    for (int i = 0; i < 2; ++i) { int R, C; stage_rc(tid * 16 + i * 8192, R, C); const int Rb = Epi::PERM ? ((R & ~31) + perm32(R & 31)) : R;
        voffA[i] = (unsigned)(R * K + C) * 2u; voffB[i] = (unsigned)(Rb * K + C) * 2u; }
    const size_t kstep = (size_t)(BK * 2);
    const size_t hstep = (size_t)HALF * K * 2;
    const size_t tstep = 2 * hstep;
    const unsigned ldsw = (unsigned)wid * 1024u;
    const int aoff = lds_byte(wr * 64 + fr, fq * 8), boff = lds_byte(wc * 32 + fr, fq * 8);
#define PG8_SA(b, h) (((b) * 2 + (h)) * HTB)
#define PG8_SB(b, h) ((4 + (b) * 2 + (h)) * HTB)
#define PG8_STAGE(bufoff, gbase, voff) do { _Pragma("unroll") for (int _i = 0; _i < 2; ++_i) \
        __builtin_amdgcn_global_load_lds((const unsigned*)((const char*)(gbase) + (voff)[_i]), (PG8_LAS unsigned*)(lds + (bufoff) + ldsw + _i * 8192), 16, 0, 0); } while (0)
#define PG8_LDA(dst, b, h) do { _Pragma("unroll") for (int m = 0; m < 4; ++m) _Pragma("unroll") for (int k = 0; k < 2; ++k) dst[m][k] = *(const PG8_LAS bf16x8*)(lds + PG8_SA(b, h) + aoff + m * 2048 + k * 1024); } while (0)
#define PG8_LDB(dst, b, h) do { _Pragma("unroll") for (int n = 0; n < 2; ++n) _Pragma("unroll") for (int k = 0; k < 2; ++k) dst[n][k] = *(const PG8_LAS bf16x8*)(lds + PG8_SB(b, h) + boff + n * 2048 + k * 1024); } while (0)
#define PG8_MMA(ai, bj, At, Bt) do { __builtin_amdgcn_s_setprio(1); _Pragma("unroll") for (int m = 0; m < 4; ++m) _Pragma("unroll") for (int n = 0; n < 2; ++n) _Pragma("unroll") for (int k = 0; k < 2; ++k) \
        acc[ai][bj][m][n] = __builtin_amdgcn_mfma_f32_16x16x32_bf16(Bt[n][k], At[m][k], acc[ai][bj][m][n], 0, 0, 0); __builtin_amdgcn_s_setprio(0); } while (0)
#define PG8_WAIT_V(n) asm volatile("s_waitcnt vmcnt(" #n ")" ::: "memory")
#define PG8_WAIT_L(n) asm volatile("s_waitcnt lgkmcnt(" #n ")" ::: "memory")
#define PG8_BAR __builtin_amdgcn_s_barrier()
#define PG8_SCHED __builtin_amdgcn_sched_barrier(0)
    Unit cur, nxt; int ui = 0;
    if (!S.next(0, cur)) return;
    f32x4 acc[2][2][4][2];
#pragma unroll
    for (int a = 0; a < 2; ++a)
#pragma unroll
        for (int b = 0; b < 2; ++b)
#pragma unroll
            for (int m = 0; m < 4; ++m)
#pragma unroll
                for (int n = 0; n < 2; ++n) acc[a][b][m][n] = (f32x4){0.f, 0.f, 0.f, 0.f};
    bf16x8 At[4][2], B0[2][2], B1[2][2];
    const char* cA = (const char*)g.A + (size_t)cur.pm * tstep; const char* cB = (const char*)g.Bt + (size_t)cur.pn * tstep;
    S.a_ready(cur);
    if constexpr (SP2) {
        PG8_STAGE(PG8_SB(0, 0), cB, voffB); PG8_STAGE(PG8_SB(0, 1), cB + hstep, voffB); PG8_STAGE(PG8_SA(0, 0), cA, voffA); PG8_STAGE(PG8_SA(0, 1), cA + hstep, voffA);
        if (wr == 1) PG8_BAR;
        PG8_WAIT_V(2); PG8_BAR;
        PG8_STAGE(PG8_SB(1, 0), cB + kstep, voffB); PG8_STAGE(PG8_SA(1, 0), cA + kstep, voffA); PG8_STAGE(PG8_SB(1, 1), cB + hstep + kstep, voffB);
        PG8_WAIT_V(6); PG8_BAR;
    } else {
        PG8_STAGE(PG8_SB(0, 0), cB, voffB); PG8_STAGE(PG8_SA(0, 0), cA, voffA); PG8_STAGE(PG8_SB(0, 1), cB + hstep, voffB); PG8_STAGE(PG8_SA(0, 1), cA + hstep, voffA);
        if (wr == 1) PG8_BAR;
        PG8_WAIT_V(4); PG8_BAR;
        PG8_STAGE(PG8_SB(1, 0), cB + kstep, voffB); PG8_STAGE(PG8_SA(1, 0), cA + kstep, voffA); PG8_STAGE(PG8_SB(1, 1), cB + hstep + kstep, voffB);
        PG8_WAIT_V(6); PG8_BAR;
    }
    for (;;) {
        const bool has_next = S.next(ui + 1, nxt);
        const char* nA = has_next ? (const char*)g.A + (size_t)nxt.pm * tstep : cA; const char* nB = has_next ? (const char*)g.Bt + (size_t)nxt.pn * tstep : cB;
        for (int t = 0; t < nt; t += 2) {
            const bool last = (t == nt - 2);
            const char* a1 = cA + (size_t)(t + 1) * kstep;
            const char* a2 = last ? nA : cA + (size_t)(t + 2) * kstep; const char* b2 = last ? nB : cB + (size_t)(t + 2) * kstep;
            const char* a3 = a2 + kstep; const char* b3 = b2 + kstep;
            if (last && has_next) S.a_ready(nxt);
            if constexpr (SP2) {
            PG8_LDB(B0, 0, 0); PG8_LDB(B1, 0, 1); PG8_SCHED; PG8_LDA(At, 0, 0); PG8_STAGE(PG8_SA(1, 1), a1 + hstep, voffA);
            PG8_WAIT_V(8); PG8_WAIT_L(0); PG8_BAR; PG8_MMA(0, 0, At, B0); PG8_MMA(0, 1, At, B1); PG8_BAR; PG8_SCHED;
            PG8_LDA(At, 0, 1); PG8_STAGE(PG8_SB(0, 0), b2, voffB); PG8_STAGE(PG8_SB(0, 1), b2 + hstep, voffB); PG8_STAGE(PG8_SA(0, 0), a2, voffA);
            PG8_WAIT_V(8); PG8_WAIT_L(0); PG8_BAR; PG8_MMA(1, 0, At, B0); PG8_MMA(1, 1, At, B1); PG8_BAR; PG8_SCHED;
            PG8_LDB(B0, 1, 0); PG8_LDB(B1, 1, 1); PG8_SCHED; PG8_LDA(At, 1, 0); PG8_STAGE(PG8_SA(0, 1), a2 + hstep, voffA);
            PG8_WAIT_V(8); PG8_WAIT_L(0); PG8_BAR; PG8_MMA(0, 0, At, B0); PG8_MMA(0, 1, At, B1); PG8_BAR; PG8_SCHED;
            PG8_LDA(At, 1, 1); PG8_STAGE(PG8_SB(1, 0), b3, voffB); PG8_STAGE(PG8_SB(1, 1), b3 + hstep, voffB); PG8_STAGE(PG8_SA(1, 0), a3, voffA);
            PG8_WAIT_V(8); PG8_WAIT_L(0); PG8_BAR; PG8_MMA(1, 0, At, B0); PG8_MMA(1, 1, At, B1); PG8_BAR; PG8_SCHED;
            } else {
            PG8_LDB(B0, 0, 0); PG8_SCHED; PG8_LDA(At, 0, 0); PG8_STAGE(PG8_SA(1, 1), a1 + hstep, voffA);
            PG8_WAIT_L(8); PG8_BAR; PG8_WAIT_L(0); PG8_MMA(0, 0, At, B0); PG8_BAR; PG8_SCHED;
            PG8_LDB(B1, 0, 1); PG8_STAGE(PG8_SB(0, 0), b2, voffB);
            PG8_BAR; PG8_WAIT_L(0); PG8_MMA(0, 1, At, B1); PG8_BAR;
            PG8_LDA(At, 0, 1); PG8_STAGE(PG8_SA(0, 0), a2, voffA);
            PG8_BAR; PG8_WAIT_L(0); PG8_MMA(1, 0, At, B0); PG8_BAR; PG8_SCHED;
            PG8_STAGE(PG8_SB(0, 1), b2 + hstep, voffB);
            PG8_WAIT_V(6); PG8_BAR; PG8_MMA(1, 1, At, B1); PG8_BAR;
            PG8_LDB(B0, 1, 0); PG8_SCHED; PG8_LDA(At, 1, 0); PG8_STAGE(PG8_SA(0, 1), a2 + hstep, voffA);
            PG8_WAIT_L(8); PG8_BAR; PG8_WAIT_L(0); PG8_MMA(0, 0, At, B0); PG8_BAR; PG8_SCHED;
            PG8_LDB(B1, 1, 1); PG8_STAGE(PG8_SB(1, 0), b3, voffB);
            PG8_BAR; PG8_WAIT_L(0); PG8_MMA(0, 1, At, B1); PG8_BAR;
            PG8_LDA(At, 1, 1); PG8_STAGE(PG8_SA(1, 0), a3, voffA);
            PG8_BAR; PG8_WAIT_L(0); PG8_MMA(1, 0, At, B0); PG8_BAR; PG8_SCHED;
            PG8_STAGE(PG8_SB(1, 1), b3 + hstep, voffB);
            PG8_WAIT_V(6); PG8_BAR; PG8_MMA(1, 1, At, B1); PG8_BAR;
            }
        }
        if constexpr (ALIGN_EPI) { if (wr == 0) PG8_BAR; }
        if constexpr (!Epi::AFTER_DRAIN) { E(acc, cur, wr, wc, fr, fq); S.done(cur); }
        if (!has_next) break;
#pragma unroll
        for (int a = 0; a < 2; ++a)
#pragma unroll
            for (int b = 0; b < 2; ++b)
#pragma unroll
                for (int m = 0; m < 4; ++m)
#pragma unroll
                    for (int n = 0; n < 2; ++n) acc[a][b][m][n] = (f32x4){0.f, 0.f, 0.f, 0.f};
        cur = nxt; cA = nA; cB = nB; ++ui;
        if constexpr (ALIGN_EPI) { if (wr == 1) PG8_BAR; }
    }
    PG8_WAIT_V(0);
    if constexpr (!ALIGN_EPI) { if (wr == 0) PG8_BAR; }
    PG8_BAR;
    if constexpr (Epi::AFTER_DRAIN) { E.fused(acc, cur, wr, wc, fr, fq, lds, wid, lane); S.done(cur); }
#undef PG8_SA
#undef PG8_SB
#undef PG8_STAGE
#undef PG8_LDA
#undef PG8_LDB
#undef PG8_MMA
#undef PG8_WAIT_V
#undef PG8_WAIT_L
#undef PG8_BAR
#undef PG8_SCHED
}
}

__device__ __forceinline__ int ltid() { int t = threadIdx.x; asm volatile("" : "+v"(t)); return t; }
#define TID ltid()

__device__ __forceinline__ void cvt_kind(const float* __restrict__ src, bf16_t* __restrict__ dst, int K, int N, int Npad, LAS float* tl) {
    const int tid = TID, nk = K / 64, nn = Npad / 64, per = nk * nn, total = DEPTH * per;
    for (int t = blockIdx.x; t < total; t += gridDim.x) {
        const int l = t / per, r = t % per, kt = r / nn, nt = r % nn;
        const float* s = src + (size_t)l * K * N; bf16_t* d = dst + (size_t)l * Npad * K;
#pragma unroll
        for (int i = 0; i < 2; ++i) { const int kr = (tid >> 4) + 32 * i, nc = (tid & 15) * 4, n = nt * 64 + nc;
            f32x4 v = (f32x4){0.f, 0.f, 0.f, 0.f};
            if (n < N) v = *(const f32x4*)(s + (size_t)(kt * 64 + kr) * N + n);
            tl[kr * 65 + nc + 0] = v[0]; tl[kr * 65 + nc + 1] = v[1]; tl[kr * 65 + nc + 2] = v[2]; tl[kr * 65 + nc + 3] = v[3]; }
        __syncthreads();
        { const int n = tid >> 3, k8 = (tid & 7) * 8; u32x4 w;
            w.x = cvt_pk_bf16(tl[(k8 + 0) * 65 + n], tl[(k8 + 1) * 65 + n]); w.y = cvt_pk_bf16(tl[(k8 + 2) * 65 + n], tl[(k8 + 3) * 65 + n]);
            w.z = cvt_pk_bf16(tl[(k8 + 4) * 65 + n], tl[(k8 + 5) * 65 + n]); w.w = cvt_pk_bf16(tl[(k8 + 6) * 65 + n], tl[(k8 + 7) * 65 + n]);
            *(u32x4*)(d + (size_t)(nt * 64 + n) * K + kt * 64 + k8) = w; }
        __syncthreads();
    }
}

__device__ __forceinline__ void mod_phase(const Params& p, LAS float* sm) {
    const int tid = TID;
    LAS float* cact = sm; LAS float* red = sm + 8192;
    for (int i = tid; i < NB * DM; i += NTHREADS) cact[i] = siluf_(p.c[i]);
    __syncthreads();
    float* MOD = (float*)(p.ws + WS_MOD);
    for (int it = blockIdx.x; it < DEPTH * 96; it += gridDim.x) {
        const int l = it / 96, j0 = (it % 96) * 64, col = tid & 63, seg = tid >> 6;
        const float* w = p.ada_w + (size_t)l * DM * 6144 + j0 + col;
        float a0 = 0.f, a1 = 0.f, a2 = 0.f, a3 = 0.f, a4 = 0.f, a5 = 0.f, a6 = 0.f, a7 = 0.f;
#pragma unroll 8
        for (int k = seg * 128; k < seg * 128 + 128; ++k) { const float wv = w[(size_t)k * 6144];
            a0 += cact[0 * DM + k] * wv; a1 += cact[1 * DM + k] * wv; a2 += cact[2 * DM + k] * wv; a3 += cact[3 * DM + k] * wv;
            a4 += cact[4 * DM + k] * wv; a5 += cact[5 * DM + k] * wv; a6 += cact[6 * DM + k] * wv; a7 += cact[7 * DM + k] * wv; }
        red[(seg * 8 + 0) * 64 + col] = a0; red[(seg * 8 + 1) * 64 + col] = a1; red[(seg * 8 + 2) * 64 + col] = a2; red[(seg * 8 + 3) * 64 + col] = a3;
        red[(seg * 8 + 4) * 64 + col] = a4; red[(seg * 8 + 5) * 64 + col] = a5; red[(seg * 8 + 6) * 64 + col] = a6; red[(seg * 8 + 7) * 64 + col] = a7;
        __syncthreads();
        { const int b = tid >> 6; float s = p.ada_b[l * 6144 + j0 + col];
#pragma unroll
            for (int sg = 0; sg < 8; ++sg) s += red[(sg * 8 + b) * 64 + col];
            MOD[(size_t)(l * NB + b) * 6144 + j0 + col] = s; }
        __syncthreads();
    }
}

__device__ __forceinline__ void lb_phase(const Params& p) {
    if (blockIdx.x != 0) return;
    const int k = TID; float* LB = (float*)(p.ws + WS_LB);
    const float v0 = p.lb_logits[k], v1 = p.lb_logits[512 + k], v2 = p.lb_logits[1024 + k], v3 = p.lb_logits[1536 + k];
    const float mx = fmaxf(fmaxf(v0, v1), fmaxf(v2, v3));
    const float e0 = expf(v0 - mx), e1 = expf(v1 - mx), e2 = expf(v2 - mx), e3 = expf(v3 - mx), inv = 1.f / (e0 + e1 + e2 + e3);
    const float p0 = e0 * inv, p1 = e1 * inv, p2 = e2 * inv, p3 = e3 * inv;
    LB[k] = p0 - p0; LB[512 + k] = (p0 + p1) - p0; LB[1024 + k] = ((p0 + p1) + p2) - p0; LB[1536 + k] = (((p0 + p1) + p2) + p3) - p0;
}

__device__ __forceinline__ void rmsnorm_mod(const float* __restrict__ xs, const float* __restrict__ w, const float* __restrict__ mod, int sh_off, int sc_off, bf16_t* __restrict__ dst) {
    const int tid = TID, wave = tid >> 6, lane = tid & 63;
    for (int row = blockIdx.x * 8 + wave; row < NTOK; row += gridDim.x * 8) {
        const float* xr = xs + (size_t)row * DM; f32x4 v[4]; float ss = 0.f;
#pragma unroll
        for (int i = 0; i < 4; ++i) { v[i] = *(const f32x4*)(xr + i * 256 + lane * 4); ss += v[i][0] * v[i][0] + v[i][1] * v[i][1] + v[i][2] * v[i][2] + v[i][3] * v[i][3]; }
        ss = wave_sum(ss);
        const float rstd = rsqrtf(ss * (1.f / DM) + EPS);
        const float* mb = mod + (size_t)(row >> 12) * 6144;
#pragma unroll
        for (int i = 0; i < 4; ++i) { const int col = i * 256 + lane * 4;
            const f32x4 ww = *(const f32x4*)(w + col), sc = *(const f32x4*)(mb + sc_off + col), sh = *(const f32x4*)(mb + sh_off + col);
            const f32x4 h = (v[i] * rstd * ww) * (sc + 1.f) + sh;
            u32x2 o; o.x = cvt_pk_bf16(h[0], h[1]); o.y = cvt_pk_bf16(h[2], h[3]);
            *(u32x2*)(dst + (size_t)row * DM + col) = o; }
    }
}
__device__ __forceinline__ void final_norm(float* __restrict__ x, const float* __restrict__ w) {
    const int tid = TID, wave = tid >> 6, lane = tid & 63;
    for (int row = blockIdx.x * 8 + wave; row < NTOK; row += gridDim.x * 8) {
        float* xr = x + (size_t)row * DM; f32x4 v[4]; float ss = 0.f;
#pragma unroll
        for (int i = 0; i < 4; ++i) { v[i] = *(const f32x4*)(xr + i * 256 + lane * 4); ss += v[i][0] * v[i][0] + v[i][1] * v[i][1] + v[i][2] * v[i][2] + v[i][3] * v[i][3]; }
        ss = wave_sum(ss);
        const float rstd = rsqrtf(ss * (1.f / DM) + EPS);
#pragma unroll
        for (int i = 0; i < 4; ++i) { const int col = i * 256 + lane * 4; const f32x4 ww = *(const f32x4*)(w + col); *(f32x4*)(xr + col) = v[i] * rstd * ww; }
    }
}

__device__ __forceinline__ void vt_item(const Params& p, int b, int tt, LAS unsigned char* sm) {
    const int tid = TID; LAS bf16_t* vb = (LAS bf16_t*)sm;
    const bf16_t* proj = (const bf16_t*)(p.ws + WS_BIG) + (size_t)(b * SEQ + tt * 64) * DINP + OFF_SV;
#pragma unroll
    for (int i = 0; i < 4; ++i) { const int idx = tid + NTHREADS * i, row = idx >> 5, c8 = (idx & 31) * 8;
        *(LAS bf16x8*)(vb + row * 264 + c8) = *(const bf16x8*)(proj + (size_t)row * DINP + c8); }
    __syncthreads();
    { const int col = tid >> 1, half = tid & 1;
        bf16_t* dst = (bf16_t*)(p.ws + WS_VT) + ((size_t)(b * 4 + (col >> 6)) * 64 + (col & 63)) * SEQ + tt * 64 + half * 32;
#pragma unroll
        for (int i = 0; i < 4; ++i) { bf16x8 o;
#pragma unroll
            for (int e = 0; e < 8; ++e) o[e] = (short)vb[(half * 32 + i * 8 + e) * 264 + col];
            *(bf16x8*)(dst + i * 8) = o; } }
    __syncthreads();
}

__device__ __forceinline__ void conv_item(const Params& p, int l, int b, int tt, LAS unsigned char* sm) {
    const int tid = TID; LAS float* hb = (LAS float*)sm;
    LAS float* ob = (LAS float*)(sm + 62 * 256 * 4);
    const int t0 = tt * 32;
    const bf16_t* proj = (const bf16_t*)(p.ws + WS_BIG) + (size_t)b * SEQ * DINP + OFF_CU;
#pragma unroll
    for (int i = 0; i < 4; ++i) { const int idx = tid + NTHREADS * i;
        if (idx < 62 * 32) { const int row = idx >> 5, c8 = (idx & 31) * 8, t = t0 - 30 + row;
            f32x4 h0 = (f32x4){0.f, 0.f, 0.f, 0.f}, h1 = h0;
            if (t >= 0) { const bf16x8 a = *(const bf16x8*)(proj + (size_t)t * DINP + c8), g = *(const bf16x8*)(proj + (size_t)t * DINP + 256 + c8);
#pragma unroll
                for (int j = 0; j < 4; ++j) { h0[j] = bf2f(a[j]) * sigmoidf_(bf2f(g[j])); h1[j] = bf2f(a[4 + j]) * sigmoidf_(bf2f(g[4 + j])); } }
            *(LAS f32x4*)(hb + row * 256 + c8) = h0; *(LAS f32x4*)(hb + row * 256 + c8 + 4) = h1; } }
    __syncthreads();
    { const int ch = tid & 255, half = tid >> 8;
        float w[31];
#pragma unroll
        for (int j = 0; j < 31; ++j) w[j] = p.cv_w[(size_t)(l * 31 + j) * 256 + ch];
        const float bias = p.cv_b[l * 256 + ch];
        float o[16];
#pragma unroll
        for (int i = 0; i < 16; ++i) o[i] = bias;
#pragma unroll
        for (int r = 0; r < 46; ++r) { const float hv = hb[(half * 16 + r) * 256 + ch];
#pragma unroll
            for (int i = 0; i < 16; ++i) { const int j = r - i; if (j >= 0 && j <= 30) o[i] = fmaf(hv, w[j], o[i]); } }
#pragma unroll
        for (int i = 0; i < 16; ++i) ob[(half * 16 + i) * 256 + ch] = o[i]; }
    __syncthreads();
    { const int wave = tid >> 6, lane = tid & 63;
        const f32x4 lw = *(const f32x4*)(p.cv_ln_w + l * 256 + lane * 4), lbv = *(const f32x4*)(p.cv_ln_b + l * 256 + lane * 4);
        bf16_t* mix = (bf16_t*)(p.ws + WS_HB);
#pragma unroll
        for (int i = 0; i < 4; ++i) { const int tl = wave * 4 + i;
            const f32x4 xv = *(LAS f32x4*)(ob + tl * 256 + lane * 4);
            const float mu = wave_sum(xv[0] + xv[1] + xv[2] + xv[3]) * (1.f / 256.f);
            const f32x4 dv = xv - mu;
            const float var = wave_sum(dv[0] * dv[0] + dv[1] * dv[1] + dv[2] * dv[2] + dv[3] * dv[3]) * (1.f / 256.f);
            const float rs = rsqrtf(var + EPS);
            const f32x4 y = dv * rs * lw + lbv;
            u32x2 o2; o2.x = cvt_pk_bf16(siluf_(y[0]), siluf_(y[1])); o2.y = cvt_pk_bf16(siluf_(y[2]), siluf_(y[3]));
            *(u32x2*)(mix + (size_t)(b * SEQ + t0 + tl) * DM + 768 + lane * 4) = o2; } }
    __syncthreads();
}

constexpr float IDX_WSCALE = 0.35355339059327373f * 0.17677669529663687f;
__device__ __forceinline__ f32x4 idx_scores(const bf16x8 ka, const bf16x8 (&qi)[8], const float (&wq)[8]) {
    f32x4 s = (f32x4){0.f, 0.f, 0.f, 0.f};
#pragma unroll
    for (int h = 0; h < 8; ++h) { const f32x4 d = mfma16(ka, qi[h], (f32x4){0.f, 0.f, 0.f, 0.f});
#pragma unroll
        for (int r = 0; r < 4; ++r) s[r] = __builtin_fmaf(wq[h], fmaxf(d[r], 0.f), s[r]); }
    return s;
}

__device__ __forceinline__ void cnt_ge(int& cn, unsigned a, unsigned b) { asm("v_cmp_ge_u32 vcc, %1, %2\n\tv_addc_co_u32 %0, vcc, 0, %0, vcc" : "+v"(cn) : "v"(a), "v"(b) : "vcc"); }
__device__ __forceinline__ void thr_item(const Params& p, int b, int qt, LAS unsigned char* sm) {
    const int tid = TID, w = __builtin_amdgcn_readfirstlane(tid >> 6), l = tid & 63, c16 = l & 15, g = l >> 4;
    LAS unsigned* cnt = (LAS unsigned*)sm;
    const bf16_t* proj = (const bf16_t*)(p.ws + WS_BIG) + (size_t)b * SEQ * DINP;
    const int q = qt * 16 + c16;
    const bf16_t* qrow = proj + (size_t)q * DINP;
    bf16x8 qi[8]; float wq[8];
#pragma unroll
    for (int h = 0; h < 8; ++h) qi[h] = *(const bf16x8*)(qrow + OFF_IQ + h * 32 + g * 8);
    { const bf16x8 wv = *(const bf16x8*)(qrow + OFF_IW);
#pragma unroll
        for (int h = 0; h < 8; ++h) wq[h] = bf2f(wv[h]) * IDX_WSCALE; }
    unsigned sc[32][4];
    const int ni = (qt >= w) ? ((qt - w) >> 3) + 1 : 0;
#pragma unroll
    for (int i = 0; i < 32; ++i) {
        if (i < ni) { const int kt = w + 8 * i;
            const bf16x8 ka = *(const bf16x8*)(proj + (size_t)(kt * 16 + c16) * DINP + OFF_IK + g * 8);
            const f32x4 s = idx_scores(ka, qi, wq);
#pragma unroll
            for (int r = 0; r < 4; ++r) { const int key = kt * 16 + 4 * g + r; sc[i][r] = (key <= q) ? sortable(s[r]) : 0u; }
        } else { sc[i][0] = 0u; sc[i][1] = 0u; sc[i][2] = 0u; sc[i][3] = 0u; }
        __builtin_amdgcn_sched_barrier(0);
    }
    unsigned T = 0u; int ngt = 0, nge = 0;
    for (int it = 0; it < 34; ++it) {
        const unsigned cand = (it < 32) ? (T | (1u << (31 - it))) : (it == 32 ? T + 1u : T); int cn = 0;
#pragma unroll
        for (int i = 0; i < 32; ++i) if (i < ni) { cnt_ge(cn, sc[i][0], cand); cnt_ge(cn, sc[i][1], cand); cnt_ge(cn, sc[i][2], cand); cnt_ge(cn, sc[i][3], cand); }
        cn += __shfl_xor(cn, 16); cn += __shfl_xor(cn, 32);
        const int buf = it & 1;
        if (l < 16) cnt[(buf * 8 + w) * 16 + l] = (unsigned)cn;
        __syncthreads();
        int tot = 0;
#pragma unroll
        for (int ww = 0; ww < 8; ++ww) tot += (int)cnt[(buf * 8 + ww) * 16 + c16];
        if (it < 32) { if (tot >= TOPK) T = cand; } else if (it == 32) ngt = tot; else nge = tot;
    }
    const int need = TOPK - ngt, excess = (T != 0u) && (nge - ngt > need);
    unsigned ceq = 4095u;
    if (__syncthreads_or(excess)) {
#pragma unroll
        for (int i = 0; i < 32; ++i)
#pragma unroll
            for (int r = 0; r < 4; ++r) sc[i][r] = (sc[i][r] == T) ? (unsigned)((w + 8 * i) * 16 + 4 * g + r) : 0xffffffffu;
        unsigned c = 0u;
        for (int it = 0; it < 12; ++it) {
            const unsigned cand = c | (1u << (11 - it)); int cn = 0;
#pragma unroll
            for (int i = 0; i < 32; ++i) if (i < ni) { cnt_ge(cn, cand - 1u, sc[i][0]); cnt_ge(cn, cand - 1u, sc[i][1]); cnt_ge(cn, cand - 1u, sc[i][2]); cnt_ge(cn, cand - 1u, sc[i][3]); }
            cn += __shfl_xor(cn, 16); cn += __shfl_xor(cn, 32);
            const int buf = it & 1;
            if (l < 16) cnt[(buf * 8 + w) * 16 + l] = (unsigned)cn;
            __syncthreads();
            int tot = 0;
#pragma unroll
            for (int ww = 0; ww < 8; ++ww) tot += (int)cnt[(buf * 8 + ww) * 16 + c16];
            if (tot < need) c = cand;
        }
        if (excess) ceq = c;
    }
    if (w == 0 && l < 16) { ((unsigned*)(p.ws + WS_THRT))[b * SEQ + q] = T; ((unsigned*)(p.ws + WS_THRC))[b * SEQ + q] = ceq; }
    __syncthreads();
}

__device__ __forceinline__ void attn_item(const Params& p, int b, int qb) {
    const int tid = TID, w = __builtin_amdgcn_readfirstlane(tid >> 6), l = tid & 63, c16 = l & 15, g = l >> 4, qs = w & 3, hp = w >> 2;
    const bf16_t* proj = (const bf16_t*)(p.ws + WS_BIG) + (size_t)b * SEQ * DINP;
    const bf16_t* vt = (const bf16_t*)(p.ws + WS_VT) + (size_t)b * 4 * 64 * SEQ;
    const int q = qb * 64 + qs * 16 + c16;
    const bf16_t* qrow = proj + (size_t)q * DINP;
    bf16x8 qi[8]; float wq[8];
#pragma unroll
    for (int h = 0; h < 8; ++h) qi[h] = *(const bf16x8*)(qrow + OFF_IQ + h * 32 + g * 8);
    { const bf16x8 wv = *(const bf16x8*)(qrow + OFF_IW);
#pragma unroll
        for (int h = 0; h < 8; ++h) wq[h] = bf2f(wv[h]) * IDX_WSCALE; }
    const unsigned T = ((const unsigned*)(p.ws + WS_THRT))[b * SEQ + q], CE = ((const unsigned*)(p.ws + WS_THRC))[b * SEQ + q];
    bf16x8 Qb[2][2];
#pragma unroll
    for (int hh = 0; hh < 2; ++hh)
#pragma unroll
        for (int kk = 0; kk < 2; ++kk) { const bf16x8 raw = *(const bf16x8*)(qrow + OFF_SQ + (2 * hp + hh) * 64 + kk * 32 + g * 8); bf16x8 o;
#pragma unroll
            for (int e = 0; e < 8; ++e) o[e] = (short)f2bf(bf2f(raw[e]) * 0.125f);
            Qb[hh][kk] = o; }
    f32x4 O[2][4];
#pragma unroll
    for (int hh = 0; hh < 2; ++hh)
#pragma unroll
        for (int dt = 0; dt < 4; ++dt) O[hh][dt] = (f32x4){0.f, 0.f, 0.f, 0.f};
    float mrun[2] = {-1e30f, -1e30f}, lrun[2] = {0.f, 0.f};
    const int ntile = (qb * 64 + qs * 16 + 15) / 32 + 1;
    for (int t = 0; t < ntile; ++t) {
        const int k0 = t * 32;
        bool sel[2][4]; float lg[2][2][4];
#pragma unroll
        for (int s = 0; s < 2; ++s) {
            const int keyA = k0 + 8 * (c16 >> 2) + 4 * s + (c16 & 3);
            const bf16_t* krow = proj + (size_t)keyA * DINP;
            const bf16x8 ka = *(const bf16x8*)(krow + OFF_IK + g * 8);
            const f32x4 sv = idx_scores(ka, qi, wq);
#pragma unroll
            for (int r = 0; r < 4; ++r) { const int key = k0 + 8 * g + 4 * s + r; const unsigned u = sortable(sv[r]);
                sel[s][r] = (key <= q) && (u > T || (u == T && (unsigned)key <= CE)); }
#pragma unroll
            for (int hh = 0; hh < 2; ++hh) { f32x4 S = (f32x4){0.f, 0.f, 0.f, 0.f};
#pragma unroll
                for (int kk = 0; kk < 2; ++kk) { const bf16x8 kf = *(const bf16x8*)(krow + OFF_SK + (2 * hp + hh) * 64 + kk * 32 + g * 8); S = mfma16(kf, Qb[hh][kk], S); }
#pragma unroll
                for (int r = 0; r < 4; ++r) lg[hh][s][r] = S[r]; }
        }
#pragma unroll
        for (int hh = 0; hh < 2; ++hh) {
            float mx = -1e30f;
#pragma unroll
            for (int s = 0; s < 2; ++s)
#pragma unroll
                for (int r = 0; r < 4; ++r) mx = sel[s][r] ? fmaxf(mx, lg[hh][s][r]) : mx;
            mx = fmaxf(mx, __shfl_xor(mx, 16)); mx = fmaxf(mx, __shfl_xor(mx, 32));
            const float mn = fmaxf(mrun[hh], mx), alpha = __expf(mrun[hh] - mn);
            mrun[hh] = mn;
            float pv[8]; float ps = 0.f;
#pragma unroll
            for (int s = 0; s < 2; ++s)
#pragma unroll
                for (int r = 0; r < 4; ++r) { const float e = sel[s][r] ? __expf(lg[hh][s][r] - mn) : 0.f; pv[s * 4 + r] = e; ps += e; }
            lrun[hh] = lrun[hh] * alpha + ps;
            union { bf16x8 v; unsigned u[4]; } pb;
            pb.u[0] = cvt_pk_bf16(pv[0], pv[1]); pb.u[1] = cvt_pk_bf16(pv[2], pv[3]); pb.u[2] = cvt_pk_bf16(pv[4], pv[5]); pb.u[3] = cvt_pk_bf16(pv[6], pv[7]);
#pragma unroll
            for (int dt = 0; dt < 4; ++dt) {
                const bf16x8 va = *(const bf16x8*)(vt + (size_t)((2 * hp + hh) * 64 + dt * 16 + c16) * SEQ + k0 + g * 8);
                O[hh][dt] = mfma16(va, pb.v, O[hh][dt] * alpha); }
        }
    }
    bf16_t* mix = (bf16_t*)(p.ws + WS_HB) + (size_t)(b * SEQ + q) * DM + 512;
#pragma unroll
    for (int hh = 0; hh < 2; ++hh) { float tot = lrun[hh]; tot += __shfl_xor(tot, 16); tot += __shfl_xor(tot, 32);
        const float inv = 1.f / tot;
#pragma unroll
        for (int dt = 0; dt < 4; ++dt) { const f32x4 o = O[hh][dt] * inv; u32x2 o2; o2.x = cvt_pk_bf16(o[0], o[1]); o2.y = cvt_pk_bf16(o[2], o[3]);
            *(u32x2*)(mix + (2 * hp + hh) * 64 + dt * 16 + 4 * g) = o2; } }
}

__device__ __forceinline__ void hgrn_G(const bf16_t* prow0, const float* lb, int h, LAS float* Gs, LAS float* segtot) {
    const int tid = TID;
#pragma unroll
    for (int i = 0; i < 2; ++i) { const int row = (tid >> 4) + 32 * i, c8 = (tid & 15) * 8;
        const bf16x8 v = *(const bf16x8*)(prow0 + (size_t)row * DINP + OFF_HF + h * 128 + c8);
#pragma unroll
        for (int j = 0; j < 8; ++j) { const float fr = bf2f(v[j]), lbv = lb[c8 + j]; const float f = lbv + (1.f - lbv) * sigmoidf_(fr);
            Gs[row * 129 + c8 + j] = __logf(fmaxf(f, 1e-30f)); } }
    __syncthreads();
    const int col = tid & 127, seg = tid >> 7;
    { float run = 0.f;
#pragma unroll
        for (int r = 0; r < 16; ++r) { const int idx = (seg * 16 + r) * 129 + col; run += Gs[idx]; Gs[idx] = run; }
        segtot[seg * 128 + col] = run; }
    __syncthreads();
    { float off = 0.f;
#pragma unroll
        for (int s = 0; s < 3; ++s) if (s < seg) off += segtot[s * 128 + col];
        if (seg > 0) {
#pragma unroll
            for (int r = 0; r < 16; ++r) Gs[(seg * 16 + r) * 129 + col] += off; } }
    __syncthreads();
}

__device__ __forceinline__ void hgrn_local_item(const Params& p, int l, int b, int h, int c, LAS unsigned char* sm) {
    const int tid = TID, w = __builtin_amdgcn_readfirstlane(tid >> 6), ln = tid & 63, c16 = ln & 15, g = ln >> 4;
    LAS float* Gs = (LAS float*)sm; LAS float* segtot = (LAS float*)(sm + 33024);
    LAS bf16_t* KgT = (LAS bf16_t*)(sm + 35072); LAS bf16_t* vT = (LAS bf16_t*)(sm + 53504);
    const bf16_t* prow0 = (const bf16_t*)(p.ws + WS_BIG) + (size_t)(b * SEQ + c * 64) * DINP;
    const float* lb = (const float*)(p.ws + WS_LB) + l * 512 + h * 128;
    hgrn_G(prow0, lb, h, Gs, segtot);
    { const int j = tid & 63, kg = tid >> 6;
        const bf16_t* rp = prow0 + (size_t)j * DINP + h * 128 + kg * 16;
        const bf16x8 f0 = *(const bf16x8*)(rp + OFF_HF), f1 = *(const bf16x8*)(rp + OFF_HF + 8), v0 = *(const bf16x8*)(rp + OFF_HI), v1 = *(const bf16x8*)(rp + OFF_HI + 8);
#pragma unroll
        for (int e = 0; e < 16; ++e) { const int k = kg * 16 + e; const float fr = bf2f(e < 8 ? f0[e & 7] : f1[e & 7]), lbv = lb[k];
            const float kval = (1.f - lbv) * sigmoidf_(-fr);
            KgT[k * 72 + j] = f2bf(kval * __expf(Gs[63 * 129 + k] - Gs[j * 129 + k]));
            vT[k * 72 + j] = (bf16_t)(e < 8 ? v0[e & 7] : v1[e & 7]); } }
    const size_t bhc = (size_t)((b * 4 + h) * 64 + c);
    if (tid < 128) ((float*)(p.ws + WS_DEC))[bhc * 128 + tid] = __expf(Gs[63 * 129 + tid]);
    __syncthreads();
    f32x4 acc[8];
#pragma unroll
    for (int vt = 0; vt < 8; ++vt) acc[vt] = (f32x4){0.f, 0.f, 0.f, 0.f};
#pragma unroll
    for (int kk = 0; kk < 2; ++kk) { const bf16x8 a = *(LAS bf16x8*)(KgT + (w * 16 + c16) * 72 + kk * 32 + g * 8);
#pragma unroll
        for (int vt = 0; vt < 8; ++vt) { const bf16x8 bb = *(LAS bf16x8*)(vT + (vt * 16 + c16) * 72 + kk * 32 + g * 8); acc[vt] = mfma16(a, bb, acc[vt]); } }
    bf16_t* st = (bf16_t*)(p.ws + WS_ST) + bhc * 16384;
#pragma unroll
    for (int vt = 0; vt < 8; ++vt) { u32x2 o; o.x = cvt_pk_bf16(acc[vt][0], acc[vt][1]); o.y = cvt_pk_bf16(acc[vt][2], acc[vt][3]);
        *(u32x2*)(st + (size_t)(vt * 16 + c16) * 128 + w * 16 + 4 * g) = o; }
    __syncthreads();
}

__device__ __forceinline__ void hgrn_scan(const Params& p) {
    bf16_t* ST = (bf16_t*)(p.ws + WS_ST); const float* DEC = (const float*)(p.ws + WS_DEC);
    for (int e = blockIdx.x * NTHREADS + TID; e < 32 * 4096; e += gridDim.x * NTHREADS) {
        const int bh = e >> 12, idx4 = (e & 4095) * 4, k = idx4 & 127;
        bf16_t* base = ST + (size_t)bh * 64 * 16384 + idx4; const float* dec = DEC + (size_t)bh * 64 * 128 + k;
        f32x4 S = (f32x4){0.f, 0.f, 0.f, 0.f};
#pragma unroll 8
        for (int c = 0; c < 64; ++c) { const u32x2 loc = *(const u32x2*)(base + (size_t)c * 16384); const f32x4 d = *(const f32x4*)(dec + c * 128);
            u32x2 o; o.x = cvt_pk_bf16(S[0], S[1]); o.y = cvt_pk_bf16(S[2], S[3]);
            *(u32x2*)(base + (size_t)c * 16384) = o;
            S[0] = d[0] * S[0] + bflo(loc.x); S[1] = d[1] * S[1] + bfhi(loc.x); S[2] = d[2] * S[2] + bflo(loc.y); S[3] = d[3] * S[3] + bfhi(loc.y); }
    }
}

__device__ __forceinline__ void hgrn_out_item(const Params& p, int l, int b, int h, int c, LAS unsigned char* sm) {
    const int tid = TID, w = __builtin_amdgcn_readfirstlane(tid >> 6), ln = tid & 63, c16 = ln & 15, g = ln >> 4;
    LAS float* Gs = (LAS float*)sm; LAS float* segtot = (LAS float*)(sm + 33024);
    LAS bf16_t* qt_ = (LAS bf16_t*)(sm + 35072); LAS bf16_t* kt_ = (LAS bf16_t*)(sm + 52480); LAS bf16_t* qg_ = (LAS bf16_t*)(sm + 69888);
    LAS bf16_t* vT = (LAS bf16_t*)(sm + 87296); LAS bf16_t* Am = (LAS bf16_t*)(sm + 105728); LAS float* ssq = (LAS float*)(sm + 114944);
    const bf16_t* prow0 = (const bf16_t*)(p.ws + WS_BIG) + (size_t)(b * SEQ + c * 64) * DINP;
    const float* lb = (const float*)(p.ws + WS_LB) + l * 512 + h * 128;
    hgrn_G(prow0, lb, h, Gs, segtot);
#pragma unroll
    for (int i = 0; i < 2; ++i) { const int row = (tid >> 4) + 32 * i, c8 = (tid & 15) * 8;
        const bf16_t* rp = prow0 + (size_t)row * DINP + h * 128 + c8;
        const bf16x8 qv8 = *(const bf16x8*)(rp + OFF_HQ), fv8 = *(const bf16x8*)(rp + OFF_HF);
        float a[8], bq[8], cq[8];
#pragma unroll
        for (int j = 0; j < 8; ++j) { const int k = c8 + j; const float G = Gs[row * 129 + k], Gm = Gs[31 * 129 + k], lbv = lb[k];
            const float qv = siluf_(bf2f(qv8[j])) * 0.08838834764831845f, kval = (1.f - lbv) * sigmoidf_(-bf2f(fv8[j]));
            a[j] = qv * __expf(fminf(G - Gm, 80.f)); bq[j] = kval * __expf(fminf(Gm - G, 80.f)); cq[j] = qv * __expf(G); }
        u32x4 o;
        o.x = cvt_pk_bf16(a[0], a[1]); o.y = cvt_pk_bf16(a[2], a[3]); o.z = cvt_pk_bf16(a[4], a[5]); o.w = cvt_pk_bf16(a[6], a[7]); *(LAS u32x4*)(qt_ + row * 136 + c8) = o;
        o.x = cvt_pk_bf16(bq[0], bq[1]); o.y = cvt_pk_bf16(bq[2], bq[3]); o.z = cvt_pk_bf16(bq[4], bq[5]); o.w = cvt_pk_bf16(bq[6], bq[7]); *(LAS u32x4*)(kt_ + row * 136 + c8) = o;
        o.x = cvt_pk_bf16(cq[0], cq[1]); o.y = cvt_pk_bf16(cq[2], cq[3]); o.z = cvt_pk_bf16(cq[4], cq[5]); o.w = cvt_pk_bf16(cq[6], cq[7]); *(LAS u32x4*)(qg_ + row * 136 + c8) = o; }
    { const int j = tid & 63, kg = tid >> 6;
        const bf16_t* rp = prow0 + (size_t)j * DINP + OFF_HI + h * 128 + kg * 16;
        const bf16x8 v0 = *(const bf16x8*)(rp), v1 = *(const bf16x8*)(rp + 8);
#pragma unroll
        for (int e = 0; e < 16; ++e) vT[(kg * 16 + e) * 72 + j] = (bf16_t)(e < 8 ? v0[e & 7] : v1[e & 7]); }
    __syncthreads();
#pragma unroll
    for (int s = 0; s < 2; ++s) { const int tI = w * 2 + s, itile = tI >> 2, jt = tI & 3;
        f32x4 d = (f32x4){0.f, 0.f, 0.f, 0.f};
        if (jt <= itile) {
#pragma unroll
            for (int kk = 0; kk < 4; ++kk) { const bf16x8 a = *(LAS bf16x8*)(kt_ + (jt * 16 + c16) * 136 + kk * 32 + g * 8), bb = *(LAS bf16x8*)(qt_ + (itile * 16 + c16) * 136 + kk * 32 + g * 8);
                d = mfma16(a, bb, d); } }
        const int i = itile * 16 + c16, j0 = jt * 16 + 4 * g;
        u32x2 o; o.x = cvt_pk_bf16((j0 + 0 <= i) ? d[0] : 0.f, (j0 + 1 <= i) ? d[1] : 0.f); o.y = cvt_pk_bf16((j0 + 2 <= i) ? d[2] : 0.f, (j0 + 3 <= i) ? d[3] : 0.f);
        *(LAS u32x2*)(Am + i * 72 + j0) = o; }
    __syncthreads();
    const int itile = w & 3, vh = w >> 2;
    const size_t bhc = (size_t)((b * 4 + h) * 64 + c);
    const bf16_t* st = (const bf16_t*)(p.ws + WS_ST) + bhc * 16384;
    f32x4 acc[4];
#pragma unroll
    for (int vt = 0; vt < 4; ++vt) acc[vt] = (f32x4){0.f, 0.f, 0.f, 0.f};
#pragma unroll
    for (int kk = 0; kk < 2; ++kk) { const bf16x8 bb = *(LAS bf16x8*)(Am + (itile * 16 + c16) * 72 + kk * 32 + g * 8);
#pragma unroll
        for (int vt = 0; vt < 4; ++vt) { const bf16x8 a = *(LAS bf16x8*)(vT + ((vh * 4 + vt) * 16 + c16) * 72 + kk * 32 + g * 8); acc[vt] = mfma16(a, bb, acc[vt]); } }
#pragma unroll
    for (int kk = 0; kk < 4; ++kk) { const bf16x8 bb = *(LAS bf16x8*)(qg_ + (itile * 16 + c16) * 136 + kk * 32 + g * 8);
#pragma unroll
        for (int vt = 0; vt < 4; ++vt) { const bf16x8 a = *(const bf16x8*)(st + (size_t)((vh * 4 + vt) * 16 + c16) * 128 + kk * 32 + g * 8); acc[vt] = mfma16(a, bb, acc[vt]); } }
    float ss = 0.f;
#pragma unroll
    for (int vt = 0; vt < 4; ++vt) ss += acc[vt][0] * acc[vt][0] + acc[vt][1] * acc[vt][1] + acc[vt][2] * acc[vt][2] + acc[vt][3] * acc[vt][3];
    ss += __shfl_xor(ss, 16); ss += __shfl_xor(ss, 32);
    const int i = itile * 16 + c16;
    if (g == 0) ssq[vh * 64 + i] = ss;
    __syncthreads();
    const float rstd = rsqrtf((ssq[i] + ssq[64 + i]) * (1.f / 128.f) + EPS);
    bf16_t* mix = (bf16_t*)(p.ws + WS_HB) + (size_t)(b * SEQ + c * 64 + i) * DM + h * 128;
    const bf16_t* grow = prow0 + (size_t)i * DINP + OFF_HG + h * 128;
#pragma unroll
    for (int vt = 0; vt < 4; ++vt) { const int v0 = (vh * 4 + vt) * 16 + 4 * g;
        const u32x2 gr = *(const u32x2*)(grow + v0); const f32x4 ow = *(const f32x4*)(p.onorm_w + l * 512 + h * 128 + v0);
        const float r0 = acc[vt][0] * rstd * ow[0] * siluf_(bflo(gr.x)), r1 = acc[vt][1] * rstd * ow[1] * siluf_(bfhi(gr.x));
        const float r2 = acc[vt][2] * rstd * ow[2] * siluf_(bflo(gr.y)), r3 = acc[vt][3] * rstd * ow[3] * siluf_(bfhi(gr.y));
        u32x2 o; o.x = cvt_pk_bf16(r0, r1); o.y = cvt_pk_bf16(r2, r3);
        *(u32x2*)(mix + v0) = o; }
    __syncthreads();
}


#ifdef DIAG_CUT
__device__ __forceinline__ void diag_phase(const Params& p) {
    const int tid = TID, wave = tid >> 6, lane = tid & 63;
    const bf16_t* HB = (const bf16_t*)(p.ws + WS_HB); const bf16_t* ST = (const bf16_t*)(p.ws + WS_ST); const float* DEC = (const float*)(p.ws + WS_DEC);
    const bf16_t* BIG = (const bf16_t*)(p.ws + WS_BIG);
    for (int row = blockIdx.x * 8 + wave; row < NTOK; row += gridDim.x * 8) {
        float* orow = p.out + (size_t)row * DM;
        for (int i = 0; i < 16; ++i) { const int col = i * 64 + lane; float v = 0.f;
#if DIAG_MODE == 1
            for (int t = 0; t < 3; ++t) v += bf2f((short)BIG[(size_t)row * DINP + col + 1024 * t]);
            if (col < 768) v += bf2f((short)BIG[(size_t)row * DINP + 3072 + col]);
#elif DIAG_MODE == 2
            v = bf2f((short)ST[(size_t)row * 1024 + col]) + DEC[((size_t)row * 8 + (col & 7)) % (32 * 64 * 128)];
#elif DIAG_MODE == 5
            v = DEC[((size_t)row * 8 + (col & 7)) % (32 * 64 * 128)];
#elif DIAG_MODE == 6
            v = bf2f((short)ST[(size_t)row * 1024 + col]);
#elif DIAG_MODE == 4
            v = bf2f((short)HB[(size_t)row * DM + col]);
#endif
            if (!(fabsf(v) < 1e30f)) v = 12345.f;
            orow[col] = v; }
    }
}
#endif
template <class Epi>
__device__ __forceinline__ void run_gemm(LAS unsigned char* lds, const bf16_t* A, const bf16_t* Bt, int M, int N, int K, const Epi& E) {
    pg8::Gemm g; g.A = A; g.Bt = Bt; g.M = M; g.N = N; g.K = K;
    pg8::StaticOrder S; S.init(M, N, (int)gridDim.x, (int)blockIdx.x);
    pg8::gemm_phase<Epi, pg8::StaticOrder, true, true>(lds, g, S, E);
}

constexpr int NPHASE = 2 + 9 * DEPTH;

__global__ void __launch_bounds__(NTHREADS, 2) fwd_megakernel(Params pin) {
    extern __shared__ __attribute__((aligned(16))) unsigned char lds_raw[];
    LAS unsigned char* lds = (LAS unsigned char*)lds_raw;
    cg::grid_group grid = cg::this_grid();
    const int G = (int)gridDim.x, blk = (int)blockIdx.x;
    for (int ph = pin.ph_lo; ph < pin.ph_hi; ++ph) {
        Params p = pin;
        asm volatile("" : "+s"(p.ws), "+s"(p.out), "+s"(p.x));
        bf16_t* WIN = (bf16_t*)(p.ws + WS_WIN); bf16_t* WOUT = (bf16_t*)(p.ws + WS_WOUT); bf16_t* W1B = (bf16_t*)(p.ws + WS_W1); bf16_t* W2B = (bf16_t*)(p.ws + WS_W2);
        const float* MOD = (const float*)(p.ws + WS_MOD);
        bf16_t* BIG = (bf16_t*)(p.ws + WS_BIG); bf16_t* HB = (bf16_t*)(p.ws + WS_HB);
        if (ph == 0) {
            cvt_kind(p.w_in, WIN, DM, DIN, DINP, (LAS float*)lds);
            cvt_kind(p.w_out, WOUT, DM, DM, DM, (LAS float*)lds);
            cvt_kind(p.w1, W1B, DM, DFF, DFF, (LAS float*)lds);
            cvt_kind(p.w2, W2B, DFF, DM, DM, (LAS float*)lds);
            mod_phase(p, (LAS float*)lds);
            lb_phase(p);
        } else if (ph == NPHASE - 1) {
            final_norm(p.out, p.final_w);
        } else {
            const int l = (ph - 1) / 9, s = (ph - 1) % 9;
            const float* modl = MOD + (size_t)l * NB * 6144;
            const float* xcur = (l == 0) ? p.x : p.out;
            if (s == 0) {
                rmsnorm_mod(xcur, p.norm_mix_w + l * DM, modl, 0, 1024, HB);
            } else if (s == 1) {
                pg8::EpiBf16<0> E; E.O = BIG; E.ldc = DINP;
                run_gemm(lds, HB, WIN + (size_t)l * DINP * DM, NTOK, DINP, DM, E);
            } else if (s == 2) {
#ifndef DIAG_NOTHR
                for (int v = blk; v < 2048; v += G) { const int itp = v >> 8, rem = v & 255, b = rem & 7, jj = rem >> 3; const int qt = itp * 32 + ((itp & 1) ? 31 - jj : jj); thr_item(p, b, qt, lds); }
#endif
                for (int v = blk; v < 2048; v += G) { const int c = v & 63, bh = v >> 6; hgrn_local_item(p, l, bh >> 2, bh & 3, c, lds); }
                for (int v = blk; v < 1024; v += G) conv_item(p, l, v >> 7, v & 127, lds);
                for (int v = blk; v < 512; v += G) vt_item(p, v >> 6, v & 63, lds);
            } else if (s == 3) {
                hgrn_scan(p);
                for (int v = blk; v < 512; v += G) { const int itp = v >> 8, rem = v & 255, b = rem & 7, jj = rem >> 3; const int qb = itp ? 63 - jj : jj; attn_item(p, b, qb); }
            } else if (s == 4) {
                for (int v = blk; v < 2048; v += G) { const int c = v & 63, bh = v >> 6; hgrn_out_item(p, l, bh >> 2, bh & 3, c, lds); }
            } else if (s == 5) {
                pg8::EpiResid E; E.xs = xcur; E.xd = p.out; E.gate = modl + 2048;
                run_gemm(lds, HB, WOUT + (size_t)l * DM * DM, NTOK, DM, DM, E);
            } else if (s == 6) {
                rmsnorm_mod(p.out, p.norm_mlp_w + l * DM, modl, 3072, 4096, HB);
            } else if (s == 7) {
                pg8::EpiBf16<1> E; E.O = BIG; E.ldc = DFF;
                run_gemm(lds, HB, W1B + (size_t)l * DFF * DM, NTOK, DFF, DM, E);
            } else {
                pg8::EpiResid E; E.xs = p.out; E.xd = p.out; E.gate = modl + 5120;
                run_gemm(lds, BIG, W2B + (size_t)l * DM * DFF, NTOK, DM, DFF, E);
            }
        }
        if (ph + 1 < pin.ph_hi) { __builtin_amdgcn_fence(__ATOMIC_RELEASE, "agent"); grid.sync(); __builtin_amdgcn_fence(__ATOMIC_ACQUIRE, "agent"); }
    }
#ifdef DIAG_CUT
    __builtin_amdgcn_fence(__ATOMIC_RELEASE, "agent"); grid.sync(); __builtin_amdgcn_fence(__ATOMIC_ACQUIRE, "agent"); diag_phase(pin);
#endif
}

extern "C" void kernel_launch(void* const* d_in, const int* in_sizes, int n_in, void* d_out, int out_size, void* d_ws, size_t ws_size, hipStream_t stream) {
    static int grid_blocks = 0;
    if (grid_blocks == 0) {
        if (n_in != 17 || out_size != NTOK * DM || ws_size < WS_END) { fprintf(stderr, "kernel_launch: unexpected shapes (n_in %d out %d ws %zu need %zu)\n", n_in, out_size, ws_size, (size_t)WS_END); grid_blocks = -1; return; }
        int dev = 0, cus = 0, per_cu = 0;
        hipGetDevice(&dev);
        hipDeviceGetAttribute(&cus, hipDeviceAttributeMultiprocessorCount, dev);
        if (hipFuncSetAttribute((const void*)fwd_megakernel, hipFuncAttributeMaxDynamicSharedMemorySize, LDS_BYTES) != hipSuccess) { fprintf(stderr, "kernel_launch: hipFuncSetAttribute failed\n"); grid_blocks = -1; return; }
        if (hipOccupancyMaxActiveBlocksPerMultiprocessor(&per_cu, (const void*)fwd_megakernel, NTHREADS, LDS_BYTES) != hipSuccess || per_cu < 1) { fprintf(stderr, "kernel_launch: occupancy query says %d blocks/CU\n", per_cu); per_cu = 1; }
        (void)hipGetLastError();
        grid_blocks = cus * (per_cu > 1 ? 1 : per_cu);
    }
    if (grid_blocks < 0) return;
    Params p{};
    p.x = (const float*)d_in[0]; p.c = (const float*)d_in[1]; p.ada_w = (const float*)d_in[2]; p.ada_b = (const float*)d_in[3];
    p.norm_mix_w = (const float*)d_in[4]; p.norm_mlp_w = (const float*)d_in[5]; p.w_in = (const float*)d_in[6]; p.lb_logits = (const float*)d_in[7];
    p.onorm_w = (const float*)d_in[8]; p.cv_w = (const float*)d_in[9]; p.cv_b = (const float*)d_in[10]; p.cv_ln_w = (const float*)d_in[11]; p.cv_ln_b = (const float*)d_in[12];
    p.w_out = (const float*)d_in[13]; p.w1 = (const float*)d_in[14]; p.w2 = (const float*)d_in[15]; p.final_w = (const float*)d_in[16];
    p.out = (float*)d_out; p.ws = (unsigned char*)d_ws; p.ph_lo = 0; p.ph_hi = NPHASE;
#ifdef DIAG_CUT
    p.ph_hi = DIAG_CUT;
#endif
    void* args[] = {&p};
    hipError_t e = hipLaunchCooperativeKernel((const void*)fwd_megakernel, dim3(grid_blocks), dim3(NTHREADS), args, LDS_BYTES, stream);
    if (e != hipSuccess) fprintf(stderr, "kernel_launch: cooperative launch failed: %s (grid %d)\n", hipGetErrorString(e), grid_blocks);
}
```

```cpp
#include <hip/hip_runtime.h>
#include <hip/hip_cooperative_groups.h>
#include <cstdio>
#include <cstdint>
namespace cg = cooperative_groups;

#define LAS __attribute__((address_space(3)))
typedef unsigned short bf16_t;
typedef short bf16x8 __attribute__((ext_vector_type(8)));
typedef float f32x4 __attribute__((ext_vector_type(4)));
typedef unsigned u32x4 __attribute__((ext_vector_type(4)));
typedef unsigned u32x2 __attribute__((ext_vector_type(2)));

constexpr int DM = 1024, NB = 8, SEQ = 4096, DEPTH = 4, NTOK = NB * SEQ;
constexpr int DIN = 3624, DINP = 3840, DFF = 4096;
constexpr int OFF_HQ = 0, OFF_HF = 512, OFF_HI = 1024, OFF_HG = 1536, OFF_SQ = 2048, OFF_SK = 2304, OFF_SV = 2560, OFF_IQ = 2816, OFF_IK = 3072, OFF_IW = 3104, OFF_CU = 3112;
constexpr int TOPK = 256;
constexpr float EPS = 1e-6f;
constexpr int NTHREADS = 512;
constexpr int LDS_BYTES = 131072;

constexpr size_t WS_WIN = 0;
constexpr size_t WS_WOUT = WS_WIN + (size_t)DEPTH * DINP * DM * 2;
constexpr size_t WS_W1 = WS_WOUT + (size_t)DEPTH * DM * DM * 2;
constexpr size_t WS_W2 = WS_W1 + (size_t)DEPTH * DFF * DM * 2;
constexpr size_t WS_MOD = WS_W2 + (size_t)DEPTH * DM * DFF * 2;
constexpr size_t WS_LB = WS_MOD + (size_t)DEPTH * NB * 6 * DM * 4;
constexpr size_t WS_BIG = WS_LB + (size_t)DEPTH * 512 * 4;
constexpr size_t WS_HB = WS_BIG + (size_t)NTOK * DFF * 2;
constexpr size_t WS_ST = WS_HB + (size_t)NTOK * DM * 2;
constexpr size_t WS_DEC = WS_ST + (size_t)32 * 64 * 16384 * 2;
constexpr size_t WS_VT = WS_DEC + (size_t)32 * 64 * 128 * 4;
constexpr size_t WS_THRT = WS_VT + (size_t)NB * 4 * 64 * SEQ * 2;
constexpr size_t WS_THRC = WS_THRT + (size_t)NTOK * 4;
constexpr size_t WS_END = WS_THRC + (size_t)NTOK * 4;
static_assert(WS_END <= (size_t)512 * 1024 * 1024, "workspace map exceeds 512 MiB");

struct Params {
    const float* x; const float* c; const float* ada_w; const float* ada_b; const float* norm_mix_w; const float* norm_mlp_w;
    const float* w_in; const float* lb_logits; const float* onorm_w; const float* cv_w; const float* cv_b; const float* cv_ln_w; const float* cv_ln_b;
    const float* w_out; const float* w1; const float* w2; const float* final_w;
    float* out; unsigned char* ws;
    int ph_lo, ph_hi;
};

typedef float f32x2_t __attribute__((ext_vector_type(2)));
typedef __bf16 bf16x2_t __attribute__((ext_vector_type(2)));
__device__ __forceinline__ unsigned cvt_pk_bf16(float lo, float hi) { const f32x2_t v = {lo, hi}; return __builtin_bit_cast(unsigned, __builtin_convertvector(v, bf16x2_t)); }
__device__ __forceinline__ float bf2f(short h) { return __uint_as_float(((unsigned)(unsigned short)h) << 16); }
__device__ __forceinline__ float bflo(unsigned w) { return __uint_as_float(w << 16); }
__device__ __forceinline__ float bfhi(unsigned w) { return __uint_as_float(w & 0xffff0000u); }
__device__ __forceinline__ bf16_t f2bf(float f) { return (bf16_t)(cvt_pk_bf16(f, 0.f) & 0xffffu); }
__device__ __forceinline__ float wave_sum(float v) {
    v += __shfl_xor(v, 32); v += __shfl_xor(v, 16); v += __shfl_xor(v, 8); v += __shfl_xor(v, 4); v += __shfl_xor(v, 2); v += __shfl_xor(v, 1); return v;
}
__device__ __forceinline__ float sigmoidf_(float x) { return 1.f / (1.f + __expf(-x)); }
__device__ __forceinline__ float siluf_(float x) { return x / (1.f + __expf(-x)); }
__device__ __forceinline__ unsigned sortable(float f) { unsigned b = __float_as_uint(f); return b ^ ((b & 0x80000000u) ? 0xffffffffu : 0x80000000u); }
__device__ __forceinline__ f32x4 mfma16(bf16x8 a, bf16x8 b, f32x4 c) { return __builtin_amdgcn_mfma_f32_16x16x32_bf16(a, b, c, 0, 0, 0); }

namespace pg8 {
#define PG8_LAS __attribute__((address_space(3)))
constexpr int BM = 256, BK = 64, HALF = 128, HTB = HALF * BK * 2, STAGE_BYTES = 8 * HTB, NXCD = 8, WGM = 8;
__host__ __device__ __forceinline__ int lds_byte(int r, int c) { const int st = (r >> 4) * 2 + (c >> 5), rr = r & 15, cc = c & 31, ob = rr * 64 + cc * 2; return st * 1024 + (ob ^ (((ob >> 9) & 1) << 5)); }
__host__ __device__ __forceinline__ void stage_rc(int b, int& R, int& C) { const int st = b / 1024, sb = b % 1024, swz = sb ^ (((sb >> 9) & 1) << 5); R = (st >> 1) * 16 + swz / 64; C = (st & 1) * 32 + (swz % 64) / 2; }
__host__ __device__ __forceinline__ int perm32(int rho) { const int n = rho >> 4, i = rho & 15; return 8 * (i >> 2) + 4 * n + (i & 3); }
struct Unit { int pm, pn; };
struct Gemm { const bf16_t* A; const bf16_t* Bt; int M, N, K; };
struct StaticOrder {
    int nM, nN, nwg, G, c;
    __host__ __device__ void init(int M, int N, int G_, int c_) { nM = M / BM; nN = N / BM; nwg = nM * nN; G = G_; c = c_; }
    __host__ __device__ bool next(int i, Unit& u) const {
        const long L = (long)i * G + c; if (L >= nwg) return false;
        int wgid = (int)L; { const int q = nwg / NXCD, r = nwg % NXCD, xcd = wgid % NXCD, off = wgid / NXCD; wgid = (xcd < r ? xcd * (q + 1) : r * (q + 1) + (xcd - r) * q) + off; }
        const int nig = WGM * nN, gid = wgid / nig, fm = gid * WGM, gsz = (nM - fm) < WGM ? (nM - fm) : WGM;
        u.pm = fm + ((wgid % nig) % gsz); u.pn = (wgid % nig) / gsz; return true;
    }
    __device__ __forceinline__ void a_ready(const Unit&) const {}
    __device__ __forceinline__ void done(const Unit&) const {}
};

template <int ACT  > struct EpiBf16 {
    static constexpr bool PERM = true, AFTER_DRAIN = false;
    bf16_t* O; int ldc;
    __device__ __forceinline__ void operator()(const f32x4 (&acc)[2][2][4][2], const Unit& u, int wr, int wc, int fr, int fq) const {
        const int row0 = u.pm * BM + wr * 64 + fr, col0 = u.pn * BM + wc * 32 + 8 * fq;
#pragma unroll
        for (int ai = 0; ai < 2; ++ai)
#pragma unroll
            for (int m = 0; m < 4; ++m) { bf16_t* rowp = O + (size_t)(row0 + ai * HALF + m * 16) * ldc + col0;
#pragma unroll
                for (int bj = 0; bj < 2; ++bj) { f32x4 v0 = acc[ai][bj][m][0], v1 = acc[ai][bj][m][1];
                    if (ACT == 1) {
#pragma unroll
                        for (int j = 0; j < 4; ++j) { const float a = fmaxf(v0[j], 0.f), b = fmaxf(v1[j], 0.f); v0[j] = a * a; v1[j] = b * b; } }
                    u32x4 w; w.x = cvt_pk_bf16(v0[0], v0[1]); w.y = cvt_pk_bf16(v0[2], v0[3]); w.z = cvt_pk_bf16(v1[0], v1[1]); w.w = cvt_pk_bf16(v1[2], v1[3]);
                    *(u32x4*)(rowp + bj * HALF) = w; } }
    }
};
struct EpiResid {
    static constexpr bool PERM = true, AFTER_DRAIN = false;
    const float* xs; float* xd; const float* gate;
    __device__ __forceinline__ void operator()(const f32x4 (&acc)[2][2][4][2], const Unit& u, int wr, int wc, int fr, int fq) const {
        const int row0 = u.pm * BM + wr * 64 + fr, col0 = u.pn * BM + wc * 32 + 8 * fq;
        const float* gp = gate + (size_t)((u.pm * BM) >> 12) * 6144 + col0;
        f32x4 gv[2][2];
#pragma unroll
        for (int bj = 0; bj < 2; ++bj)
#pragma unroll
            for (int n = 0; n < 2; ++n) gv[bj][n] = *(const f32x4*)(gp + bj * HALF + 4 * n);
#pragma unroll
        for (int ai = 0; ai < 2; ++ai)
#pragma unroll
            for (int m = 0; m < 4; ++m) { const size_t off = (size_t)(row0 + ai * HALF + m * 16) * DM + col0;
#pragma unroll
                for (int bj = 0; bj < 2; ++bj)
#pragma unroll
                    for (int n = 0; n < 2; ++n) { const f32x4 xv = *(const f32x4*)(xs + off + bj * HALF + 4 * n);
                        *(f32x4*)(xd + off + bj * HALF + 4 * n) = xv + gv[bj][n] * acc[ai][bj][m][n]; } }
    }
};
template <class Epi, class Sched, bool ALIGN_EPI = false, bool SP2 = false>
__device__ __forceinline__ void gemm_phase(PG8_LAS unsigned char* lds, const Gemm g, const Sched& S, const Epi& E) {
    int tid_ = threadIdx.x; asm volatile("" : "+v"(tid_)); const int tid = tid_, wid = __builtin_amdgcn_readfirstlane(tid >> 6), lane = tid & 63, wr = wid >> 2, wc = wid & 3, fr = lane & 15, fq = lane >> 4;
    const int K = g.K, nt = K / BK;
    unsigned voffA[2], voffB[2];
#pragma unroll
    for (int i = 0; i < 2; ++i) { int R, C; stage_rc(tid * 16 + i * 8192, R, C); const int Rb = Epi::PERM ? ((R & ~31) + perm32(R & 31)) : R;
        voffA[i] = (unsigned)(R * K + C) * 2u; voffB[i] = (unsigned)(Rb * K + C) * 2u; }
    const size_t kstep = (size_t)(BK * 2);
    const size_t hstep = (size_t)HALF * K * 2;
    const size_t tstep = 2 * hstep;
    const unsigned ldsw = (unsigned)wid * 1024u;
    const int aoff = lds_byte(wr * 64 + fr, fq * 8), boff = lds_byte(wc * 32 + fr, fq * 8);
#define PG8_SA(b, h) (((b) * 2 + (h)) * HTB)
#define PG8_SB(b, h) ((4 + (b) * 2 + (h)) * HTB)
#define PG8_STAGE(bufoff, gbase, voff) do { _Pragma("unroll") for (int _i = 0; _i < 2; ++_i) \
        __builtin_amdgcn_global_load_lds((const unsigned*)((const char*)(gbase) + (voff)[_i]), (PG8_LAS unsigned*)(lds + (bufoff) + ldsw + _i * 8192), 16, 0, 0); } while (0)
#define PG8_LDA(dst, b, h) do { _Pragma("unroll") for (int m = 0; m < 4; ++m) _Pragma("unroll") for (int k = 0; k < 2; ++k) dst[m][k] = *(const PG8_LAS bf16x8*)(lds + PG8_SA(b, h) + aoff + m * 2048 + k * 1024); } while (0)
#define PG8_LDB(dst, b, h) do { _Pragma("unroll") for (int n = 0; n < 2; ++n) _Pragma("unroll") for (int k = 0; k < 2; ++k) dst[n][k] = *(const PG8_LAS bf16x8*)(lds + PG8_SB(b, h) + boff + n * 2048 + k * 1024); } while (0)
#define PG8_MMA(ai, bj, At, Bt) do { __builtin_amdgcn_s_setprio(1); _Pragma("unroll") for (int m = 0; m < 4; ++m) _Pragma("unroll") for (int n = 0; n < 2; ++n) _Pragma("unroll") for (int k = 0; k < 2; ++k) \
        acc[ai][bj][m][n] = __builtin_amdgcn_mfma_f32_16x16x32_bf16(Bt[n][k], At[m][k], acc[ai][bj][m][n], 0, 0, 0); __builtin_amdgcn_s_setprio(0); } while (0)
#define PG8_WAIT_V(n) asm volatile("s_waitcnt vmcnt(" #n ")" ::: "memory")
#define PG8_WAIT_L(n) asm volatile("s_waitcnt lgkmcnt(" #n ")" ::: "memory")
#define PG8_BAR __builtin_amdgcn_s_barrier()
#define PG8_SCHED __builtin_amdgcn_sched_barrier(0)
    Unit cur, nxt; int ui = 0;
    if (!S.next(0, cur)) return;
    f32x4 acc[2][2][4][2];
#pragma unroll
    for (int a = 0; a < 2; ++a)
#pragma unroll
        for (int b = 0; b < 2; ++b)
#pragma unroll
            for (int m = 0; m < 4; ++m)
#pragma unroll
                for (int n = 0; n < 2; ++n) acc[a][b][m][n] = (f32x4){0.f, 0.f, 0.f, 0.f};
    bf16x8 At[4][2], B0[2][2], B1[2][2];
    const char* cA = (const char*)g.A + (size_t)cur.pm * tstep; const char* cB = (const char*)g.Bt + (size_t)cur.pn * tstep;
    S.a_ready(cur);
    if constexpr (SP2) {
        PG8_STAGE(PG8_SB(0, 0), cB, voffB); PG8_STAGE(PG8_SB(0, 1), cB + hstep, voffB); PG8_STAGE(PG8_SA(0, 0), cA, voffA); PG8_STAGE(PG8_SA(0, 1), cA + hstep, voffA);
        if (wr == 1) PG8_BAR;
        PG8_WAIT_V(2); PG8_BAR;
        PG8_STAGE(PG8_SB(1, 0), cB + kstep, voffB); PG8_STAGE(PG8_SA(1, 0), cA + kstep, voffA); PG8_STAGE(PG8_SB(1, 1), cB + hstep + kstep, voffB);
        PG8_WAIT_V(6); PG8_BAR;
    } else {
        PG8_STAGE(PG8_SB(0, 0), cB, voffB); PG8_STAGE(PG8_SA(0, 0), cA, voffA); PG8_STAGE(PG8_SB(0, 1), cB + hstep, voffB); PG8_STAGE(PG8_SA(0, 1), cA + hstep, voffA);
        if (wr == 1) PG8_BAR;
        PG8_WAIT_V(4); PG8_BAR;
        PG8_STAGE(PG8_SB(1, 0), cB + kstep, voffB); PG8_STAGE(PG8_SA(1, 0), cA + kstep, voffA); PG8_STAGE(PG8_SB(1, 1), cB + hstep + kstep, voffB);
        PG8_WAIT_V(6); PG8_BAR;
    }
    for (;;) {
        const bool has_next = S.next(ui + 1, nxt);
        const char* nA = has_next ? (const char*)g.A + (size_t)nxt.pm * tstep : cA; const char* nB = has_next ? (const char*)g.Bt + (size_t)nxt.pn * tstep : cB;
        for (int t = 0; t < nt; t += 2) {
            const bool last = (t == nt - 2);
            const char* a1 = cA + (size_t)(t + 1) * kstep;
            const char* a2 = last ? nA : cA + (size_t)(t + 2) * kstep; const char* b2 = last ? nB : cB + (size_t)(t + 2) * kstep;
            const char* a3 = a2 + kstep; const char* b3 = b2 + kstep;
            if (last && has_next) S.a_ready(nxt);
            if constexpr (SP2) {
            PG8_LDB(B0, 0, 0); PG8_LDB(B1, 0, 1); PG8_SCHED; PG8_LDA(At, 0, 0); PG8_STAGE(PG8_SA(1, 1), a1 + hstep, voffA);
            PG8_WAIT_V(8); PG8_WAIT_L(0); PG8_BAR; PG8_MMA(0, 0, At, B0); PG8_MMA(0, 1, At, B1); PG8_BAR; PG8_SCHED;
            PG8_LDA(At, 0, 1); PG8_STAGE(PG8_SB(0, 0), b2, voffB); PG8_STAGE(PG8_SB(0, 1), b2 + hstep, voffB); PG8_STAGE(PG8_SA(0, 0), a2, voffA);
            PG8_WAIT_V(8); PG8_WAIT_L(0); PG8_BAR; PG8_MMA(1, 0, At, B0); PG8_MMA(1, 1, At, B1); PG8_BAR; PG8_SCHED;
            PG8_LDB(B0, 1, 0); PG8_LDB(B1, 1, 1); PG8_SCHED; PG8_LDA(At, 1, 0); PG8_STAGE(PG8_SA(0, 1), a2 + hstep, voffA);
            PG8_WAIT_V(8); PG8_WAIT_L(0); PG8_BAR; PG8_MMA(0, 0, At, B0); PG8_MMA(0, 1, At, B1); PG8_BAR; PG8_SCHED;
            PG8_LDA(At, 1, 1); PG8_STAGE(PG8_SB(1, 0), b3, voffB); PG8_STAGE(PG8_SB(1, 1), b3 + hstep, voffB); PG8_STAGE(PG8_SA(1, 0), a3, voffA);
            PG8_WAIT_V(8); PG8_WAIT_L(0); PG8_BAR; PG8_MMA(1, 0, At, B0); PG8_MMA(1, 1, At, B1); PG8_BAR; PG8_SCHED;
            } else {
            PG8_LDB(B0, 0, 0); PG8_SCHED; PG8_LDA(At, 0, 0); PG8_STAGE(PG8_SA(1, 1), a1 + hstep, voffA);
            PG8_WAIT_L(8); PG8_BAR; PG8_WAIT_L(0); PG8_MMA(0, 0, At, B0); PG8_BAR; PG8_SCHED;
            PG8_LDB(B1, 0, 1); PG8_STAGE(PG8_SB(0, 0), b2, voffB);
            PG8_BAR; PG8_WAIT_L(0); PG8_MMA(0, 1, At, B1); PG8_BAR;
            PG8_LDA(At, 0, 1); PG8_STAGE(PG8_SA(0, 0), a2, voffA);
            PG8_BAR; PG8_WAIT_L(0); PG8_MMA(1, 0, At, B0); PG8_BAR; PG8_SCHED;
            PG8_STAGE(PG8_SB(0, 1), b2 + hstep, voffB);
            PG8_WAIT_V(6); PG8_BAR; PG8_MMA(1, 1, At, B1); PG8_BAR;
            PG8_LDB(B0, 1, 0); PG8_SCHED; PG8_LDA(At, 1, 0); PG8_STAGE(PG8_SA(0, 1), a2 + hstep, voffA);
            PG8_WAIT_L(8); PG8_BAR; PG8_WAIT_L(0); PG8_MMA(0, 0, At, B0); PG8_BAR; PG8_SCHED;
            PG8_LDB(B1, 1, 1); PG8_STAGE(PG8_SB(1, 0), b3, voffB);
            PG8_BAR; PG8_WAIT_L(0); PG8_MMA(0, 1, At, B1); PG8_BAR;
            PG8_LDA(At, 1, 1); PG8_STAGE(PG8_SA(1, 0), a3, voffA);
            PG8_BAR; PG8_WAIT_L(0); PG8_MMA(1, 0, At, B0); PG8_BAR; PG8_SCHED;
            PG8_STAGE(PG8_SB(1, 1), b3 + hstep, voffB);
            PG8_WAIT_V(6); PG8_BAR; PG8_MMA(1, 1, At, B1); PG8_BAR;
            }
        }
        if constexpr (ALIGN_EPI) { if (wr == 0) PG8_BAR; }
        if constexpr (!Epi::AFTER_DRAIN) { E(acc, cur, wr, wc, fr, fq); S.done(cur); }
        if (!has_next) break;
#pragma unroll
        for (int a = 0; a < 2; ++a)
#pragma unroll
            for (int b = 0; b < 2; ++b)
#pragma unroll
                for (int m = 0; m < 4; ++m)
#pragma unroll
                    for (int n = 0; n < 2; ++n) acc[a][b][m][n] = (f32x4){0.f, 0.f, 0.f, 0.f};
        cur = nxt; cA = nA; cB = nB; ++ui;
        if constexpr (ALIGN_EPI) { if (wr == 1) PG8_BAR; }
    }
    PG8_WAIT_V(0);
    if constexpr (!ALIGN_EPI) { if (wr == 0) PG8_BAR; }
    PG8_BAR;
    if constexpr (Epi::AFTER_DRAIN) { E.fused(acc, cur, wr, wc, fr, fq, lds, wid, lane); S.done(cur); }
#undef PG8_SA
#undef PG8_SB
#undef PG8_STAGE
#undef PG8_LDA
#undef PG8_LDB
#undef PG8_MMA
#undef PG8_WAIT_V
#undef PG8_WAIT_L
#undef PG8_BAR
#undef PG8_SCHED
}
}

#ifndef REP_THR
#define REP_THR 1
#endif
#ifndef REP_ATTN
#define REP_ATTN 1
#endif
#ifndef REP_S2
#define REP_S2 1
#endif
#ifndef REP_GEMM
#define REP_GEMM 1
#endif
#ifndef REP_HO
#define REP_HO 1
#endif
__device__ __forceinline__ int ltid() { int t = threadIdx.x; asm volatile("" : "+v"(t)); return t; }
#define TID ltid()

__device__ __forceinline__ void cvt_kind(const float* __restrict__ src, bf16_t* __restrict__ dst, int K, int N, int Npad, LAS float* tl) {
    const int tid = TID, nk = K / 64, nn = Npad / 64, per = nk * nn, total = DEPTH * per;
    for (int t = blockIdx.x; t < total; t += gridDim.x) {
        const int l = t / per, r = t % per, kt = r / nn, nt = r % nn;
        const float* s = src + (size_t)l * K * N; bf16_t* d = dst + (size_t)l * Npad * K;
#pragma unroll
        for (int i = 0; i < 2; ++i) { const int kr = (tid >> 4) + 32 * i, nc = (tid & 15) * 4, n = nt * 64 + nc;
            f32x4 v = (f32x4){0.f, 0.f, 0.f, 0.f};
            if (n < N) v = *(const f32x4*)(s + (size_t)(kt * 64 + kr) * N + n);
            tl[kr * 65 + nc + 0] = v[0]; tl[kr * 65 + nc + 1] = v[1]; tl[kr * 65 + nc + 2] = v[2]; tl[kr * 65 + nc + 3] = v[3]; }
        __syncthreads();
        { const int n = tid >> 3, k8 = (tid & 7) * 8; u32x4 w;
            w.x = cvt_pk_bf16(tl[(k8 + 0) * 65 + n], tl[(k8 + 1) * 65 + n]); w.y = cvt_pk_bf16(tl[(k8 + 2) * 65 + n], tl[(k8 + 3) * 65 + n]);
            w.z = cvt_pk_bf16(tl[(k8 + 4) * 65 + n], tl[(k8 + 5) * 65 + n]); w.w = cvt_pk_bf16(tl[(k8 + 6) * 65 + n], tl[(k8 + 7) * 65 + n]);
            *(u32x4*)(d + (size_t)(nt * 64 + n) * K + kt * 64 + k8) = w; }
        __syncthreads();
    }
}

__device__ __forceinline__ void mod_phase(const Params& p, LAS float* sm) {
    const int tid = TID;
    LAS float* cact = sm; LAS float* red = sm + 8192;
    for (int i = tid; i < NB * DM; i += NTHREADS) cact[i] = siluf_(p.c[i]);
    __syncthreads();
    float* MOD = (float*)(p.ws + WS_MOD);
    for (int it = blockIdx.x; it < DEPTH * 96; it += gridDim.x) {
        const int l = it / 96, j0 = (it % 96) * 64, col = tid & 63, seg = tid >> 6;
        const float* w = p.ada_w + (size_t)l * DM * 6144 + j0 + col;
        float a0 = 0.f, a1 = 0.f, a2 = 0.f, a3 = 0.f, a4 = 0.f, a5 = 0.f, a6 = 0.f, a7 = 0.f;
#pragma unroll 8
        for (int k = seg * 128; k < seg * 128 + 128; ++k) { const float wv = w[(size_t)k * 6144];
            a0 += cact[0 * DM + k] * wv; a1 += cact[1 * DM + k] * wv; a2 += cact[2 * DM + k] * wv; a3 += cact[3 * DM + k] * wv;
            a4 += cact[4 * DM + k] * wv; a5 += cact[5 * DM + k] * wv; a6 += cact[6 * DM + k] * wv; a7 += cact[7 * DM + k] * wv; }
        red[(seg * 8 + 0) * 64 + col] = a0; red[(seg * 8 + 1) * 64 + col] = a1; red[(seg * 8 + 2) * 64 + col] = a2; red[(seg * 8 + 3) * 64 + col] = a3;
        red[(seg * 8 + 4) * 64 + col] = a4; red[(seg * 8 + 5) * 64 + col] = a5; red[(seg * 8 + 6) * 64 + col] = a6; red[(seg * 8 + 7) * 64 + col] = a7;
        __syncthreads();
        { const int b = tid >> 6; float s = p.ada_b[l * 6144 + j0 + col];
#pragma unroll
            for (int sg = 0; sg < 8; ++sg) s += red[(sg * 8 + b) * 64 + col];
            MOD[(size_t)(l * NB + b) * 6144 + j0 + col] = s; }
        __syncthreads();
    }
}

__device__ __forceinline__ void lb_phase(const Params& p) {
    if (blockIdx.x != 0) return;
    const int k = TID; float* LB = (float*)(p.ws + WS_LB);
    const float v0 = p.lb_logits[k], v1 = p.lb_logits[512 + k], v2 = p.lb_logits[1024 + k], v3 = p.lb_logits[1536 + k];
    const float mx = fmaxf(fmaxf(v0, v1), fmaxf(v2, v3));
    const float e0 = expf(v0 - mx), e1 = expf(v1 - mx), e2 = expf(v2 - mx), e3 = expf(v3 - mx), inv = 1.f / (e0 + e1 + e2 + e3);
    const float p0 = e0 * inv, p1 = e1 * inv, p2 = e2 * inv, p3 = e3 * inv;
    LB[k] = p0 - p0; LB[512 + k] = (p0 + p1) - p0; LB[1024 + k] = ((p0 + p1) + p2) - p0; LB[1536 + k] = (((p0 + p1) + p2) + p3) - p0;
}

__device__ __forceinline__ void rmsnorm_mod(const float* __restrict__ xs, const float* __restrict__ w, const float* __restrict__ mod, int sh_off, int sc_off, bf16_t* __restrict__ dst) {
    const int tid = TID, wave = tid >> 6, lane = tid & 63;
    for (int row = blockIdx.x * 8 + wave; row < NTOK; row += gridDim.x * 8) {
        const float* xr = xs + (size_t)row * DM; f32x4 v[4]; float ss = 0.f;
#pragma unroll
        for (int i = 0; i < 4; ++i) { v[i] = *(const f32x4*)(xr + i * 256 + lane * 4); ss += v[i][0] * v[i][0] + v[i][1] * v[i][1] + v[i][2] * v[i][2] + v[i][3] * v[i][3]; }
        ss = wave_sum(ss);
        const float rstd = rsqrtf(ss * (1.f / DM) + EPS);
        const float* mb = mod + (size_t)(row >> 12) * 6144;
#pragma unroll
        for (int i = 0; i < 4; ++i) { const int col = i * 256 + lane * 4;
            const f32x4 ww = *(const f32x4*)(w + col), sc = *(const f32x4*)(mb + sc_off + col), sh = *(const f32x4*)(mb + sh_off + col);
            const f32x4 h = (v[i] * rstd * ww) * (sc + 1.f) + sh;
            u32x2 o; o.x = cvt_pk_bf16(h[0], h[1]); o.y = cvt_pk_bf16(h[2], h[3]);
            *(u32x2*)(dst + (size_t)row * DM + col) = o; }
    }
}
__device__ __forceinline__ void final_norm(float* __restrict__ x, const float* __restrict__ w) {
    const int tid = TID, wave = tid >> 6, lane = tid & 63;
    for (int row = blockIdx.x * 8 + wave; row < NTOK; row += gridDim.x * 8) {
        float* xr = x + (size_t)row * DM; f32x4 v[4]; float ss = 0.f;
#pragma unroll
        for (int i = 0; i < 4; ++i) { v[i] = *(const f32x4*)(xr + i * 256 + lane * 4); ss += v[i][0] * v[i][0] + v[i][1] * v[i][1] + v[i][2] * v[i][2] + v[i][3] * v[i][3]; }
        ss = wave_sum(ss);
        const float rstd = rsqrtf(ss * (1.f / DM) + EPS);
#pragma unroll
        for (int i = 0; i < 4; ++i) { const int col = i * 256 + lane * 4; const f32x4 ww = *(const f32x4*)(w + col); *(f32x4*)(xr + col) = v[i] * rstd * ww; }
    }
}

__device__ __forceinline__ void vt_item(const Params& p, int b, int tt, LAS unsigned char* sm) {
    const int tid = TID; LAS bf16_t* vb = (LAS bf16_t*)sm;
    const bf16_t* proj = (const bf16_t*)(p.ws + WS_BIG) + (size_t)(b * SEQ + tt * 64) * DINP + OFF_SV;
#pragma unroll
    for (int i = 0; i < 4; ++i) { const int idx = tid + NTHREADS * i, row = idx >> 5, c8 = (idx & 31) * 8;
        *(LAS bf16x8*)(vb + row * 264 + c8) = *(const bf16x8*)(proj + (size_t)row * DINP + c8); }
    __syncthreads();
    { const int col = tid >> 1, half = tid & 1;
        bf16_t* dst = (bf16_t*)(p.ws + WS_VT) + ((size_t)(b * 4 + (col >> 6)) * 64 + (col & 63)) * SEQ + tt * 64 + half * 32;
#pragma unroll
        for (int i = 0; i < 4; ++i) { bf16x8 o;
#pragma unroll
            for (int e = 0; e < 8; ++e) o[e] = (short)vb[(half * 32 + i * 8 + e) * 264 + col];
            *(bf16x8*)(dst + i * 8) = o; } }
    __syncthreads();
}

__device__ __forceinline__ void conv_item(const Params& p, int l, int b, int tt, LAS unsigned char* sm) {
    const int tid = TID; LAS float* hb = (LAS float*)sm;
    LAS float* ob = (LAS float*)(sm + 62 * 256 * 4);
    const int t0 = tt * 32;
    const bf16_t* proj = (const bf16_t*)(p.ws + WS_BIG) + (size_t)b * SEQ * DINP + OFF_CU;
#pragma unroll
    for (int i = 0; i < 4; ++i) { const int idx = tid + NTHREADS * i;
        if (idx < 62 * 32) { const int row = idx >> 5, c8 = (idx & 31) * 8, t = t0 - 30 + row;
            f32x4 h0 = (f32x4){0.f, 0.f, 0.f, 0.f}, h1 = h0;
            if (t >= 0) { const bf16x8 a = *(const bf16x8*)(proj + (size_t)t * DINP + c8), g = *(const bf16x8*)(proj + (size_t)t * DINP + 256 + c8);
#pragma unroll
                for (int j = 0; j < 4; ++j) { h0[j] = bf2f(a[j]) * sigmoidf_(bf2f(g[j])); h1[j] = bf2f(a[4 + j]) * sigmoidf_(bf2f(g[4 + j])); } }
            *(LAS f32x4*)(hb + row * 256 + c8) = h0; *(LAS f32x4*)(hb + row * 256 + c8 + 4) = h1; } }
    __syncthreads();
    { const int ch = tid & 255, half = tid >> 8;
        float w[31];
#pragma unroll
        for (int j = 0; j < 31; ++j) w[j] = p.cv_w[(size_t)(l * 31 + j) * 256 + ch];
        const float bias = p.cv_b[l * 256 + ch];
        float o[16];
#pragma unroll
        for (int i = 0; i < 16; ++i) o[i] = bias;
#pragma unroll
        for (int r = 0; r < 46; ++r) { const float hv = hb[(half * 16 + r) * 256 + ch];
#pragma unroll
            for (int i = 0; i < 16; ++i) { const int j = r - i; if (j >= 0 && j <= 30) o[i] = fmaf(hv, w[j], o[i]); } }
#pragma unroll
        for (int i = 0; i < 16; ++i) ob[(half * 16 + i) * 256 + ch] = o[i]; }
    __syncthreads();
    { const int wave = tid >> 6, lane = tid & 63;
        const f32x4 lw = *(const f32x4*)(p.cv_ln_w + l * 256 + lane * 4), lbv = *(const f32x4*)(p.cv_ln_b + l * 256 + lane * 4);
        bf16_t* mix = (bf16_t*)(p.ws + WS_HB);
#pragma unroll
        for (int i = 0; i < 4; ++i) { const int tl = wave * 4 + i;
            const f32x4 xv = *(LAS f32x4*)(ob + tl * 256 + lane * 4);
            const float mu = wave_sum(xv[0] + xv[1] + xv[2] + xv[3]) * (1.f / 256.f);
            const f32x4 dv = xv - mu;
            const float var = wave_sum(dv[0] * dv[0] + dv[1] * dv[1] + dv[2] * dv[2] + dv[3] * dv[3]) * (1.f / 256.f);
            const float rs = rsqrtf(var + EPS);
            const f32x4 y = dv * rs * lw + lbv;
            u32x2 o2; o2.x = cvt_pk_bf16(siluf_(y[0]), siluf_(y[1])); o2.y = cvt_pk_bf16(siluf_(y[2]), siluf_(y[3]));
            *(u32x2*)(mix + (size_t)(b * SEQ + t0 + tl) * DM + 768 + lane * 4) = o2; } }
    __syncthreads();
}

constexpr float IDX_WSCALE = 0.35355339059327373f * 0.17677669529663687f;
__device__ __forceinline__ f32x4 idx_scores(const bf16x8 ka, const bf16x8 (&qi)[8], const float (&wq)[8]) {
    f32x4 s = (f32x4){0.f, 0.f, 0.f, 0.f};
#pragma unroll
    for (int h = 0; h < 8; ++h) { const f32x4 d = mfma16(ka, qi[h], (f32x4){0.f, 0.f, 0.f, 0.f});
#pragma unroll
        for (int r = 0; r < 4; ++r) s[r] = __builtin_fmaf(wq[h], fmaxf(d[r], 0.f), s[r]); }
    return s;
}

__device__ __forceinline__ void cnt_ge(int& cn, unsigned a, unsigned b) { asm("v_cmp_ge_u32 vcc, %1, %2\n\tv_addc_co_u32 %0, vcc, 0, %0, vcc" : "+v"(cn) : "v"(a), "v"(b) : "vcc"); }
constexpr int TH_ROW = 40, TH_BUF = 512 * TH_ROW * 2, TH_CNT = 2 * TH_BUF;
__device__ __forceinline__ void thr_item(const Params& p, int b, int qt, LAS unsigned char* sm) {
    const int tid = TID, w = __builtin_amdgcn_readfirstlane(tid >> 6), l = tid & 63, c16 = l & 15, g = l >> 4;
    LAS unsigned* cnt = (LAS unsigned*)(sm + TH_CNT);
    const bf16_t* proj = (const bf16_t*)(p.ws + WS_BIG) + (size_t)b * SEQ * DINP;
    const int q = qt * 16 + c16;
    const bf16_t* qrow = proj + (size_t)q * DINP;
    bf16x8 qi[8]; float wq[8];
#pragma unroll
    for (int h = 0; h < 8; ++h) qi[h] = *(const bf16x8*)(qrow + OFF_IQ + h * 32 + g * 8);
    { const bf16x8 wv = *(const bf16x8*)(qrow + OFF_IW);
#pragma unroll
        for (int h = 0; h < 8; ++h) wq[h] = bf2f(wv[h]) * IDX_WSCALE; }
    unsigned sc[32][4];
    const int ni = (qt >= w) ? ((qt - w) >> 3) + 1 : 0;
    const int nchunk = (qt >> 5) + 1;
    const bf16_t* gsrc = proj + (size_t)(tid >> 2) * DINP + OFF_IK + (tid & 3) * 8;
    const int ldst = (tid >> 2) * TH_ROW + (tid & 3) * 8;
    bf16x8 st0, st1, st2, st3;
#define TH_LOAD(ck_) do { const bf16_t* s_ = gsrc + (size_t)(ck_) * 512 * DINP; st0 = *(const bf16x8*)(s_); st1 = *(const bf16x8*)(s_ + (size_t)128 * DINP); \
        st2 = *(const bf16x8*)(s_ + (size_t)256 * DINP); st3 = *(const bf16x8*)(s_ + (size_t)384 * DINP); } while (0)
#define TH_STORE(buf_) do { LAS bf16_t* d_ = (LAS bf16_t*)(sm + (buf_) * TH_BUF) + ldst; *(LAS bf16x8*)(d_) = st0; *(LAS bf16x8*)(d_ + 128 * TH_ROW) = st1; \
        *(LAS bf16x8*)(d_ + 256 * TH_ROW) = st2; *(LAS bf16x8*)(d_ + 384 * TH_ROW) = st3; } while (0)
    TH_LOAD(0); TH_STORE(0);
    __syncthreads();
#pragma unroll
    for (int ck = 0; ck < 8; ++ck) {
        if (ck < nchunk) {
            if (ck + 1 < nchunk) TH_LOAD(ck + 1);
            LAS bf16_t* B = (LAS bf16_t*)(sm + (ck & 1) * TH_BUF);
#pragma unroll
            for (int j = 0; j < 4; ++j) { const int i = ck * 4 + j, kt = w + 8 * i;
                if (kt <= qt) { const bf16x8 ka = *(LAS bf16x8*)(B + ((j * 8 + w) * 16 + c16) * TH_ROW + g * 8);
                    const f32x4 s = idx_scores(ka, qi, wq);
#pragma unroll
                    for (int r = 0; r < 4; ++r) { const int key = kt * 16 + 4 * g + r; sc[i][r] = (key <= q) ? sortable(s[r]) : 0u; }
                } else { sc[i][0] = 0u; sc[i][1] = 0u; sc[i][2] = 0u; sc[i][3] = 0u; } }
            if (ck + 1 < nchunk) TH_STORE((ck + 1) & 1);
            __syncthreads();
        } else {
#pragma unroll
            for (int j = 0; j < 4; ++j) { sc[ck * 4 + j][0] = 0u; sc[ck * 4 + j][1] = 0u; sc[ck * 4 + j][2] = 0u; sc[ck * 4 + j][3] = 0u; }
        }
    }
#undef TH_LOAD
#undef TH_STORE
    unsigned T = 0u; bool done = false; int it = 0;
    for (; it < 32; ++it) {
        const unsigned cand = T | (1u << (31 - it)); int cn = 0;
#pragma unroll
        for (int gi = 0; gi < 4; ++gi) if (ni > 8 * gi) {
#pragma unroll
            for (int i = 8 * gi; i < 8 * gi + 8; ++i) { cnt_ge(cn, sc[i][0], cand); cnt_ge(cn, sc[i][1], cand); cnt_ge(cn, sc[i][2], cand); cnt_ge(cn, sc[i][3], cand); } }
        cn += __shfl_xor(cn, 16); cn += __shfl_xor(cn, 32);
        const int buf = it & 1;
        if (l < 16) cnt[(buf * 8 + w) * 16 + l] = (unsigned)cn;
        __syncthreads();
        int tot = 0;
#pragma unroll
        for (int ww = 0; ww < 8; ++ww) tot += (int)cnt[(buf * 8 + ww) * 16 + c16];
        if (!done) { if (tot >= TOPK) T = cand; if (tot == TOPK) done = true; }
        if (__all(done)) { ++it; break; }
    }
    unsigned ceq = 4095u;
    const bool open = !done && (T != 0u);
    if (!__all(!open)) {
        int ngt = 0, nge = 0;
        for (int e = 0; e < 2; ++e, ++it) {
            const unsigned cand = (e == 0) ? T + 1u : T; int cn = 0;
#pragma unroll
            for (int gi = 0; gi < 4; ++gi) if (ni > 8 * gi) {
#pragma unroll
            for (int i = 8 * gi; i < 8 * gi + 8; ++i) { cnt_ge(cn, sc[i][0], cand); cnt_ge(cn, sc[i][1], cand); cnt_ge(cn, sc[i][2], cand); cnt_ge(cn, sc[i][3], cand); } }
            cn += __shfl_xor(cn, 16); cn += __shfl_xor(cn, 32);
            const int buf = it & 1;
            if (l < 16) cnt[(buf * 8 + w) * 16 + l] = (unsigned)cn;
            __syncthreads();
            int tot = 0;
#pragma unroll
            for (int ww = 0; ww < 8; ++ww) tot += (int)cnt[(buf * 8 + ww) * 16 + c16];
            if (e == 0) ngt = tot; else nge = tot;
        }
        const int need = TOPK - ngt; const bool excess = open && (nge - ngt > need);
#pragma unroll
        for (int i = 0; i < 32; ++i)
#pragma unroll
            for (int r = 0; r < 4; ++r) sc[i][r] = (sc[i][r] == T) ? (unsigned)((w + 8 * i) * 16 + 4 * g + r) : 0xffffffffu;
        unsigned c = 0u;
        for (int s = 0; s < 12; ++s, ++it) {
            const unsigned cand = c | (1u << (11 - s)); int cn = 0;
#pragma unroll
            for (int gi = 0; gi < 4; ++gi) if (ni > 8 * gi) {
#pragma unroll
                for (int i = 8 * gi; i < 8 * gi + 8; ++i) { cnt_ge(cn, cand - 1u, sc[i][0]); cnt_ge(cn, cand - 1u, sc[i][1]); cnt_ge(cn, cand - 1u, sc[i][2]); cnt_ge(cn, cand - 1u, sc[i][3]); } }
            cn += __shfl_xor(cn, 16); cn += __shfl_xor(cn, 32);
            const int buf = it & 1;
            if (l < 16) cnt[(buf * 8 + w) * 16 + l] = (unsigned)cn;
            __syncthreads();
            int tot = 0;
#pragma unroll
            for (int ww = 0; ww < 8; ++ww) tot += (int)cnt[(buf * 8 + ww) * 16 + c16];
            if (tot < need) c = cand;
        }
        if (excess) ceq = c;
    }
    if (w == 0 && l < 16) { ((unsigned*)(p.ws + WS_THRT))[b * SEQ + q] = T; ((unsigned*)(p.ws + WS_THRC))[b * SEQ + q] = ceq; }
    __syncthreads();
}

constexpr int AT_KROW = 264, AT_IROW = 40, AT_VROW = 40;
constexpr int AT_OFFI = 32 * AT_KROW * 2, AT_OFFV = AT_OFFI + 32 * AT_IROW * 2, AT_BUF = AT_OFFV + 256 * AT_VROW * 2;
__device__ __forceinline__ int at_row(int r) { return (r & 3) + 4 * ((r >> 3) & 3) + 16 * ((r >> 2) & 1); }
__device__ __forceinline__ void attn_item(const Params& p, int b, int qb, LAS unsigned char* sm) {
    const int tid = TID, w = __builtin_amdgcn_readfirstlane(tid >> 6), l = tid & 63, c16 = l & 15, g = l >> 4, qs = w & 3, hp = w >> 2;
    const bf16_t* proj = (const bf16_t*)(p.ws + WS_BIG) + (size_t)b * SEQ * DINP;
    const bf16_t* vt = (const bf16_t*)(p.ws + WS_VT) + (size_t)b * 4 * 64 * SEQ;
    const int q = qb * 64 + qs * 16 + c16;
    const bf16_t* qrow = proj + (size_t)q * DINP;
    bf16x8 qi[8]; float wq[8];
#pragma unroll
    for (int h = 0; h < 8; ++h) qi[h] = *(const bf16x8*)(qrow + OFF_IQ + h * 32 + g * 8);
    { const bf16x8 wv = *(const bf16x8*)(qrow + OFF_IW);
#pragma unroll
        for (int h = 0; h < 8; ++h) wq[h] = bf2f(wv[h]) * IDX_WSCALE; }
    const unsigned T = ((const unsigned*)(p.ws + WS_THRT))[b * SEQ + q], CE = ((const unsigned*)(p.ws + WS_THRC))[b * SEQ + q];
    bf16x8 Qb[2][2];
#pragma unroll
    for (int hh = 0; hh < 2; ++hh)
#pragma unroll
        for (int kk = 0; kk < 2; ++kk) { const bf16x8 raw = *(const bf16x8*)(qrow + OFF_SQ + (2 * hp + hh) * 64 + kk * 32 + g * 8); bf16x8 o;
#pragma unroll
            for (int e = 0; e < 8; ++e) o[e] = (short)f2bf(bf2f(raw[e]) * 0.125f);
            Qb[hh][kk] = o; }
    f32x4 O[2][4];
#pragma unroll
    for (int hh = 0; hh < 2; ++hh)
#pragma unroll
        for (int dt = 0; dt < 4; ++dt) O[hh][dt] = (f32x4){0.f, 0.f, 0.f, 0.f};
    float mrun[2] = {-1e30f, -1e30f}, lrun[2] = {0.f, 0.f};
    const int nt = 2 * qb + 2, my_nt = (qb * 64 + qs * 16 + 15) / 32 + 1;
    const int kr0 = tid >> 5, kc = (tid & 31) * 8, ir = tid >> 2, ic = (tid & 3) * 8, vr0 = tid >> 2, vc = (tid & 3) * 8;
    const bf16_t* gK = proj + (size_t)kr0 * DINP + OFF_SK + kc;
    const bf16_t* gI = proj + (size_t)(ir & 31) * DINP + OFF_IK + ic;
    const bf16_t* gV = vt + (size_t)vr0 * SEQ + vc;
    const int lK0 = at_row(kr0) * AT_KROW + kc, lK1 = at_row(kr0 + 16) * AT_KROW + kc, lI = AT_OFFI / 2 + at_row(ir & 31) * AT_IROW + ic;
    const int lV0 = AT_OFFV / 2 + vr0 * AT_VROW + vc, lV1 = AT_OFFV / 2 + (vr0 + 128) * AT_VROW + vc;
    bf16x8 sK0, sK1, sI, sV0, sV1;
#define AT_LOAD(k0_) do { sK0 = *(const bf16x8*)(gK + (size_t)(k0_) * DINP); sK1 = *(const bf16x8*)(gK + (size_t)((k0_) + 16) * DINP); \
        if (tid < 128) sI = *(const bf16x8*)(gI + (size_t)(k0_) * DINP); sV0 = *(const bf16x8*)(gV + (k0_)); sV1 = *(const bf16x8*)(gV + (size_t)128 * SEQ + (k0_)); } while (0)
#define AT_STORE(buf_) do { LAS bf16_t* B_ = (LAS bf16_t*)(sm + (buf_) * AT_BUF); *(LAS bf16x8*)(B_ + lK0) = sK0; *(LAS bf16x8*)(B_ + lK1) = sK1; \
        if (tid < 128) *(LAS bf16x8*)(B_ + lI) = sI; *(LAS bf16x8*)(B_ + lV0) = sV0; *(LAS bf16x8*)(B_ + lV1) = sV1; } while (0)
    AT_LOAD(0); AT_STORE(0);
    __syncthreads();
    for (int t = 0; t < nt; ++t) {
        const int k0 = t * 32;
        if (t + 1 < nt) AT_LOAD(k0 + 32);
        if (t < my_nt) {
            LAS bf16_t* Bk = (LAS bf16_t*)(sm + (t & 1) * AT_BUF); LAS bf16_t* Bi = Bk + AT_OFFI / 2; LAS bf16_t* Bv = Bk + AT_OFFV / 2;
            bool sel[2][4]; float lg[2][2][4];
#pragma unroll
            for (int s = 0; s < 2; ++s) {
                const int lrow = 16 * s + c16;
                const bf16x8 ka = *(LAS bf16x8*)(Bi + lrow * AT_IROW + g * 8);
                const f32x4 sv = idx_scores(ka, qi, wq);
#pragma unroll
                for (int r = 0; r < 4; ++r) { const int key = k0 + 8 * g + 4 * s + r; const unsigned u = sortable(sv[r]);
                    sel[s][r] = (key <= q) && (u > T || (u == T && (unsigned)key <= CE)); }
#pragma unroll
                for (int hh = 0; hh < 2; ++hh) { f32x4 S = (f32x4){0.f, 0.f, 0.f, 0.f};
#pragma unroll
                    for (int kk = 0; kk < 2; ++kk) { const bf16x8 kf = *(LAS bf16x8*)(Bk + lrow * AT_KROW + (2 * hp + hh) * 64 + kk * 32 + g * 8); S = mfma16(kf, Qb[hh][kk], S); }
#pragma unroll
                    for (int r = 0; r < 4; ++r) lg[hh][s][r] = S[r]; }
            }
#pragma unroll
            for (int hh = 0; hh < 2; ++hh) {
                float mx = -1e30f;
#pragma unroll
                for (int s = 0; s < 2; ++s)
#pragma unroll
                    for (int r = 0; r < 4; ++r) mx = sel[s][r] ? fmaxf(mx, lg[hh][s][r]) : mx;
                mx = fmaxf(mx, __shfl_xor(mx, 16)); mx = fmaxf(mx, __shfl_xor(mx, 32));
                const float mn = fmaxf(mrun[hh], mx), alpha = __expf(mrun[hh] - mn);
                mrun[hh] = mn;
                float pv[8]; float ps = 0.f;
#pragma unroll
                for (int s = 0; s < 2; ++s)
#pragma unroll
                    for (int r = 0; r < 4; ++r) { const float e = sel[s][r] ? __expf(lg[hh][s][r] - mn) : 0.f; pv[s * 4 + r] = e; ps += e; }
                lrun[hh] = lrun[hh] * alpha + ps;
                union { bf16x8 v; unsigned u[4]; } pb;
                pb.u[0] = cvt_pk_bf16(pv[0], pv[1]); pb.u[1] = cvt_pk_bf16(pv[2], pv[3]); pb.u[2] = cvt_pk_bf16(pv[4], pv[5]); pb.u[3] = cvt_pk_bf16(pv[6], pv[7]);
#pragma unroll
                for (int dt = 0; dt < 4; ++dt) {
                    const bf16x8 va = *(LAS bf16x8*)(Bv + ((2 * hp + hh) * 64 + dt * 16 + c16) * AT_VROW + g * 8);
                    O[hh][dt] = mfma16(va, pb.v, O[hh][dt] * alpha); }
            }
        }
        if (t + 1 < nt) AT_STORE((t + 1) & 1);
        __syncthreads();
    }
#undef AT_LOAD
#undef AT_STORE
    bf16_t* mix = (bf16_t*)(p.ws + WS_HB) + (size_t)(b * SEQ + q) * DM + 512;
#pragma unroll
    for (int hh = 0; hh < 2; ++hh) { float tot = lrun[hh]; tot += __shfl_xor(tot, 16); tot += __shfl_xor(tot, 32);
        const float inv = 1.f / tot;
#pragma unroll
        for (int dt = 0; dt < 4; ++dt) { const f32x4 o = O[hh][dt] * inv; u32x2 o2; o2.x = cvt_pk_bf16(o[0], o[1]); o2.y = cvt_pk_bf16(o[2], o[3]);
            *(u32x2*)(mix + (2 * hp + hh) * 64 + dt * 16 + 4 * g) = o2; } }
}

__device__ __forceinline__ void hgrn_G(const bf16_t* prow0, const float* lb, int h, LAS float* Gs, LAS float* segtot) {
    const int tid = TID;
#pragma unroll
    for (int i = 0; i < 2; ++i) { const int row = (tid >> 4) + 32 * i, c8 = (tid & 15) * 8;
        const bf16x8 v = *(const bf16x8*)(prow0 + (size_t)row * DINP + OFF_HF + h * 128 + c8);
#pragma unroll
        for (int j = 0; j < 8; ++j) { const float fr = bf2f(v[j]), lbv = lb[c8 + j]; const float f = lbv + (1.f - lbv) * sigmoidf_(fr);
            Gs[row * 129 + c8 + j] = __logf(fmaxf(f, 1e-30f)); } }
    __syncthreads();
    const int col = tid & 127, seg = tid >> 7;
    { float run = 0.f;
#pragma unroll
        for (int r = 0; r < 16; ++r) { const int idx = (seg * 16 + r) * 129 + col; run += Gs[idx]; Gs[idx] = run; }
        segtot[seg * 128 + col] = run; }
    __syncthreads();
    { float off = 0.f;
#pragma unroll
        for (int s = 0; s < 3; ++s) if (s < seg) off += segtot[s * 128 + col];
        if (seg > 0) {
#pragma unroll
            for (int r = 0; r < 16; ++r) Gs[(seg * 16 + r) * 129 + col] += off; } }
    __syncthreads();
}

__device__ __forceinline__ void hgrn_local_item(const Params& p, int l, int b, int h, int c, LAS unsigned char* sm) {
    const int tid = TID, w = __builtin_amdgcn_readfirstlane(tid >> 6), ln = tid & 63, c16 = ln & 15, g = ln >> 4;
    LAS float* Gs = (LAS float*)sm; LAS float* segtot = (LAS float*)(sm + 33024);
    LAS bf16_t* KgT = (LAS bf16_t*)(sm + 35072); LAS bf16_t* vT = (LAS bf16_t*)(sm + 53504);
    const bf16_t* prow0 = (const bf16_t*)(p.ws + WS_BIG) + (size_t)(b * SEQ + c * 64) * DINP;
    const float* lb = (const float*)(p.ws + WS_LB) + l * 512 + h * 128;
    hgrn_G(prow0, lb, h, Gs, segtot);
    { const int j = tid & 63, kg = tid >> 6;
        const bf16_t* rp = prow0 + (size_t)j * DINP + h * 128 + kg * 16;
        const bf16x8 f0 = *(const bf16x8*)(rp + OFF_HF), f1 = *(const bf16x8*)(rp + OFF_HF + 8), v0 = *(const bf16x8*)(rp + OFF_HI), v1 = *(const bf16x8*)(rp + OFF_HI + 8);
#pragma unroll
        for (int e = 0; e < 16; ++e) { const int k = kg * 16 + e; const float fr = bf2f(e < 8 ? f0[e & 7] : f1[e & 7]), lbv = lb[k];
            const float kval = (1.f - lbv) * sigmoidf_(-fr);
            KgT[k * 72 + j] = f2bf(kval * __expf(Gs[63 * 129 + k] - Gs[j * 129 + k]));
            vT[k * 72 + j] = (bf16_t)(e < 8 ? v0[e & 7] : v1[e & 7]); } }
    const size_t bhc = (size_t)((b * 4 + h) * 64 + c);
    if (tid < 128) ((float*)(p.ws + WS_DEC))[bhc * 128 + tid] = __expf(Gs[63 * 129 + tid]);
    __syncthreads();
    f32x4 acc[8];
#pragma unroll
    for (int vt = 0; vt < 8; ++vt) acc[vt] = (f32x4){0.f, 0.f, 0.f, 0.f};
#pragma unroll
    for (int kk = 0; kk < 2; ++kk) { const bf16x8 a = *(LAS bf16x8*)(KgT + (w * 16 + c16) * 72 + kk * 32 + g * 8);
#pragma unroll
        for (int vt = 0; vt < 8; ++vt) { const bf16x8 bb = *(LAS bf16x8*)(vT + (vt * 16 + c16) * 72 + kk * 32 + g * 8); acc[vt] = mfma16(a, bb, acc[vt]); } }
    bf16_t* st = (bf16_t*)(p.ws + WS_ST) + bhc * 16384;
#pragma unroll
    for (int vt = 0; vt < 8; ++vt) { u32x2 o; o.x = cvt_pk_bf16(acc[vt][0], acc[vt][1]); o.y = cvt_pk_bf16(acc[vt][2], acc[vt][3]);
        *(u32x2*)(st + (size_t)(vt * 16 + c16) * 128 + w * 16 + 4 * g) = o; }
    __syncthreads();
}

__device__ __forceinline__ void hgrn_scan(const Params& p) {
    bf16_t* ST = (bf16_t*)(p.ws + WS_ST); const float* DEC = (const float*)(p.ws + WS_DEC);
    for (int e = blockIdx.x * NTHREADS + TID; e < 32 * 4096; e += gridDim.x * NTHREADS) {
        const int bh = e >> 12, idx4 = (e & 4095) * 4, k = idx4 & 127;
        bf16_t* base = ST + (size_t)bh * 64 * 16384 + idx4; const float* dec = DEC + (size_t)bh * 64 * 128 + k;
        f32x4 S = (f32x4){0.f, 0.f, 0.f, 0.f};
#pragma unroll 8
        for (int c = 0; c < 64; ++c) { const u32x2 loc = *(const u32x2*)(base + (size_t)c * 16384); const f32x4 d = *(const f32x4*)(dec + c * 128);
            u32x2 o; o.x = cvt_pk_bf16(S[0], S[1]); o.y = cvt_pk_bf16(S[2], S[3]);
            *(u32x2*)(base + (size_t)c * 16384) = o;
            S[0] = d[0] * S[0] + bflo(loc.x); S[1] = d[1] * S[1] + bfhi(loc.x); S[2] = d[2] * S[2] + bflo(loc.y); S[3] = d[3] * S[3] + bfhi(loc.y); }
    }
}

__device__ __forceinline__ void hgrn_out_item(const Params& p, int l, int b, int h, int c, LAS unsigned char* sm) {
    const int tid = TID, w = __builtin_amdgcn_readfirstlane(tid >> 6), ln = tid & 63, c16 = ln & 15, g = ln >> 4;
    LAS float* Gs = (LAS float*)sm; LAS float* segtot = (LAS float*)(sm + 33024);
    LAS bf16_t* qt_ = (LAS bf16_t*)(sm + 35072); LAS bf16_t* kt_ = (LAS bf16_t*)(sm + 52480); LAS bf16_t* qg_ = (LAS bf16_t*)(sm + 69888);
    LAS bf16_t* vT = (LAS bf16_t*)(sm + 87296); LAS bf16_t* Am = (LAS bf16_t*)(sm + 105728); LAS float* ssq = (LAS float*)(sm + 114944);
    const bf16_t* prow0 = (const bf16_t*)(p.ws + WS_BIG) + (size_t)(b * SEQ + c * 64) * DINP;
    const float* lb = (const float*)(p.ws + WS_LB) + l * 512 + h * 128;
    hgrn_G(prow0, lb, h, Gs, segtot);
#pragma unroll
    for (int i = 0; i < 2; ++i) { const int row = (tid >> 4) + 32 * i, c8 = (tid & 15) * 8;
        const bf16_t* rp = prow0 + (size_t)row * DINP + h * 128 + c8;
        const bf16x8 qv8 = *(const bf16x8*)(rp + OFF_HQ), fv8 = *(const bf16x8*)(rp + OFF_HF);
        float a[8], bq[8], cq[8];
#pragma unroll
        for (int j = 0; j < 8; ++j) { const int k = c8 + j; const float G = Gs[row * 129 + k], Gm = Gs[31 * 129 + k], lbv = lb[k];
            const float qv = siluf_(bf2f(qv8[j])) * 0.08838834764831845f, kval = (1.f - lbv) * sigmoidf_(-bf2f(fv8[j]));
            a[j] = qv * __expf(fminf(G - Gm, 80.f)); bq[j] = kval * __expf(fminf(Gm - G, 80.f)); cq[j] = qv * __expf(G); }
        u32x4 o;
        o.x = cvt_pk_bf16(a[0], a[1]); o.y = cvt_pk_bf16(a[2], a[3]); o.z = cvt_pk_bf16(a[4], a[5]); o.w = cvt_pk_bf16(a[6], a[7]); *(LAS u32x4*)(qt_ + row * 136 + c8) = o;
        o.x = cvt_pk_bf16(bq[0], bq[1]); o.y = cvt_pk_bf16(bq[2], bq[3]); o.z = cvt_pk_bf16(bq[4], bq[5]); o.w = cvt_pk_bf16(bq[6], bq[7]); *(LAS u32x4*)(kt_ + row * 136 + c8) = o;
        o.x = cvt_pk_bf16(cq[0], cq[1]); o.y = cvt_pk_bf16(cq[2], cq[3]); o.z = cvt_pk_bf16(cq[4], cq[5]); o.w = cvt_pk_bf16(cq[6], cq[7]); *(LAS u32x4*)(qg_ + row * 136 + c8) = o; }
    { const int j = tid & 63, kg = tid >> 6;
        const bf16_t* rp = prow0 + (size_t)j * DINP + OFF_HI + h * 128 + kg * 16;
        const bf16x8 v0 = *(const bf16x8*)(rp), v1 = *(const bf16x8*)(rp + 8);
#pragma unroll
        for (int e = 0; e < 16; ++e) vT[(kg * 16 + e) * 72 + j] = (bf16_t)(e < 8 ? v0[e & 7] : v1[e & 7]); }
    __syncthreads();
#pragma unroll
    for (int s = 0; s < 2; ++s) { const int tI = w * 2 + s, itile = tI >> 2, jt = tI & 3;
        f32x4 d = (f32x4){0.f, 0.f, 0.f, 0.f};
        if (jt <= itile) {
#pragma unroll
            for (int kk = 0; kk < 4; ++kk) { const bf16x8 a = *(LAS bf16x8*)(kt_ + (jt * 16 + c16) * 136 + kk * 32 + g * 8), bb = *(LAS bf16x8*)(qt_ + (itile * 16 + c16) * 136 + kk * 32 + g * 8);
                d = mfma16(a, bb, d); } }
        const int i = itile * 16 + c16, j0 = jt * 16 + 4 * g;
        u32x2 o; o.x = cvt_pk_bf16((j0 + 0 <= i) ? d[0] : 0.f, (j0 + 1 <= i) ? d[1] : 0.f); o.y = cvt_pk_bf16((j0 + 2 <= i) ? d[2] : 0.f, (j0 + 3 <= i) ? d[3] : 0.f);
        *(LAS u32x2*)(Am + i * 72 + j0) = o; }
    __syncthreads();
    const int itile = w & 3, vh = w >> 2;
    const size_t bhc = (size_t)((b * 4 + h) * 64 + c);
    const bf16_t* st = (const bf16_t*)(p.ws + WS_ST) + bhc * 16384;
    f32x4 acc[4];
#pragma unroll
    for (int vt = 0; vt < 4; ++vt) acc[vt] = (f32x4){0.f, 0.f, 0.f, 0.f};
#pragma unroll
    for (int kk = 0; kk < 2; ++kk) { const bf16x8 bb = *(LAS bf16x8*)(Am + (itile * 16 + c16) * 72 + kk * 32 + g * 8);
#pragma unroll
        for (int vt = 0; vt < 4; ++vt) { const bf16x8 a = *(LAS bf16x8*)(vT + ((vh * 4 + vt) * 16 + c16) * 72 + kk * 32 + g * 8); acc[vt] = mfma16(a, bb, acc[vt]); } }
#pragma unroll
    for (int kk = 0; kk < 4; ++kk) { const bf16x8 bb = *(LAS bf16x8*)(qg_ + (itile * 16 + c16) * 136 + kk * 32 + g * 8);
#pragma unroll
        for (int vt = 0; vt < 4; ++vt) { const bf16x8 a = *(const bf16x8*)(st + (size_t)((vh * 4 + vt) * 16 + c16) * 128 + kk * 32 + g * 8); acc[vt] = mfma16(a, bb, acc[vt]); } }
    float ss = 0.f;
#pragma unroll
    for (int vt = 0; vt < 4; ++vt) ss += acc[vt][0] * acc[vt][0] + acc[vt][1] * acc[vt][1] + acc[vt][2] * acc[vt][2] + acc[vt][3] * acc[vt][3];
    ss += __shfl_xor(ss, 16); ss += __shfl_xor(ss, 32);
    const int i = itile * 16 + c16;
    if (g == 0) ssq[vh * 64 + i] = ss;
    __syncthreads();
    const float rstd = rsqrtf((ssq[i] + ssq[64 + i]) * (1.f / 128.f) + EPS);
    bf16_t* mix = (bf16_t*)(p.ws + WS_HB) + (size_t)(b * SEQ + c * 64 + i) * DM + h * 128;
    const bf16_t* grow = prow0 + (size_t)i * DINP + OFF_HG + h * 128;
#pragma unroll
    for (int vt = 0; vt < 4; ++vt) { const int v0 = (vh * 4 + vt) * 16 + 4 * g;
        const u32x2 gr = *(const u32x2*)(grow + v0); const f32x4 ow = *(const f32x4*)(p.onorm_w + l * 512 + h * 128 + v0);
        const float r0 = acc[vt][0] * rstd * ow[0] * siluf_(bflo(gr.x)), r1 = acc[vt][1] * rstd * ow[1] * siluf_(bfhi(gr.x));
        const float r2 = acc[vt][2] * rstd * ow[2] * siluf_(bflo(gr.y)), r3 = acc[vt][3] * rstd * ow[3] * siluf_(bfhi(gr.y));
        u32x2 o; o.x = cvt_pk_bf16(r0, r1); o.y = cvt_pk_bf16(r2, r3);
        *(u32x2*)(mix + v0) = o; }
    __syncthreads();
}


#ifdef DIAG_CUT
__device__ __forceinline__ void diag_phase(const Params& p) {
    const int tid = TID, wave = tid >> 6, lane = tid & 63;
    const bf16_t* HB = (const bf16_t*)(p.ws + WS_HB); const bf16_t* ST = (const bf16_t*)(p.ws + WS_ST); const float* DEC = (const float*)(p.ws + WS_DEC);
    const bf16_t* BIG = (const bf16_t*)(p.ws + WS_BIG);
    for (int row = blockIdx.x * 8 + wave; row < NTOK; row += gridDim.x * 8) {
        float* orow = p.out + (size_t)row * DM;
        for (int i = 0; i < 16; ++i) { const int col = i * 64 + lane; float v = 0.f;
#if DIAG_MODE == 1
            for (int t = 0; t < 3; ++t) v += bf2f((short)BIG[(size_t)row * DINP + col + 1024 * t]);
            if (col < 768) v += bf2f((short)BIG[(size_t)row * DINP + 3072 + col]);
#elif DIAG_MODE == 2
            v = bf2f((short)ST[(size_t)row * 1024 + col]) + DEC[((size_t)row * 8 + (col & 7)) % (32 * 64 * 128)];
#elif DIAG_MODE == 5
            v = DEC[((size_t)row * 8 + (col & 7)) % (32 * 64 * 128)];
#elif DIAG_MODE == 6
            v = bf2f((short)ST[(size_t)row * 1024 + col]);
#elif DIAG_MODE == 4
            v = bf2f((short)HB[(size_t)row * DM + col]);
#endif
            if (!(fabsf(v) < 1e30f)) v = 12345.f;
            orow[col] = v; }
    }
}
#endif
template <class Epi>
__device__ __forceinline__ void run_gemm(LAS unsigned char* lds, const bf16_t* A, const bf16_t* Bt, int M, int N, int K, const Epi& E) {
    pg8::Gemm g; g.A = A; g.Bt = Bt; g.M = M; g.N = N; g.K = K;
    pg8::StaticOrder S; S.init(M, N, (int)gridDim.x, (int)blockIdx.x);
    pg8::gemm_phase<Epi, pg8::StaticOrder, true, true>(lds, g, S, E);
}

constexpr int NPHASE = 2 + 9 * DEPTH;
#ifndef SYNC_MODE
#define SYNC_MODE 0
#endif
#if SYNC_MODE == 0
#define GRID_SYNC() grid.sync()
#else
#define GRID_SYNC() do { __builtin_amdgcn_fence(__ATOMIC_RELEASE, "agent"); grid.sync(); __builtin_amdgcn_fence(__ATOMIC_ACQUIRE, "agent"); } while (0)
#endif

__global__ void __launch_bounds__(NTHREADS, 2) fwd_megakernel(Params pin) {
    extern __shared__ __attribute__((aligned(16))) unsigned char lds_raw[];
    LAS unsigned char* lds = (LAS unsigned char*)lds_raw;
    cg::grid_group grid = cg::this_grid();
    const int G = (int)gridDim.x, blk = (int)blockIdx.x;
    for (int ph = pin.ph_lo; ph < pin.ph_hi; ++ph) {
        Params p = pin;
        asm volatile("" : "+s"(p.ws), "+s"(p.out), "+s"(p.x));
        bf16_t* WIN = (bf16_t*)(p.ws + WS_WIN); bf16_t* WOUT = (bf16_t*)(p.ws + WS_WOUT); bf16_t* W1B = (bf16_t*)(p.ws + WS_W1); bf16_t* W2B = (bf16_t*)(p.ws + WS_W2);
        const float* MOD = (const float*)(p.ws + WS_MOD);
        bf16_t* BIG = (bf16_t*)(p.ws + WS_BIG); bf16_t* HB = (bf16_t*)(p.ws + WS_HB);
        if (ph == 0) {
            cvt_kind(p.w_in, WIN, DM, DIN, DINP, (LAS float*)lds);
            cvt_kind(p.w_out, WOUT, DM, DM, DM, (LAS float*)lds);
            cvt_kind(p.w1, W1B, DM, DFF, DFF, (LAS float*)lds);
            cvt_kind(p.w2, W2B, DFF, DM, DM, (LAS float*)lds);
            mod_phase(p, (LAS float*)lds);
            lb_phase(p);
        } else if (ph == NPHASE - 1) {
            final_norm(p.out, p.final_w);
        } else {
            const int l = (ph - 1) / 9, s = (ph - 1) % 9;
            const float* modl = MOD + (size_t)l * NB * 6144;
            const float* xcur = (l == 0) ? p.x : p.out;
            if (s == 0) {
                rmsnorm_mod(xcur, p.norm_mix_w + l * DM, modl, 0, 1024, HB);
            } else if (s == 1) {
                pg8::EpiBf16<0> E; E.O = BIG; E.ldc = DINP;
                for (int rep_ = 0; rep_ < REP_GEMM; ++rep_) run_gemm(lds, HB, WIN + (size_t)l * DINP * DM, NTOK, DINP, DM, E);
            } else if (s == 2) {
              for (int rep2_ = 0; rep2_ < REP_S2; ++rep2_) {
#ifndef DIAG_NOTHR
                for (int v = blk; v < 2048; v += G) { const int itp = v >> 8, rem = v & 255, b = rem & 7, jj = rem >> 3; const int qt = itp * 32 + ((itp & 1) ? 31 - jj : jj); for (int rep_ = 0; rep_ < REP_THR; ++rep_) thr_item(p, b, qt, lds); }
#endif
                for (int v = blk; v < 2048; v += G) { const int c = v & 63, bh = v >> 6; hgrn_local_item(p, l, bh >> 2, bh & 3, c, lds); }
                for (int v = blk; v < 1024; v += G) conv_item(p, l, v >> 7, v & 127, lds);
                for (int v = blk; v < 512; v += G) vt_item(p, v >> 6, v & 63, lds);
              }
            } else if (s == 3) {
                hgrn_scan(p);
                for (int v = blk; v < 512; v += G) { const int itp = v >> 8, rem = v & 255, b = rem & 7, jj = rem >> 3; const int qb = itp ? 63 - jj : jj; for (int rep_ = 0; rep_ < REP_ATTN; ++rep_) attn_item(p, b, qb, lds); }
            } else if (s == 4) {
                for (int rep_ = 0; rep_ < REP_HO; ++rep_) for (int v = blk; v < 2048; v += G) { const int c = v & 63, bh = v >> 6; hgrn_out_item(p, l, bh >> 2, bh & 3, c, lds); }
            } else if (s == 5) {
                pg8::EpiResid E; E.xs = xcur; E.xd = p.out; E.gate = modl + 2048;
                run_gemm(lds, HB, WOUT + (size_t)l * DM * DM, NTOK, DM, DM, E);
            } else if (s == 6) {
                rmsnorm_mod(p.out, p.norm_mlp_w + l * DM, modl, 3072, 4096, HB);
            } else if (s == 7) {
                pg8::EpiBf16<1> E; E.O = BIG; E.ldc = DFF;
                for (int rep_ = 0; rep_ < REP_GEMM; ++rep_) run_gemm(lds, HB, W1B + (size_t)l * DFF * DM, NTOK, DFF, DM, E);
            } else {
                pg8::EpiResid E; E.xs = p.out; E.xd = p.out; E.gate = modl + 5120;
                run_gemm(lds, BIG, W2B + (size_t)l * DM * DFF, NTOK, DM, DFF, E);
            }
        }
        if (ph + 1 < pin.ph_hi) { GRID_SYNC(); }
    }
#ifdef DIAG_CUT
    GRID_SYNC(); diag_phase(pin);
#endif
}

extern "C" void kernel_launch(void* const* d_in, const int* in_sizes, int n_in, void* d_out, int out_size, void* d_ws, size_t ws_size, hipStream_t stream) {
    static int grid_blocks = 0;
    if (grid_blocks == 0) {
        if (n_in != 17 || out_size != NTOK * DM || ws_size < WS_END) { fprintf(stderr, "kernel_launch: unexpected shapes (n_in %d out %d ws %zu need %zu)\n", n_in, out_size, ws_size, (size_t)WS_END); grid_blocks = -1; return; }
        int dev = 0, cus = 0, per_cu = 0;
        hipGetDevice(&dev);
        hipDeviceGetAttribute(&cus, hipDeviceAttributeMultiprocessorCount, dev);
        if (hipFuncSetAttribute((const void*)fwd_megakernel, hipFuncAttributeMaxDynamicSharedMemorySize, LDS_BYTES) != hipSuccess) { fprintf(stderr, "kernel_launch: hipFuncSetAttribute failed\n"); grid_blocks = -1; return; }
        if (hipOccupancyMaxActiveBlocksPerMultiprocessor(&per_cu, (const void*)fwd_megakernel, NTHREADS, LDS_BYTES) != hipSuccess || per_cu < 1) { fprintf(stderr, "kernel_launch: occupancy query says %d blocks/CU\n", per_cu); per_cu = 1; }
        (void)hipGetLastError();
        grid_blocks = cus * (per_cu > 1 ? 1 : per_cu);
    }
    if (grid_blocks < 0) return;
    Params p{};
    p.x = (const float*)d_in[0]; p.c = (const float*)d_in[1]; p.ada_w = (const float*)d_in[2]; p.ada_b = (const float*)d_in[3];
    p.norm_mix_w = (const float*)d_in[4]; p.norm_mlp_w = (const float*)d_in[5]; p.w_in = (const float*)d_in[6]; p.lb_logits = (const float*)d_in[7];
    p.onorm_w = (const float*)d_in[8]; p.cv_w = (const float*)d_in[9]; p.cv_b = (const float*)d_in[10]; p.cv_ln_w = (const float*)d_in[11]; p.cv_ln_b = (const float*)d_in[12];
    p.w_out = (const float*)d_in[13]; p.w1 = (const float*)d_in[14]; p.w2 = (const float*)d_in[15]; p.final_w = (const float*)d_in[16];
    p.out = (float*)d_out; p.ws = (unsigned char*)d_ws; p.ph_lo = 0; p.ph_hi = NPHASE;
#ifdef DIAG_CUT
    p.ph_hi = DIAG_CUT;
#endif
    void* args[] = {&p};
    hipError_t e = hipLaunchCooperativeKernel((const void*)fwd_megakernel, dim3(grid_blocks), dim3(NTHREADS), args, LDS_BYTES, stream);
    if (e != hipSuccess) fprintf(stderr, "kernel_launch: cooperative launch failed: %s (grid %d)\n", hipGetErrorString(e), grid_blocks);
}
```

```cpp
#include <hip/hip_runtime.h>
#include <hip/hip_cooperative_groups.h>
#include <cstdio>
#include <cstdint>
namespace cg = cooperative_groups;

#define LAS __attribute__((address_space(3)))
typedef unsigned short bf16_t;
typedef short bf16x8 __attribute__((ext_vector_type(8)));
typedef float f32x4 __attribute__((ext_vector_type(4)));
typedef unsigned u32x4 __attribute__((ext_vector_type(4)));
typedef unsigned u32x2 __attribute__((ext_vector_type(2)));

constexpr int DM = 1024, NB = 8, SEQ = 4096, DEPTH = 4, NTOK = NB * SEQ;
constexpr int DIN = 3624, DINP = 3840, DFF = 4096;
constexpr int OFF_HQ = 0, OFF_HF = 512, OFF_HI = 1024, OFF_HG = 1536, OFF_SQ = 2048, OFF_SK = 2304, OFF_SV = 2560, OFF_IQ = 2816, OFF_IK = 3072, OFF_IW = 3104, OFF_CU = 3112;
constexpr int TOPK = 256;
constexpr float EPS = 1e-6f;
constexpr int NTHREADS = 512;
constexpr int LDS_BYTES = 131072 + 64;

constexpr size_t WS_WIN = 0;
constexpr size_t WS_WOUT = WS_WIN + (size_t)DEPTH * DINP * DM * 2;
constexpr size_t WS_W1 = WS_WOUT + (size_t)DEPTH * DM * DM * 2;
constexpr size_t WS_W2 = WS_W1 + (size_t)DEPTH * DFF * DM * 2;
constexpr size_t WS_MOD = WS_W2 + (size_t)DEPTH * DM * DFF * 2;
constexpr size_t WS_LB = WS_MOD + (size_t)DEPTH * NB * 6 * DM * 4;
constexpr size_t WS_BIG = WS_LB + (size_t)DEPTH * 512 * 4;
constexpr size_t WS_MASK = WS_BIG + (size_t)NTOK * DINP * 2;
static_assert((size_t)NTOK * DINP * 2 + (size_t)NTOK * 128 * 4 <= (size_t)NTOK * DFF * 2, "mask overlay");
constexpr size_t WS_HB = WS_BIG + (size_t)NTOK * DFF * 2;
constexpr size_t WS_ST = WS_HB + (size_t)NTOK * DM * 2;
constexpr size_t WS_DEC = WS_ST + (size_t)32 * 64 * 16384 * 2;
constexpr size_t WS_VT = WS_DEC + (size_t)32 * 64 * 128 * 4;
constexpr size_t WS_THRT = WS_VT + (size_t)NB * 4 * 64 * SEQ * 2;
constexpr size_t WS_THRC = WS_THRT + (size_t)NTOK * 4;
constexpr size_t WS_BAR = WS_THRC + (size_t)NTOK * 4;
constexpr size_t WS_END = WS_BAR + 16384;
static_assert(WS_END <= (size_t)512 * 1024 * 1024, "workspace map exceeds 512 MiB");

struct Params {
    const float* x; const float* c; const float* ada_w; const float* ada_b; const float* norm_mix_w; const float* norm_mlp_w;
    const float* w_in; const float* lb_logits; const float* onorm_w; const float* cv_w; const float* cv_b; const float* cv_ln_w; const float* cv_ln_b;
    const float* w_out; const float* w1; const float* w2; const float* final_w;
    float* out; unsigned char* ws;
    int ph_lo, ph_hi;
};

typedef float f32x2_t __attribute__((ext_vector_type(2)));
typedef __bf16 bf16x2_t __attribute__((ext_vector_type(2)));
__device__ __forceinline__ unsigned cvt_pk_bf16(float lo, float hi) { const f32x2_t v = {lo, hi}; return __builtin_bit_cast(unsigned, __builtin_convertvector(v, bf16x2_t)); }
__device__ __forceinline__ float bf2f(short h) { return __uint_as_float(((unsigned)(unsigned short)h) << 16); }
__device__ __forceinline__ float bflo(unsigned w) { return __uint_as_float(w << 16); }
__device__ __forceinline__ float bfhi(unsigned w) { return __uint_as_float(w & 0xffff0000u); }
__device__ __forceinline__ bf16_t f2bf(float f) { return (bf16_t)(cvt_pk_bf16(f, 0.f) & 0xffffu); }
__device__ __forceinline__ float wave_sum(float v) {
    v += __shfl_xor(v, 32); v += __shfl_xor(v, 16); v += __shfl_xor(v, 8); v += __shfl_xor(v, 4); v += __shfl_xor(v, 2); v += __shfl_xor(v, 1); return v;
}
__device__ __forceinline__ float sigmoidf_(float x) { return __builtin_amdgcn_rcpf(1.f + __expf(-x)); }
__device__ __forceinline__ float siluf_(float x) { return x * __builtin_amdgcn_rcpf(1.f + __expf(-x)); }
__device__ __forceinline__ unsigned sortable(float f) { unsigned b = __float_as_uint(f); return b ^ ((b & 0x80000000u) ? 0xffffffffu : 0x80000000u); }
__device__ __forceinline__ f32x4 mfma16(bf16x8 a, bf16x8 b, f32x4 c) { return __builtin_amdgcn_mfma_f32_16x16x32_bf16(a, b, c, 0, 0, 0); }

namespace pg8 {
#define PG8_LAS __attribute__((address_space(3)))
constexpr int BM = 256, BK = 64, HALF = 128, HTB = HALF * BK * 2, STAGE_BYTES = 8 * HTB, NXCD = 8, WGM = 8;
__host__ __device__ __forceinline__ int lds_byte(int r, int c) { const int st = (r >> 4) * 2 + (c >> 5), rr = r & 15, cc = c & 31, ob = rr * 64 + cc * 2; return st * 1024 + (ob ^ (((ob >> 9) & 1) << 5)); }
__host__ __device__ __forceinline__ void stage_rc(int b, int& R, int& C) { const int st = b / 1024, sb = b % 1024, swz = sb ^ (((sb >> 9) & 1) << 5); R = (st >> 1) * 16 + swz / 64; C = (st & 1) * 32 + (swz % 64) / 2; }
__host__ __device__ __forceinline__ int perm32(int rho) { const int n = rho >> 4, i = rho & 15; return 8 * (i >> 2) + 4 * n + (i & 3); }
struct Unit { int pm, pn; };
struct Gemm { const bf16_t* A; const bf16_t* Bt; int M, N, K; };
struct StaticOrder {
    int nM, nN, nwg, G, c;
    __host__ __device__ void init(int M, int N, int G_, int c_) { nM = M / BM; nN = N / BM; nwg = nM * nN; G = G_; c = c_; }
    __host__ __device__ bool next(int i, Unit& u) const {
        const long L = (long)i * G + c; if (L >= nwg) return false;
        int wgid = (int)L; { const int q = nwg / NXCD, r = nwg % NXCD, xcd = wgid % NXCD, off = wgid / NXCD; wgid = (xcd < r ? xcd * (q + 1) : r * (q + 1) + (xcd - r) * q) + off; }
        const int nig = WGM * nN, gid = wgid / nig, fm = gid * WGM, gsz = (nM - fm) < WGM ? (nM - fm) : WGM;
        u.pm = fm + ((wgid % nig) % gsz); u.pn = (wgid % nig) / gsz; return true;
    }
    __device__ __forceinline__ void a_ready(const Unit&) const {}
    __device__ __forceinline__ void done(const Unit&) const {}
};

template <int ACT  > struct EpiBf16 {
    static constexpr bool PERM = true, AFTER_DRAIN = false;
    bf16_t* O; int ldc;
    __device__ __forceinline__ void operator()(const f32x4 (&acc)[2][2][4][2], const Unit& u, int wr, int wc, int fr, int fq) const {
        const int row0 = u.pm * BM + wr * 64 + fr, col0 = u.pn * BM + wc * 32 + 8 * fq;
#pragma unroll
        for (int ai = 0; ai < 2; ++ai)
#pragma unroll
            for (int m = 0; m < 4; ++m) { bf16_t* rowp = O + (size_t)(row0 + ai * HALF + m * 16) * ldc + col0;
#pragma unroll
                for (int bj = 0; bj < 2; ++bj) { f32x4 v0 = acc[ai][bj][m][0], v1 = acc[ai][bj][m][1];
                    if (ACT == 1) {
#pragma unroll
                        for (int j = 0; j < 4; ++j) { const float a = fmaxf(v0[j], 0.f), b = fmaxf(v1[j], 0.f); v0[j] = a * a; v1[j] = b * b; } }
                    u32x4 w; w.x = cvt_pk_bf16(v0[0], v0[1]); w.y = cvt_pk_bf16(v0[2], v0[3]); w.z = cvt_pk_bf16(v1[0], v1[1]); w.w = cvt_pk_bf16(v1[2], v1[3]);
                    *(u32x4*)(rowp + bj * HALF) = w; } }
    }
};
struct EpiResid {
    static constexpr bool PERM = true, AFTER_DRAIN = false;
    const float* xs; float* xd; const float* gate;
    __device__ __forceinline__ void operator()(const f32x4 (&acc)[2][2][4][2], const Unit& u, int wr, int wc, int fr, int fq) const {
        const int row0 = u.pm * BM + wr * 64 + fr, col0 = u.pn * BM + wc * 32 + 8 * fq;
        const float* gp = gate + (size_t)((u.pm * BM) >> 12) * 6144 + col0;
        f32x4 gv[2][2];
#pragma unroll
        for (int bj = 0; bj < 2; ++bj)
#pragma unroll
            for (int n = 0; n < 2; ++n) gv[bj][n] = *(const f32x4*)(gp + bj * HALF + 4 * n);
#pragma unroll
        for (int ai = 0; ai < 2; ++ai)
#pragma unroll
            for (int m = 0; m < 4; ++m) { const size_t off = (size_t)(row0 + ai * HALF + m * 16) * DM + col0;
#pragma unroll
                for (int bj = 0; bj < 2; ++bj)
#pragma unroll
                    for (int n = 0; n < 2; ++n) { const f32x4 xv = *(const f32x4*)(xs + off + bj * HALF + 4 * n);
                        *(f32x4*)(xd + off + bj * HALF + 4 * n) = xv + gv[bj][n] * acc[ai][bj][m][n]; } }
    }
};
template <class Epi, class Sched, bool ALIGN_EPI = false, bool SP2 = false>
__device__ __forceinline__ void gemm_phase(PG8_LAS unsigned char* lds, const Gemm g, const Sched& S, const Epi& E) {
    int tid_ = threadIdx.x; asm volatile("" : "+v"(tid_)); const int tid = tid_, wid = __builtin_amdgcn_readfirstlane(tid >> 6), lane = tid & 63, wr = wid >> 2, wc = wid & 3, fr = lane & 15, fq = lane >> 4;
    const int K = g.K, nt = K / BK;
    unsigned voffA[2], voffB[2];
#pragma unroll
    for (int i = 0; i < 2; ++i) { int R, C; stage_rc(tid * 16 + i * 8192, R, C); const int Rb = Epi::PERM ? ((R & ~31) + perm32(R & 31)) : R;
        voffA[i] = (unsigned)(R * K + C) * 2u; voffB[i] = (unsigned)(Rb * K + C) * 2u; }
    const size_t kstep = (size_t)(BK * 2);
    const size_t hstep = (size_t)HALF * K * 2;
    const size_t tstep = 2 * hstep;
    const unsigned ldsw = (unsigned)wid * 1024u;
    const int aoff = lds_byte(wr * 64 + fr, fq * 8), boff = lds_byte(wc * 32 + fr, fq * 8);
#define PG8_SA(b, h) (((b) * 2 + (h)) * HTB)
#define PG8_SB(b, h) ((4 + (b) * 2 + (h)) * HTB)
#define PG8_STAGE(bufoff, gbase, voff) do { _Pragma("unroll") for (int _i = 0; _i < 2; ++_i) \
        __builtin_amdgcn_global_load_lds((const unsigned*)((const char*)(gbase) + (voff)[_i]), (PG8_LAS unsigned*)(lds + (bufoff) + ldsw + _i * 8192), 16, 0, 0); } while (0)
#define PG8_LDA(dst, b, h) do { _Pragma("unroll") for (int m = 0; m < 4; ++m) _Pragma("unroll") for (int k = 0; k < 2; ++k) dst[m][k] = *(const PG8_LAS bf16x8*)(lds + PG8_SA(b, h) + aoff + m * 2048 + k * 1024); } while (0)
#define PG8_LDB(dst, b, h) do { _Pragma("unroll") for (int n = 0; n < 2; ++n) _Pragma("unroll") for (int k = 0; k < 2; ++k) dst[n][k] = *(const PG8_LAS bf16x8*)(lds + PG8_SB(b, h) + boff + n * 2048 + k * 1024); } while (0)
#define PG8_MMA(ai, bj, At, Bt) do { __builtin_amdgcn_s_setprio(1); _Pragma("unroll") for (int m = 0; m < 4; ++m) _Pragma("unroll") for (int n = 0; n < 2; ++n) _Pragma("unroll") for (int k = 0; k < 2; ++k) \
        acc[ai][bj][m][n] = __builtin_amdgcn_mfma_f32_16x16x32_bf16(Bt[n][k], At[m][k], acc[ai][bj][m][n], 0, 0, 0); __builtin_amdgcn_s_setprio(0); } while (0)
#define PG8_WAIT_V(n) asm volatile("s_waitcnt vmcnt(" #n ")" ::: "memory")
#define PG8_WAIT_L(n) asm volatile("s_waitcnt lgkmcnt(" #n ")" ::: "memory")
#define PG8_BAR __builtin_amdgcn_s_barrier()
#define PG8_SCHED __builtin_amdgcn_sched_barrier(0)
    Unit cur, nxt; int ui = 0;
    if (!S.next(0, cur)) return;
    f32x4 acc[2][2][4][2];
#pragma unroll
    for (int a = 0; a < 2; ++a)
#pragma unroll
        for (int b = 0; b < 2; ++b)
#pragma unroll
            for (int m = 0; m < 4; ++m)
#pragma unroll
                for (int n = 0; n < 2; ++n) acc[a][b][m][n] = (f32x4){0.f, 0.f, 0.f, 0.f};
    bf16x8 At[4][2], B0[2][2], B1[2][2];
    const char* cA = (const char*)g.A + (size_t)cur.pm * tstep; const char* cB = (const char*)g.Bt + (size_t)cur.pn * tstep;
    S.a_ready(cur);
    if constexpr (SP2) {
        PG8_STAGE(PG8_SB(0, 0), cB, voffB); PG8_STAGE(PG8_SB(0, 1), cB + hstep, voffB); PG8_STAGE(PG8_SA(0, 0), cA, voffA); PG8_STAGE(PG8_SA(0, 1), cA + hstep, voffA);
        if (wr == 1) PG8_BAR;
        PG8_WAIT_V(2); PG8_BAR;
        PG8_STAGE(PG8_SB(1, 0), cB + kstep, voffB); PG8_STAGE(PG8_SA(1, 0), cA + kstep, voffA); PG8_STAGE(PG8_SB(1, 1), cB + hstep + kstep, voffB);
        PG8_WAIT_V(6); PG8_BAR;
    } else {
        PG8_STAGE(PG8_SB(0, 0), cB, voffB); PG8_STAGE(PG8_SA(0, 0), cA, voffA); PG8_STAGE(PG8_SB(0, 1), cB + hstep, voffB); PG8_STAGE(PG8_SA(0, 1), cA + hstep, voffA);
        if (wr == 1) PG8_BAR;
        PG8_WAIT_V(4); PG8_BAR;
        PG8_STAGE(PG8_SB(1, 0), cB + kstep, voffB); PG8_STAGE(PG8_SA(1, 0), cA + kstep, voffA); PG8_STAGE(PG8_SB(1, 1), cB + hstep + kstep, voffB);
        PG8_WAIT_V(6); PG8_BAR;
    }
    for (;;) {
        const bool has_next = S.next(ui + 1, nxt);
        const char* nA = has_next ? (const char*)g.A + (size_t)nxt.pm * tstep : cA; const char* nB = has_next ? (const char*)g.Bt + (size_t)nxt.pn * tstep : cB;
        for (int t = 0; t < nt; t += 2) {
            const bool last = (t == nt - 2);
            const char* a1 = cA + (size_t)(t + 1) * kstep;
            const char* a2 = last ? nA : cA + (size_t)(t + 2) * kstep; const char* b2 = last ? nB : cB + (size_t)(t + 2) * kstep;
            const char* a3 = a2 + kstep; const char* b3 = b2 + kstep;
            if (last && has_next) S.a_ready(nxt);
            if constexpr (SP2) {
            PG8_LDB(B0, 0, 0); PG8_LDB(B1, 0, 1); PG8_SCHED; PG8_LDA(At, 0, 0); PG8_STAGE(PG8_SA(1, 1), a1 + hstep, voffA);
            PG8_WAIT_V(8); PG8_WAIT_L(0); PG8_BAR; PG8_MMA(0, 0, At, B0); PG8_MMA(0, 1, At, B1); PG8_BAR; PG8_SCHED;
            PG8_LDA(At, 0, 1); PG8_STAGE(PG8_SB(0, 0), b2, voffB); PG8_STAGE(PG8_SB(0, 1), b2 + hstep, voffB); PG8_STAGE(PG8_SA(0, 0), a2, voffA);
            PG8_WAIT_V(8); PG8_WAIT_L(0); PG8_BAR; PG8_MMA(1, 0, At, B0); PG8_MMA(1, 1, At, B1); PG8_BAR; PG8_SCHED;
            PG8_LDB(B0, 1, 0); PG8_LDB(B1, 1, 1); PG8_SCHED; PG8_LDA(At, 1, 0); PG8_STAGE(PG8_SA(0, 1), a2 + hstep, voffA);
            PG8_WAIT_V(8); PG8_WAIT_L(0); PG8_BAR; PG8_MMA(0, 0, At, B0); PG8_MMA(0, 1, At, B1); PG8_BAR; PG8_SCHED;
            PG8_LDA(At, 1, 1); PG8_STAGE(PG8_SB(1, 0), b3, voffB); PG8_STAGE(PG8_SB(1, 1), b3 + hstep, voffB); PG8_STAGE(PG8_SA(1, 0), a3, voffA);
            PG8_WAIT_V(8); PG8_WAIT_L(0); PG8_BAR; PG8_MMA(1, 0, At, B0); PG8_MMA(1, 1, At, B1); PG8_BAR; PG8_SCHED;
            } else {
            PG8_LDB(B0, 0, 0); PG8_SCHED; PG8_LDA(At, 0, 0); PG8_STAGE(PG8_SA(1, 1), a1 + hstep, voffA);
            PG8_WAIT_L(8); PG8_BAR; PG8_WAIT_L(0); PG8_MMA(0, 0, At, B0); PG8_BAR; PG8_SCHED;
            PG8_LDB(B1, 0, 1); PG8_STAGE(PG8_SB(0, 0), b2, voffB);
            PG8_BAR; PG8_WAIT_L(0); PG8_MMA(0, 1, At, B1); PG8_BAR;
            PG8_LDA(At, 0, 1); PG8_STAGE(PG8_SA(0, 0), a2, voffA);
            PG8_BAR; PG8_WAIT_L(0); PG8_MMA(1, 0, At, B0); PG8_BAR; PG8_SCHED;
            PG8_STAGE(PG8_SB(0, 1), b2 + hstep, voffB);
            PG8_WAIT_V(6); PG8_BAR; PG8_MMA(1, 1, At, B1); PG8_BAR;
            PG8_LDB(B0, 1, 0); PG8_SCHED; PG8_LDA(At, 1, 0); PG8_STAGE(PG8_SA(0, 1), a2 + hstep, voffA);
            PG8_WAIT_L(8); PG8_BAR; PG8_WAIT_L(0); PG8_MMA(0, 0, At, B0); PG8_BAR; PG8_SCHED;
            PG8_LDB(B1, 1, 1); PG8_STAGE(PG8_SB(1, 0), b3, voffB);
            PG8_BAR; PG8_WAIT_L(0); PG8_MMA(0, 1, At, B1); PG8_BAR;
            PG8_LDA(At, 1, 1); PG8_STAGE(PG8_SA(1, 0), a3, voffA);
            PG8_BAR; PG8_WAIT_L(0); PG8_MMA(1, 0, At, B0); PG8_BAR; PG8_SCHED;
            PG8_STAGE(PG8_SB(1, 1), b3 + hstep, voffB);
            PG8_WAIT_V(6); PG8_BAR; PG8_MMA(1, 1, At, B1); PG8_BAR;
            }
        }
        if constexpr (ALIGN_EPI) { if (wr == 0) PG8_BAR; }
        if constexpr (!Epi::AFTER_DRAIN) { E(acc, cur, wr, wc, fr, fq); S.done(cur); }
        if (!has_next) break;
#pragma unroll
        for (int a = 0; a < 2; ++a)
#pragma unroll
            for (int b = 0; b < 2; ++b)
#pragma unroll
                for (int m = 0; m < 4; ++m)
#pragma unroll
                    for (int n = 0; n < 2; ++n) acc[a][b][m][n] = (f32x4){0.f, 0.f, 0.f, 0.f};
        cur = nxt; cA = nA; cB = nB; ++ui;
        if constexpr (ALIGN_EPI) { if (wr == 1) PG8_BAR; }
    }
    PG8_WAIT_V(0);
    if constexpr (!ALIGN_EPI) { if (wr == 0) PG8_BAR; }
    PG8_BAR;
    if constexpr (Epi::AFTER_DRAIN) { E.fused(acc, cur, wr, wc, fr, fq, lds, wid, lane); S.done(cur); }
#undef PG8_SA
#undef PG8_SB
#undef PG8_STAGE
#undef PG8_LDA
#undef PG8_LDB
#undef PG8_MMA
#undef PG8_WAIT_V
#undef PG8_WAIT_L
#undef PG8_BAR
#undef PG8_SCHED
}
}

#ifndef REP_THR
#define REP_THR 1
#endif
#ifndef REP_NORM
#define REP_NORM 1
#endif
#ifndef REP_PRO
#define REP_PRO 1
#endif
#ifndef REP_ATTN
#define REP_ATTN 1
#endif
#ifndef REP_S2
#define REP_S2 1
#endif
#ifndef REP_GEMM
#define REP_GEMM 1
#endif
#ifndef REP_HO
#define REP_HO 1
#endif
__device__ __forceinline__ int ltid() { int t = threadIdx.x; asm volatile("" : "+v"(t)); return t; }
#define TID ltid()

__device__ __forceinline__ void cvt_kind(const float* __restrict__ src, bf16_t* __restrict__ dst, int K, int N, int Npad, LAS float* tl) {
    const int tid = TID, nk = K / 64, nn = Npad / 64, per = nk * nn, total = DEPTH * per;
    for (int t = blockIdx.x; t < total; t += gridDim.x) {
        const int l = t / per, r = t % per, kt = r / nn, nt = r % nn;
        const float* s = src + (size_t)l * K * N; bf16_t* d = dst + (size_t)l * Npad * K;
#pragma unroll
        for (int i = 0; i < 2; ++i) { const int kr = (tid >> 4) + 32 * i, nc = (tid & 15) * 4, n = nt * 64 + nc;
            f32x4 v = (f32x4){0.f, 0.f, 0.f, 0.f};
            if (n < N) v = *(const f32x4*)(s + (size_t)(kt * 64 + kr) * N + n);
            tl[kr * 65 + nc + 0] = v[0]; tl[kr * 65 + nc + 1] = v[1]; tl[kr * 65 + nc + 2] = v[2]; tl[kr * 65 + nc + 3] = v[3]; }
        __syncthreads();
        { const int n = tid >> 3, k8 = (tid & 7) * 8; u32x4 w;
            w.x = cvt_pk_bf16(tl[(k8 + 0) * 65 + n], tl[(k8 + 1) * 65 + n]); w.y = cvt_pk_bf16(tl[(k8 + 2) * 65 + n], tl[(k8 + 3) * 65 + n]);
            w.z = cvt_pk_bf16(tl[(k8 + 4) * 65 + n], tl[(k8 + 5) * 65 + n]); w.w = cvt_pk_bf16(tl[(k8 + 6) * 65 + n], tl[(k8 + 7) * 65 + n]);
            *(u32x4*)(d + (size_t)(nt * 64 + n) * K + kt * 64 + k8) = w; }
        __syncthreads();
    }
}

__device__ __forceinline__ void mod_phase(const Params& p, LAS float* sm) {
    const int tid = TID;
    LAS float* cact = sm; LAS float* red = sm + 8192;
    for (int i = tid; i < NB * DM; i += NTHREADS) cact[i] = siluf_(p.c[i]);
    __syncthreads();
    float* MOD = (float*)(p.ws + WS_MOD);
    for (int it = blockIdx.x; it < DEPTH * 96; it += gridDim.x) {
        const int l = it / 96, j0 = (it % 96) * 64, col = tid & 63, seg = tid >> 6;
        const float* w = p.ada_w + (size_t)l * DM * 6144 + j0 + col;
        float a0 = 0.f, a1 = 0.f, a2 = 0.f, a3 = 0.f, a4 = 0.f, a5 = 0.f, a6 = 0.f, a7 = 0.f;
#pragma unroll 8
        for (int k = seg * 128; k < seg * 128 + 128; ++k) { const float wv = w[(size_t)k * 6144];
            a0 += cact[0 * DM + k] * wv; a1 += cact[1 * DM + k] * wv; a2 += cact[2 * DM + k] * wv; a3 += cact[3 * DM + k] * wv;
            a4 += cact[4 * DM + k] * wv; a5 += cact[5 * DM + k] * wv; a6 += cact[6 * DM + k] * wv; a7 += cact[7 * DM + k] * wv; }
        red[(seg * 8 + 0) * 64 + col] = a0; red[(seg * 8 + 1) * 64 + col] = a1; red[(seg * 8 + 2) * 64 + col] = a2; red[(seg * 8 + 3) * 64 + col] = a3;
        red[(seg * 8 + 4) * 64 + col] = a4; red[(seg * 8 + 5) * 64 + col] = a5; red[(seg * 8 + 6) * 64 + col] = a6; red[(seg * 8 + 7) * 64 + col] = a7;
        __syncthreads();
        { const int b = tid >> 6; float s = p.ada_b[l * 6144 + j0 + col];
#pragma unroll
            for (int sg = 0; sg < 8; ++sg) s += red[(sg * 8 + b) * 64 + col];
            MOD[(size_t)(l * NB + b) * 6144 + j0 + col] = s; }
        __syncthreads();
    }
}

__device__ __forceinline__ void lb_phase(const Params& p) {
    if (blockIdx.x != 0) return;
    const int k = TID; float* LB = (float*)(p.ws + WS_LB);
    const float v0 = p.lb_logits[k], v1 = p.lb_logits[512 + k], v2 = p.lb_logits[1024 + k], v3 = p.lb_logits[1536 + k];
    const float mx = fmaxf(fmaxf(v0, v1), fmaxf(v2, v3));
    const float e0 = expf(v0 - mx), e1 = expf(v1 - mx), e2 = expf(v2 - mx), e3 = expf(v3 - mx), inv = 1.f / (e0 + e1 + e2 + e3);
    const float p0 = e0 * inv, p1 = e1 * inv, p2 = e2 * inv, p3 = e3 * inv;
    LB[k] = p0 - p0; LB[512 + k] = (p0 + p1) - p0; LB[1024 + k] = ((p0 + p1) + p2) - p0; LB[1536 + k] = (((p0 + p1) + p2) + p3) - p0;
}

__device__ __forceinline__ void rmsnorm_mod(const float* __restrict__ xs, const float* __restrict__ w, const float* __restrict__ mod, int sh_off, int sc_off, bf16_t* __restrict__ dst) {
    const int tid = TID, wave = tid >> 6, lane = tid & 63;
    for (int row = blockIdx.x * 8 + wave; row < NTOK; row += gridDim.x * 8) {
        const float* xr = xs + (size_t)row * DM; f32x4 v[4]; float ss = 0.f;
#pragma unroll
        for (int i = 0; i < 4; ++i) { v[i] = *(const f32x4*)(xr + i * 256 + lane * 4); ss += v[i][0] * v[i][0] + v[i][1] * v[i][1] + v[i][2] * v[i][2] + v[i][3] * v[i][3]; }
        ss = wave_sum(ss);
        const float rstd = rsqrtf(ss * (1.f / DM) + EPS);
        const float* mb = mod + (size_t)(row >> 12) * 6144;
#pragma unroll
        for (int i = 0; i < 4; ++i) { const int col = i * 256 + lane * 4;
            const f32x4 ww = *(const f32x4*)(w + col), sc = *(const f32x4*)(mb + sc_off + col), sh = *(const f32x4*)(mb + sh_off + col);
            const f32x4 h = (v[i] * rstd * ww) * (sc + 1.f) + sh;
            u32x2 o; o.x = cvt_pk_bf16(h[0], h[1]); o.y = cvt_pk_bf16(h[2], h[3]);
            *(u32x2*)(dst + (size_t)row * DM + col) = o; }
    }
}
__device__ __forceinline__ void final_norm(float* __restrict__ x, const float* __restrict__ w) {
    const int tid = TID, wave = tid >> 6, lane = tid & 63;
    for (int row = blockIdx.x * 8 + wave; row < NTOK; row += gridDim.x * 8) {
        float* xr = x + (size_t)row * DM; f32x4 v[4]; float ss = 0.f;
#pragma unroll
        for (int i = 0; i < 4; ++i) { v[i] = *(const f32x4*)(xr + i * 256 + lane * 4); ss += v[i][0] * v[i][0] + v[i][1] * v[i][1] + v[i][2] * v[i][2] + v[i][3] * v[i][3]; }
        ss = wave_sum(ss);
        const float rstd = rsqrtf(ss * (1.f / DM) + EPS);
#pragma unroll
        for (int i = 0; i < 4; ++i) { const int col = i * 256 + lane * 4; const f32x4 ww = *(const f32x4*)(w + col); *(f32x4*)(xr + col) = v[i] * rstd * ww; }
    }
}

__device__ __forceinline__ void vt_item(const Params& p, int b, int tt, LAS unsigned char* sm) {
    const int tid = TID; LAS bf16_t* vb = (LAS bf16_t*)sm;
    const bf16_t* proj = (const bf16_t*)(p.ws + WS_BIG) + (size_t)(b * SEQ + tt * 64) * DINP + OFF_SV;
#pragma unroll
    for (int i = 0; i < 4; ++i) { const int idx = tid + NTHREADS * i, row = idx >> 5, c8 = (idx & 31) * 8;
        *(LAS bf16x8*)(vb + row * 264 + c8) = *(const bf16x8*)(proj + (size_t)row * DINP + c8); }
    __syncthreads();
    { const int col = tid >> 1, half = tid & 1;
        bf16_t* dst = (bf16_t*)(p.ws + WS_VT) + ((size_t)(b * 4 + (col >> 6)) * 64 + (col & 63)) * SEQ + tt * 64 + half * 32;
#pragma unroll
        for (int i = 0; i < 4; ++i) { bf16x8 o;
#pragma unroll
            for (int e = 0; e < 8; ++e) o[e] = (short)vb[(half * 32 + i * 8 + e) * 264 + col];
            *(bf16x8*)(dst + i * 8) = o; } }
    __syncthreads();
}

__device__ __forceinline__ void conv_item(const Params& p, int l, int b, int tt, LAS unsigned char* sm) {
    const int tid = TID; LAS float* hb = (LAS float*)sm;
    LAS float* ob = (LAS float*)(sm + 62 * 256 * 4);
    const int t0 = tt * 32;
    const bf16_t* proj = (const bf16_t*)(p.ws + WS_BIG) + (size_t)b * SEQ * DINP + OFF_CU;
#pragma unroll
    for (int i = 0; i < 4; ++i) { const int idx = tid + NTHREADS * i;
        if (idx < 62 * 32) { const int row = idx >> 5, c8 = (idx & 31) * 8, t = t0 - 30 + row;
            f32x4 h0 = (f32x4){0.f, 0.f, 0.f, 0.f}, h1 = h0;
            if (t >= 0) { const bf16x8 a = *(const bf16x8*)(proj + (size_t)t * DINP + c8), g = *(const bf16x8*)(proj + (size_t)t * DINP + 256 + c8);
#pragma unroll
                for (int j = 0; j < 4; ++j) { h0[j] = bf2f(a[j]) * sigmoidf_(bf2f(g[j])); h1[j] = bf2f(a[4 + j]) * sigmoidf_(bf2f(g[4 + j])); } }
            *(LAS f32x4*)(hb + row * 256 + c8) = h0; *(LAS f32x4*)(hb + row * 256 + c8 + 4) = h1; } }
    __syncthreads();
    { const int ch = tid & 255, half = tid >> 8;
        float w[31];
#pragma unroll
        for (int j = 0; j < 31; ++j) w[j] = p.cv_w[(size_t)(l * 31 + j) * 256 + ch];
        const float bias = p.cv_b[l * 256 + ch];
        float o[16];
#pragma unroll
        for (int i = 0; i < 16; ++i) o[i] = bias;
#pragma unroll
        for (int r = 0; r < 46; ++r) { const float hv = hb[(half * 16 + r) * 256 + ch];
#pragma unroll
            for (int i = 0; i < 16; ++i) { const int j = r - i; if (j >= 0 && j <= 30) o[i] = fmaf(hv, w[j], o[i]); } }
#pragma unroll
        for (int i = 0; i < 16; ++i) ob[(half * 16 + i) * 256 + ch] = o[i]; }
    __syncthreads();
    { const int wave = tid >> 6, lane = tid & 63;
        const f32x4 lw = *(const f32x4*)(p.cv_ln_w + l * 256 + lane * 4), lbv = *(const f32x4*)(p.cv_ln_b + l * 256 + lane * 4);
        bf16_t* mix = (bf16_t*)(p.ws + WS_HB);
#pragma unroll
        for (int i = 0; i < 4; ++i) { const int tl = wave * 4 + i;
            const f32x4 xv = *(LAS f32x4*)(ob + tl * 256 + lane * 4);
            const float mu = wave_sum(xv[0] + xv[1] + xv[2] + xv[3]) * (1.f / 256.f);
            const f32x4 dv = xv - mu;
            const float var = wave_sum(dv[0] * dv[0] + dv[1] * dv[1] + dv[2] * dv[2] + dv[3] * dv[3]) * (1.f / 256.f);
            const float rs = rsqrtf(var + EPS);
            const f32x4 y = dv * rs * lw + lbv;
            u32x2 o2; o2.x = cvt_pk_bf16(siluf_(y[0]), siluf_(y[1])); o2.y = cvt_pk_bf16(siluf_(y[2]), siluf_(y[3]));
            *(u32x2*)(mix + (size_t)(b * SEQ + t0 + tl) * DM + 768 + lane * 4) = o2; } }
    __syncthreads();
}

constexpr float IDX_WSCALE = 0.35355339059327373f * 0.17677669529663687f;
__device__ __forceinline__ f32x4 idx_scores(const bf16x8 ka, const bf16x8 (&qi)[8], const float (&wq)[8]) {
    f32x4 s = (f32x4){0.f, 0.f, 0.f, 0.f};
#pragma unroll
    for (int h = 0; h < 8; ++h) { const f32x4 d = mfma16(ka, qi[h], (f32x4){0.f, 0.f, 0.f, 0.f});
#pragma unroll
        for (int r = 0; r < 4; ++r) s[r] = __builtin_fmaf(wq[h], fmaxf(d[r], 0.f), s[r]); }
    return s;
}

__device__ __forceinline__ void cnt_ge(int& cn, unsigned a, unsigned b) { asm("v_cmp_ge_u32 vcc, %1, %2\n\tv_addc_co_u32 %0, vcc, 0, %0, vcc" : "+v"(cn) : "v"(a), "v"(b) : "vcc"); }
constexpr int TH_ROW = 40, TH_BUF = 1024 * TH_ROW * 2, TH_CNT = TH_BUF;
__device__ __forceinline__ void thr_item(const Params& p, int b, int qt, LAS unsigned char* sm) {
    const int tid = TID, w = __builtin_amdgcn_readfirstlane(tid >> 6), l = tid & 63, c16 = l & 15, g = l >> 4;
    LAS unsigned* cnt = (LAS unsigned*)(sm + TH_CNT);
    const bf16_t* proj = (const bf16_t*)(p.ws + WS_BIG) + (size_t)b * SEQ * DINP;
    const int q = qt * 16 + c16;
    const bf16_t* qrow = proj + (size_t)q * DINP;
    bf16x8 qi[8]; float wq[8];
#pragma unroll
    for (int h = 0; h < 8; ++h) qi[h] = *(const bf16x8*)(qrow + OFF_IQ + h * 32 + g * 8);
    { const bf16x8 wv = *(const bf16x8*)(qrow + OFF_IW);
#pragma unroll
        for (int h = 0; h < 8; ++h) wq[h] = bf2f(wv[h]) * IDX_WSCALE; }
    unsigned sc[32][4];
    const int ni = (qt >= w) ? ((qt - w) >> 3) + 1 : 0;
    const int nchunk = (qt >> 6) + 1;
    const bf16_t* gsrc = proj + (size_t)(tid >> 2) * DINP + OFF_IK + (tid & 3) * 8;
    const int ldst = (tid >> 2) * TH_ROW + (tid & 3) * 8;
    bf16x8 stg[8];
#define TH_LOAD(ck_) do { const bf16_t* s_ = gsrc + (size_t)(ck_) * 1024 * DINP; _Pragma("unroll") for (int m_ = 0; m_ < 8; ++m_) stg[m_] = *(const bf16x8*)(s_ + (size_t)(128 * m_) * DINP); } while (0)
#define TH_STORE() do { LAS bf16_t* d_ = (LAS bf16_t*)sm + ldst; _Pragma("unroll") for (int m_ = 0; m_ < 8; ++m_) *(LAS bf16x8*)(d_ + 128 * m_ * TH_ROW) = stg[m_]; } while (0)
    TH_LOAD(0);
    for (int i = tid; i < 48 * 16; i += NTHREADS) cnt[i] = 0u;
#pragma unroll
    for (int ck = 0; ck < 4; ++ck) {
        if (ck < nchunk) {
            TH_STORE();
            __syncthreads();
            if (ck + 1 < nchunk) TH_LOAD(ck + 1);
            LAS bf16_t* B = (LAS bf16_t*)sm;
#pragma unroll
            for (int j = 0; j < 8; ++j) { const int i = ck * 8 + j, kt = w + 8 * i;
                if (kt <= qt) { const bf16x8 ka = *(LAS bf16x8*)(B + ((j * 8 + w) * 16 + c16) * TH_ROW + g * 8);
                    const f32x4 s = idx_scores(ka, qi, wq);
#pragma unroll
                    for (int r = 0; r < 4; ++r) { const int key = kt * 16 + 4 * g + r; sc[i][r] = (key <= q) ? sortable(s[r]) : 0u; }
                } else { sc[i][0] = 0u; sc[i][1] = 0u; sc[i][2] = 0u; sc[i][3] = 0u; } }
            if (ck + 1 < nchunk) __syncthreads();
        } else {
#pragma unroll
            for (int j = 0; j < 8; ++j) { sc[ck * 8 + j][0] = 0u; sc[ck * 8 + j][1] = 0u; sc[ck * 8 + j][2] = 0u; sc[ck * 8 + j][3] = 0u; }
        }
    }
#undef TH_LOAD
#undef TH_STORE
#define TH_XCHG(tot_) do { __hip_atomic_fetch_add(&cnt[it * 16 + c16], (unsigned)cn, __ATOMIC_RELAXED, __HIP_MEMORY_SCOPE_WORKGROUP); __syncthreads(); tot_ = (int)cnt[it * 16 + c16]; } while (0)
    unsigned T = 0u; bool done = false; int it = 0;
    for (; it < 32; ++it) {
        const unsigned cand = T | (1u << (31 - it)); int cn = 0;
#pragma unroll
        for (int gi = 0; gi < 4; ++gi) if (ni > 8 * gi) {
#pragma unroll
            for (int i = 8 * gi; i < 8 * gi + 8; ++i) { cnt_ge(cn, sc[i][0], cand); cnt_ge(cn, sc[i][1], cand); cnt_ge(cn, sc[i][2], cand); cnt_ge(cn, sc[i][3], cand); } }
        int tot; TH_XCHG(tot);
        if (!done) { if (tot >= TOPK) T = cand; if (tot == TOPK) done = true; }
        if (__all(done)) { ++it; break; }
    }
    unsigned ceq = 4095u; bool tied = false;
    const bool open = !done && (T != 0u);
    if (!__all(!open)) {
        int ngt = 0, nge = 0;
        for (int e = 0; e < 2; ++e, ++it) {
            const unsigned cand = (e == 0) ? T + 1u : T; int cn = 0;
#pragma unroll
            for (int gi = 0; gi < 4; ++gi) if (ni > 8 * gi) {
#pragma unroll
            for (int i = 8 * gi; i < 8 * gi + 8; ++i) { cnt_ge(cn, sc[i][0], cand); cnt_ge(cn, sc[i][1], cand); cnt_ge(cn, sc[i][2], cand); cnt_ge(cn, sc[i][3], cand); } }
            int tot; TH_XCHG(tot);
            if (e == 0) ngt = tot; else nge = tot;
        }
        const int need = TOPK - ngt; const bool excess = open && (nge - ngt > need);
#pragma unroll
        for (int i = 0; i < 32; ++i)
#pragma unroll
            for (int r = 0; r < 4; ++r) sc[i][r] = (sc[i][r] == T) ? (unsigned)((w + 8 * i) * 16 + 4 * g + r) : (sc[i][r] > T ? 0xfffffffeu : 0xffffffffu);
        unsigned c = 0u;
        for (int s = 0; s < 12; ++s, ++it) {
            const unsigned cand = c | (1u << (11 - s)); int cn = 0;
#pragma unroll
            for (int gi = 0; gi < 4; ++gi) if (ni > 8 * gi) {
#pragma unroll
                for (int i = 8 * gi; i < 8 * gi + 8; ++i) { cnt_ge(cn, cand - 1u, sc[i][0]); cnt_ge(cn, cand - 1u, sc[i][1]); cnt_ge(cn, cand - 1u, sc[i][2]); cnt_ge(cn, cand - 1u, sc[i][3]); } }
            int tot; TH_XCHG(tot);
            if (tot < need) c = cand;
        }
        if (excess) ceq = c;
        tied = true;
    }
#undef TH_XCHG
    LAS unsigned* lm = (LAS unsigned*)sm;
    __syncthreads();
    for (int i = tid; i < 2048; i += NTHREADS) lm[i] = 0u;
    __syncthreads();
    { const unsigned Tm = T > 1u ? T : 1u; const bool allow_eq = (T != 0u);
#pragma unroll
        for (int gi = 0; gi < 4; ++gi) if (ni > 8 * gi) {
#pragma unroll
            for (int i = 8 * gi; i < 8 * gi + 8; ++i) { unsigned nib = 0u;
#pragma unroll
                for (int r = 0; r < 4; ++r) { const unsigned v = sc[i][r];
                    const bool s_ = tied ? ((v == 0xfffffffeu) || (allow_eq && v <= ceq)) : (v >= Tm);
                    nib |= s_ ? (1u << r) : 0u; }
                const int kt = w + 8 * i;
                if (nib) __hip_atomic_fetch_or(&lm[c16 * 128 + (kt >> 1)], nib << (4 * g + 16 * (kt & 1)), __ATOMIC_RELAXED, __HIP_MEMORY_SCOPE_WORKGROUP); } }
    }
    __syncthreads();
    { unsigned* gm = (unsigned*)(p.ws + WS_MASK) + (size_t)(b * SEQ + qt * 16) * 128;
        *(u32x4*)(gm + tid * 4) = *(LAS u32x4*)(lm + tid * 4); }
    __syncthreads();
}

constexpr int AT_KROW = 264, AT_IROW = 40, AT_VROW = 40;
constexpr int AT_OFFI = 32 * AT_KROW * 2, AT_OFFV = AT_OFFI + 32 * AT_IROW * 2, AT_BUF = AT_OFFV + 256 * AT_VROW * 2;
__device__ __forceinline__ int at_row(int r) { return (r & 3) + 4 * ((r >> 3) & 3) + 16 * ((r >> 2) & 1); }
__device__ __forceinline__ void attn_item(const Params& p, int b, int qb, LAS unsigned char* sm) {
    const int tid = TID, w = __builtin_amdgcn_readfirstlane(tid >> 6), l = tid & 63, c16 = l & 15, g = l >> 4, qs = w & 3, hp = w >> 2;
    const bf16_t* proj = (const bf16_t*)(p.ws + WS_BIG) + (size_t)b * SEQ * DINP;
    const bf16_t* vt = (const bf16_t*)(p.ws + WS_VT) + (size_t)b * 4 * 64 * SEQ;
    const int q = qb * 64 + qs * 16 + c16;
    const bf16_t* qrow = proj + (size_t)q * DINP;
    const unsigned* mrow = (const unsigned*)(p.ws + WS_MASK) + (size_t)(b * SEQ + q) * 128;
    bf16x8 Qb[2][2];
#pragma unroll
    for (int hh = 0; hh < 2; ++hh)
#pragma unroll
        for (int kk = 0; kk < 2; ++kk) { const bf16x8 raw = *(const bf16x8*)(qrow + OFF_SQ + (2 * hp + hh) * 64 + kk * 32 + g * 8); bf16x8 o;
#pragma unroll
            for (int e = 0; e < 8; ++e) o[e] = (short)f2bf(bf2f(raw[e]) * 0.125f);
            Qb[hh][kk] = o; }
    f32x4 O[2][4];
#pragma unroll
    for (int hh = 0; hh < 2; ++hh)
#pragma unroll
        for (int dt = 0; dt < 4; ++dt) O[hh][dt] = (f32x4){0.f, 0.f, 0.f, 0.f};
    float mrun[2] = {-1e30f, -1e30f}, lrun[2] = {0.f, 0.f};
    const int nt = 2 * qb + 2, my_nt = (qb * 64 + qs * 16 + 15) / 32 + 1;
    const int kr0 = tid >> 5, kc = (tid & 31) * 8, vr0 = tid >> 2, vc = (tid & 3) * 8;
    const bf16_t* gK = proj + (size_t)kr0 * DINP + OFF_SK + kc;
    const bf16_t* gV = vt + (size_t)vr0 * SEQ + vc;
    const int lK0 = at_row(kr0) * AT_KROW + kc, lK1 = at_row(kr0 + 16) * AT_KROW + kc;
    const int lV0 = AT_OFFV / 2 + vr0 * AT_VROW + vc, lV1 = AT_OFFV / 2 + (vr0 + 128) * AT_VROW + vc;
    bf16x8 sK0, sK1, sV0, sV1; unsigned mw, mw_next = 0u;
#define AT_LOAD(k0_) do { sK0 = *(const bf16x8*)(gK + (size_t)(k0_) * DINP); sK1 = *(const bf16x8*)(gK + (size_t)((k0_) + 16) * DINP); \
        mw_next = mrow[(k0_) >> 5]; sV0 = *(const bf16x8*)(gV + (k0_)); sV1 = *(const bf16x8*)(gV + (size_t)128 * SEQ + (k0_)); } while (0)
#define AT_STORE(buf_) do { LAS bf16_t* B_ = (LAS bf16_t*)(sm + (buf_) * AT_BUF); *(LAS bf16x8*)(B_ + lK0) = sK0; *(LAS bf16x8*)(B_ + lK1) = sK1; \
        *(LAS bf16x8*)(B_ + lV0) = sV0; *(LAS bf16x8*)(B_ + lV1) = sV1; } while (0)
    AT_LOAD(0); AT_STORE(0);
    __syncthreads();
    for (int t = 0; t < nt; ++t) {
        const int k0 = t * 32;
        mw = mw_next;
        if (t + 1 < nt) AT_LOAD(k0 + 32);
        if (t < my_nt) {
            LAS bf16_t* Bk = (LAS bf16_t*)(sm + (t & 1) * AT_BUF); LAS bf16_t* Bv = Bk + AT_OFFV / 2;
            bool sel[2][4]; float lg[2][2][4];
#pragma unroll
            for (int s = 0; s < 2; ++s) {
                const int lrow = 16 * s + c16;
#pragma unroll
                for (int r = 0; r < 4; ++r) sel[s][r] = ((mw >> (8 * g + 4 * s + r)) & 1u) != 0u;
#pragma unroll
                for (int hh = 0; hh < 2; ++hh) { f32x4 S = (f32x4){0.f, 0.f, 0.f, 0.f};
#pragma unroll
                    for (int kk = 0; kk < 2; ++kk) { const bf16x8 kf = *(LAS bf16x8*)(Bk + lrow * AT_KROW + (2 * hp + hh) * 64 + kk * 32 + g * 8); S = mfma16(kf, Qb[hh][kk], S); }
#pragma unroll
                    for (int r = 0; r < 4; ++r) lg[hh][s][r] = S[r]; }
            }
#pragma unroll
            for (int hh = 0; hh < 2; ++hh) {
                float mx = -1e30f;
#pragma unroll
                for (int s = 0; s < 2; ++s)
#pragma unroll
                    for (int r = 0; r < 4; ++r) mx = sel[s][r] ? fmaxf(mx, lg[hh][s][r]) : mx;
                mx = fmaxf(mx, __shfl_xor(mx, 16)); mx = fmaxf(mx, __shfl_xor(mx, 32));
                const float mn = fmaxf(mrun[hh], mx), alpha = __expf(mrun[hh] - mn);
                mrun[hh] = mn;
                float pv[8]; float ps = 0.f;
#pragma unroll
                for (int s = 0; s < 2; ++s)
#pragma unroll
                    for (int r = 0; r < 4; ++r) { const float e = sel[s][r] ? __expf(lg[hh][s][r] - mn) : 0.f; pv[s * 4 + r] = e; ps += e; }
                lrun[hh] = lrun[hh] * alpha + ps;
                union { bf16x8 v; unsigned u[4]; } pb;
                pb.u[0] = cvt_pk_bf16(pv[0], pv[1]); pb.u[1] = cvt_pk_bf16(pv[2], pv[3]); pb.u[2] = cvt_pk_bf16(pv[4], pv[5]); pb.u[3] = cvt_pk_bf16(pv[6], pv[7]);
#pragma unroll
                for (int dt = 0; dt < 4; ++dt) {
                    const bf16x8 va = *(LAS bf16x8*)(Bv + ((2 * hp + hh) * 64 + dt * 16 + c16) * AT_VROW + g * 8);
                    O[hh][dt] = mfma16(va, pb.v, O[hh][dt] * alpha); }
            }
        }
        if (t + 1 < nt) AT_STORE((t + 1) & 1);
        __syncthreads();
    }
#undef AT_LOAD
#undef AT_STORE
    bf16_t* mix = (bf16_t*)(p.ws + WS_HB) + (size_t)(b * SEQ + q) * DM + 512;
#pragma unroll
    for (int hh = 0; hh < 2; ++hh) { float tot = lrun[hh]; tot += __shfl_xor(tot, 16); tot += __shfl_xor(tot, 32);
        const float inv = 1.f / tot;
#pragma unroll
        for (int dt = 0; dt < 4; ++dt) { const f32x4 o = O[hh][dt] * inv; u32x2 o2; o2.x = cvt_pk_bf16(o[0], o[1]); o2.y = cvt_pk_bf16(o[2], o[3]);
            *(u32x2*)(mix + (2 * hp + hh) * 64 + dt * 16 + 4 * g) = o2; } }
}

__device__ __forceinline__ void hgrn_G(const bf16x8 (&fv)[2], const float* lb, LAS float* Gs, LAS float* segtot) {
    const int tid = TID;
#pragma unroll
    for (int i = 0; i < 2; ++i) { const int row = (tid >> 4) + 32 * i, c8 = (tid & 15) * 8;
        const bf16x8 v = fv[i];
#pragma unroll
        for (int j = 0; j < 8; ++j) { const float fr = bf2f(v[j]), lbv = lb[c8 + j]; const float f = lbv + (1.f - lbv) * sigmoidf_(fr);
            Gs[row * 129 + c8 + j] = __logf(fmaxf(f, 1e-30f)); } }
    __syncthreads();
    const int col = tid & 127, seg = tid >> 7;
    { float run = 0.f;
#pragma unroll
        for (int r = 0; r < 16; ++r) { const int idx = (seg * 16 + r) * 129 + col; run += Gs[idx]; Gs[idx] = run; }
        segtot[seg * 128 + col] = run; }
    __syncthreads();
    { float off = 0.f;
#pragma unroll
        for (int s = 0; s < 3; ++s) if (s < seg) off += segtot[s * 128 + col];
        if (seg > 0) {
#pragma unroll
            for (int r = 0; r < 16; ++r) Gs[(seg * 16 + r) * 129 + col] += off; } }
    __syncthreads();
}

__device__ __forceinline__ void hgrn_local_item(const Params& p, int l, int b, int h, int c, LAS unsigned char* sm) {
    const int tid = TID, w = __builtin_amdgcn_readfirstlane(tid >> 6), ln = tid & 63, c16 = ln & 15, g = ln >> 4;
    LAS float* Gs = (LAS float*)sm; LAS float* segtot = (LAS float*)(sm + 33024);
    LAS bf16_t* KgT = (LAS bf16_t*)(sm + 35072); LAS bf16_t* vT = (LAS bf16_t*)(sm + 53504);
    const bf16_t* prow0 = (const bf16_t*)(p.ws + WS_BIG) + (size_t)(b * SEQ + c * 64) * DINP;
    const float* lb = (const float*)(p.ws + WS_LB) + l * 512 + h * 128;
    bf16x8 fG[2];
#pragma unroll
    for (int i = 0; i < 2; ++i) fG[i] = *(const bf16x8*)(prow0 + (size_t)((tid >> 4) + 32 * i) * DINP + OFF_HF + h * 128 + (tid & 15) * 8);
    const bf16_t* rp = prow0 + (size_t)(tid & 63) * DINP + h * 128 + (tid >> 6) * 16;
    const bf16x8 f0 = *(const bf16x8*)(rp + OFF_HF), f1 = *(const bf16x8*)(rp + OFF_HF + 8), v0 = *(const bf16x8*)(rp + OFF_HI), v1 = *(const bf16x8*)(rp + OFF_HI + 8);
    hgrn_G(fG, lb, Gs, segtot);
    { const int j = tid & 63, kg = tid >> 6;
#pragma unroll
        for (int e = 0; e < 16; ++e) { const int k = kg * 16 + e; const float fr = bf2f(e < 8 ? f0[e & 7] : f1[e & 7]), lbv = lb[k];
            const float kval = (1.f - lbv) * sigmoidf_(-fr);
            KgT[k * 72 + j] = f2bf(kval * __expf(Gs[63 * 129 + k] - Gs[j * 129 + k]));
            vT[k * 72 + j] = (bf16_t)(e < 8 ? v0[e & 7] : v1[e & 7]); } }
    const size_t bhc = (size_t)((b * 4 + h) * 64 + c);
    if (tid < 128) ((float*)(p.ws + WS_DEC))[bhc * 128 + tid] = __expf(Gs[63 * 129 + tid]);
    __syncthreads();
    f32x4 acc[8];
#pragma unroll
    for (int vt = 0; vt < 8; ++vt) acc[vt] = (f32x4){0.f, 0.f, 0.f, 0.f};
#pragma unroll
    for (int kk = 0; kk < 2; ++kk) { const bf16x8 a = *(LAS bf16x8*)(KgT + (w * 16 + c16) * 72 + kk * 32 + g * 8);
#pragma unroll
        for (int vt = 0; vt < 8; ++vt) { const bf16x8 bb = *(LAS bf16x8*)(vT + (vt * 16 + c16) * 72 + kk * 32 + g * 8); acc[vt] = mfma16(a, bb, acc[vt]); } }
    bf16_t* st = (bf16_t*)(p.ws + WS_ST) + bhc * 16384;
#pragma unroll
    for (int vt = 0; vt < 8; ++vt) { u32x2 o; o.x = cvt_pk_bf16(acc[vt][0], acc[vt][1]); o.y = cvt_pk_bf16(acc[vt][2], acc[vt][3]);
        *(u32x2*)(st + (size_t)(vt * 16 + c16) * 128 + w * 16 + 4 * g) = o; }
    __syncthreads();
}

__device__ __forceinline__ void hgrn_scan(const Params& p) {
    bf16_t* ST = (bf16_t*)(p.ws + WS_ST); const float* DEC = (const float*)(p.ws + WS_DEC);
    for (int e = blockIdx.x * NTHREADS + TID; e < 32 * 4096; e += gridDim.x * NTHREADS) {
        const int bh = e >> 12, idx4 = (e & 4095) * 4, k = idx4 & 127;
        bf16_t* base = ST + (size_t)bh * 64 * 16384 + idx4; const float* dec = DEC + (size_t)bh * 64 * 128 + k;
        f32x4 S = (f32x4){0.f, 0.f, 0.f, 0.f};
#pragma unroll 8
        for (int c = 0; c < 64; ++c) { const u32x2 loc = *(const u32x2*)(base + (size_t)c * 16384); const f32x4 d = *(const f32x4*)(dec + c * 128);
            u32x2 o; o.x = cvt_pk_bf16(S[0], S[1]); o.y = cvt_pk_bf16(S[2], S[3]);
            *(u32x2*)(base + (size_t)c * 16384) = o;
            S[0] = d[0] * S[0] + bflo(loc.x); S[1] = d[1] * S[1] + bfhi(loc.x); S[2] = d[2] * S[2] + bflo(loc.y); S[3] = d[3] * S[3] + bfhi(loc.y); }
    }
}

__device__ __forceinline__ void hgrn_out_item(const Params& p, int l, int b, int h, int c, LAS unsigned char* sm) {
    const int tid = TID, w = __builtin_amdgcn_readfirstlane(tid >> 6), ln = tid & 63, c16 = ln & 15, g = ln >> 4;
    LAS float* Gs = (LAS float*)sm; LAS float* segtot = (LAS float*)(sm + 33024);
    LAS bf16_t* qt_ = (LAS bf16_t*)(sm + 35072); LAS bf16_t* kt_ = (LAS bf16_t*)(sm + 52480); LAS bf16_t* qg_ = (LAS bf16_t*)(sm + 69888);
    LAS bf16_t* vT = (LAS bf16_t*)(sm + 87296); LAS bf16_t* Am = (LAS bf16_t*)(sm + 105728); LAS float* ssq = (LAS float*)(sm + 114944);
    const bf16_t* prow0 = (const bf16_t*)(p.ws + WS_BIG) + (size_t)(b * SEQ + c * 64) * DINP;
    const float* lb = (const float*)(p.ws + WS_LB) + l * 512 + h * 128;
    bf16x8 fG[2], qG[2];
#pragma unroll
    for (int i = 0; i < 2; ++i) { const bf16_t* rp = prow0 + (size_t)((tid >> 4) + 32 * i) * DINP + h * 128 + (tid & 15) * 8; fG[i] = *(const bf16x8*)(rp + OFF_HF); qG[i] = *(const bf16x8*)(rp + OFF_HQ); }
    bf16x8 vG0, vG1;
    { const bf16_t* rp = prow0 + (size_t)(tid & 63) * DINP + OFF_HI + h * 128 + (tid >> 6) * 16; vG0 = *(const bf16x8*)(rp); vG1 = *(const bf16x8*)(rp + 8); }
    u32x2 grG[4];
    { const bf16_t* grow_ = prow0 + (size_t)((w & 3) * 16 + c16) * DINP + OFF_HG + h * 128;
#pragma unroll
        for (int vt = 0; vt < 4; ++vt) grG[vt] = *(const u32x2*)(grow_ + ((w >> 2) * 4 + vt) * 16 + 4 * g); }
    bf16x8 stG[4][4];
    { const bf16_t* st_ = (const bf16_t*)(p.ws + WS_ST) + (size_t)((b * 4 + h) * 64 + c) * 16384;
#pragma unroll
        for (int kk = 0; kk < 4; ++kk)
#pragma unroll
            for (int vt = 0; vt < 4; ++vt) stG[kk][vt] = *(const bf16x8*)(st_ + (size_t)(((w >> 2) * 4 + vt) * 16 + c16) * 128 + kk * 32 + g * 8); }
    hgrn_G(fG, lb, Gs, segtot);
#pragma unroll
    for (int i = 0; i < 2; ++i) { const int row = (tid >> 4) + 32 * i, c8 = (tid & 15) * 8;
        const bf16x8 qv8 = qG[i], fv8 = fG[i];
        float a[8], bq[8], cq[8];
#pragma unroll
        for (int j = 0; j < 8; ++j) { const int k = c8 + j; const float G = Gs[row * 129 + k], Gm = Gs[31 * 129 + k], lbv = lb[k];
            const float qv = siluf_(bf2f(qv8[j])) * 0.08838834764831845f, kval = (1.f - lbv) * sigmoidf_(-bf2f(fv8[j]));
            a[j] = qv * __expf(fminf(G - Gm, 80.f)); bq[j] = kval * __expf(fminf(Gm - G, 80.f)); cq[j] = qv * __expf(G); }
        u32x4 o;
        o.x = cvt_pk_bf16(a[0], a[1]); o.y = cvt_pk_bf16(a[2], a[3]); o.z = cvt_pk_bf16(a[4], a[5]); o.w = cvt_pk_bf16(a[6], a[7]); *(LAS u32x4*)(qt_ + row * 136 + c8) = o;
        o.x = cvt_pk_bf16(bq[0], bq[1]); o.y = cvt_pk_bf16(bq[2], bq[3]); o.z = cvt_pk_bf16(bq[4], bq[5]); o.w = cvt_pk_bf16(bq[6], bq[7]); *(LAS u32x4*)(kt_ + row * 136 + c8) = o;
        o.x = cvt_pk_bf16(cq[0], cq[1]); o.y = cvt_pk_bf16(cq[2], cq[3]); o.z = cvt_pk_bf16(cq[4], cq[5]); o.w = cvt_pk_bf16(cq[6], cq[7]); *(LAS u32x4*)(qg_ + row * 136 + c8) = o; }
    { const int j = tid & 63, kg = tid >> 6;
#pragma unroll
        for (int e = 0; e < 16; ++e) vT[(kg * 16 + e) * 72 + j] = (bf16_t)(e < 8 ? vG0[e & 7] : vG1[e & 7]); }
    __syncthreads();
#pragma unroll
    for (int s = 0; s < 2; ++s) { const int tI = w * 2 + s, itile = tI >> 2, jt = tI & 3;
        f32x4 d = (f32x4){0.f, 0.f, 0.f, 0.f};
        if (jt <= itile) {
#pragma unroll
            for (int kk = 0; kk < 4; ++kk) { const bf16x8 a = *(LAS bf16x8*)(kt_ + (jt * 16 + c16) * 136 + kk * 32 + g * 8), bb = *(LAS bf16x8*)(qt_ + (itile * 16 + c16) * 136 + kk * 32 + g * 8);
                d = mfma16(a, bb, d); } }
        const int i = itile * 16 + c16, j0 = jt * 16 + 4 * g;
        u32x2 o; o.x = cvt_pk_bf16((j0 + 0 <= i) ? d[0] : 0.f, (j0 + 1 <= i) ? d[1] : 0.f); o.y = cvt_pk_bf16((j0 + 2 <= i) ? d[2] : 0.f, (j0 + 3 <= i) ? d[3] : 0.f);
        *(LAS u32x2*)(Am + i * 72 + j0) = o; }
    __syncthreads();
    const int itile = w & 3, vh = w >> 2;
    const size_t bhc = (size_t)((b * 4 + h) * 64 + c);
    const bf16_t* st = (const bf16_t*)(p.ws + WS_ST) + bhc * 16384;
    f32x4 acc[4];
#pragma unroll
    for (int vt = 0; vt < 4; ++vt) acc[vt] = (f32x4){0.f, 0.f, 0.f, 0.f};
#pragma unroll
    for (int kk = 0; kk < 2; ++kk) { const bf16x8 bb = *(LAS bf16x8*)(Am + (itile * 16 + c16) * 72 + kk * 32 + g * 8);
#pragma unroll
        for (int vt = 0; vt < 4; ++vt) { const bf16x8 a = *(LAS bf16x8*)(vT + ((vh * 4 + vt) * 16 + c16) * 72 + kk * 32 + g * 8); acc[vt] = mfma16(a, bb, acc[vt]); } }
#pragma unroll
    for (int kk = 0; kk < 4; ++kk) { const bf16x8 bb = *(LAS bf16x8*)(qg_ + (itile * 16 + c16) * 136 + kk * 32 + g * 8);
#pragma unroll
        for (int vt = 0; vt < 4; ++vt) acc[vt] = mfma16(stG[kk][vt], bb, acc[vt]); }
    float ss = 0.f;
#pragma unroll
    for (int vt = 0; vt < 4; ++vt) ss += acc[vt][0] * acc[vt][0] + acc[vt][1] * acc[vt][1] + acc[vt][2] * acc[vt][2] + acc[vt][3] * acc[vt][3];
    ss += __shfl_xor(ss, 16); ss += __shfl_xor(ss, 32);
    const int i = itile * 16 + c16;
    if (g == 0) ssq[vh * 64 + i] = ss;
    __syncthreads();
    const float rstd = rsqrtf((ssq[i] + ssq[64 + i]) * (1.f / 128.f) + EPS);
    bf16_t* mix = (bf16_t*)(p.ws + WS_HB) + (size_t)(b * SEQ + c * 64 + i) * DM + h * 128;
    const bf16_t* grow = prow0 + (size_t)i * DINP + OFF_HG + h * 128;
#pragma unroll
    for (int vt = 0; vt < 4; ++vt) { const int v0 = (vh * 4 + vt) * 16 + 4 * g;
        const u32x2 gr = grG[vt]; const f32x4 ow = *(const f32x4*)(p.onorm_w + l * 512 + h * 128 + v0);
        const float r0 = acc[vt][0] * rstd * ow[0] * siluf_(bflo(gr.x)), r1 = acc[vt][1] * rstd * ow[1] * siluf_(bfhi(gr.x));
        const float r2 = acc[vt][2] * rstd * ow[2] * siluf_(bflo(gr.y)), r3 = acc[vt][3] * rstd * ow[3] * siluf_(bfhi(gr.y));
        u32x2 o; o.x = cvt_pk_bf16(r0, r1); o.y = cvt_pk_bf16(r2, r3);
        *(u32x2*)(mix + v0) = o; }
    __syncthreads();
}


#ifdef DIAG_CUT
__device__ __forceinline__ void diag_phase(const Params& p) {
    const int tid = TID, wave = tid >> 6, lane = tid & 63;
    const bf16_t* HB = (const bf16_t*)(p.ws + WS_HB); const bf16_t* ST = (const bf16_t*)(p.ws + WS_ST); const float* DEC = (const float*)(p.ws + WS_DEC);
    const bf16_t* BIG = (const bf16_t*)(p.ws + WS_BIG);
    for (int row = blockIdx.x * 8 + wave; row < NTOK; row += gridDim.x * 8) {
        float* orow = p.out + (size_t)row * DM;
        for (int i = 0; i < 16; ++i) { const int col = i * 64 + lane; float v = 0.f;
#if DIAG_MODE == 1
            for (int t = 0; t < 3; ++t) v += bf2f((short)BIG[(size_t)row * DINP + col + 1024 * t]);
            if (col < 768) v += bf2f((short)BIG[(size_t)row * DINP + 3072 + col]);
#elif DIAG_MODE == 2
            v = bf2f((short)ST[(size_t)row * 1024 + col]) + DEC[((size_t)row * 8 + (col & 7)) % (32 * 64 * 128)];
#elif DIAG_MODE == 5
            v = DEC[((size_t)row * 8 + (col & 7)) % (32 * 64 * 128)];
#elif DIAG_MODE == 6
            v = bf2f((short)ST[(size_t)row * 1024 + col]);
#elif DIAG_MODE == 4
            v = bf2f((short)HB[(size_t)row * DM + col]);
#endif
            if (!(fabsf(v) < 1e30f)) v = 12345.f;
            orow[col] = v; }
    }
}
#endif
#define XB_TMO      128
#define XB_XCNT(j)  (256  + 64 * (j))
#define XB_XSUB(j)  (1280 + 64 * (j))
#define XB_XGEN(j)  (2304 + 64 * (j))
#define XB_TOP      3328
#define XB_TOPGEN   3392
#define XCD_BAR_WORDS 3456
#define XB_SPIN_CAP (1u << 18)

__device__ __forceinline__ unsigned xb_ld(unsigned* p)              { return __hip_atomic_load(p, __ATOMIC_RELAXED, __HIP_MEMORY_SCOPE_AGENT); }
__device__ __forceinline__ unsigned xb_add(unsigned* p, unsigned v) { return __hip_atomic_fetch_add(p, v, __ATOMIC_RELAXED, __HIP_MEMORY_SCOPE_AGENT); }
__device__ __forceinline__ unsigned xb_xcc_id() { return (unsigned)__builtin_amdgcn_s_getreg((3 << 11) | 20) & 0xFu; }
#define XB_SPIN(cond, bar) do { unsigned _sp = 0; while (cond) { __builtin_amdgcn_s_sleep(1); \
    if ((++_sp & 255u) == 0u) { if (xb_ld(&(bar)[XB_TMO])) break; if (_sp > XB_SPIN_CAP) { atomicAdd(&(bar)[XB_TMO], 1u); break; } } } } while (0)

struct XcdBarrier {
    unsigned* bar; unsigned x;
    volatile LAS unsigned* st;
};

__device__ __forceinline__ XcdBarrier xcd_barrier_post(unsigned* bar, volatile LAS unsigned* st) {
    XcdBarrier b; b.bar = bar; b.x = xb_xcc_id(); b.st = st;
    if (threadIdx.x == 0) (void)xb_add(&bar[XB_XCNT(b.x)], 1u);
    return b;
}
__device__ __forceinline__ void xcd_barrier_complete(unsigned* bar, unsigned x, unsigned& nloc, unsigned& nx) {
    const unsigned G = gridDim.x * gridDim.y * gridDim.z;
    unsigned sum, cnt, mine, sp = 0u;
    for (;;) {
        sum = 0u; cnt = 0u; mine = 0u;
#pragma unroll
        for (unsigned j = 0; j < 16; ++j) { const unsigned c = xb_ld(&bar[XB_XCNT(j)]); sum += c; cnt += (c > 0u) ? 1u : 0u; mine = (j == x) ? c : mine; }
        if (sum == G) break;
        __builtin_amdgcn_s_sleep(1);
        if ((++sp & 255u) == 0u) { if (xb_ld(&bar[XB_TMO])) break; if (sp > XB_SPIN_CAP) { atomicAdd(&bar[XB_TMO], 1u); break; } }
    }
    nloc = mine > 0u ? mine : 1u; nx = cnt > 0u ? cnt : 1u;
}

__device__ __forceinline__ void xcd_barrier(const XcdBarrier& b) {
    asm volatile("s_waitcnt vmcnt(0)" ::: "memory");
    __syncthreads();
    if (threadIdx.x == 0) {
        unsigned* bar = b.bar;
        __builtin_amdgcn_s_waitcnt(0);
        unsigned nloc = b.st[0], nx = b.st[1];
        if (nloc == 0u) { xcd_barrier_complete(bar, b.x, nloc, nx); b.st[0] = nloc; b.st[1] = nx; }
        const unsigned old = xb_add(&bar[XB_XSUB(b.x)], 1u);
        const unsigned gen = old / nloc;
        if (old + 1u == (gen + 1u) * nloc) {
            __builtin_amdgcn_fence(__ATOMIC_RELEASE, "agent");
            asm volatile("s_waitcnt vmcnt(0)" ::: "memory");
            const unsigned og = xb_add(&bar[XB_TOP], 1u);
            const unsigned tg = og / nx;
            if (og + 1u == (tg + 1u) * nx) xb_add(&bar[XB_TOPGEN], 1u);
            else XB_SPIN(xb_ld(&bar[XB_TOPGEN]) == tg, bar);
            __builtin_amdgcn_fence(__ATOMIC_ACQUIRE, "agent");
            xb_add(&bar[XB_XGEN(b.x)], 1u);
            asm volatile("s_waitcnt vmcnt(0)" ::: "memory");
        } else {
            XB_SPIN(xb_ld(&bar[XB_XGEN(b.x)]) == gen, bar);
            __builtin_amdgcn_fence(__ATOMIC_ACQUIRE, "agent");
            asm volatile("s_waitcnt vmcnt(0)" ::: "memory");
        }
    }
    __syncthreads();
}


template <class Epi>
__device__ __forceinline__ void run_gemm(LAS unsigned char* lds, const bf16_t* A, const bf16_t* Bt, int M, int N, int K, const Epi& E) {
    pg8::Gemm g; g.A = A; g.Bt = Bt; g.M = M; g.N = N; g.K = K;
    pg8::StaticOrder S; S.init(M, N, (int)gridDim.x, (int)blockIdx.x);
    pg8::gemm_phase<Epi, pg8::StaticOrder, true, true>(lds, g, S, E);
}

constexpr int NPHASE = 2 + 9 * DEPTH;
#define GRID_SYNC() do { if (ph == 0) grid.sync(); else xcd_barrier(xb); } while (0)

__global__ void __launch_bounds__(NTHREADS, 2) fwd_megakernel(Params pin) {
    extern __shared__ __attribute__((aligned(16))) unsigned char lds_raw[];
    LAS unsigned char* lds = (LAS unsigned char*)lds_raw;
    cg::grid_group grid = cg::this_grid();
    volatile LAS unsigned* xst = (volatile LAS unsigned*)(lds + 131072);
    if (threadIdx.x == 0) { xst[0] = 0u; xst[1] = 0u; }
    __syncthreads();
    XcdBarrier xb = xcd_barrier_post((unsigned*)(pin.ws + WS_BAR), xst);
    const int G = (int)gridDim.x, blk = (int)blockIdx.x;
    for (int ph = pin.ph_lo; ph < pin.ph_hi; ++ph) {
        Params p = pin;
        asm volatile("" : "+s"(p.ws), "+s"(p.out), "+s"(p.x));
        bf16_t* WIN = (bf16_t*)(p.ws + WS_WIN); bf16_t* WOUT = (bf16_t*)(p.ws + WS_WOUT); bf16_t* W1B = (bf16_t*)(p.ws + WS_W1); bf16_t* W2B = (bf16_t*)(p.ws + WS_W2);
        const float* MOD = (const float*)(p.ws + WS_MOD);
        bf16_t* BIG = (bf16_t*)(p.ws + WS_BIG); bf16_t* HB = (bf16_t*)(p.ws + WS_HB);
        if (ph == 0) {
          for (int rep_ = 0; rep_ < REP_PRO; ++rep_) {
            cvt_kind(p.w_in, WIN, DM, DIN, DINP, (LAS float*)lds);
            cvt_kind(p.w_out, WOUT, DM, DM, DM, (LAS float*)lds);
            cvt_kind(p.w1, W1B, DM, DFF, DFF, (LAS float*)lds);
            cvt_kind(p.w2, W2B, DFF, DM, DM, (LAS float*)lds);
            mod_phase(p, (LAS float*)lds);
            lb_phase(p);
          }
        } else if (ph == NPHASE - 1) {
            final_norm(p.out, p.final_w);
        } else {
            const int l = (ph - 1) / 9, s = (ph - 1) % 9;
            const float* modl = MOD + (size_t)l * NB * 6144;
            const float* xcur = (l == 0) ? p.x : p.out;
            if (s == 0) {
                for (int rep_ = 0; rep_ < REP_NORM; ++rep_) rmsnorm_mod(xcur, p.norm_mix_w + l * DM, modl, 0, 1024, HB);
            } else if (s == 1) {
                pg8::EpiBf16<0> E; E.O = BIG; E.ldc = DINP;
                for (int rep_ = 0; rep_ < REP_GEMM; ++rep_) run_gemm(lds, HB, WIN + (size_t)l * DINP * DM, NTOK, DINP, DM, E);
            } else if (s == 2) {
              for (int rep2_ = 0; rep2_ < REP_S2; ++rep2_) {
#ifndef DIAG_NOTHR
                for (int v = blk; v < 2048; v += G) { const int itp = v >> 8, rem = v & 255, b = rem & 7, jj = rem >> 3; const int qt = itp * 32 + ((itp & 1) ? 31 - jj : jj); for (int rep_ = 0; rep_ < REP_THR; ++rep_) thr_item(p, b, qt, lds); }
#endif
                for (int v = blk; v < 2048; v += G) { const int c = v & 63, bh = v >> 6; hgrn_local_item(p, l, bh >> 2, bh & 3, c, lds); }
                for (int v = blk; v < 1024; v += G) conv_item(p, l, v >> 7, v & 127, lds);
                for (int v = blk; v < 512; v += G) vt_item(p, v >> 6, v & 63, lds);
              }
            } else if (s == 3) {
                hgrn_scan(p);
                for (int v = blk; v < 512; v += G) { const int itp = v >> 8, rem = v & 255, b = rem & 7, jj = rem >> 3; const int qb = itp ? 63 - jj : jj; for (int rep_ = 0; rep_ < REP_ATTN; ++rep_) attn_item(p, b, qb, lds); }
            } else if (s == 4) {
                for (int rep_ = 0; rep_ < REP_HO; ++rep_) for (int v = blk; v < 2048; v += G) { const int c = v & 63, bh = v >> 6; hgrn_out_item(p, l, bh >> 2, bh & 3, c, lds); }
            } else if (s == 5) {
                pg8::EpiResid E; E.xs = xcur; E.xd = p.out; E.gate = modl + 2048;
                run_gemm(lds, HB, WOUT + (size_t)l * DM * DM, NTOK, DM, DM, E);
            } else if (s == 6) {
                for (int rep_ = 0; rep_ < REP_NORM; ++rep_) rmsnorm_mod(p.out, p.norm_mlp_w + l * DM, modl, 3072, 4096, HB);
            } else if (s == 7) {
                pg8::EpiBf16<1> E; E.O = BIG; E.ldc = DFF;
                for (int rep_ = 0; rep_ < REP_GEMM; ++rep_) run_gemm(lds, HB, W1B + (size_t)l * DFF * DM, NTOK, DFF, DM, E);
            } else {
                pg8::EpiResid E; E.xs = p.out; E.xd = p.out; E.gate = modl + 5120;
                run_gemm(lds, BIG, W2B + (size_t)l * DM * DFF, NTOK, DM, DFF, E);
            }
        }
        if (ph + 1 < pin.ph_hi) { GRID_SYNC(); }
    }
#ifdef DIAG_CUT
    { const int ph = 1; GRID_SYNC(); } diag_phase(pin);
#endif
}

extern "C" void kernel_launch(void* const* d_in, const int* in_sizes, int n_in, void* d_out, int out_size, void* d_ws, size_t ws_size, hipStream_t stream) {
    static int grid_blocks = 0;
    if (grid_blocks == 0) {
        if (n_in != 17 || out_size != NTOK * DM || ws_size < WS_END) { fprintf(stderr, "kernel_launch: unexpected shapes (n_in %d out %d ws %zu need %zu)\n", n_in, out_size, ws_size, (size_t)WS_END); grid_blocks = -1; return; }
        int dev = 0, cus = 0, per_cu = 0;
        hipGetDevice(&dev);
        hipDeviceGetAttribute(&cus, hipDeviceAttributeMultiprocessorCount, dev);
        if (hipFuncSetAttribute((const void*)fwd_megakernel, hipFuncAttributeMaxDynamicSharedMemorySize, LDS_BYTES) != hipSuccess) { fprintf(stderr, "kernel_launch: hipFuncSetAttribute failed\n"); grid_blocks = -1; return; }
        if (hipOccupancyMaxActiveBlocksPerMultiprocessor(&per_cu, (const void*)fwd_megakernel, NTHREADS, LDS_BYTES) != hipSuccess || per_cu < 1) { fprintf(stderr, "kernel_launch: occupancy query says %d blocks/CU\n", per_cu); per_cu = 1; }
        (void)hipGetLastError();
        grid_blocks = cus * (per_cu > 1 ? 1 : per_cu);
    }
    if (grid_blocks < 0) return;
    Params p{};
    p.x = (const float*)d_in[0]; p.c = (const float*)d_in[1]; p.ada_w = (const float*)d_in[2]; p.ada_b = (const float*)d_in[3];
    p.norm_mix_w = (const float*)d_in[4]; p.norm_mlp_w = (const float*)d_in[5]; p.w_in = (const float*)d_in[6]; p.lb_logits = (const float*)d_in[7];
    p.onorm_w = (const float*)d_in[8]; p.cv_w = (const float*)d_in[9]; p.cv_b = (const float*)d_in[10]; p.cv_ln_w = (const float*)d_in[11]; p.cv_ln_b = (const float*)d_in[12];
    p.w_out = (const float*)d_in[13]; p.w1 = (const float*)d_in[14]; p.w2 = (const float*)d_in[15]; p.final_w = (const float*)d_in[16];
    p.out = (float*)d_out; p.ws = (unsigned char*)d_ws; p.ph_lo = 0; p.ph_hi = NPHASE;
#ifdef DIAG_CUT
    p.ph_hi = DIAG_CUT;
#endif
    if (hipMemsetAsync((char*)d_ws + WS_BAR, 0, 16384, stream) != hipSuccess) { fprintf(stderr, "kernel_launch: hipMemsetAsync failed\n"); return; }
    void* args[] = {&p};
    hipError_t e = hipLaunchCooperativeKernel((const void*)fwd_megakernel, dim3(grid_blocks), dim3(NTHREADS), args, LDS_BYTES, stream);
    if (e != hipSuccess) fprintf(stderr, "kernel_launch: cooperative launch failed: %s (grid %d)\n", hipGetErrorString(e), grid_blocks);
}
```

```cpp
#include <hip/hip_runtime.h>
#include <hip/hip_cooperative_groups.h>
#include <cstdio>
#include <cstdint>
namespace cg = cooperative_groups;

#define LAS __attribute__((address_space(3)))
typedef unsigned short bf16_t;
typedef short bf16x8 __attribute__((ext_vector_type(8)));
typedef float f32x4 __attribute__((ext_vector_type(4)));
typedef unsigned u32x4 __attribute__((ext_vector_type(4)));
typedef unsigned u32x2 __attribute__((ext_vector_type(2)));

constexpr int DM = 1024, NB = 8, SEQ = 4096, DEPTH = 4, NTOK = NB * SEQ;
constexpr int DIN = 3624, DINP = 3840, DFF = 4096;
constexpr int OFF_HQ = 0, OFF_HF = 512, OFF_HI = 1024, OFF_HG = 1536, OFF_SQ = 2048, OFF_SK = 2304, OFF_SV = 2560, OFF_IQ = 2816, OFF_IK = 3072, OFF_IW = 3104, OFF_CU = 3112;
constexpr int TOPK = 256;
constexpr float EPS = 1e-6f;
constexpr int NTHREADS = 512;
constexpr int LDS_BYTES = 131072 + 64;

constexpr size_t WS_WIN = 0;
constexpr size_t WS_WOUT = WS_WIN + (size_t)DEPTH * DINP * DM * 2;
constexpr size_t WS_W1 = WS_WOUT + (size_t)DEPTH * DM * DM * 2;
constexpr size_t WS_W2 = WS_W1 + (size_t)DEPTH * DFF * DM * 2;
constexpr size_t WS_MOD = WS_W2 + (size_t)DEPTH * DM * DFF * 2;
constexpr size_t WS_LB = WS_MOD + (size_t)DEPTH * NB * 6 * DM * 4;
constexpr size_t WS_BIG = WS_LB + (size_t)DEPTH * 512 * 4;
constexpr size_t WS_MASK = WS_BIG + (size_t)NTOK * DINP * 2;
static_assert((size_t)NTOK * DINP * 2 + (size_t)NTOK * 128 * 4 <= (size_t)NTOK * DFF * 2, "mask overlay");
constexpr size_t WS_HB = WS_BIG + (size_t)NTOK * DFF * 2;
constexpr size_t WS_ST = WS_HB + (size_t)NTOK * DM * 2;
constexpr size_t WS_DEC = WS_ST + (size_t)32 * 64 * 16384 * 2;
constexpr size_t WS_VT = WS_DEC + (size_t)32 * 64 * 128 * 4;
constexpr size_t WS_THRT = WS_VT + (size_t)NB * 4 * 64 * SEQ * 2;
constexpr size_t WS_THRC = WS_THRT + (size_t)NTOK * 4;
constexpr size_t WS_BAR = WS_THRC + (size_t)NTOK * 4;
constexpr size_t WS_END = WS_BAR + 16384;
static_assert(WS_END <= (size_t)512 * 1024 * 1024, "workspace map exceeds 512 MiB");

struct Params {
    const float* x; const float* c; const float* ada_w; const float* ada_b; const float* norm_mix_w; const float* norm_mlp_w;
    const float* w_in; const float* lb_logits; const float* onorm_w; const float* cv_w; const float* cv_b; const float* cv_ln_w; const float* cv_ln_b;
    const float* w_out; const float* w1; const float* w2; const float* final_w;
    float* out; unsigned char* ws;
    int ph_lo, ph_hi;
};

typedef float f32x2_t __attribute__((ext_vector_type(2)));
typedef __bf16 bf16x2_t __attribute__((ext_vector_type(2)));
__device__ __forceinline__ unsigned cvt_pk_bf16(float lo, float hi) { const f32x2_t v = {lo, hi}; return __builtin_bit_cast(unsigned, __builtin_convertvector(v, bf16x2_t)); }
__device__ __forceinline__ float bf2f(short h) { return __uint_as_float(((unsigned)(unsigned short)h) << 16); }
__device__ __forceinline__ float bflo(unsigned w) { return __uint_as_float(w << 16); }
__device__ __forceinline__ float bfhi(unsigned w) { return __uint_as_float(w & 0xffff0000u); }
__device__ __forceinline__ bf16_t f2bf(float f) { return (bf16_t)(cvt_pk_bf16(f, 0.f) & 0xffffu); }
__device__ __forceinline__ float wave_sum(float v) {
    v += __shfl_xor(v, 32); v += __shfl_xor(v, 16); v += __shfl_xor(v, 8); v += __shfl_xor(v, 4); v += __shfl_xor(v, 2); v += __shfl_xor(v, 1); return v;
}
__device__ __forceinline__ float sigmoidf_(float x) { return __builtin_amdgcn_rcpf(1.f + __expf(-x)); }
__device__ __forceinline__ float siluf_(float x) { return x * __builtin_amdgcn_rcpf(1.f + __expf(-x)); }
__device__ __forceinline__ unsigned sortable(float f) { unsigned b = __float_as_uint(f); return b ^ ((b & 0x80000000u) ? 0xffffffffu : 0x80000000u); }
__device__ __forceinline__ f32x4 mfma16(bf16x8 a, bf16x8 b, f32x4 c) { return __builtin_amdgcn_mfma_f32_16x16x32_bf16(a, b, c, 0, 0, 0); }

namespace pg8 {
#define PG8_LAS __attribute__((address_space(3)))
constexpr int BM = 256, BK = 64, HALF = 128, HTB = HALF * BK * 2, STAGE_BYTES = 8 * HTB, NXCD = 8, WGM = 8;
__host__ __device__ __forceinline__ int lds_byte(int r, int c) { const int st = (r >> 4) * 2 + (c >> 5), rr = r & 15, cc = c & 31, ob = rr * 64 + cc * 2; return st * 1024 + (ob ^ (((ob >> 9) & 1) << 5)); }
__host__ __device__ __forceinline__ void stage_rc(int b, int& R, int& C) { const int st = b / 1024, sb = b % 1024, swz = sb ^ (((sb >> 9) & 1) << 5); R = (st >> 1) * 16 + swz / 64; C = (st & 1) * 32 + (swz % 64) / 2; }
__host__ __device__ __forceinline__ int perm32(int rho) { const int n = rho >> 4, i = rho & 15; return 8 * (i >> 2) + 4 * n + (i & 3); }
struct Unit { int pm, pn; };
struct Gemm { const bf16_t* A; const bf16_t* Bt; int M, N, K; };
struct StaticOrder {
    int nM, nN, nwg, G, c;
    __host__ __device__ void init(int M, int N, int G_, int c_) { nM = M / BM; nN = N / BM; nwg = nM * nN; G = G_; c = c_; }
    __host__ __device__ bool next(int i, Unit& u) const {
        const long L = (long)i * G + c; if (L >= nwg) return false;
        int wgid = (int)L; { const int q = nwg / NXCD, r = nwg % NXCD, xcd = wgid % NXCD, off = wgid / NXCD; wgid = (xcd < r ? xcd * (q + 1) : r * (q + 1) + (xcd - r) * q) + off; }
        const int nig = WGM * nN, gid = wgid / nig, fm = gid * WGM, gsz = (nM - fm) < WGM ? (nM - fm) : WGM;
        u.pm = fm + ((wgid % nig) % gsz); u.pn = (wgid % nig) / gsz; return true;
    }
    __device__ __forceinline__ void a_ready(const Unit&) const {}
    __device__ __forceinline__ void done(const Unit&) const {}
};

template <int ACT  > struct EpiBf16 {
    static constexpr bool PERM = true, AFTER_DRAIN = false;
    bf16_t* O; int ldc;
    __device__ __forceinline__ void operator()(const f32x4 (&acc)[2][2][4][2], const Unit& u, int wr, int wc, int fr, int fq) const {
        const int row0 = u.pm * BM + wr * 64 + fr, col0 = u.pn * BM + wc * 32 + 8 * fq;
#pragma unroll
        for (int ai = 0; ai < 2; ++ai)
#pragma unroll
            for (int m = 0; m < 4; ++m) { bf16_t* rowp = O + (size_t)(row0 + ai * HALF + m * 16) * ldc + col0;
#pragma unroll
                for (int bj = 0; bj < 2; ++bj) { f32x4 v0 = acc[ai][bj][m][0], v1 = acc[ai][bj][m][1];
                    if (ACT == 1) {
#pragma unroll
                        for (int j = 0; j < 4; ++j) { const float a = fmaxf(v0[j], 0.f), b = fmaxf(v1[j], 0.f); v0[j] = a * a; v1[j] = b * b; } }
                    u32x4 w; w.x = cvt_pk_bf16(v0[0], v0[1]); w.y = cvt_pk_bf16(v0[2], v0[3]); w.z = cvt_pk_bf16(v1[0], v1[1]); w.w = cvt_pk_bf16(v1[2], v1[3]);
                    *(u32x4*)(rowp + bj * HALF) = w; } }
    }
};
struct EpiResid {
    static constexpr bool PERM = true, AFTER_DRAIN = false;
    const float* xs; float* xd; const float* gate;
    __device__ __forceinline__ void operator()(const f32x4 (&acc)[2][2][4][2], const Unit& u, int wr, int wc, int fr, int fq) const {
        const int row0 = u.pm * BM + wr * 64 + fr, col0 = u.pn * BM + wc * 32 + 8 * fq;
        const float* gp = gate + (size_t)((u.pm * BM) >> 12) * 6144 + col0;
        f32x4 gv[2][2];
#pragma unroll
        for (int bj = 0; bj < 2; ++bj)
#pragma unroll
            for (int n = 0; n < 2; ++n) gv[bj][n] = *(const f32x4*)(gp + bj * HALF + 4 * n);
#pragma unroll
        for (int ai = 0; ai < 2; ++ai)
#pragma unroll
            for (int m = 0; m < 4; ++m) { const size_t off = (size_t)(row0 + ai * HALF + m * 16) * DM + col0;
#pragma unroll
                for (int bj = 0; bj < 2; ++bj)
#pragma unroll
                    for (int n = 0; n < 2; ++n) { const f32x4 xv = *(const f32x4*)(xs + off + bj * HALF + 4 * n);
                        *(f32x4*)(xd + off + bj * HALF + 4 * n) = xv + gv[bj][n] * acc[ai][bj][m][n]; } }
    }
};
template <class Epi, class Sched, bool ALIGN_EPI = false, bool SP2 = false>
__device__ __forceinline__ void gemm_phase(PG8_LAS unsigned char* lds, const Gemm g, const Sched& S, const Epi& E) {
    int tid_ = threadIdx.x; asm volatile("" : "+v"(tid_)); const int tid = tid_, wid = __builtin_amdgcn_readfirstlane(tid >> 6), lane = tid & 63, wr = wid >> 2, wc = wid & 3, fr = lane & 15, fq = lane >> 4;
    const int K = g.K, nt = K / BK;
    unsigned voffA[2], voffB[2];
#pragma unroll
    for (int i = 0; i < 2; ++i) { int R, C; stage_rc(tid * 16 + i * 8192, R, C); const int Rb = Epi::PERM ? ((R & ~31) + perm32(R & 31)) : R;
        voffA[i] = (unsigned)(R * K + C) * 2u; voffB[i] = (unsigned)(Rb * K + C) * 2u; }
    const size_t kstep = (size_t)(BK * 2);
    const size_t hstep = (size_t)HALF * K * 2;
    const size_t tstep = 2 * hstep;
    const unsigned ldsw = (unsigned)wid * 1024u;
    const int aoff = lds_byte(wr * 64 + fr, fq * 8), boff = lds_byte(wc * 32 + fr, fq * 8);
#define PG8_SA(b, h) (((b) * 2 + (h)) * HTB)
#define PG8_SB(b, h) ((4 + (b) * 2 + (h)) * HTB)
#define PG8_STAGE(bufoff, gbase, voff) do { _Pragma("unroll") for (int _i = 0; _i < 2; ++_i) \
        __builtin_amdgcn_global_load_lds((const unsigned*)((const char*)(gbase) + (voff)[_i]), (PG8_LAS unsigned*)(lds + (bufoff) + ldsw + _i * 8192), 16, 0, 0); } while (0)
#define PG8_LDA(dst, b, h) do { _Pragma("unroll") for (int m = 0; m < 4; ++m) _Pragma("unroll") for (int k = 0; k < 2; ++k) dst[m][k] = *(const PG8_LAS bf16x8*)(lds + PG8_SA(b, h) + aoff + m * 2048 + k * 1024); } while (0)
#define PG8_LDB(dst, b, h) do { _Pragma("unroll") for (int n = 0; n < 2; ++n) _Pragma("unroll") for (int k = 0; k < 2; ++k) dst[n][k] = *(const PG8_LAS bf16x8*)(lds + PG8_SB(b, h) + boff + n * 2048 + k * 1024); } while (0)
#define PG8_MMA(ai, bj, At, Bt) do { __builtin_amdgcn_s_setprio(1); _Pragma("unroll") for (int m = 0; m < 4; ++m) _Pragma("unroll") for (int n = 0; n < 2; ++n) _Pragma("unroll") for (int k = 0; k < 2; ++k) \
        acc[ai][bj][m][n] = __builtin_amdgcn_mfma_f32_16x16x32_bf16(Bt[n][k], At[m][k], acc[ai][bj][m][n], 0, 0, 0); __builtin_amdgcn_s_setprio(0); } while (0)
#define PG8_WAIT_V(n) asm volatile("s_waitcnt vmcnt(" #n ")" ::: "memory")
#define PG8_WAIT_L(n) asm volatile("s_waitcnt lgkmcnt(" #n ")" ::: "memory")
#define PG8_BAR __builtin_amdgcn_s_barrier()
#define PG8_SCHED __builtin_amdgcn_sched_barrier(0)
    Unit cur, nxt; int ui = 0;
    if (!S.next(0, cur)) return;
    f32x4 acc[2][2][4][2];
#pragma unroll
    for (int a = 0; a < 2; ++a)
#pragma unroll
        for (int b = 0; b < 2; ++b)
#pragma unroll
            for (int m = 0; m < 4; ++m)
#pragma unroll
                for (int n = 0; n < 2; ++n) acc[a][b][m][n] = (f32x4){0.f, 0.f, 0.f, 0.f};
    bf16x8 At[4][2], B0[2][2], B1[2][2];
    const char* cA = (const char*)g.A + (size_t)cur.pm * tstep; const char* cB = (const char*)g.Bt + (size_t)cur.pn * tstep;
    S.a_ready(cur);
    if constexpr (SP2) {
        PG8_STAGE(PG8_SB(0, 0), cB, voffB); PG8_STAGE(PG8_SB(0, 1), cB + hstep, voffB); PG8_STAGE(PG8_SA(0, 0), cA, voffA); PG8_STAGE(PG8_SA(0, 1), cA + hstep, voffA);
        if (wr == 1) PG8_BAR;
        PG8_WAIT_V(2); PG8_BAR;
        PG8_STAGE(PG8_SB(1, 0), cB + kstep, voffB); PG8_STAGE(PG8_SA(1, 0), cA + kstep, voffA); PG8_STAGE(PG8_SB(1, 1), cB + hstep + kstep, voffB);
        PG8_WAIT_V(6); PG8_BAR;
    } else {
        PG8_STAGE(PG8_SB(0, 0), cB, voffB); PG8_STAGE(PG8_SA(0, 0), cA, voffA); PG8_STAGE(PG8_SB(0, 1), cB + hstep, voffB); PG8_STAGE(PG8_SA(0, 1), cA + hstep, voffA);
        if (wr == 1) PG8_BAR;
        PG8_WAIT_V(4); PG8_BAR;
        PG8_STAGE(PG8_SB(1, 0), cB + kstep, voffB); PG8_STAGE(PG8_SA(1, 0), cA + kstep, voffA); PG8_STAGE(PG8_SB(1, 1), cB + hstep + kstep, voffB);
        PG8_WAIT_V(6); PG8_BAR;
    }
    for (;;) {
        const bool has_next = S.next(ui + 1, nxt);
        const char* nA = has_next ? (const char*)g.A + (size_t)nxt.pm * tstep : cA; const char* nB = has_next ? (const char*)g.Bt + (size_t)nxt.pn * tstep : cB;
        for (int t = 0; t < nt; t += 2) {
            const bool last = (t == nt - 2);
            const char* a1 = cA + (size_t)(t + 1) * kstep;
            const char* a2 = last ? nA : cA + (size_t)(t + 2) * kstep; const char* b2 = last ? nB : cB + (size_t)(t + 2) * kstep;
            const char* a3 = a2 + kstep; const char* b3 = b2 + kstep;
            if (last && has_next) S.a_ready(nxt);
            if constexpr (SP2) {
            PG8_LDB(B0, 0, 0); PG8_LDB(B1, 0, 1); PG8_SCHED; PG8_LDA(At, 0, 0); PG8_STAGE(PG8_SA(1, 1), a1 + hstep, voffA);
            PG8_WAIT_V(8); PG8_WAIT_L(0); PG8_BAR; PG8_MMA(0, 0, At, B0); PG8_MMA(0, 1, At, B1); PG8_BAR; PG8_SCHED;
            PG8_LDA(At, 0, 1); PG8_STAGE(PG8_SB(0, 0), b2, voffB); PG8_STAGE(PG8_SB(0, 1), b2 + hstep, voffB); PG8_STAGE(PG8_SA(0, 0), a2, voffA);
            PG8_WAIT_V(8); PG8_WAIT_L(0); PG8_BAR; PG8_MMA(1, 0, At, B0); PG8_MMA(1, 1, At, B1); PG8_BAR; PG8_SCHED;
            PG8_LDB(B0, 1, 0); PG8_LDB(B1, 1, 1); PG8_SCHED; PG8_LDA(At, 1, 0); PG8_STAGE(PG8_SA(0, 1), a2 + hstep, voffA);
            PG8_WAIT_V(8); PG8_WAIT_L(0); PG8_BAR; PG8_MMA(0, 0, At, B0); PG8_MMA(0, 1, At, B1); PG8_BAR; PG8_SCHED;
            PG8_LDA(At, 1, 1); PG8_STAGE(PG8_SB(1, 0), b3, voffB); PG8_STAGE(PG8_SB(1, 1), b3 + hstep, voffB); PG8_STAGE(PG8_SA(1, 0), a3, voffA);
            PG8_WAIT_V(8); PG8_WAIT_L(0); PG8_BAR; PG8_MMA(1, 0, At, B0); PG8_MMA(1, 1, At, B1); PG8_BAR; PG8_SCHED;
            } else {
            PG8_LDB(B0, 0, 0); PG8_SCHED; PG8_LDA(At, 0, 0); PG8_STAGE(PG8_SA(1, 1), a1 + hstep, voffA);
            PG8_WAIT_L(8); PG8_BAR; PG8_WAIT_L(0); PG8_MMA(0, 0, At, B0); PG8_BAR; PG8_SCHED;
            PG8_LDB(B1, 0, 1); PG8_STAGE(PG8_SB(0, 0), b2, voffB);
            PG8_BAR; PG8_WAIT_L(0); PG8_MMA(0, 1, At, B1); PG8_BAR;
            PG8_LDA(At, 0, 1); PG8_STAGE(PG8_SA(0, 0), a2, voffA);
            PG8_BAR; PG8_WAIT_L(0); PG8_MMA(1, 0, At, B0); PG8_BAR; PG8_SCHED;
            PG8_STAGE(PG8_SB(0, 1), b2 + hstep, voffB);
            PG8_WAIT_V(6); PG8_BAR; PG8_MMA(1, 1, At, B1); PG8_BAR;
            PG8_LDB(B0, 1, 0); PG8_SCHED; PG8_LDA(At, 1, 0); PG8_STAGE(PG8_SA(0, 1), a2 + hstep, voffA);
            PG8_WAIT_L(8); PG8_BAR; PG8_WAIT_L(0); PG8_MMA(0, 0, At, B0); PG8_BAR; PG8_SCHED;
            PG8_LDB(B1, 1, 1); PG8_STAGE(PG8_SB(1, 0), b3, voffB);
            PG8_BAR; PG8_WAIT_L(0); PG8_MMA(0, 1, At, B1); PG8_BAR;
            PG8_LDA(At, 1, 1); PG8_STAGE(PG8_SA(1, 0), a3, voffA);
            PG8_BAR; PG8_WAIT_L(0); PG8_MMA(1, 0, At, B0); PG8_BAR; PG8_SCHED;
            PG8_STAGE(PG8_SB(1, 1), b3 + hstep, voffB);
            PG8_WAIT_V(6); PG8_BAR; PG8_MMA(1, 1, At, B1); PG8_BAR;
            }
        }
        if constexpr (ALIGN_EPI) { if (wr == 0) PG8_BAR; }
        if constexpr (!Epi::AFTER_DRAIN) { E(acc, cur, wr, wc, fr, fq); S.done(cur); }
        if (!has_next) break;
#pragma unroll
        for (int a = 0; a < 2; ++a)
#pragma unroll
            for (int b = 0; b < 2; ++b)
#pragma unroll
                for (int m = 0; m < 4; ++m)
#pragma unroll
                    for (int n = 0; n < 2; ++n) acc[a][b][m][n] = (f32x4){0.f, 0.f, 0.f, 0.f};
        cur = nxt; cA = nA; cB = nB; ++ui;
        if constexpr (ALIGN_EPI) { if (wr == 1) PG8_BAR; }
    }
    PG8_WAIT_V(0);
    if constexpr (!ALIGN_EPI) { if (wr == 0) PG8_BAR; }
    PG8_BAR;
    if constexpr (Epi::AFTER_DRAIN) { E.fused(acc, cur, wr, wc, fr, fq, lds, wid, lane); S.done(cur); }
#undef PG8_SA
#undef PG8_SB
#undef PG8_STAGE
#undef PG8_LDA
#undef PG8_LDB
#undef PG8_MMA
#undef PG8_WAIT_V
#undef PG8_WAIT_L
#undef PG8_BAR
#undef PG8_SCHED
}
}

#ifndef REP_THR
#define REP_THR 1
#endif
#ifndef REP_NORM
#define REP_NORM 1
#endif
#ifndef REP_PRO
#define REP_PRO 1
#endif
#ifndef REP_ATTN
#define REP_ATTN 1
#endif
#ifndef REP_S2
#define REP_S2 1
#endif
#ifndef REP_GEMM
#define REP_GEMM 1
#endif
#ifndef REP_HO
#define REP_HO 1
#endif
__device__ __forceinline__ int ltid() { int t = threadIdx.x; asm volatile("" : "+v"(t)); return t; }
#define TID ltid()

__device__ __forceinline__ void cvt_kind(const float* __restrict__ src, bf16_t* __restrict__ dst, int K, int N, int Npad, LAS float* tl) {
    const int tid = TID, nk = K / 64, nn = Npad / 64, per = nk * nn, total = DEPTH * per;
    for (int t = blockIdx.x; t < total; t += gridDim.x) {
        const int l = t / per, r = t % per, kt = r / nn, nt = r % nn;
        const float* s = src + (size_t)l * K * N; bf16_t* d = dst + (size_t)l * Npad * K;
#pragma unroll
        for (int i = 0; i < 2; ++i) { const int kr = (tid >> 4) + 32 * i, nc = (tid & 15) * 4, n = nt * 64 + nc;
            f32x4 v = (f32x4){0.f, 0.f, 0.f, 0.f};
            if (n < N) v = *(const f32x4*)(s + (size_t)(kt * 64 + kr) * N + n);
            tl[kr * 65 + nc + 0] = v[0]; tl[kr * 65 + nc + 1] = v[1]; tl[kr * 65 + nc + 2] = v[2]; tl[kr * 65 + nc + 3] = v[3]; }
        __syncthreads();
        { const int n = tid >> 3, k8 = (tid & 7) * 8; u32x4 w;
            w.x = cvt_pk_bf16(tl[(k8 + 0) * 65 + n], tl[(k8 + 1) * 65 + n]); w.y = cvt_pk_bf16(tl[(k8 + 2) * 65 + n], tl[(k8 + 3) * 65 + n]);
            w.z = cvt_pk_bf16(tl[(k8 + 4) * 65 + n], tl[(k8 + 5) * 65 + n]); w.w = cvt_pk_bf16(tl[(k8 + 6) * 65 + n], tl[(k8 + 7) * 65 + n]);
            *(u32x4*)(d + (size_t)(nt * 64 + n) * K + kt * 64 + k8) = w; }
        __syncthreads();
    }
}

__device__ __forceinline__ void mod_phase(const Params& p, LAS float* sm) {
    const int tid = TID;
    LAS float* cact = sm; LAS float* red = sm + 8192;
    for (int i = tid; i < NB * DM; i += NTHREADS) cact[i] = siluf_(p.c[i]);
    __syncthreads();
    float* MOD = (float*)(p.ws + WS_MOD);
    for (int it = blockIdx.x; it < DEPTH * 96; it += gridDim.x) {
        const int l = it / 96, j0 = (it % 96) * 64, col = tid & 63, seg = tid >> 6;
        const float* w = p.ada_w + (size_t)l * DM * 6144 + j0 + col;
        float a0 = 0.f, a1 = 0.f, a2 = 0.f, a3 = 0.f, a4 = 0.f, a5 = 0.f, a6 = 0.f, a7 = 0.f;
#pragma unroll 8
        for (int k = seg * 128; k < seg * 128 + 128; ++k) { const float wv = w[(size_t)k * 6144];
            a0 += cact[0 * DM + k] * wv; a1 += cact[1 * DM + k] * wv; a2 += cact[2 * DM + k] * wv; a3 += cact[3 * DM + k] * wv;
            a4 += cact[4 * DM + k] * wv; a5 += cact[5 * DM + k] * wv; a6 += cact[6 * DM + k] * wv; a7 += cact[7 * DM + k] * wv; }
        red[(seg * 8 + 0) * 64 + col] = a0; red[(seg * 8 + 1) * 64 + col] = a1; red[(seg * 8 + 2) * 64 + col] = a2; red[(seg * 8 + 3) * 64 + col] = a3;
        red[(seg * 8 + 4) * 64 + col] = a4; red[(seg * 8 + 5) * 64 + col] = a5; red[(seg * 8 + 6) * 64 + col] = a6; red[(seg * 8 + 7) * 64 + col] = a7;
        __syncthreads();
        { const int b = tid >> 6; float s = p.ada_b[l * 6144 + j0 + col];
#pragma unroll
            for (int sg = 0; sg < 8; ++sg) s += red[(sg * 8 + b) * 64 + col];
            MOD[(size_t)(l * NB + b) * 6144 + j0 + col] = s; }
        __syncthreads();
    }
}

__device__ __forceinline__ void lb_phase(const Params& p) {
    if (blockIdx.x != 0) return;
    const int k = TID; float* LB = (float*)(p.ws + WS_LB);
    const float v0 = p.lb_logits[k], v1 = p.lb_logits[512 + k], v2 = p.lb_logits[1024 + k], v3 = p.lb_logits[1536 + k];
    const float mx = fmaxf(fmaxf(v0, v1), fmaxf(v2, v3));
    const float e0 = expf(v0 - mx), e1 = expf(v1 - mx), e2 = expf(v2 - mx), e3 = expf(v3 - mx), inv = 1.f / (e0 + e1 + e2 + e3);
    const float p0 = e0 * inv, p1 = e1 * inv, p2 = e2 * inv, p3 = e3 * inv;
    LB[k] = p0 - p0; LB[512 + k] = (p0 + p1) - p0; LB[1024 + k] = ((p0 + p1) + p2) - p0; LB[1536 + k] = (((p0 + p1) + p2) + p3) - p0;
}

__device__ __forceinline__ void rmsnorm_mod(const float* __restrict__ xs, const float* __restrict__ w, const float* __restrict__ mod, int sh_off, int sc_off, bf16_t* __restrict__ dst) {
    const int tid = TID, wave = tid >> 6, lane = tid & 63;
    for (int row = blockIdx.x * 8 + wave; row < NTOK; row += gridDim.x * 8) {
        const float* xr = xs + (size_t)row * DM; f32x4 v[4]; float ss = 0.f;
#pragma unroll
        for (int i = 0; i < 4; ++i) { v[i] = *(const f32x4*)(xr + i * 256 + lane * 4); ss += v[i][0] * v[i][0] + v[i][1] * v[i][1] + v[i][2] * v[i][2] + v[i][3] * v[i][3]; }
        ss = wave_sum(ss);
        const float rstd = rsqrtf(ss * (1.f / DM) + EPS);
        const float* mb = mod + (size_t)(row >> 12) * 6144;
#pragma unroll
        for (int i = 0; i < 4; ++i) { const int col = i * 256 + lane * 4;
            const f32x4 ww = *(const f32x4*)(w + col), sc = *(const f32x4*)(mb + sc_off + col), sh = *(const f32x4*)(mb + sh_off + col);
            const f32x4 h = (v[i] * rstd * ww) * (sc + 1.f) + sh;
            u32x2 o; o.x = cvt_pk_bf16(h[0], h[1]); o.y = cvt_pk_bf16(h[2], h[3]);
            *(u32x2*)(dst + (size_t)row * DM + col) = o; }
    }
}
__device__ __forceinline__ void final_norm(float* __restrict__ x, const float* __restrict__ w) {
    const int tid = TID, wave = tid >> 6, lane = tid & 63;
    for (int row = blockIdx.x * 8 + wave; row < NTOK; row += gridDim.x * 8) {
        float* xr = x + (size_t)row * DM; f32x4 v[4]; float ss = 0.f;
#pragma unroll
        for (int i = 0; i < 4; ++i) { v[i] = *(const f32x4*)(xr + i * 256 + lane * 4); ss += v[i][0] * v[i][0] + v[i][1] * v[i][1] + v[i][2] * v[i][2] + v[i][3] * v[i][3]; }
        ss = wave_sum(ss);
        const float rstd = rsqrtf(ss * (1.f / DM) + EPS);
#pragma unroll
        for (int i = 0; i < 4; ++i) { const int col = i * 256 + lane * 4; const f32x4 ww = *(const f32x4*)(w + col); *(f32x4*)(xr + col) = v[i] * rstd * ww; }
    }
}

__device__ __forceinline__ void vt_item(const Params& p, int b, int tt, LAS unsigned char* sm) {
    const int tid = TID; LAS bf16_t* vb = (LAS bf16_t*)sm;
    const bf16_t* proj = (const bf16_t*)(p.ws + WS_BIG) + (size_t)(b * SEQ + tt * 64) * DINP + OFF_SV;
#pragma unroll
    for (int i = 0; i < 4; ++i) { const int idx = tid + NTHREADS * i, row = idx >> 5, c8 = (idx & 31) * 8;
        *(LAS bf16x8*)(vb + row * 264 + c8) = *(const bf16x8*)(proj + (size_t)row * DINP + c8); }
    __syncthreads();
    { const int col = tid >> 1, half = tid & 1;
        bf16_t* dst = (bf16_t*)(p.ws + WS_VT) + ((size_t)(b * 4 + (col >> 6)) * 64 + (col & 63)) * SEQ + tt * 64 + half * 32;
#pragma unroll
        for (int i = 0; i < 4; ++i) { bf16x8 o;
#pragma unroll
            for (int e = 0; e < 8; ++e) o[e] = (short)vb[(half * 32 + i * 8 + e) * 264 + col];
            *(bf16x8*)(dst + i * 8) = o; } }
    __syncthreads();
}

__device__ __forceinline__ void conv_item(const Params& p, int l, int b, int tt, LAS unsigned char* sm) {
    const int tid = TID; LAS float* hb = (LAS float*)sm;
    LAS float* ob = (LAS float*)(sm + 62 * 256 * 4);
    const int t0 = tt * 32;
    const bf16_t* proj = (const bf16_t*)(p.ws + WS_BIG) + (size_t)b * SEQ * DINP + OFF_CU;
#pragma unroll
    for (int i = 0; i < 4; ++i) { const int idx = tid + NTHREADS * i;
        if (idx < 62 * 32) { const int row = idx >> 5, c8 = (idx & 31) * 8, t = t0 - 30 + row;
            f32x4 h0 = (f32x4){0.f, 0.f, 0.f, 0.f}, h1 = h0;
            if (t >= 0) { const bf16x8 a = *(const bf16x8*)(proj + (size_t)t * DINP + c8), g = *(const bf16x8*)(proj + (size_t)t * DINP + 256 + c8);
#pragma unroll
                for (int j = 0; j < 4; ++j) { h0[j] = bf2f(a[j]) * sigmoidf_(bf2f(g[j])); h1[j] = bf2f(a[4 + j]) * sigmoidf_(bf2f(g[4 + j])); } }
            *(LAS f32x4*)(hb + row * 256 + c8) = h0; *(LAS f32x4*)(hb + row * 256 + c8 + 4) = h1; } }
    __syncthreads();
    { const int ch = tid & 255, half = tid >> 8;
        float w[31];
#pragma unroll
        for (int j = 0; j < 31; ++j) w[j] = p.cv_w[(size_t)(l * 31 + j) * 256 + ch];
        const float bias = p.cv_b[l * 256 + ch];
        float o[16];
#pragma unroll
        for (int i = 0; i < 16; ++i) o[i] = bias;
#pragma unroll
        for (int r = 0; r < 46; ++r) { const float hv = hb[(half * 16 + r) * 256 + ch];
#pragma unroll
            for (int i = 0; i < 16; ++i) { const int j = r - i; if (j >= 0 && j <= 30) o[i] = fmaf(hv, w[j], o[i]); } }
#pragma unroll
        for (int i = 0; i < 16; ++i) ob[(half * 16 + i) * 256 + ch] = o[i]; }
    __syncthreads();
    { const int wave = tid >> 6, lane = tid & 63;
        const f32x4 lw = *(const f32x4*)(p.cv_ln_w + l * 256 + lane * 4), lbv = *(const f32x4*)(p.cv_ln_b + l * 256 + lane * 4);
        bf16_t* mix = (bf16_t*)(p.ws + WS_HB);
#pragma unroll
        for (int i = 0; i < 4; ++i) { const int tl = wave * 4 + i;
            const f32x4 xv = *(LAS f32x4*)(ob + tl * 256 + lane * 4);
            const float mu = wave_sum(xv[0] + xv[1] + xv[2] + xv[3]) * (1.f / 256.f);
            const f32x4 dv = xv - mu;
            const float var = wave_sum(dv[0] * dv[0] + dv[1] * dv[1] + dv[2] * dv[2] + dv[3] * dv[3]) * (1.f / 256.f);
            const float rs = rsqrtf(var + EPS);
            const f32x4 y = dv * rs * lw + lbv;
            u32x2 o2; o2.x = cvt_pk_bf16(siluf_(y[0]), siluf_(y[1])); o2.y = cvt_pk_bf16(siluf_(y[2]), siluf_(y[3]));
            *(u32x2*)(mix + (size_t)(b * SEQ + t0 + tl) * DM + 768 + lane * 4) = o2; } }
    __syncthreads();
}

constexpr float IDX_WSCALE = 0.35355339059327373f * 0.17677669529663687f;
__device__ __forceinline__ f32x4 idx_scores(const bf16x8 ka, const bf16x8 (&qi)[8], const float (&wq)[8]) {
    f32x4 s = (f32x4){0.f, 0.f, 0.f, 0.f};
#pragma unroll
    for (int h = 0; h < 8; ++h) { const f32x4 d = mfma16(ka, qi[h], (f32x4){0.f, 0.f, 0.f, 0.f});
#pragma unroll
        for (int r = 0; r < 4; ++r) s[r] = __builtin_fmaf(wq[h], fmaxf(d[r], 0.f), s[r]); }
    return s;
}

__device__ __forceinline__ void cnt_ge(int& cn, unsigned a, unsigned b) { asm("v_cmp_ge_u32 vcc, %1, %2\n\tv_addc_co_u32 %0, vcc, 0, %0, vcc" : "+v"(cn) : "v"(a), "v"(b) : "vcc"); }
constexpr int TH_ROW = 40, TH_BUF = 1024 * TH_ROW * 2, TH_CNT = TH_BUF;
__device__ __forceinline__ void thr_item(const Params& p, int b, int qt, LAS unsigned char* sm) {
    const int tid = TID, w = __builtin_amdgcn_readfirstlane(tid >> 6), l = tid & 63, c16 = l & 15, g = l >> 4;
    LAS unsigned* cnt = (LAS unsigned*)(sm + TH_CNT);
    const bf16_t* proj = (const bf16_t*)(p.ws + WS_BIG) + (size_t)b * SEQ * DINP;
    const int q = qt * 16 + c16;
    const bf16_t* qrow = proj + (size_t)q * DINP;
    bf16x8 qi[8]; float wq[8];
#pragma unroll
    for (int h = 0; h < 8; ++h) qi[h] = *(const bf16x8*)(qrow + OFF_IQ + h * 32 + g * 8);
    { const bf16x8 wv = *(const bf16x8*)(qrow + OFF_IW);
#pragma unroll
        for (int h = 0; h < 8; ++h) wq[h] = bf2f(wv[h]) * IDX_WSCALE; }
    unsigned sc[32][4];
    const int ni = (qt >= w) ? ((qt - w) >> 3) + 1 : 0;
    const int nchunk = (qt >> 6) + 1;
    const bf16_t* gsrc = proj + (size_t)(tid >> 2) * DINP + OFF_IK + (tid & 3) * 8;
    const int ldst = (tid >> 2) * TH_ROW + (tid & 3) * 8;
    bf16x8 stg[8];
#define TH_LOAD(ck_) do { const bf16_t* s_ = gsrc + (size_t)(ck_) * 1024 * DINP; _Pragma("unroll") for (int m_ = 0; m_ < 8; ++m_) stg[m_] = *(const bf16x8*)(s_ + (size_t)(128 * m_) * DINP); } while (0)
#define TH_STORE() do { LAS bf16_t* d_ = (LAS bf16_t*)sm + ldst; _Pragma("unroll") for (int m_ = 0; m_ < 8; ++m_) *(LAS bf16x8*)(d_ + 128 * m_ * TH_ROW) = stg[m_]; } while (0)
    TH_LOAD(0);
    for (int i = tid; i < 48 * 16; i += NTHREADS) cnt[i] = 0u;
#pragma unroll
    for (int ck = 0; ck < 4; ++ck) {
        if (ck < nchunk) {
            TH_STORE();
            __syncthreads();
            if (ck + 1 < nchunk) TH_LOAD(ck + 1);
            LAS bf16_t* B = (LAS bf16_t*)sm;
#pragma unroll
            for (int j = 0; j < 8; ++j) { const int i = ck * 8 + j, kt = w + 8 * i;
                if (kt <= qt) { const bf16x8 ka = *(LAS bf16x8*)(B + ((j * 8 + w) * 16 + c16) * TH_ROW + g * 8);
                    const f32x4 s = idx_scores(ka, qi, wq);
#pragma unroll
                    for (int r = 0; r < 4; ++r) { const int key = kt * 16 + 4 * g + r; sc[i][r] = (key <= q) ? sortable(s[r]) : 0u; }
                } else { sc[i][0] = 0u; sc[i][1] = 0u; sc[i][2] = 0u; sc[i][3] = 0u; } }
            if (ck + 1 < nchunk) __syncthreads();
        } else {
#pragma unroll
            for (int j = 0; j < 8; ++j) { sc[ck * 8 + j][0] = 0u; sc[ck * 8 + j][1] = 0u; sc[ck * 8 + j][2] = 0u; sc[ck * 8 + j][3] = 0u; }
        }
    }
#undef TH_LOAD
#undef TH_STORE
#define TH_XCHG(tot_) do { __hip_atomic_fetch_add(&cnt[it * 16 + c16], (unsigned)cn, __ATOMIC_RELAXED, __HIP_MEMORY_SCOPE_WORKGROUP); __syncthreads(); tot_ = (int)cnt[it * 16 + c16]; } while (0)
    unsigned T = 0u; bool done = false; int it = 0;
    for (; it < 32; ++it) {
        const unsigned cand = T | (1u << (31 - it)); int cn = 0;
#pragma unroll
        for (int gi = 0; gi < 4; ++gi) if (ni > 8 * gi) {
#pragma unroll
            for (int i = 8 * gi; i < 8 * gi + 8; ++i) { cnt_ge(cn, sc[i][0], cand); cnt_ge(cn, sc[i][1], cand); cnt_ge(cn, sc[i][2], cand); cnt_ge(cn, sc[i][3], cand); } }
        int tot; TH_XCHG(tot);
        if (!done) { if (tot >= TOPK) T = cand; if (tot == TOPK) done = true; }
        if (__all(done)) { ++it; break; }
    }
    unsigned ceq = 4095u; bool tied = false;
    const bool open = !done && (T != 0u);
    if (!__all(!open)) {
        int ngt = 0, nge = 0;
        for (int e = 0; e < 2; ++e, ++it) {
            const unsigned cand = (e == 0) ? T + 1u : T; int cn = 0;
#pragma unroll
            for (int gi = 0; gi < 4; ++gi) if (ni > 8 * gi) {
#pragma unroll
            for (int i = 8 * gi; i < 8 * gi + 8; ++i) { cnt_ge(cn, sc[i][0], cand); cnt_ge(cn, sc[i][1], cand); cnt_ge(cn, sc[i][2], cand); cnt_ge(cn, sc[i][3], cand); } }
            int tot; TH_XCHG(tot);
            if (e == 0) ngt = tot; else nge = tot;
        }
        const int need = TOPK - ngt; const bool excess = open && (nge - ngt > need);
#pragma unroll
        for (int i = 0; i < 32; ++i)
#pragma unroll
            for (int r = 0; r < 4; ++r) sc[i][r] = (sc[i][r] == T) ? (unsigned)((w + 8 * i) * 16 + 4 * g + r) : (sc[i][r] > T ? 0xfffffffeu : 0xffffffffu);
        unsigned c = 0u;
        for (int s = 0; s < 12; ++s, ++it) {
            const unsigned cand = c | (1u << (11 - s)); int cn = 0;
#pragma unroll
            for (int gi = 0; gi < 4; ++gi) if (ni > 8 * gi) {
#pragma unroll
                for (int i = 8 * gi; i < 8 * gi + 8; ++i) { cnt_ge(cn, cand - 1u, sc[i][0]); cnt_ge(cn, cand - 1u, sc[i][1]); cnt_ge(cn, cand - 1u, sc[i][2]); cnt_ge(cn, cand - 1u, sc[i][3]); } }
            int tot; TH_XCHG(tot);
            if (tot < need) c = cand;
        }
        if (excess) ceq = c;
        tied = true;
    }
#undef TH_XCHG
    LAS unsigned* lm = (LAS unsigned*)sm;
    __syncthreads();
    for (int i = tid; i < 2048; i += NTHREADS) lm[i] = 0u;
    __syncthreads();
    { const unsigned Tm = T > 1u ? T : 1u; const bool allow_eq = (T != 0u);
#pragma unroll
        for (int gi = 0; gi < 4; ++gi) if (ni > 8 * gi) {
#pragma unroll
            for (int i = 8 * gi; i < 8 * gi + 8; ++i) { unsigned nib = 0u;
#pragma unroll
                for (int r = 0; r < 4; ++r) { const unsigned v = sc[i][r];
                    const bool s_ = tied ? ((v == 0xfffffffeu) || (allow_eq && v <= ceq)) : (v >= Tm);
                    nib |= s_ ? (1u << r) : 0u; }
                const int kt = w + 8 * i;
                if (nib) __hip_atomic_fetch_or(&lm[c16 * 128 + (kt >> 1)], nib << (4 * g + 16 * (kt & 1)), __ATOMIC_RELAXED, __HIP_MEMORY_SCOPE_WORKGROUP); } }
    }
    __syncthreads();
    { unsigned* gm = (unsigned*)(p.ws + WS_MASK) + (size_t)(b * SEQ + qt * 16) * 128;
        *(u32x4*)(gm + tid * 4) = *(LAS u32x4*)(lm + tid * 4); }
    __syncthreads();
}

constexpr int AT_KROW = 264, AT_IROW = 40, AT_VROW = 40;
constexpr int AT_OFFI = 32 * AT_KROW * 2, AT_OFFV = AT_OFFI + 32 * AT_IROW * 2, AT_BUF = AT_OFFV + 256 * AT_VROW * 2;
__device__ __forceinline__ int at_row(int r) { return (r & 3) + 4 * ((r >> 3) & 3) + 16 * ((r >> 2) & 1); }
__device__ __forceinline__ void attn_item(const Params& p, int b, int qb, LAS unsigned char* sm) {
    const int tid = TID, w = __builtin_amdgcn_readfirstlane(tid >> 6), l = tid & 63, c16 = l & 15, g = l >> 4, qs = w & 3, hp = w >> 2;
    const bf16_t* proj = (const bf16_t*)(p.ws + WS_BIG) + (size_t)b * SEQ * DINP;
    const bf16_t* vt = (const bf16_t*)(p.ws + WS_VT) + (size_t)b * 4 * 64 * SEQ;
    const int q = qb * 64 + qs * 16 + c16;
    const bf16_t* qrow = proj + (size_t)q * DINP;
    const unsigned* mrow = (const unsigned*)(p.ws + WS_MASK) + (size_t)(b * SEQ + q) * 128;
    bf16x8 Qb[2][2];
#pragma unroll
    for (int hh = 0; hh < 2; ++hh)
#pragma unroll
        for (int kk = 0; kk < 2; ++kk) { const bf16x8 raw = *(const bf16x8*)(qrow + OFF_SQ + (2 * hp + hh) * 64 + kk * 32 + g * 8); bf16x8 o;
#pragma unroll
            for (int e = 0; e < 8; ++e) o[e] = (short)f2bf(bf2f(raw[e]) * 0.125f);
            Qb[hh][kk] = o; }
    f32x4 O[2][4];
#pragma unroll
    for (int hh = 0; hh < 2; ++hh)
#pragma unroll
        for (int dt = 0; dt < 4; ++dt) O[hh][dt] = (f32x4){0.f, 0.f, 0.f, 0.f};
    float mrun[2] = {-1e30f, -1e30f}, lrun[2] = {0.f, 0.f};
    const int nt = 2 * qb + 2, my_nt = (qb * 64 + qs * 16 + 15) / 32 + 1;
    const int kr0 = tid >> 5, kc = (tid & 31) * 8, vr0 = tid >> 2, vc = (tid & 3) * 8;
    const bf16_t* gK = proj + (size_t)kr0 * DINP + OFF_SK + kc;
    const bf16_t* gV = vt + (size_t)vr0 * SEQ + vc;
    const int lK0 = at_row(kr0) * AT_KROW + kc, lK1 = at_row(kr0 + 16) * AT_KROW + kc;
    const int lV0 = AT_OFFV / 2 + vr0 * AT_VROW + vc, lV1 = AT_OFFV / 2 + (vr0 + 128) * AT_VROW + vc;
    bf16x8 sA[4], sB[4]; unsigned mw = 0u, mwA = 0u, mwB = 0u;
#define AT_LOAD(S_, M_, k0_) do { S_[0] = *(const bf16x8*)(gK + (size_t)(k0_) * DINP); S_[1] = *(const bf16x8*)(gK + (size_t)((k0_) + 16) * DINP); \
        M_ = mrow[(k0_) >> 5]; S_[2] = *(const bf16x8*)(gV + (k0_)); S_[3] = *(const bf16x8*)(gV + (size_t)128 * SEQ + (k0_)); } while (0)
#define AT_STORE(S_, buf_) do { LAS bf16_t* B_ = (LAS bf16_t*)(sm + (buf_) * AT_BUF); *(LAS bf16x8*)(B_ + lK0) = S_[0]; *(LAS bf16x8*)(B_ + lK1) = S_[1]; \
        *(LAS bf16x8*)(B_ + lV0) = S_[2]; *(LAS bf16x8*)(B_ + lV1) = S_[3]; } while (0)
    AT_LOAD(sA, mwA, 0); AT_STORE(sA, 0); mw = mwA;
    AT_LOAD(sB, mwB, 32);
    __syncthreads();
    for (int t2 = 0; t2 < nt; t2 += 2) {
#pragma unroll
      for (int par = 0; par < 2; ++par) {
        const int t = t2 + par, k0 = t * 32;
        if (t + 2 < nt) { if (par == 0) AT_LOAD(sA, mwA, k0 + 64); else AT_LOAD(sB, mwB, k0 + 64); }
        if (t < my_nt) {
            LAS bf16_t* Bk = (LAS bf16_t*)(sm + par * AT_BUF); LAS bf16_t* Bv = Bk + AT_OFFV / 2;
            bool sel[2][4]; float lg[2][2][4];
#pragma unroll
            for (int s = 0; s < 2; ++s) {
                const int lrow = 16 * s + c16;
#pragma unroll
                for (int r = 0; r < 4; ++r) sel[s][r] = ((mw >> (8 * g + 4 * s + r)) & 1u) != 0u;
#pragma unroll
                for (int hh = 0; hh < 2; ++hh) { f32x4 S = (f32x4){0.f, 0.f, 0.f, 0.f};
#pragma unroll
                    for (int kk = 0; kk < 2; ++kk) { const bf16x8 kf = *(LAS bf16x8*)(Bk + lrow * AT_KROW + (2 * hp + hh) * 64 + kk * 32 + g * 8); S = mfma16(kf, Qb[hh][kk], S); }
#pragma unroll
                    for (int r = 0; r < 4; ++r) lg[hh][s][r] = S[r]; }
            }
#pragma unroll
            for (int hh = 0; hh < 2; ++hh) {
                float lm_[8];
#pragma unroll
                for (int s = 0; s < 2; ++s)
#pragma unroll
                    for (int r = 0; r < 4; ++r) lm_[s * 4 + r] = sel[s][r] ? lg[hh][s][r] : -1e30f;
                float mx = fmaxf(fmaxf(fmaxf(lm_[0], lm_[1]), fmaxf(lm_[2], lm_[3])), fmaxf(fmaxf(lm_[4], lm_[5]), fmaxf(lm_[6], lm_[7])));
                mx = fmaxf(mx, __shfl_xor(mx, 16)); mx = fmaxf(mx, __shfl_xor(mx, 32));
                const float mn = fmaxf(mrun[hh], mx), alpha = __expf(mrun[hh] - mn);
                mrun[hh] = mn;
                float pv[8]; float ps = 0.f;
#pragma unroll
                for (int e = 0; e < 8; ++e) { pv[e] = (mn > -1e29f) ? __expf(lm_[e] - mn) : 0.f; ps += pv[e]; }
                lrun[hh] = lrun[hh] * alpha + ps;
                union { bf16x8 v; unsigned u[4]; } pb;
                pb.u[0] = cvt_pk_bf16(pv[0], pv[1]); pb.u[1] = cvt_pk_bf16(pv[2], pv[3]); pb.u[2] = cvt_pk_bf16(pv[4], pv[5]); pb.u[3] = cvt_pk_bf16(pv[6], pv[7]);
                if (__any(alpha != 1.f)) {
#pragma unroll
                    for (int dt = 0; dt < 4; ++dt) O[hh][dt] = O[hh][dt] * alpha; }
#pragma unroll
                for (int dt = 0; dt < 4; ++dt) {
                    const bf16x8 va = *(LAS bf16x8*)(Bv + ((2 * hp + hh) * 64 + dt * 16 + c16) * AT_VROW + g * 8);
                    O[hh][dt] = mfma16(va, pb.v, O[hh][dt]); }
            }
        }
        if (t + 1 < nt) { if (par == 0) { AT_STORE(sB, 1); mw = mwB; } else { AT_STORE(sA, 0); mw = mwA; } }
        __syncthreads();
      }
    }
#undef AT_LOAD
#undef AT_STORE
    bf16_t* mix = (bf16_t*)(p.ws + WS_HB) + (size_t)(b * SEQ + q) * DM + 512;
#pragma unroll
    for (int hh = 0; hh < 2; ++hh) { float tot = lrun[hh]; tot += __shfl_xor(tot, 16); tot += __shfl_xor(tot, 32);
        const float inv = 1.f / tot;
#pragma unroll
        for (int dt = 0; dt < 4; ++dt) { const f32x4 o = O[hh][dt] * inv; u32x2 o2; o2.x = cvt_pk_bf16(o[0], o[1]); o2.y = cvt_pk_bf16(o[2], o[3]);
            *(u32x2*)(mix + (2 * hp + hh) * 64 + dt * 16 + 4 * g) = o2; } }
}

__device__ __forceinline__ void hgrn_G(const bf16x8 (&fv)[2], const float* lb, LAS float* Gs, LAS float* segtot) {
    const int tid = TID;
#pragma unroll
    for (int i = 0; i < 2; ++i) { const int row = (tid >> 4) + 32 * i, c8 = (tid & 15) * 8;
        const bf16x8 v = fv[i];
#pragma unroll
        for (int j = 0; j < 8; ++j) { const float fr = bf2f(v[j]), lbv = lb[c8 + j]; const float f = lbv + (1.f - lbv) * sigmoidf_(fr);
            Gs[row * 129 + c8 + j] = __logf(fmaxf(f, 1e-30f)); } }
    __syncthreads();
    const int col = tid & 127, seg = tid >> 7;
    { float run = 0.f;
#pragma unroll
        for (int r = 0; r < 16; ++r) { const int idx = (seg * 16 + r) * 129 + col; run += Gs[idx]; Gs[idx] = run; }
        segtot[seg * 128 + col] = run; }
    __syncthreads();
    { float off = 0.f;
#pragma unroll
        for (int s = 0; s < 3; ++s) if (s < seg) off += segtot[s * 128 + col];
        if (seg > 0) {
#pragma unroll
            for (int r = 0; r < 16; ++r) Gs[(seg * 16 + r) * 129 + col] += off; } }
    __syncthreads();
}

__device__ __forceinline__ void hgrn_local_item(const Params& p, int l, int b, int h, int c, LAS unsigned char* sm) {
    const int tid = TID, w = __builtin_amdgcn_readfirstlane(tid >> 6), ln = tid & 63, c16 = ln & 15, g = ln >> 4;
    LAS float* Gs = (LAS float*)sm; LAS float* segtot = (LAS float*)(sm + 33024);
    LAS bf16_t* KgT = (LAS bf16_t*)(sm + 35072); LAS bf16_t* vT = (LAS bf16_t*)(sm + 53504);
    const bf16_t* prow0 = (const bf16_t*)(p.ws + WS_BIG) + (size_t)(b * SEQ + c * 64) * DINP;
    const float* lb = (const float*)(p.ws + WS_LB) + l * 512 + h * 128;
    bf16x8 fG[2];
#pragma unroll
    for (int i = 0; i < 2; ++i) fG[i] = *(const bf16x8*)(prow0 + (size_t)((tid >> 4) + 32 * i) * DINP + OFF_HF + h * 128 + (tid & 15) * 8);
    const bf16_t* rp = prow0 + (size_t)(tid & 63) * DINP + h * 128 + (tid >> 6) * 16;
    const bf16x8 f0 = *(const bf16x8*)(rp + OFF_HF), f1 = *(const bf16x8*)(rp + OFF_HF + 8), v0 = *(const bf16x8*)(rp + OFF_HI), v1 = *(const bf16x8*)(rp + OFF_HI + 8);
    hgrn_G(fG, lb, Gs, segtot);
    { const int j = tid & 63, kg = tid >> 6;
#pragma unroll
        for (int e = 0; e < 16; ++e) { const int k = kg * 16 + e; const float fr = bf2f(e < 8 ? f0[e & 7] : f1[e & 7]), lbv = lb[k];
            const float kval = (1.f - lbv) * sigmoidf_(-fr);
            KgT[k * 72 + j] = f2bf(kval * __expf(Gs[63 * 129 + k] - Gs[j * 129 + k]));
            vT[k * 72 + j] = (bf16_t)(e < 8 ? v0[e & 7] : v1[e & 7]); } }
    const size_t bhc = (size_t)((b * 4 + h) * 64 + c);
    if (tid < 128) ((float*)(p.ws + WS_DEC))[bhc * 128 + tid] = __expf(Gs[63 * 129 + tid]);
    __syncthreads();
    f32x4 acc[8];
#pragma unroll
    for (int vt = 0; vt < 8; ++vt) acc[vt] = (f32x4){0.f, 0.f, 0.f, 0.f};
#pragma unroll
    for (int kk = 0; kk < 2; ++kk) { const bf16x8 a = *(LAS bf16x8*)(KgT + (w * 16 + c16) * 72 + kk * 32 + g * 8);
#pragma unroll
        for (int vt = 0; vt < 8; ++vt) { const bf16x8 bb = *(LAS bf16x8*)(vT + (vt * 16 + c16) * 72 + kk * 32 + g * 8); acc[vt] = mfma16(a, bb, acc[vt]); } }
    bf16_t* st = (bf16_t*)(p.ws + WS_ST) + bhc * 16384;
#pragma unroll
    for (int vt = 0; vt < 8; ++vt) { u32x2 o; o.x = cvt_pk_bf16(acc[vt][0], acc[vt][1]); o.y = cvt_pk_bf16(acc[vt][2], acc[vt][3]);
        *(u32x2*)(st + (size_t)(vt * 16 + c16) * 128 + w * 16 + 4 * g) = o; }
    __syncthreads();
}

__device__ __forceinline__ void hgrn_scan(const Params& p) {
    bf16_t* ST = (bf16_t*)(p.ws + WS_ST); const float* DEC = (const float*)(p.ws + WS_DEC);
    for (int e = blockIdx.x * NTHREADS + TID; e < 32 * 4096; e += gridDim.x * NTHREADS) {
        const int bh = e >> 12, idx4 = (e & 4095) * 4, k = idx4 & 127;
        bf16_t* base = ST + (size_t)bh * 64 * 16384 + idx4; const float* dec = DEC + (size_t)bh * 64 * 128 + k;
        f32x4 S = (f32x4){0.f, 0.f, 0.f, 0.f};
#pragma unroll 8
        for (int c = 0; c < 64; ++c) { const u32x2 loc = *(const u32x2*)(base + (size_t)c * 16384); const f32x4 d = *(const f32x4*)(dec + c * 128);
            u32x2 o; o.x = cvt_pk_bf16(S[0], S[1]); o.y = cvt_pk_bf16(S[2], S[3]);
            *(u32x2*)(base + (size_t)c * 16384) = o;
            S[0] = d[0] * S[0] + bflo(loc.x); S[1] = d[1] * S[1] + bfhi(loc.x); S[2] = d[2] * S[2] + bflo(loc.y); S[3] = d[3] * S[3] + bfhi(loc.y); }
    }
}

__device__ __forceinline__ void hgrn_out_item(const Params& p, int l, int b, int h, int c, LAS unsigned char* sm) {
    const int tid = TID, w = __builtin_amdgcn_readfirstlane(tid >> 6), ln = tid & 63, c16 = ln & 15, g = ln >> 4;
    LAS float* Gs = (LAS float*)sm; LAS float* segtot = (LAS float*)(sm + 33024);
    LAS bf16_t* qt_ = (LAS bf16_t*)(sm + 35072); LAS bf16_t* kt_ = (LAS bf16_t*)(sm + 52480); LAS bf16_t* qg_ = (LAS bf16_t*)(sm + 69888);
    LAS bf16_t* vT = (LAS bf16_t*)(sm + 87296); LAS bf16_t* Am = (LAS bf16_t*)(sm + 105728); LAS float* ssq = (LAS float*)(sm + 114944);
    const bf16_t* prow0 = (const bf16_t*)(p.ws + WS_BIG) + (size_t)(b * SEQ + c * 64) * DINP;
    const float* lb = (const float*)(p.ws + WS_LB) + l * 512 + h * 128;
    bf16x8 fG[2], qG[2];
#pragma unroll
    for (int i = 0; i < 2; ++i) { const bf16_t* rp = prow0 + (size_t)((tid >> 4) + 32 * i) * DINP + h * 128 + (tid & 15) * 8; fG[i] = *(const bf16x8*)(rp + OFF_HF); qG[i] = *(const bf16x8*)(rp + OFF_HQ); }
    bf16x8 vG0, vG1;
    { const bf16_t* rp = prow0 + (size_t)(tid & 63) * DINP + OFF_HI + h * 128 + (tid >> 6) * 16; vG0 = *(const bf16x8*)(rp); vG1 = *(const bf16x8*)(rp + 8); }
    u32x2 grG[4];
    { const bf16_t* grow_ = prow0 + (size_t)((w & 3) * 16 + c16) * DINP + OFF_HG + h * 128;
#pragma unroll
        for (int vt = 0; vt < 4; ++vt) grG[vt] = *(const u32x2*)(grow_ + ((w >> 2) * 4 + vt) * 16 + 4 * g); }
    bf16x8 stG[4][4];
    { const bf16_t* st_ = (const bf16_t*)(p.ws + WS_ST) + (size_t)((b * 4 + h) * 64 + c) * 16384;
#pragma unroll
        for (int kk = 0; kk < 4; ++kk)
#pragma unroll
            for (int vt = 0; vt < 4; ++vt) stG[kk][vt] = *(const bf16x8*)(st_ + (size_t)(((w >> 2) * 4 + vt) * 16 + c16) * 128 + kk * 32 + g * 8); }
    hgrn_G(fG, lb, Gs, segtot);
#pragma unroll
    for (int i = 0; i < 2; ++i) { const int row = (tid >> 4) + 32 * i, c8 = (tid & 15) * 8;
        const bf16x8 qv8 = qG[i], fv8 = fG[i];
        float a[8], bq[8], cq[8];
#pragma unroll
        for (int j = 0; j < 8; ++j) { const int k = c8 + j; const float G = Gs[row * 129 + k], Gm = Gs[31 * 129 + k], lbv = lb[k];
            const float qv = siluf_(bf2f(qv8[j])) * 0.08838834764831845f, kval = (1.f - lbv) * sigmoidf_(-bf2f(fv8[j]));
            a[j] = qv * __expf(fminf(G - Gm, 80.f)); bq[j] = kval * __expf(fminf(Gm - G, 80.f)); cq[j] = qv * __expf(G); }
        u32x4 o;
        o.x = cvt_pk_bf16(a[0], a[1]); o.y = cvt_pk_bf16(a[2], a[3]); o.z = cvt_pk_bf16(a[4], a[5]); o.w = cvt_pk_bf16(a[6], a[7]); *(LAS u32x4*)(qt_ + row * 136 + c8) = o;
        o.x = cvt_pk_bf16(bq[0], bq[1]); o.y = cvt_pk_bf16(bq[2], bq[3]); o.z = cvt_pk_bf16(bq[4], bq[5]); o.w = cvt_pk_bf16(bq[6], bq[7]); *(LAS u32x4*)(kt_ + row * 136 + c8) = o;
        o.x = cvt_pk_bf16(cq[0], cq[1]); o.y = cvt_pk_bf16(cq[2], cq[3]); o.z = cvt_pk_bf16(cq[4], cq[5]); o.w = cvt_pk_bf16(cq[6], cq[7]); *(LAS u32x4*)(qg_ + row * 136 + c8) = o; }
    { const int j = tid & 63, kg = tid >> 6;
#pragma unroll
        for (int e = 0; e < 16; ++e) vT[(kg * 16 + e) * 72 + j] = (bf16_t)(e < 8 ? vG0[e & 7] : vG1[e & 7]); }
    __syncthreads();
#pragma unroll
    for (int s = 0; s < 2; ++s) { const int tI = w * 2 + s, itile = tI >> 2, jt = tI & 3;
        f32x4 d = (f32x4){0.f, 0.f, 0.f, 0.f};
        if (jt <= itile) {
#pragma unroll
            for (int kk = 0; kk < 4; ++kk) { const bf16x8 a = *(LAS bf16x8*)(kt_ + (jt * 16 + c16) * 136 + kk * 32 + g * 8), bb = *(LAS bf16x8*)(qt_ + (itile * 16 + c16) * 136 + kk * 32 + g * 8);
                d = mfma16(a, bb, d); } }
        const int i = itile * 16 + c16, j0 = jt * 16 + 4 * g;
        u32x2 o; o.x = cvt_pk_bf16((j0 + 0 <= i) ? d[0] : 0.f, (j0 + 1 <= i) ? d[1] : 0.f); o.y = cvt_pk_bf16((j0 + 2 <= i) ? d[2] : 0.f, (j0 + 3 <= i) ? d[3] : 0.f);
        *(LAS u32x2*)(Am + i * 72 + j0) = o; }
    __syncthreads();
    const int itile = w & 3, vh = w >> 2;
    const size_t bhc = (size_t)((b * 4 + h) * 64 + c);
    const bf16_t* st = (const bf16_t*)(p.ws + WS_ST) + bhc * 16384;
    f32x4 acc[4];
#pragma unroll
    for (int vt = 0; vt < 4; ++vt) acc[vt] = (f32x4){0.f, 0.f, 0.f, 0.f};
#pragma unroll
    for (int kk = 0; kk < 2; ++kk) { const bf16x8 bb = *(LAS bf16x8*)(Am + (itile * 16 + c16) * 72 + kk * 32 + g * 8);
#pragma unroll
        for (int vt = 0; vt < 4; ++vt) { const bf16x8 a = *(LAS bf16x8*)(vT + ((vh * 4 + vt) * 16 + c16) * 72 + kk * 32 + g * 8); acc[vt] = mfma16(a, bb, acc[vt]); } }
#pragma unroll
    for (int kk = 0; kk < 4; ++kk) { const bf16x8 bb = *(LAS bf16x8*)(qg_ + (itile * 16 + c16) * 136 + kk * 32 + g * 8);
#pragma unroll
        for (int vt = 0; vt < 4; ++vt) acc[vt] = mfma16(stG[kk][vt], bb, acc[vt]); }
    float ss = 0.f;
#pragma unroll
    for (int vt = 0; vt < 4; ++vt) ss += acc[vt][0] * acc[vt][0] + acc[vt][1] * acc[vt][1] + acc[vt][2] * acc[vt][2] + acc[vt][3] * acc[vt][3];
    ss += __shfl_xor(ss, 16); ss += __shfl_xor(ss, 32);
    const int i = itile * 16 + c16;
    if (g == 0) ssq[vh * 64 + i] = ss;
    __syncthreads();
    const float rstd = rsqrtf((ssq[i] + ssq[64 + i]) * (1.f / 128.f) + EPS);
    bf16_t* mix = (bf16_t*)(p.ws + WS_HB) + (size_t)(b * SEQ + c * 64 + i) * DM + h * 128;
    const bf16_t* grow = prow0 + (size_t)i * DINP + OFF_HG + h * 128;
#pragma unroll
    for (int vt = 0; vt < 4; ++vt) { const int v0 = (vh * 4 + vt) * 16 + 4 * g;
        const u32x2 gr = grG[vt]; const f32x4 ow = *(const f32x4*)(p.onorm_w + l * 512 + h * 128 + v0);
        const float r0 = acc[vt][0] * rstd * ow[0] * siluf_(bflo(gr.x)), r1 = acc[vt][1] * rstd * ow[1] * siluf_(bfhi(gr.x));
        const float r2 = acc[vt][2] * rstd * ow[2] * siluf_(bflo(gr.y)), r3 = acc[vt][3] * rstd * ow[3] * siluf_(bfhi(gr.y));
        u32x2 o; o.x = cvt_pk_bf16(r0, r1); o.y = cvt_pk_bf16(r2, r3);
        *(u32x2*)(mix + v0) = o; }
    __syncthreads();
}


#ifdef DIAG_CUT
__device__ __forceinline__ void diag_phase(const Params& p) {
    const int tid = TID, wave = tid >> 6, lane = tid & 63;
    const bf16_t* HB = (const bf16_t*)(p.ws + WS_HB); const bf16_t* ST = (const bf16_t*)(p.ws + WS_ST); const float* DEC = (const float*)(p.ws + WS_DEC);
    const bf16_t* BIG = (const bf16_t*)(p.ws + WS_BIG);
    for (int row = blockIdx.x * 8 + wave; row < NTOK; row += gridDim.x * 8) {
        float* orow = p.out + (size_t)row * DM;
        for (int i = 0; i < 16; ++i) { const int col = i * 64 + lane; float v = 0.f;
#if DIAG_MODE == 1
            for (int t = 0; t < 3; ++t) v += bf2f((short)BIG[(size_t)row * DINP + col + 1024 * t]);
            if (col < 768) v += bf2f((short)BIG[(size_t)row * DINP + 3072 + col]);
#elif DIAG_MODE == 2
            v = bf2f((short)ST[(size_t)row * 1024 + col]) + DEC[((size_t)row * 8 + (col & 7)) % (32 * 64 * 128)];
#elif DIAG_MODE == 5
            v = DEC[((size_t)row * 8 + (col & 7)) % (32 * 64 * 128)];
#elif DIAG_MODE == 6
            v = bf2f((short)ST[(size_t)row * 1024 + col]);
#elif DIAG_MODE == 4
            v = bf2f((short)HB[(size_t)row * DM + col]);
#endif
            if (!(fabsf(v) < 1e30f)) v = 12345.f;
            orow[col] = v; }
    }
}
#endif
#define XB_TMO      128
#define XB_XCNT(j)  (256  + 64 * (j))
#define XB_XSUB(j)  (1280 + 64 * (j))
#define XB_XGEN(j)  (2304 + 64 * (j))
#define XB_TOP      3328
#define XB_TOPGEN   3392
#define XCD_BAR_WORDS 3456
#define XB_SPIN_CAP (1u << 21)

__device__ __forceinline__ unsigned xb_ld(unsigned* p)              { return __hip_atomic_load(p, __ATOMIC_RELAXED, __HIP_MEMORY_SCOPE_AGENT); }
__device__ __forceinline__ unsigned xb_add(unsigned* p, unsigned v) { return __hip_atomic_fetch_add(p, v, __ATOMIC_RELAXED, __HIP_MEMORY_SCOPE_AGENT); }
__device__ __forceinline__ unsigned xb_xcc_id() { return (unsigned)__builtin_amdgcn_s_getreg((3 << 11) | 20) & 0xFu; }
#define XB_SPIN(cond, bar) do { unsigned _sp = 0; while (cond) { __builtin_amdgcn_s_sleep(1); \
    if ((++_sp & 255u) == 0u) { if (xb_ld(&(bar)[XB_TMO])) break; if (_sp > XB_SPIN_CAP) { atomicAdd(&(bar)[XB_TMO], 1u); break; } } } } while (0)

struct XcdBarrier {
    unsigned* bar; unsigned x;
    volatile LAS unsigned* st;
};

__device__ __forceinline__ XcdBarrier xcd_barrier_post(unsigned* bar, volatile LAS unsigned* st) {
    XcdBarrier b; b.bar = bar; b.x = xb_xcc_id(); b.st = st;
    if (threadIdx.x == 0) (void)xb_add(&bar[XB_XCNT(b.x)], 1u);
    return b;
}
__device__ __forceinline__ void xcd_barrier_complete(unsigned* bar, unsigned x, unsigned& nloc, unsigned& nx) {
    const unsigned G = gridDim.x * gridDim.y * gridDim.z;
    unsigned sum, cnt, mine, sp = 0u;
    for (;;) {
        sum = 0u; cnt = 0u; mine = 0u;
#pragma unroll
        for (unsigned j = 0; j < 16; ++j) { const unsigned c = xb_ld(&bar[XB_XCNT(j)]); sum += c; cnt += (c > 0u) ? 1u : 0u; mine = (j == x) ? c : mine; }
        if (sum == G) break;
        __builtin_amdgcn_s_sleep(1);
        if ((++sp & 255u) == 0u) { if (xb_ld(&bar[XB_TMO])) break; if (sp > XB_SPIN_CAP) { atomicAdd(&bar[XB_TMO], 1u); break; } }
    }
    nloc = mine > 0u ? mine : 1u; nx = cnt > 0u ? cnt : 1u;
}

__device__ __forceinline__ void xcd_barrier(const XcdBarrier& b) {
    asm volatile("s_waitcnt vmcnt(0)" ::: "memory");
    __syncthreads();
    if (threadIdx.x == 0) {
        unsigned* bar = b.bar;
        __builtin_amdgcn_s_waitcnt(0);
        unsigned nloc = b.st[0], nx = b.st[1];
        if (nloc == 0u) { xcd_barrier_complete(bar, b.x, nloc, nx); b.st[0] = nloc; b.st[1] = nx; }
        const unsigned old = xb_add(&bar[XB_XSUB(b.x)], 1u);
        const unsigned gen = old / nloc;
        if (old + 1u == (gen + 1u) * nloc) {
            __builtin_amdgcn_fence(__ATOMIC_RELEASE, "agent");
            asm volatile("s_waitcnt vmcnt(0)" ::: "memory");
            const unsigned og = xb_add(&bar[XB_TOP], 1u);
            const unsigned tg = og / nx;
            if (og + 1u == (tg + 1u) * nx) xb_add(&bar[XB_TOPGEN], 1u);
            else XB_SPIN(xb_ld(&bar[XB_TOPGEN]) == tg, bar);
            __builtin_amdgcn_fence(__ATOMIC_ACQUIRE, "agent");
            xb_add(&bar[XB_XGEN(b.x)], 1u);
            asm volatile("s_waitcnt vmcnt(0)" ::: "memory");
        } else {
            XB_SPIN(xb_ld(&bar[XB_XGEN(b.x)]) == gen, bar);
            __builtin_amdgcn_fence(__ATOMIC_ACQUIRE, "agent");
            asm volatile("s_waitcnt vmcnt(0)" ::: "memory");
        }
    }
    __syncthreads();
}


template <class Epi>
__device__ __forceinline__ void run_gemm(LAS unsigned char* lds, const bf16_t* A, const bf16_t* Bt, int M, int N, int K, const Epi& E) {
    pg8::Gemm g; g.A = A; g.Bt = Bt; g.M = M; g.N = N; g.K = K;
    pg8::StaticOrder S; S.init(M, N, (int)gridDim.x, (int)blockIdx.x);
    pg8::gemm_phase<Epi, pg8::StaticOrder, true, true>(lds, g, S, E);
}

constexpr int NPHASE = 2 + 9 * DEPTH;
#define GRID_SYNC() do { if (ph == 0) grid.sync(); else xcd_barrier(xb); } while (0)

__global__ void __launch_bounds__(NTHREADS, 2) fwd_megakernel(Params pin) {
    extern __shared__ __attribute__((aligned(16))) unsigned char lds_raw[];
    LAS unsigned char* lds = (LAS unsigned char*)lds_raw;
    cg::grid_group grid = cg::this_grid();
    volatile LAS unsigned* xst = (volatile LAS unsigned*)(lds + 131072);
    if (threadIdx.x == 0) { xst[0] = 0u; xst[1] = 0u; }
    __syncthreads();
    XcdBarrier xb = xcd_barrier_post((unsigned*)(pin.ws + WS_BAR), xst);
    const int G = (int)gridDim.x, blk = (int)blockIdx.x;
    for (int ph = pin.ph_lo; ph < pin.ph_hi; ++ph) {
        Params p = pin;
        asm volatile("" : "+s"(p.ws), "+s"(p.out), "+s"(p.x));
        bf16_t* WIN = (bf16_t*)(p.ws + WS_WIN); bf16_t* WOUT = (bf16_t*)(p.ws + WS_WOUT); bf16_t* W1B = (bf16_t*)(p.ws + WS_W1); bf16_t* W2B = (bf16_t*)(p.ws + WS_W2);
        const float* MOD = (const float*)(p.ws + WS_MOD);
        bf16_t* BIG = (bf16_t*)(p.ws + WS_BIG); bf16_t* HB = (bf16_t*)(p.ws + WS_HB);
        if (ph == 0) {
          for (int rep_ = 0; rep_ < REP_PRO; ++rep_) {
            cvt_kind(p.w_in, WIN, DM, DIN, DINP, (LAS float*)lds);
            cvt_kind(p.w_out, WOUT, DM, DM, DM, (LAS float*)lds);
            cvt_kind(p.w1, W1B, DM, DFF, DFF, (LAS float*)lds);
            cvt_kind(p.w2, W2B, DFF, DM, DM, (LAS float*)lds);
            mod_phase(p, (LAS float*)lds);
            lb_phase(p);
          }
        } else if (ph == NPHASE - 1) {
            final_norm(p.out, p.final_w);
        } else {
            const int l = (ph - 1) / 9, s = (ph - 1) % 9;
            const float* modl = MOD + (size_t)l * NB * 6144;
            const float* xcur = (l == 0) ? p.x : p.out;
            if (s == 0) {
                for (int rep_ = 0; rep_ < REP_NORM; ++rep_) rmsnorm_mod(xcur, p.norm_mix_w + l * DM, modl, 0, 1024, HB);
            } else if (s == 1) {
                pg8::EpiBf16<0> E; E.O = BIG; E.ldc = DINP;
                for (int rep_ = 0; rep_ < REP_GEMM; ++rep_) run_gemm(lds, HB, WIN + (size_t)l * DINP * DM, NTOK, DINP, DM, E);
            } else if (s == 2) {
              for (int rep2_ = 0; rep2_ < REP_S2; ++rep2_) {
#ifndef DIAG_NOTHR
                for (int v = blk; v < 2048; v += G) { const int itp = v >> 8, rem = v & 255, b = rem & 7, jj = rem >> 3; const int qt = itp * 32 + ((itp & 1) ? 31 - jj : jj); for (int rep_ = 0; rep_ < REP_THR; ++rep_) thr_item(p, b, qt, lds); }
#endif
                for (int v = blk; v < 2048; v += G) { const int c = v & 63, bh = v >> 6; hgrn_local_item(p, l, bh >> 2, bh & 3, c, lds); }
                for (int v = blk; v < 1024; v += G) conv_item(p, l, v >> 7, v & 127, lds);
                for (int v = blk; v < 512; v += G) vt_item(p, v >> 6, v & 63, lds);
              }
            } else if (s == 3) {
                hgrn_scan(p);
                for (int v = blk; v < 512; v += G) { const int itp = v >> 8, rem = v & 255, b = rem & 7, jj = rem >> 3; const int qb = itp ? 63 - jj : jj; for (int rep_ = 0; rep_ < REP_ATTN; ++rep_) attn_item(p, b, qb, lds); }
            } else if (s == 4) {
                for (int rep_ = 0; rep_ < REP_HO; ++rep_) for (int v = blk; v < 2048; v += G) { const int c = v & 63, bh = v >> 6; hgrn_out_item(p, l, bh >> 2, bh & 3, c, lds); }
            } else if (s == 5) {
                pg8::EpiResid E; E.xs = xcur; E.xd = p.out; E.gate = modl + 2048;
                run_gemm(lds, HB, WOUT + (size_t)l * DM * DM, NTOK, DM, DM, E);
            } else if (s == 6) {
                for (int rep_ = 0; rep_ < REP_NORM; ++rep_) rmsnorm_mod(p.out, p.norm_mlp_w + l * DM, modl, 3072, 4096, HB);
            } else if (s == 7) {
                pg8::EpiBf16<1> E; E.O = BIG; E.ldc = DFF;
                for (int rep_ = 0; rep_ < REP_GEMM; ++rep_) run_gemm(lds, HB, W1B + (size_t)l * DFF * DM, NTOK, DFF, DM, E);
            } else {
                pg8::EpiResid E; E.xs = p.out; E.xd = p.out; E.gate = modl + 5120;
                run_gemm(lds, BIG, W2B + (size_t)l * DM * DFF, NTOK, DM, DFF, E);
            }
        }
        if (ph + 1 < pin.ph_hi) { GRID_SYNC(); }
    }
#ifdef DIAG_CUT
    { const int ph = 1; GRID_SYNC(); } diag_phase(pin);
#endif
}

extern "C" void kernel_launch(void* const* d_in, const int* in_sizes, int n_in, void* d_out, int out_size, void* d_ws, size_t ws_size, hipStream_t stream) {
    static int grid_blocks = 0;
    if (grid_blocks == 0) {
        if (n_in != 17 || out_size != NTOK * DM || ws_size < WS_END) { fprintf(stderr, "kernel_launch: unexpected shapes (n_in %d out %d ws %zu need %zu)\n", n_in, out_size, ws_size, (size_t)WS_END); grid_blocks = -1; return; }
        int dev = 0, cus = 0, per_cu = 0;
        hipGetDevice(&dev);
        hipDeviceGetAttribute(&cus, hipDeviceAttributeMultiprocessorCount, dev);
        if (hipFuncSetAttribute((const void*)fwd_megakernel, hipFuncAttributeMaxDynamicSharedMemorySize, LDS_BYTES) != hipSuccess) { fprintf(stderr, "kernel_launch: hipFuncSetAttribute failed\n"); grid_blocks = -1; return; }
        if (hipOccupancyMaxActiveBlocksPerMultiprocessor(&per_cu, (const void*)fwd_megakernel, NTHREADS, LDS_BYTES) != hipSuccess || per_cu < 1) { fprintf(stderr, "kernel_launch: occupancy query says %d blocks/CU\n", per_cu); per_cu = 1; }
        (void)hipGetLastError();
        grid_blocks = cus * (per_cu > 1 ? 1 : per_cu);
    }
    if (grid_blocks < 0) return;
    Params p{};
    p.x = (const float*)d_in[0]; p.c = (const float*)d_in[1]; p.ada_w = (const float*)d_in[2]; p.ada_b = (const float*)d_in[3];
    p.norm_mix_w = (const float*)d_in[4]; p.norm_mlp_w = (const float*)d_in[5]; p.w_in = (const float*)d_in[6]; p.lb_logits = (const float*)d_in[7];
    p.onorm_w = (const float*)d_in[8]; p.cv_w = (const float*)d_in[9]; p.cv_b = (const float*)d_in[10]; p.cv_ln_w = (const float*)d_in[11]; p.cv_ln_b = (const float*)d_in[12];
    p.w_out = (const float*)d_in[13]; p.w1 = (const float*)d_in[14]; p.w2 = (const float*)d_in[15]; p.final_w = (const float*)d_in[16];
    p.out = (float*)d_out; p.ws = (unsigned char*)d_ws; p.ph_lo = 0; p.ph_hi = NPHASE;
#ifdef DIAG_CUT
    p.ph_hi = DIAG_CUT;
#endif
    if (hipMemsetAsync((char*)d_ws + WS_BAR, 0, 16384, stream) != hipSuccess) { fprintf(stderr, "kernel_launch: hipMemsetAsync failed\n"); return; }
    void* args[] = {&p};
    hipError_t e = hipLaunchCooperativeKernel((const void*)fwd_megakernel, dim3(grid_blocks), dim3(NTHREADS), args, LDS_BYTES, stream);
    if (e != hipSuccess) fprintf(stderr, "kernel_launch: cooperative launch failed: %s (grid %d)\n", hipGetErrorString(e), grid_blocks);
}
```

```cpp
#include <hip/hip_runtime.h>
#include <hip/hip_cooperative_groups.h>
#include <cstdio>
#include <cstdint>
namespace cg = cooperative_groups;

#define LAS __attribute__((address_space(3)))
typedef unsigned short bf16_t;
typedef short bf16x8 __attribute__((ext_vector_type(8)));
typedef float f32x4 __attribute__((ext_vector_type(4)));
typedef unsigned u32x4 __attribute__((ext_vector_type(4)));
typedef unsigned u32x2 __attribute__((ext_vector_type(2)));

constexpr int DM = 1024, NB = 8, SEQ = 4096, DEPTH = 4, NTOK = NB * SEQ;
constexpr int DIN = 3624, DINP = 3840, DFF = 4096;
constexpr int OFF_HQ = 0, OFF_HF = 512, OFF_HI = 1024, OFF_HG = 1536, OFF_SQ = 2048, OFF_SK = 2304, OFF_SV = 2560, OFF_IQ = 2816, OFF_IK = 3072, OFF_IW = 3104, OFF_CU = 3112;
constexpr int TOPK = 256;
constexpr float EPS = 1e-6f;
constexpr int NTHREADS = 512;
constexpr int LDS_BYTES = 131072 + 64;

constexpr size_t WS_WIN = 0;
constexpr size_t WS_WOUT = WS_WIN + (size_t)DEPTH * DINP * DM * 2;
constexpr size_t WS_W1 = WS_WOUT + (size_t)DEPTH * DM * DM * 2;
constexpr size_t WS_W2 = WS_W1 + (size_t)DEPTH * DFF * DM * 2;
constexpr size_t WS_MOD = WS_W2 + (size_t)DEPTH * DM * DFF * 2;
constexpr size_t WS_LB = WS_MOD + (size_t)DEPTH * NB * 6 * DM * 4;
constexpr size_t WS_BIG = WS_LB + (size_t)DEPTH * 512 * 4;
constexpr size_t WS_MASK = WS_BIG + (size_t)NTOK * DINP * 2;
static_assert((size_t)NTOK * DINP * 2 + (size_t)NTOK * 128 * 4 <= (size_t)NTOK * DFF * 2, "mask overlay");
constexpr size_t WS_HB = WS_BIG + (size_t)NTOK * DFF * 2;
constexpr size_t WS_ST = WS_HB + (size_t)NTOK * DM * 2;
constexpr size_t WS_DEC = WS_ST + (size_t)32 * 64 * 16384 * 2;
constexpr size_t WS_VT = WS_DEC + (size_t)32 * 64 * 128 * 4;
constexpr size_t WS_THRT = WS_VT + (size_t)NB * 4 * 64 * SEQ * 2;
constexpr size_t WS_THRC = WS_THRT + (size_t)NTOK * 4;
constexpr size_t WS_BAR = WS_THRC + (size_t)NTOK * 4;
constexpr size_t WS_END = WS_BAR + 16384;
static_assert(WS_END <= (size_t)512 * 1024 * 1024, "workspace map exceeds 512 MiB");

struct Params {
    const float* x; const float* c; const float* ada_w; const float* ada_b; const float* norm_mix_w; const float* norm_mlp_w;
    const float* w_in; const float* lb_logits; const float* onorm_w; const float* cv_w; const float* cv_b; const float* cv_ln_w; const float* cv_ln_b;
    const float* w_out; const float* w1; const float* w2; const float* final_w;
    float* out; unsigned char* ws;
    int ph_lo, ph_hi;
};

typedef float f32x2_t __attribute__((ext_vector_type(2)));
typedef __bf16 bf16x2_t __attribute__((ext_vector_type(2)));
__device__ __forceinline__ unsigned cvt_pk_bf16(float lo, float hi) { const f32x2_t v = {lo, hi}; return __builtin_bit_cast(unsigned, __builtin_convertvector(v, bf16x2_t)); }
__device__ __forceinline__ float bf2f(short h) { return __uint_as_float(((unsigned)(unsigned short)h) << 16); }
__device__ __forceinline__ float bflo(unsigned w) { return __uint_as_float(w << 16); }
__device__ __forceinline__ float bfhi(unsigned w) { return __uint_as_float(w & 0xffff0000u); }
__device__ __forceinline__ bf16_t f2bf(float f) { return (bf16_t)(cvt_pk_bf16(f, 0.f) & 0xffffu); }
__device__ __forceinline__ float wave_sum(float v) {
    v += __shfl_xor(v, 32); v += __shfl_xor(v, 16); v += __shfl_xor(v, 8); v += __shfl_xor(v, 4); v += __shfl_xor(v, 2); v += __shfl_xor(v, 1); return v;
}
__device__ __forceinline__ float xrow16_max(float x) {
    auto s = __builtin_amdgcn_permlane16_swap(__float_as_uint(x), __float_as_uint(x), false, false);
    x = fmaxf(__uint_as_float(s[0]), __uint_as_float(s[1]));
    auto t = __builtin_amdgcn_permlane32_swap(__float_as_uint(x), __float_as_uint(x), false, false);
    return fmaxf(__uint_as_float(t[0]), __uint_as_float(t[1]));
}
__device__ __forceinline__ float xrow16_sum(float x) {
    auto s = __builtin_amdgcn_permlane16_swap(__float_as_uint(x), __float_as_uint(x), false, false);
    x = __uint_as_float(s[0]) + __uint_as_float(s[1]);
    auto t = __builtin_amdgcn_permlane32_swap(__float_as_uint(x), __float_as_uint(x), false, false);
    return __uint_as_float(t[0]) + __uint_as_float(t[1]);
}
__device__ __forceinline__ float sigmoidf_(float x) { return __builtin_amdgcn_rcpf(1.f + __expf(-x)); }
__device__ __forceinline__ float siluf_(float x) { return x * __builtin_amdgcn_rcpf(1.f + __expf(-x)); }
__device__ __forceinline__ unsigned sortable(float f) { unsigned b = __float_as_uint(f); return b ^ ((b & 0x80000000u) ? 0xffffffffu : 0x80000000u); }
__device__ __forceinline__ f32x4 mfma16(bf16x8 a, bf16x8 b, f32x4 c) { return __builtin_amdgcn_mfma_f32_16x16x32_bf16(a, b, c, 0, 0, 0); }

namespace pg8 {
#define PG8_LAS __attribute__((address_space(3)))
constexpr int BM = 256, BK = 64, HALF = 128, HTB = HALF * BK * 2, STAGE_BYTES = 8 * HTB, NXCD = 8, WGM = 8;
__host__ __device__ __forceinline__ int lds_byte(int r, int c) { const int st = (r >> 4) * 2 + (c >> 5), rr = r & 15, cc = c & 31, ob = rr * 64 + cc * 2; return st * 1024 + (ob ^ (((ob >> 9) & 1) << 5)); }
__host__ __device__ __forceinline__ void stage_rc(int b, int& R, int& C) { const int st = b / 1024, sb = b % 1024, swz = sb ^ (((sb >> 9) & 1) << 5); R = (st >> 1) * 16 + swz / 64; C = (st & 1) * 32 + (swz % 64) / 2; }
__host__ __device__ __forceinline__ int perm32(int rho) { const int n = rho >> 4, i = rho & 15; return 8 * (i >> 2) + 4 * n + (i & 3); }
struct Unit { int pm, pn; };
struct Gemm { const bf16_t* A; const bf16_t* Bt; int M, N, K; };
struct StaticOrder {
    int nM, nN, nwg, G, c;
    __host__ __device__ void init(int M, int N, int G_, int c_) { nM = M / BM; nN = N / BM; nwg = nM * nN; G = G_; c = c_; }
    __host__ __device__ bool next(int i, Unit& u) const {
        const long L = (long)i * G + c; if (L >= nwg) return false;
        int wgid = (int)L; { const int q = nwg / NXCD, r = nwg % NXCD, xcd = wgid % NXCD, off = wgid / NXCD; wgid = (xcd < r ? xcd * (q + 1) : r * (q + 1) + (xcd - r) * q) + off; }
        const int nig = WGM * nN, gid = wgid / nig, fm = gid * WGM, gsz = (nM - fm) < WGM ? (nM - fm) : WGM;
        u.pm = fm + ((wgid % nig) % gsz); u.pn = (wgid % nig) / gsz; return true;
    }
    __device__ __forceinline__ void a_ready(const Unit&) const {}
    __device__ __forceinline__ void done(const Unit&) const {}
};

template <int ACT  > struct EpiBf16 {
    static constexpr bool PERM = true, AFTER_DRAIN = false;
    bf16_t* O; int ldc;
    __device__ __forceinline__ void operator()(const f32x4 (&acc)[2][2][4][2], const Unit& u, int wr, int wc, int fr, int fq) const {
        const int row0 = u.pm * BM + wr * 64 + fr, col0 = u.pn * BM + wc * 32 + 8 * fq;
#pragma unroll
        for (int ai = 0; ai < 2; ++ai)
#pragma unroll
            for (int m = 0; m < 4; ++m) { bf16_t* rowp = O + (size_t)(row0 + ai * HALF + m * 16) * ldc + col0;
#pragma unroll
                for (int bj = 0; bj < 2; ++bj) { f32x4 v0 = acc[ai][bj][m][0], v1 = acc[ai][bj][m][1];
                    if (ACT == 1) {
#pragma unroll
                        for (int j = 0; j < 4; ++j) { const float a = fmaxf(v0[j], 0.f), b = fmaxf(v1[j], 0.f); v0[j] = a * a; v1[j] = b * b; } }
                    u32x4 w; w.x = cvt_pk_bf16(v0[0], v0[1]); w.y = cvt_pk_bf16(v0[2], v0[3]); w.z = cvt_pk_bf16(v1[0], v1[1]); w.w = cvt_pk_bf16(v1[2], v1[3]);
                    *(u32x4*)(rowp + bj * HALF) = w; } }
    }
};
struct EpiResid {
    static constexpr bool PERM = true, AFTER_DRAIN = false;
    const float* xs; float* xd; const float* gate;
    __device__ __forceinline__ void operator()(const f32x4 (&acc)[2][2][4][2], const Unit& u, int wr, int wc, int fr, int fq) const {
        const int row0 = u.pm * BM + wr * 64 + fr, col0 = u.pn * BM + wc * 32 + 8 * fq;
        const float* gp = gate + (size_t)((u.pm * BM) >> 12) * 6144 + col0;
        f32x4 gv[2][2];
#pragma unroll
        for (int bj = 0; bj < 2; ++bj)
#pragma unroll
            for (int n = 0; n < 2; ++n) gv[bj][n] = *(const f32x4*)(gp + bj * HALF + 4 * n);
#pragma unroll
        for (int ai = 0; ai < 2; ++ai)
#pragma unroll
            for (int m = 0; m < 4; ++m) { const size_t off = (size_t)(row0 + ai * HALF + m * 16) * DM + col0;
#pragma unroll
                for (int bj = 0; bj < 2; ++bj)
#pragma unroll
                    for (int n = 0; n < 2; ++n) { const f32x4 xv = *(const f32x4*)(xs + off + bj * HALF + 4 * n);
                        *(f32x4*)(xd + off + bj * HALF + 4 * n) = xv + gv[bj][n] * acc[ai][bj][m][n]; } }
    }
};
template <class Epi, class Sched, bool ALIGN_EPI = false, bool SP2 = false>
__device__ __forceinline__ void gemm_phase(PG8_LAS unsigned char* lds, const Gemm g, const Sched& S, const Epi& E) {
    int tid_ = threadIdx.x; asm volatile("" : "+v"(tid_)); const int tid = tid_, wid = __builtin_amdgcn_readfirstlane(tid >> 6), lane = tid & 63, wr = wid >> 2, wc = wid & 3, fr = lane & 15, fq = lane >> 4;
    const int K = g.K, nt = K / BK;
    unsigned voffA[2], voffB[2];
#pragma unroll
    for (int i = 0; i < 2; ++i) { int R, C; stage_rc(tid * 16 + i * 8192, R, C); const int Rb = Epi::PERM ? ((R & ~31) + perm32(R & 31)) : R;
        voffA[i] = (unsigned)(R * K + C) * 2u; voffB[i] = (unsigned)(Rb * K + C) * 2u; }
    const size_t kstep = (size_t)(BK * 2);
    const size_t hstep = (size_t)HALF * K * 2;
    const size_t tstep = 2 * hstep;
    const unsigned ldsw = (unsigned)wid * 1024u;
    const int aoff = lds_byte(wr * 64 + fr, fq * 8), boff = lds_byte(wc * 32 + fr, fq * 8);
#define PG8_SA(b, h) (((b) * 2 + (h)) * HTB)
#define PG8_SB(b, h) ((4 + (b) * 2 + (h)) * HTB)
#define PG8_STAGE(bufoff, gbase, voff) do { _Pragma("unroll") for (int _i = 0; _i < 2; ++_i) \
        __builtin_amdgcn_global_load_lds((const unsigned*)((const char*)(gbase) + (voff)[_i]), (PG8_LAS unsigned*)(lds + (bufoff) + ldsw + _i * 8192), 16, 0, 0); } while (0)
#define PG8_LDA(dst, b, h) do { _Pragma("unroll") for (int m = 0; m < 4; ++m) _Pragma("unroll") for (int k = 0; k < 2; ++k) dst[m][k] = *(const PG8_LAS bf16x8*)(lds + PG8_SA(b, h) + aoff + m * 2048 + k * 1024); } while (0)
#define PG8_LDB(dst, b, h) do { _Pragma("unroll") for (int n = 0; n < 2; ++n) _Pragma("unroll") for (int k = 0; k < 2; ++k) dst[n][k] = *(const PG8_LAS bf16x8*)(lds + PG8_SB(b, h) + boff + n * 2048 + k * 1024); } while (0)
#define PG8_MMA(ai, bj, At, Bt) do { __builtin_amdgcn_s_setprio(1); _Pragma("unroll") for (int m = 0; m < 4; ++m) _Pragma("unroll") for (int n = 0; n < 2; ++n) _Pragma("unroll") for (int k = 0; k < 2; ++k) \
        acc[ai][bj][m][n] = __builtin_amdgcn_mfma_f32_16x16x32_bf16(Bt[n][k], At[m][k], acc[ai][bj][m][n], 0, 0, 0); __builtin_amdgcn_s_setprio(0); } while (0)
#define PG8_WAIT_V(n) asm volatile("s_waitcnt vmcnt(" #n ")" ::: "memory")
#define PG8_WAIT_L(n) asm volatile("s_waitcnt lgkmcnt(" #n ")" ::: "memory")
#define PG8_BAR __builtin_amdgcn_s_barrier()
#define PG8_SCHED __builtin_amdgcn_sched_barrier(0)
    Unit cur, nxt; int ui = 0;
    if (!S.next(0, cur)) return;
    f32x4 acc[2][2][4][2];
#pragma unroll
    for (int a = 0; a < 2; ++a)
#pragma unroll
        for (int b = 0; b < 2; ++b)
#pragma unroll
            for (int m = 0; m < 4; ++m)
#pragma unroll
                for (int n = 0; n < 2; ++n) acc[a][b][m][n] = (f32x4){0.f, 0.f, 0.f, 0.f};
    bf16x8 At[4][2], B0[2][2], B1[2][2];
    const char* cA = (const char*)g.A + (size_t)cur.pm * tstep; const char* cB = (const char*)g.Bt + (size_t)cur.pn * tstep;
    S.a_ready(cur);
    if constexpr (SP2) {
        PG8_STAGE(PG8_SB(0, 0), cB, voffB); PG8_STAGE(PG8_SB(0, 1), cB + hstep, voffB); PG8_STAGE(PG8_SA(0, 0), cA, voffA); PG8_STAGE(PG8_SA(0, 1), cA + hstep, voffA);
        if (wr == 1) PG8_BAR;
        PG8_WAIT_V(2); PG8_BAR;
        PG8_STAGE(PG8_SB(1, 0), cB + kstep, voffB); PG8_STAGE(PG8_SA(1, 0), cA + kstep, voffA); PG8_STAGE(PG8_SB(1, 1), cB + hstep + kstep, voffB);
        PG8_WAIT_V(6); PG8_BAR;
    } else {
        PG8_STAGE(PG8_SB(0, 0), cB, voffB); PG8_STAGE(PG8_SA(0, 0), cA, voffA); PG8_STAGE(PG8_SB(0, 1), cB + hstep, voffB); PG8_STAGE(PG8_SA(0, 1), cA + hstep, voffA);
        if (wr == 1) PG8_BAR;
        PG8_WAIT_V(4); PG8_BAR;
        PG8_STAGE(PG8_SB(1, 0), cB + kstep, voffB); PG8_STAGE(PG8_SA(1, 0), cA + kstep, voffA); PG8_STAGE(PG8_SB(1, 1), cB + hstep + kstep, voffB);
        PG8_WAIT_V(6); PG8_BAR;
    }
    for (;;) {
        const bool has_next = S.next(ui + 1, nxt);
        const char* nA = has_next ? (const char*)g.A + (size_t)nxt.pm * tstep : cA; const char* nB = has_next ? (const char*)g.Bt + (size_t)nxt.pn * tstep : cB;
        for (int t = 0; t < nt; t += 2) {
            const bool last = (t == nt - 2);
            const char* a1 = cA + (size_t)(t + 1) * kstep;
            const char* a2 = last ? nA : cA + (size_t)(t + 2) * kstep; const char* b2 = last ? nB : cB + (size_t)(t + 2) * kstep;
            const char* a3 = a2 + kstep; const char* b3 = b2 + kstep;
            if (last && has_next) S.a_ready(nxt);
            if constexpr (SP2) {
            PG8_LDB(B0, 0, 0); PG8_LDB(B1, 0, 1); PG8_SCHED; PG8_LDA(At, 0, 0); PG8_STAGE(PG8_SA(1, 1), a1 + hstep, voffA);
            PG8_WAIT_V(8); PG8_WAIT_L(0); PG8_BAR; PG8_MMA(0, 0, At, B0); PG8_MMA(0, 1, At, B1); PG8_BAR; PG8_SCHED;
            PG8_LDA(At, 0, 1); PG8_STAGE(PG8_SB(0, 0), b2, voffB); PG8_STAGE(PG8_SB(0, 1), b2 + hstep, voffB); PG8_STAGE(PG8_SA(0, 0), a2, voffA);
            PG8_WAIT_V(8); PG8_WAIT_L(0); PG8_BAR; PG8_MMA(1, 0, At, B0); PG8_MMA(1, 1, At, B1); PG8_BAR; PG8_SCHED;
            PG8_LDB(B0, 1, 0); PG8_LDB(B1, 1, 1); PG8_SCHED; PG8_LDA(At, 1, 0); PG8_STAGE(PG8_SA(0, 1), a2 + hstep, voffA);
            PG8_WAIT_V(8); PG8_WAIT_L(0); PG8_BAR; PG8_MMA(0, 0, At, B0); PG8_MMA(0, 1, At, B1); PG8_BAR; PG8_SCHED;
            PG8_LDA(At, 1, 1); PG8_STAGE(PG8_SB(1, 0), b3, voffB); PG8_STAGE(PG8_SB(1, 1), b3 + hstep, voffB); PG8_STAGE(PG8_SA(1, 0), a3, voffA);
            PG8_WAIT_V(8); PG8_WAIT_L(0); PG8_BAR; PG8_MMA(1, 0, At, B0); PG8_MMA(1, 1, At, B1); PG8_BAR; PG8_SCHED;
            } else {
            PG8_LDB(B0, 0, 0); PG8_SCHED; PG8_LDA(At, 0, 0); PG8_STAGE(PG8_SA(1, 1), a1 + hstep, voffA);
            PG8_WAIT_L(8); PG8_BAR; PG8_WAIT_L(0); PG8_MMA(0, 0, At, B0); PG8_BAR; PG8_SCHED;
            PG8_LDB(B1, 0, 1); PG8_STAGE(PG8_SB(0, 0), b2, voffB);
            PG8_BAR; PG8_WAIT_L(0); PG8_MMA(0, 1, At, B1); PG8_BAR;
            PG8_LDA(At, 0, 1); PG8_STAGE(PG8_SA(0, 0), a2, voffA);
            PG8_BAR; PG8_WAIT_L(0); PG8_MMA(1, 0, At, B0); PG8_BAR; PG8_SCHED;
            PG8_STAGE(PG8_SB(0, 1), b2 + hstep, voffB);
            PG8_WAIT_V(6); PG8_BAR; PG8_MMA(1, 1, At, B1); PG8_BAR;
            PG8_LDB(B0, 1, 0); PG8_SCHED; PG8_LDA(At, 1, 0); PG8_STAGE(PG8_SA(0, 1), a2 + hstep, voffA);
            PG8_WAIT_L(8); PG8_BAR; PG8_WAIT_L(0); PG8_MMA(0, 0, At, B0); PG8_BAR; PG8_SCHED;
            PG8_LDB(B1, 1, 1); PG8_STAGE(PG8_SB(1, 0), b3, voffB);
            PG8_BAR; PG8_WAIT_L(0); PG8_MMA(0, 1, At, B1); PG8_BAR;
            PG8_LDA(At, 1, 1); PG8_STAGE(PG8_SA(1, 0), a3, voffA);
            PG8_BAR; PG8_WAIT_L(0); PG8_MMA(1, 0, At, B0); PG8_BAR; PG8_SCHED;
            PG8_STAGE(PG8_SB(1, 1), b3 + hstep, voffB);
            PG8_WAIT_V(6); PG8_BAR; PG8_MMA(1, 1, At, B1); PG8_BAR;
            }
        }
        if constexpr (ALIGN_EPI) { if (wr == 0) PG8_BAR; }
        if constexpr (!Epi::AFTER_DRAIN) { E(acc, cur, wr, wc, fr, fq); S.done(cur); }
        if (!has_next) break;
#pragma unroll
        for (int a = 0; a < 2; ++a)
#pragma unroll
            for (int b = 0; b < 2; ++b)
#pragma unroll
                for (int m = 0; m < 4; ++m)
#pragma unroll
                    for (int n = 0; n < 2; ++n) acc[a][b][m][n] = (f32x4){0.f, 0.f, 0.f, 0.f};
        cur = nxt; cA = nA; cB = nB; ++ui;
        if constexpr (ALIGN_EPI) { if (wr == 1) PG8_BAR; }
    }
    PG8_WAIT_V(0);
    if constexpr (!ALIGN_EPI) { if (wr == 0) PG8_BAR; }
    PG8_BAR;
    if constexpr (Epi::AFTER_DRAIN) { E.fused(acc, cur, wr, wc, fr, fq, lds, wid, lane); S.done(cur); }
#undef PG8_SA
#undef PG8_SB
#undef PG8_STAGE
#undef PG8_LDA
#undef PG8_LDB
#undef PG8_MMA
#undef PG8_WAIT_V
#undef PG8_WAIT_L
#undef PG8_BAR
#undef PG8_SCHED
}
}

#ifndef REP_THR
#define REP_THR 1
#endif
#ifndef REP_NORM
#define REP_NORM 1
#endif
#ifndef REP_PRO
#define REP_PRO 1
#endif
#ifndef REP_ATTN
#define REP_ATTN 1
#endif
#ifndef REP_S2
#define REP_S2 1
#endif
#ifndef REP_GEMM
#define REP_GEMM 1
#endif
#ifndef REP_HO
#define REP_HO 1
#endif
__device__ __forceinline__ int ltid() { int t = threadIdx.x; asm volatile("" : "+v"(t)); return t; }
#define TID ltid()

__device__ __forceinline__ void cvt_kind(const float* __restrict__ src, bf16_t* __restrict__ dst, int K, int N, int Npad, LAS float* tl) {
    const int tid = TID, nk = K / 64, nn = Npad / 64, per = nk * nn, total = DEPTH * per;
    for (int t = blockIdx.x; t < total; t += gridDim.x) {
        const int l = t / per, r = t % per, kt = r / nn, nt = r % nn;
        const float* s = src + (size_t)l * K * N; bf16_t* d = dst + (size_t)l * Npad * K;
#pragma unroll
        for (int i = 0; i < 2; ++i) { const int kr = (tid >> 4) + 32 * i, nc = (tid & 15) * 4, n = nt * 64 + nc;
            f32x4 v = (f32x4){0.f, 0.f, 0.f, 0.f};
            if (n < N) v = *(const f32x4*)(s + (size_t)(kt * 64 + kr) * N + n);
            tl[kr * 65 + nc + 0] = v[0]; tl[kr * 65 + nc + 1] = v[1]; tl[kr * 65 + nc + 2] = v[2]; tl[kr * 65 + nc + 3] = v[3]; }
        __syncthreads();
        { const int n = tid >> 3, k8 = (tid & 7) * 8; u32x4 w;
            w.x = cvt_pk_bf16(tl[(k8 + 0) * 65 + n], tl[(k8 + 1) * 65 + n]); w.y = cvt_pk_bf16(tl[(k8 + 2) * 65 + n], tl[(k8 + 3) * 65 + n]);
            w.z = cvt_pk_bf16(tl[(k8 + 4) * 65 + n], tl[(k8 + 5) * 65 + n]); w.w = cvt_pk_bf16(tl[(k8 + 6) * 65 + n], tl[(k8 + 7) * 65 + n]);
            *(u32x4*)(d + (size_t)(nt * 64 + n) * K + kt * 64 + k8) = w; }
        __syncthreads();
    }
}

__device__ __forceinline__ void mod_phase(const Params& p, LAS float* sm) {
    const int tid = TID;
    LAS float* cact = sm; LAS float* red = sm + 8192;
    for (int i = tid; i < NB * DM; i += NTHREADS) cact[i] = siluf_(p.c[i]);
    __syncthreads();
    float* MOD = (float*)(p.ws + WS_MOD);
    for (int it = blockIdx.x; it < DEPTH * 96; it += gridDim.x) {
        const int l = it / 96, j0 = (it % 96) * 64, col = tid & 63, seg = tid >> 6;
        const float* w = p.ada_w + (size_t)l * DM * 6144 + j0 + col;
        float a0 = 0.f, a1 = 0.f, a2 = 0.f, a3 = 0.f, a4 = 0.f, a5 = 0.f, a6 = 0.f, a7 = 0.f;
#pragma unroll 8
        for (int k = seg * 128; k < seg * 128 + 128; ++k) { const float wv = w[(size_t)k * 6144];
            a0 += cact[0 * DM + k] * wv; a1 += cact[1 * DM + k] * wv; a2 += cact[2 * DM + k] * wv; a3 += cact[3 * DM + k] * wv;
            a4 += cact[4 * DM + k] * wv; a5 += cact[5 * DM + k] * wv; a6 += cact[6 * DM + k] * wv; a7 += cact[7 * DM + k] * wv; }
        red[(seg * 8 + 0) * 64 + col] = a0; red[(seg * 8 + 1) * 64 + col] = a1; red[(seg * 8 + 2) * 64 + col] = a2; red[(seg * 8 + 3) * 64 + col] = a3;
        red[(seg * 8 + 4) * 64 + col] = a4; red[(seg * 8 + 5) * 64 + col] = a5; red[(seg * 8 + 6) * 64 + col] = a6; red[(seg * 8 + 7) * 64 + col] = a7;
        __syncthreads();
        { const int b = tid >> 6; float s = p.ada_b[l * 6144 + j0 + col];
#pragma unroll
            for (int sg = 0; sg < 8; ++sg) s += red[(sg * 8 + b) * 64 + col];
            MOD[(size_t)(l * NB + b) * 6144 + j0 + col] = s; }
        __syncthreads();
    }
}

__device__ __forceinline__ void lb_phase(const Params& p) {
    if (blockIdx.x != 0) return;
    const int k = TID; float* LB = (float*)(p.ws + WS_LB);
    const float v0 = p.lb_logits[k], v1 = p.lb_logits[512 + k], v2 = p.lb_logits[1024 + k], v3 = p.lb_logits[1536 + k];
    const float mx = fmaxf(fmaxf(v0, v1), fmaxf(v2, v3));
    const float e0 = expf(v0 - mx), e1 = expf(v1 - mx), e2 = expf(v2 - mx), e3 = expf(v3 - mx), inv = 1.f / (e0 + e1 + e2 + e3);
    const float p0 = e0 * inv, p1 = e1 * inv, p2 = e2 * inv, p3 = e3 * inv;
    LB[k] = p0 - p0; LB[512 + k] = (p0 + p1) - p0; LB[1024 + k] = ((p0 + p1) + p2) - p0; LB[1536 + k] = (((p0 + p1) + p2) + p3) - p0;
}

__device__ __forceinline__ void rmsnorm_mod(const float* __restrict__ xs, const float* __restrict__ w, const float* __restrict__ mod, int sh_off, int sc_off, bf16_t* __restrict__ dst) {
    const int tid = TID, wave = tid >> 6, lane = tid & 63;
    const int row0 = blockIdx.x * 8 + wave, rstep = gridDim.x * 8;
    f32x4 v[4], nv[4];
    if (row0 < NTOK) {
#pragma unroll
        for (int i = 0; i < 4; ++i) nv[i] = *(const f32x4*)(xs + (size_t)row0 * DM + i * 256 + lane * 4); }
    for (int row = row0; row < NTOK; row += rstep) {
        float ss = 0.f;
#pragma unroll
        for (int i = 0; i < 4; ++i) { v[i] = nv[i]; ss += v[i][0] * v[i][0] + v[i][1] * v[i][1] + v[i][2] * v[i][2] + v[i][3] * v[i][3]; }
        if (row + rstep < NTOK) {
#pragma unroll
            for (int i = 0; i < 4; ++i) nv[i] = *(const f32x4*)(xs + (size_t)(row + rstep) * DM + i * 256 + lane * 4); }
        ss = wave_sum(ss);
        const float rstd = rsqrtf(ss * (1.f / DM) + EPS);
        const float* mb = mod + (size_t)(row >> 12) * 6144;
#pragma unroll
        for (int i = 0; i < 4; ++i) { const int col = i * 256 + lane * 4;
            const f32x4 ww = *(const f32x4*)(w + col), sc = *(const f32x4*)(mb + sc_off + col), sh = *(const f32x4*)(mb + sh_off + col);
            const f32x4 h = (v[i] * rstd * ww) * (sc + 1.f) + sh;
            u32x2 o; o.x = cvt_pk_bf16(h[0], h[1]); o.y = cvt_pk_bf16(h[2], h[3]);
            *(u32x2*)(dst + (size_t)row * DM + col) = o; }
    }
}
__device__ __forceinline__ void final_norm(float* __restrict__ x, const float* __restrict__ w) {
    const int tid = TID, wave = tid >> 6, lane = tid & 63;
    for (int row = blockIdx.x * 8 + wave; row < NTOK; row += gridDim.x * 8) {
        float* xr = x + (size_t)row * DM; f32x4 v[4]; float ss = 0.f;
#pragma unroll
        for (int i = 0; i < 4; ++i) { v[i] = *(const f32x4*)(xr + i * 256 + lane * 4); ss += v[i][0] * v[i][0] + v[i][1] * v[i][1] + v[i][2] * v[i][2] + v[i][3] * v[i][3]; }
        ss = wave_sum(ss);
        const float rstd = rsqrtf(ss * (1.f / DM) + EPS);
#pragma unroll
        for (int i = 0; i < 4; ++i) { const int col = i * 256 + lane * 4; const f32x4 ww = *(const f32x4*)(w + col); *(f32x4*)(xr + col) = v[i] * rstd * ww; }
    }
}

__device__ __forceinline__ void vt_item(const Params& p, int b, int tt, LAS unsigned char* sm) {
    const int tid = TID; LAS bf16_t* vb = (LAS bf16_t*)sm;
    const bf16_t* proj = (const bf16_t*)(p.ws + WS_BIG) + (size_t)(b * SEQ + tt * 64) * DINP + OFF_SV;
#pragma unroll
    for (int i = 0; i < 4; ++i) { const int idx = tid + NTHREADS * i, row = idx >> 5, c8 = (idx & 31) * 8;
        *(LAS bf16x8*)(vb + row * 264 + c8) = *(const bf16x8*)(proj + (size_t)row * DINP + c8); }
    __syncthreads();
    { const int col = tid >> 1, half = tid & 1;
        bf16_t* dst = (bf16_t*)(p.ws + WS_VT) + ((size_t)(b * 4 + (col >> 6)) * 64 + (col & 63)) * SEQ + tt * 64 + half * 32;
#pragma unroll
        for (int i = 0; i < 4; ++i) { bf16x8 o;
#pragma unroll
            for (int e = 0; e < 8; ++e) o[e] = (short)vb[(half * 32 + i * 8 + e) * 264 + col];
            *(bf16x8*)(dst + i * 8) = o; } }
    __syncthreads();
}

__device__ __forceinline__ void conv_item(const Params& p, int l, int b, int tt, LAS unsigned char* sm) {
    const int tid = TID; LAS float* hb = (LAS float*)sm;
    LAS float* ob = (LAS float*)(sm + 62 * 256 * 4);
    const int t0 = tt * 32;
    const bf16_t* proj = (const bf16_t*)(p.ws + WS_BIG) + (size_t)b * SEQ * DINP + OFF_CU;
#pragma unroll
    for (int i = 0; i < 4; ++i) { const int idx = tid + NTHREADS * i;
        if (idx < 62 * 32) { const int row = idx >> 5, c8 = (idx & 31) * 8, t = t0 - 30 + row;
            f32x4 h0 = (f32x4){0.f, 0.f, 0.f, 0.f}, h1 = h0;
            if (t >= 0) { const bf16x8 a = *(const bf16x8*)(proj + (size_t)t * DINP + c8), g = *(const bf16x8*)(proj + (size_t)t * DINP + 256 + c8);
#pragma unroll
                for (int j = 0; j < 4; ++j) { h0[j] = bf2f(a[j]) * sigmoidf_(bf2f(g[j])); h1[j] = bf2f(a[4 + j]) * sigmoidf_(bf2f(g[4 + j])); } }
            *(LAS f32x4*)(hb + row * 256 + c8) = h0; *(LAS f32x4*)(hb + row * 256 + c8 + 4) = h1; } }
    __syncthreads();
    { const int ch = tid & 255, half = tid >> 8;
        float w[31];
#pragma unroll
        for (int j = 0; j < 31; ++j) w[j] = p.cv_w[(size_t)(l * 31 + j) * 256 + ch];
        const float bias = p.cv_b[l * 256 + ch];
        float o[16];
#pragma unroll
        for (int i = 0; i < 16; ++i) o[i] = bias;
#pragma unroll
        for (int r = 0; r < 46; ++r) { const float hv = hb[(half * 16 + r) * 256 + ch];
#pragma unroll
            for (int i = 0; i < 16; ++i) { const int j = r - i; if (j >= 0 && j <= 30) o[i] = fmaf(hv, w[j], o[i]); } }
#pragma unroll
        for (int i = 0; i < 16; ++i) ob[(half * 16 + i) * 256 + ch] = o[i]; }
    __syncthreads();
    { const int wave = tid >> 6, lane = tid & 63;
        const f32x4 lw = *(const f32x4*)(p.cv_ln_w + l * 256 + lane * 4), lbv = *(const f32x4*)(p.cv_ln_b + l * 256 + lane * 4);
        bf16_t* mix = (bf16_t*)(p.ws + WS_HB);
#pragma unroll
        for (int i = 0; i < 4; ++i) { const int tl = wave * 4 + i;
            const f32x4 xv = *(LAS f32x4*)(ob + tl * 256 + lane * 4);
            const float mu = wave_sum(xv[0] + xv[1] + xv[2] + xv[3]) * (1.f / 256.f);
            const f32x4 dv = xv - mu;
            const float var = wave_sum(dv[0] * dv[0] + dv[1] * dv[1] + dv[2] * dv[2] + dv[3] * dv[3]) * (1.f / 256.f);
            const float rs = rsqrtf(var + EPS);
            const f32x4 y = dv * rs * lw + lbv;
            u32x2 o2; o2.x = cvt_pk_bf16(siluf_(y[0]), siluf_(y[1])); o2.y = cvt_pk_bf16(siluf_(y[2]), siluf_(y[3]));
            *(u32x2*)(mix + (size_t)(b * SEQ + t0 + tl) * DM + 768 + lane * 4) = o2; } }
    __syncthreads();
}

constexpr float IDX_WSCALE = 0.35355339059327373f * 0.17677669529663687f;
__device__ __forceinline__ f32x4 idx_scores(const bf16x8 ka, const bf16x8 (&qi)[8], const float (&wq)[8]) {
    f32x4 s = (f32x4){0.f, 0.f, 0.f, 0.f};
#pragma unroll
    for (int h = 0; h < 8; ++h) { const f32x4 d = mfma16(ka, qi[h], (f32x4){0.f, 0.f, 0.f, 0.f});
#pragma unroll
        for (int r = 0; r < 4; ++r) s[r] = __builtin_fmaf(wq[h], fmaxf(d[r], 0.f), s[r]); }
    return s;
}

__device__ __forceinline__ void cnt_ge(int& cn, unsigned a, unsigned b) { asm("v_cmp_ge_u32 vcc, %1, %2\n\tv_addc_co_u32 %0, vcc, 0, %0, vcc" : "+v"(cn) : "v"(a), "v"(b) : "vcc"); }
__device__ __forceinline__ void cnt_ge16(int& cn, const unsigned (&A)[4], const unsigned (&B)[4], const unsigned (&C)[4], const unsigned (&D)[4], unsigned b) {
#define CG_(n) "v_cmp_ge_u32 vcc, %" #n ", %17\n\tv_addc_co_u32 %0, vcc, 0, %0, vcc\n\t"
    asm(CG_(1) CG_(2) CG_(3) CG_(4) CG_(5) CG_(6) CG_(7) CG_(8) CG_(9) CG_(10) CG_(11) CG_(12) CG_(13) CG_(14) CG_(15) CG_(16)
        : "+v"(cn) : "v"(A[0]), "v"(A[1]), "v"(A[2]), "v"(A[3]), "v"(B[0]), "v"(B[1]), "v"(B[2]), "v"(B[3]), "v"(C[0]), "v"(C[1]), "v"(C[2]), "v"(C[3]), "v"(D[0]), "v"(D[1]), "v"(D[2]), "v"(D[3]), "v"(b) : "vcc");
#undef CG_
}
constexpr int TH_ROW = 40, TH_BUF = 1024 * TH_ROW * 2, TH_CNT = TH_BUF;
__device__ __forceinline__ void thr_item(const Params& p, int b, int qt, LAS unsigned char* sm) {
    const int tid = TID, w = __builtin_amdgcn_readfirstlane(tid >> 6), l = tid & 63, c16 = l & 15, g = l >> 4;
    LAS unsigned* cnt = (LAS unsigned*)(sm + TH_CNT);
    const bf16_t* proj = (const bf16_t*)(p.ws + WS_BIG) + (size_t)b * SEQ * DINP;
    const int q = qt * 16 + c16;
    const bf16_t* qrow = proj + (size_t)q * DINP;
    bf16x8 qi[8]; float wq[8];
#pragma unroll
    for (int h = 0; h < 8; ++h) qi[h] = *(const bf16x8*)(qrow + OFF_IQ + h * 32 + g * 8);
    { const bf16x8 wv = *(const bf16x8*)(qrow + OFF_IW);
#pragma unroll
        for (int h = 0; h < 8; ++h) wq[h] = bf2f(wv[h]) * IDX_WSCALE; }
    unsigned sc[32][4];
    const int ni = (qt >= w) ? ((qt - w) >> 3) + 1 : 0;
    const int nchunk = (qt >> 6) + 1;
    const bf16_t* gsrc = proj + (size_t)(tid >> 2) * DINP + OFF_IK + (tid & 3) * 8;
    const int ldst = (tid >> 2) * TH_ROW + (tid & 3) * 8;
    bf16x8 stg[8];
#define TH_LOAD(ck_) do { const bf16_t* s_ = gsrc + (size_t)(ck_) * 1024 * DINP; _Pragma("unroll") for (int m_ = 0; m_ < 8; ++m_) stg[m_] = *(const bf16x8*)(s_ + (size_t)(128 * m_) * DINP); } while (0)
#define TH_STORE() do { LAS bf16_t* d_ = (LAS bf16_t*)sm + ldst; _Pragma("unroll") for (int m_ = 0; m_ < 8; ++m_) *(LAS bf16x8*)(d_ + 128 * m_ * TH_ROW) = stg[m_]; } while (0)
    TH_LOAD(0);
    for (int i = tid; i < 48 * 16; i += NTHREADS) cnt[i] = 0u;
#pragma unroll
    for (int ck = 0; ck < 4; ++ck) {
        if (ck < nchunk) {
            TH_STORE();
            __syncthreads();
            if (ck + 1 < nchunk) TH_LOAD(ck + 1);
            LAS bf16_t* B = (LAS bf16_t*)sm;
#pragma unroll
            for (int j = 0; j < 8; ++j) { const int i = ck * 8 + j, kt = w + 8 * i;
                if (kt <= qt) { const bf16x8 ka = *(LAS bf16x8*)(B + ((j * 8 + w) * 16 + c16) * TH_ROW + g * 8);
                    const f32x4 s = idx_scores(ka, qi, wq);
#pragma unroll
                    for (int r = 0; r < 4; ++r) { const int key = kt * 16 + 4 * g + r; sc[i][r] = (key <= q) ? sortable(s[r]) : 0u; }
                } else { sc[i][0] = 0u; sc[i][1] = 0u; sc[i][2] = 0u; sc[i][3] = 0u; } }
            if (ck + 1 < nchunk) __syncthreads();
        } else {
#pragma unroll
            for (int j = 0; j < 8; ++j) { sc[ck * 8 + j][0] = 0u; sc[ck * 8 + j][1] = 0u; sc[ck * 8 + j][2] = 0u; sc[ck * 8 + j][3] = 0u; }
        }
    }
#undef TH_LOAD
#undef TH_STORE
#define TH_XCHG(tot_) do { __hip_atomic_fetch_add(&cnt[it * 16 + c16], (unsigned)cn, __ATOMIC_RELAXED, __HIP_MEMORY_SCOPE_WORKGROUP); __syncthreads(); tot_ = (int)cnt[it * 16 + c16]; } while (0)
    unsigned T = 0u; bool done = false; int it = 0;
    for (; it < 32; ++it) {
        const unsigned cand = T | (1u << (31 - it)); int cn = 0;
#pragma unroll
        for (int gi = 0; gi < 4; ++gi) if (ni > 8 * gi) {
#pragma unroll
            for (int i = 8 * gi; i < 8 * gi + 8; i += 4) cnt_ge16(cn, sc[i], sc[i + 1], sc[i + 2], sc[i + 3], cand); }
        int tot; TH_XCHG(tot);
        if (!done) { if (tot >= TOPK) T = cand; if (tot == TOPK) done = true; }
        if (__all(done)) { ++it; break; }
    }
    unsigned ceq = 4095u; bool tied = false;
    const bool open = !done && (T != 0u);
    if (!__all(!open)) {
        int ngt = 0, nge = 0;
        for (int e = 0; e < 2; ++e, ++it) {
            const unsigned cand = (e == 0) ? T + 1u : T; int cn = 0;
#pragma unroll
            for (int gi = 0; gi < 4; ++gi) if (ni > 8 * gi) {
#pragma unroll
            for (int i = 8 * gi; i < 8 * gi + 8; ++i) { cnt_ge(cn, sc[i][0], cand); cnt_ge(cn, sc[i][1], cand); cnt_ge(cn, sc[i][2], cand); cnt_ge(cn, sc[i][3], cand); } }
            int tot; TH_XCHG(tot);
            if (e == 0) ngt = tot; else nge = tot;
        }
        const int need = TOPK - ngt; const bool excess = open && (nge - ngt > need);
#pragma unroll
        for (int i = 0; i < 32; ++i)
#pragma unroll
            for (int r = 0; r < 4; ++r) sc[i][r] = (sc[i][r] == T) ? (unsigned)((w + 8 * i) * 16 + 4 * g + r) : (sc[i][r] > T ? 0xfffffffeu : 0xffffffffu);
        unsigned c = 0u;
        for (int s = 0; s < 12; ++s, ++it) {
            const unsigned cand = c | (1u << (11 - s)); int cn = 0;
#pragma unroll
            for (int gi = 0; gi < 4; ++gi) if (ni > 8 * gi) {
#pragma unroll
                for (int i = 8 * gi; i < 8 * gi + 8; ++i) { cnt_ge(cn, cand - 1u, sc[i][0]); cnt_ge(cn, cand - 1u, sc[i][1]); cnt_ge(cn, cand - 1u, sc[i][2]); cnt_ge(cn, cand - 1u, sc[i][3]); } }
            int tot; TH_XCHG(tot);
            if (tot < need) c = cand;
        }
        if (excess) ceq = c;
        tied = true;
    }
#undef TH_XCHG
    LAS unsigned* lm = (LAS unsigned*)sm;
    __syncthreads();
    for (int i = tid; i < 2048; i += NTHREADS) lm[i] = 0u;
    __syncthreads();
    { const unsigned Tm = T > 1u ? T : 1u; const bool allow_eq = (T != 0u);
#pragma unroll
        for (int gi = 0; gi < 4; ++gi) if (ni > 8 * gi) {
#pragma unroll
            for (int i = 8 * gi; i < 8 * gi + 8; ++i) { unsigned nib = 0u;
#pragma unroll
                for (int r = 0; r < 4; ++r) { const unsigned v = sc[i][r];
                    const bool s_ = tied ? ((v == 0xfffffffeu) || (allow_eq && v <= ceq)) : (v >= Tm);
                    nib |= s_ ? (1u << r) : 0u; }
                const int kt = w + 8 * i;
                if (nib) __hip_atomic_fetch_or(&lm[c16 * 128 + (kt >> 1)], nib << (4 * g + 16 * (kt & 1)), __ATOMIC_RELAXED, __HIP_MEMORY_SCOPE_WORKGROUP); } }
    }
    __syncthreads();
    { unsigned* gm = (unsigned*)(p.ws + WS_MASK) + (size_t)(b * SEQ + qt * 16) * 128;
        *(u32x4*)(gm + tid * 4) = *(LAS u32x4*)(lm + tid * 4); }
    __syncthreads();
}

constexpr int AT_KROW = 264, AT_IROW = 40, AT_VROW = 40;
constexpr int AT_OFFI = 32 * AT_KROW * 2, AT_OFFV = AT_OFFI + 32 * AT_IROW * 2, AT_BUF = AT_OFFV + 256 * AT_VROW * 2;
__device__ __forceinline__ int at_row(int r) { return (r & 3) + 4 * ((r >> 3) & 3) + 16 * ((r >> 2) & 1); }
__device__ __forceinline__ void attn_item(const Params& p, int b, int qb, LAS unsigned char* sm) {
    const int tid = TID, w = __builtin_amdgcn_readfirstlane(tid >> 6), l = tid & 63, c16 = l & 15, g = l >> 4, qs = w & 3, hp = w >> 2;
    const bf16_t* proj = (const bf16_t*)(p.ws + WS_BIG) + (size_t)b * SEQ * DINP;
    const bf16_t* vt = (const bf16_t*)(p.ws + WS_VT) + (size_t)b * 4 * 64 * SEQ;
    const int q = qb * 64 + qs * 16 + c16;
    const bf16_t* qrow = proj + (size_t)q * DINP;
    const unsigned* mrow = (const unsigned*)(p.ws + WS_MASK) + (size_t)(b * SEQ + q) * 128;
    bf16x8 Qb[2][2];
#pragma unroll
    for (int hh = 0; hh < 2; ++hh)
#pragma unroll
        for (int kk = 0; kk < 2; ++kk) { const bf16x8 raw = *(const bf16x8*)(qrow + OFF_SQ + (2 * hp + hh) * 64 + kk * 32 + g * 8); bf16x8 o;
#pragma unroll
            for (int e = 0; e < 8; ++e) o[e] = (short)f2bf(bf2f(raw[e]) * 0.125f);
            Qb[hh][kk] = o; }
    f32x4 O[2][4];
#pragma unroll
    for (int hh = 0; hh < 2; ++hh)
#pragma unroll
        for (int dt = 0; dt < 4; ++dt) O[hh][dt] = (f32x4){0.f, 0.f, 0.f, 0.f};
    float mrun[2] = {-1e30f, -1e30f}, lrun[2] = {0.f, 0.f};
    const int nt = 2 * qb + 2, my_nt = (qb * 64 + qs * 16 + 15) / 32 + 1;
    const int kr0 = tid >> 5, kc = (tid & 31) * 8, vr0 = tid >> 2, vc = (tid & 3) * 8;
    const bf16_t* gK = proj + (size_t)kr0 * DINP + OFF_SK + kc;
    const bf16_t* gV = vt + (size_t)vr0 * SEQ + vc;
    const int lK0 = at_row(kr0) * AT_KROW + kc, lK1 = at_row(kr0 + 16) * AT_KROW + kc;
    const int lV0 = AT_OFFV / 2 + vr0 * AT_VROW + vc, lV1 = AT_OFFV / 2 + (vr0 + 128) * AT_VROW + vc;
    bf16x8 sA[4], sB[4]; unsigned mw = 0u, mwA = 0u, mwB = 0u;
#define AT_LOAD(S_, M_, k0_) do { S_[0] = *(const bf16x8*)(gK + (size_t)(k0_) * DINP); S_[1] = *(const bf16x8*)(gK + (size_t)((k0_) + 16) * DINP); \
        M_ = mrow[(k0_) >> 5]; S_[2] = *(const bf16x8*)(gV + (k0_)); S_[3] = *(const bf16x8*)(gV + (size_t)128 * SEQ + (k0_)); } while (0)
#define AT_STORE(S_, buf_) do { LAS bf16_t* B_ = (LAS bf16_t*)(sm + (buf_) * AT_BUF); *(LAS bf16x8*)(B_ + lK0) = S_[0]; *(LAS bf16x8*)(B_ + lK1) = S_[1]; \
        *(LAS bf16x8*)(B_ + lV0) = S_[2]; *(LAS bf16x8*)(B_ + lV1) = S_[3]; } while (0)
    AT_LOAD(sA, mwA, 0); AT_STORE(sA, 0); mw = mwA;
    AT_LOAD(sB, mwB, 32);
    __syncthreads();
    for (int t2 = 0; t2 < nt; t2 += 2) {
#pragma unroll
      for (int par = 0; par < 2; ++par) {
        const int t = t2 + par, k0 = t * 32;
        if (t + 2 < nt) { if (par == 0) AT_LOAD(sA, mwA, k0 + 64); else AT_LOAD(sB, mwB, k0 + 64); }
        if (t < my_nt) {
            LAS bf16_t* Bk = (LAS bf16_t*)(sm + par * AT_BUF); LAS bf16_t* Bv = Bk + AT_OFFV / 2;
            bool sel[2][4]; float lg[2][2][4];
#pragma unroll
            for (int s = 0; s < 2; ++s) {
                const int lrow = 16 * s + c16;
#pragma unroll
                for (int r = 0; r < 4; ++r) sel[s][r] = ((mw >> (8 * g + 4 * s + r)) & 1u) != 0u;
#pragma unroll
                for (int hh = 0; hh < 2; ++hh) { f32x4 S = (f32x4){0.f, 0.f, 0.f, 0.f};
#pragma unroll
                    for (int kk = 0; kk < 2; ++kk) { const bf16x8 kf = *(LAS bf16x8*)(Bk + lrow * AT_KROW + (2 * hp + hh) * 64 + kk * 32 + g * 8); S = mfma16(kf, Qb[hh][kk], S); }
#pragma unroll
                    for (int r = 0; r < 4; ++r) lg[hh][s][r] = S[r]; }
            }
#pragma unroll
            for (int hh = 0; hh < 2; ++hh) {
                float lm_[8];
#pragma unroll
                for (int s = 0; s < 2; ++s)
#pragma unroll
                    for (int r = 0; r < 4; ++r) lm_[s * 4 + r] = sel[s][r] ? lg[hh][s][r] : -1e30f;
                float mx = fmaxf(fmaxf(fmaxf(lm_[0], lm_[1]), fmaxf(lm_[2], lm_[3])), fmaxf(fmaxf(lm_[4], lm_[5]), fmaxf(lm_[6], lm_[7])));
                mx = xrow16_max(mx);
                const float mn = fmaxf(mrun[hh], mx), alpha = __expf(mrun[hh] - mn), mn2 = mn * 1.4426950408889634f;
                mrun[hh] = mn;
                float pv[8]; float ps = 0.f;
#pragma unroll
                for (int e = 0; e < 8; ++e) { pv[e] = (mn > -1e29f) ? __builtin_amdgcn_exp2f(__builtin_fmaf(lm_[e], 1.4426950408889634f, -mn2)) : 0.f; ps += pv[e]; }
                lrun[hh] = lrun[hh] * alpha + ps;
                union { bf16x8 v; unsigned u[4]; } pb;
                pb.u[0] = cvt_pk_bf16(pv[0], pv[1]); pb.u[1] = cvt_pk_bf16(pv[2], pv[3]); pb.u[2] = cvt_pk_bf16(pv[4], pv[5]); pb.u[3] = cvt_pk_bf16(pv[6], pv[7]);
                if (__any(alpha != 1.f)) {
#pragma unroll
                    for (int dt = 0; dt < 4; ++dt) O[hh][dt] = O[hh][dt] * alpha; }
#pragma unroll
                for (int dt = 0; dt < 4; ++dt) {
                    const bf16x8 va = *(LAS bf16x8*)(Bv + ((2 * hp + hh) * 64 + dt * 16 + c16) * AT_VROW + g * 8);
                    O[hh][dt] = mfma16(va, pb.v, O[hh][dt]); }
            }
        }
        if (t + 1 < nt) { if (par == 0) { AT_STORE(sB, 1); mw = mwB; } else { AT_STORE(sA, 0); mw = mwA; } }
        __syncthreads();
      }
    }
#undef AT_LOAD
#undef AT_STORE
    bf16_t* mix = (bf16_t*)(p.ws + WS_HB) + (size_t)(b * SEQ + q) * DM + 512;
#pragma unroll
    for (int hh = 0; hh < 2; ++hh) { const float tot = xrow16_sum(lrun[hh]);
        const float inv = 1.f / tot;
#pragma unroll
        for (int dt = 0; dt < 4; ++dt) { const f32x4 o = O[hh][dt] * inv; u32x2 o2; o2.x = cvt_pk_bf16(o[0], o[1]); o2.y = cvt_pk_bf16(o[2], o[3]);
            *(u32x2*)(mix + (2 * hp + hh) * 64 + dt * 16 + 4 * g) = o2; } }
}

__device__ __forceinline__ void hgrn_G(const bf16x8 (&fv)[2], const float* lb, LAS float* Gs, LAS float* segtot) {
    const int tid = TID;
#pragma unroll
    for (int i = 0; i < 2; ++i) { const int row = (tid >> 4) + 32 * i, c8 = (tid & 15) * 8;
        const bf16x8 v = fv[i];
#pragma unroll
        for (int j = 0; j < 8; ++j) { const float fr = bf2f(v[j]), lbv = lb[c8 + j]; const float f = lbv + (1.f - lbv) * sigmoidf_(fr);
            Gs[row * 129 + c8 + j] = __logf(fmaxf(f, 1e-30f)); } }
    __syncthreads();
    const int col = tid & 127, seg = tid >> 7;
    { float run = 0.f;
#pragma unroll
        for (int r = 0; r < 16; ++r) { const int idx = (seg * 16 + r) * 129 + col; run += Gs[idx]; Gs[idx] = run; }
        segtot[seg * 128 + col] = run; }
    __syncthreads();
    { float off = 0.f;
#pragma unroll
        for (int s = 0; s < 3; ++s) if (s < seg) off += segtot[s * 128 + col];
        if (seg > 0) {
#pragma unroll
            for (int r = 0; r < 16; ++r) Gs[(seg * 16 + r) * 129 + col] += off; } }
    __syncthreads();
}

__device__ __forceinline__ void hgrn_A_item(const Params& p, int l, int b, int h, int c, LAS unsigned char* sm) {
    const int tid = TID, w = __builtin_amdgcn_readfirstlane(tid >> 6), ln = tid & 63, c16 = ln & 15, g = ln >> 4;
    LAS float* Gs = (LAS float*)sm; LAS float* segtot = (LAS float*)(sm + 33024);
    LAS bf16_t* KgT = (LAS bf16_t*)(sm + 35072); LAS bf16_t* vT = (LAS bf16_t*)(sm + 53504);
    LAS bf16_t* qt_ = (LAS bf16_t*)(sm + 71936); LAS bf16_t* kt_ = (LAS bf16_t*)(sm + 89344); LAS bf16_t* Am = (LAS bf16_t*)(sm + 106752);
    bf16_t* prow0 = (bf16_t*)(p.ws + WS_BIG) + (size_t)(b * SEQ + c * 64) * DINP;
    const float* lb = (const float*)(p.ws + WS_LB) + l * 512 + h * 128;
    bf16x8 fG[2], qG[2];
#pragma unroll
    for (int i = 0; i < 2; ++i) { const bf16_t* rq = prow0 + (size_t)((tid >> 4) + 32 * i) * DINP + h * 128 + (tid & 15) * 8; fG[i] = *(const bf16x8*)(rq + OFF_HF); qG[i] = *(const bf16x8*)(rq + OFF_HQ); }
    const bf16_t* rp = prow0 + (size_t)(tid & 63) * DINP + h * 128 + (tid >> 6) * 16;
    const bf16x8 f0 = *(const bf16x8*)(rp + OFF_HF), f1 = *(const bf16x8*)(rp + OFF_HF + 8), v0 = *(const bf16x8*)(rp + OFF_HI), v1 = *(const bf16x8*)(rp + OFF_HI + 8);
    hgrn_G(fG, lb, Gs, segtot);
#pragma unroll
    for (int i = 0; i < 2; ++i) { const int row = (tid >> 4) + 32 * i, c8 = (tid & 15) * 8;
        const bf16x8 qv8 = qG[i], fv8 = fG[i];
        float a[8], bq[8], cq[8];
#pragma unroll
        for (int j = 0; j < 8; ++j) { const int k = c8 + j; const float G = Gs[row * 129 + k], Gm = Gs[31 * 129 + k], lbv = lb[k];
            const float qv = siluf_(bf2f(qv8[j])) * 0.08838834764831845f, kval = (1.f - lbv) * sigmoidf_(-bf2f(fv8[j]));
            a[j] = qv * __expf(fminf(G - Gm, 80.f)); bq[j] = kval * __expf(fminf(Gm - G, 80.f)); cq[j] = qv * __expf(G); }
        u32x4 o;
        o.x = cvt_pk_bf16(a[0], a[1]); o.y = cvt_pk_bf16(a[2], a[3]); o.z = cvt_pk_bf16(a[4], a[5]); o.w = cvt_pk_bf16(a[6], a[7]); *(LAS u32x4*)(qt_ + row * 136 + c8) = o;
        o.x = cvt_pk_bf16(bq[0], bq[1]); o.y = cvt_pk_bf16(bq[2], bq[3]); o.z = cvt_pk_bf16(bq[4], bq[5]); o.w = cvt_pk_bf16(bq[6], bq[7]); *(LAS u32x4*)(kt_ + row * 136 + c8) = o;
        o.x = cvt_pk_bf16(cq[0], cq[1]); o.y = cvt_pk_bf16(cq[2], cq[3]); o.z = cvt_pk_bf16(cq[4], cq[5]); o.w = cvt_pk_bf16(cq[6], cq[7]);
        *(u32x4*)(prow0 + (size_t)row * DINP + OFF_HQ + h * 128 + c8) = o; }
    { const int j = tid & 63, kg = tid >> 6;
#pragma unroll
        for (int e = 0; e < 16; ++e) { const int k = kg * 16 + e; const float fr = bf2f(e < 8 ? f0[e & 7] : f1[e & 7]), lbv = lb[k];
            const float kval = (1.f - lbv) * sigmoidf_(-fr);
            KgT[k * 72 + j] = f2bf(kval * __expf(Gs[63 * 129 + k] - Gs[j * 129 + k]));
            vT[k * 72 + j] = (bf16_t)(e < 8 ? v0[e & 7] : v1[e & 7]); } }
    const size_t bhc = (size_t)((b * 4 + h) * 64 + c);
    if (tid < 128) ((float*)(p.ws + WS_DEC))[bhc * 128 + tid] = __expf(Gs[63 * 129 + tid]);
    __syncthreads();
    { f32x4 acc[8];
#pragma unroll
        for (int vt = 0; vt < 8; ++vt) acc[vt] = (f32x4){0.f, 0.f, 0.f, 0.f};
#pragma unroll
        for (int kk = 0; kk < 2; ++kk) { const bf16x8 a = *(LAS bf16x8*)(KgT + (w * 16 + c16) * 72 + kk * 32 + g * 8);
#pragma unroll
            for (int vt = 0; vt < 8; ++vt) { const bf16x8 bb = *(LAS bf16x8*)(vT + (vt * 16 + c16) * 72 + kk * 32 + g * 8); acc[vt] = mfma16(a, bb, acc[vt]); } }
        bf16_t* st = (bf16_t*)(p.ws + WS_ST) + bhc * 16384;
#pragma unroll
        for (int vt = 0; vt < 8; ++vt) { u32x2 o; o.x = cvt_pk_bf16(acc[vt][0], acc[vt][1]); o.y = cvt_pk_bf16(acc[vt][2], acc[vt][3]);
            *(u32x2*)(st + (size_t)(vt * 16 + c16) * 128 + w * 16 + 4 * g) = o; } }
#pragma unroll
    for (int s = 0; s < 2; ++s) { const int tI = w * 2 + s, itile = tI >> 2, jt = tI & 3;
        f32x4 d = (f32x4){0.f, 0.f, 0.f, 0.f};
        if (jt <= itile) {
#pragma unroll
            for (int kk = 0; kk < 4; ++kk) { const bf16x8 a = *(LAS bf16x8*)(kt_ + (jt * 16 + c16) * 136 + kk * 32 + g * 8), bb = *(LAS bf16x8*)(qt_ + (itile * 16 + c16) * 136 + kk * 32 + g * 8);
                d = mfma16(a, bb, d); } }
        const int i = itile * 16 + c16, j0 = jt * 16 + 4 * g;
        u32x2 o; o.x = cvt_pk_bf16((j0 + 0 <= i) ? d[0] : 0.f, (j0 + 1 <= i) ? d[1] : 0.f); o.y = cvt_pk_bf16((j0 + 2 <= i) ? d[2] : 0.f, (j0 + 3 <= i) ? d[3] : 0.f);
        *(LAS u32x2*)(Am + i * 72 + j0) = o; }
    __syncthreads();
    { const int itile = w & 3, vh = w >> 2;
        f32x4 acc[4];
#pragma unroll
        for (int vt = 0; vt < 4; ++vt) acc[vt] = (f32x4){0.f, 0.f, 0.f, 0.f};
#pragma unroll
        for (int kk = 0; kk < 2; ++kk) { const bf16x8 bb = *(LAS bf16x8*)(Am + (itile * 16 + c16) * 72 + kk * 32 + g * 8);
#pragma unroll
            for (int vt = 0; vt < 4; ++vt) { const bf16x8 a = *(LAS bf16x8*)(vT + ((vh * 4 + vt) * 16 + c16) * 72 + kk * 32 + g * 8); acc[vt] = mfma16(a, bb, acc[vt]); } }
        bf16_t* mix = (bf16_t*)(p.ws + WS_HB) + (size_t)(b * SEQ + c * 64 + itile * 16 + c16) * DM + h * 128;
#pragma unroll
        for (int vt = 0; vt < 4; ++vt) { u32x2 o; o.x = cvt_pk_bf16(acc[vt][0], acc[vt][1]); o.y = cvt_pk_bf16(acc[vt][2], acc[vt][3]);
            *(u32x2*)(mix + (vh * 4 + vt) * 16 + 4 * g) = o; } }
    __syncthreads();
}

__device__ __forceinline__ void hgrn_scan(const Params& p) {
    bf16_t* ST = (bf16_t*)(p.ws + WS_ST); const float* DEC = (const float*)(p.ws + WS_DEC);
    for (int e = blockIdx.x * NTHREADS + TID; e < 32 * 4096; e += gridDim.x * NTHREADS) {
        const int bh = e >> 12, idx4 = (e & 4095) * 4, k = idx4 & 127;
        bf16_t* base = ST + (size_t)bh * 64 * 16384 + idx4; const float* dec = DEC + (size_t)bh * 64 * 128 + k;
        f32x4 S = (f32x4){0.f, 0.f, 0.f, 0.f};
#pragma unroll 16
        for (int c = 0; c < 64; ++c) { const u32x2 loc = *(const u32x2*)(base + (size_t)c * 16384); const f32x4 d = *(const f32x4*)(dec + c * 128);
            u32x2 o; o.x = cvt_pk_bf16(S[0], S[1]); o.y = cvt_pk_bf16(S[2], S[3]);
            *(u32x2*)(base + (size_t)c * 16384) = o;
            S[0] = d[0] * S[0] + bflo(loc.x); S[1] = d[1] * S[1] + bfhi(loc.x); S[2] = d[2] * S[2] + bflo(loc.y); S[3] = d[3] * S[3] + bfhi(loc.y); }
    }
}

__device__ __forceinline__ void hgrn_C_item(const Params& p, int l, int b, int h, int c, LAS unsigned char* sm) {
    const int tid = TID, w = __builtin_amdgcn_readfirstlane(tid >> 6), ln = tid & 63, c16 = ln & 15, g = ln >> 4;
    LAS float* ssq = (LAS float*)sm;
    const int itile = w & 3, vh = w >> 2, i = itile * 16 + c16;
    const bf16_t* prow = (const bf16_t*)(p.ws + WS_BIG) + (size_t)(b * SEQ + c * 64 + i) * DINP;
    bf16_t* mix = (bf16_t*)(p.ws + WS_HB) + (size_t)(b * SEQ + c * 64 + i) * DM + h * 128;
    const bf16_t* st_ = (const bf16_t*)(p.ws + WS_ST) + (size_t)((b * 4 + h) * 64 + c) * 16384;
    bf16x8 qgF[4], stG[4][4]; u32x2 grG[4], oi[4];
#pragma unroll
    for (int kk = 0; kk < 4; ++kk) qgF[kk] = *(const bf16x8*)(prow + OFF_HQ + h * 128 + kk * 32 + g * 8);
#pragma unroll
    for (int kk = 0; kk < 4; ++kk)
#pragma unroll
        for (int vt = 0; vt < 4; ++vt) stG[kk][vt] = *(const bf16x8*)(st_ + (size_t)((vh * 4 + vt) * 16 + c16) * 128 + kk * 32 + g * 8);
#pragma unroll
    for (int vt = 0; vt < 4; ++vt) { const int v0 = (vh * 4 + vt) * 16 + 4 * g; grG[vt] = *(const u32x2*)(prow + OFF_HG + h * 128 + v0); oi[vt] = *(const u32x2*)(mix + v0); }
    f32x4 acc[4];
#pragma unroll
    for (int vt = 0; vt < 4; ++vt) acc[vt] = (f32x4){bflo(oi[vt].x), bfhi(oi[vt].x), bflo(oi[vt].y), bfhi(oi[vt].y)};
#pragma unroll
    for (int kk = 0; kk < 4; ++kk)
#pragma unroll
        for (int vt = 0; vt < 4; ++vt) acc[vt] = mfma16(stG[kk][vt], qgF[kk], acc[vt]);
    float ss = 0.f;
#pragma unroll
    for (int vt = 0; vt < 4; ++vt) ss += acc[vt][0] * acc[vt][0] + acc[vt][1] * acc[vt][1] + acc[vt][2] * acc[vt][2] + acc[vt][3] * acc[vt][3];
    ss = xrow16_sum(ss);
    if (g == 0) ssq[vh * 64 + i] = ss;
    __syncthreads();
    const float rstd = rsqrtf((ssq[i] + ssq[64 + i]) * (1.f / 128.f) + EPS);
#pragma unroll
    for (int vt = 0; vt < 4; ++vt) { const int v0 = (vh * 4 + vt) * 16 + 4 * g;
        const u32x2 gr = grG[vt]; const f32x4 ow = *(const f32x4*)(p.onorm_w + l * 512 + h * 128 + v0);
        const float r0 = acc[vt][0] * rstd * ow[0] * siluf_(bflo(gr.x)), r1 = acc[vt][1] * rstd * ow[1] * siluf_(bfhi(gr.x));
        const float r2 = acc[vt][2] * rstd * ow[2] * siluf_(bflo(gr.y)), r3 = acc[vt][3] * rstd * ow[3] * siluf_(bfhi(gr.y));
        u32x2 o; o.x = cvt_pk_bf16(r0, r1); o.y = cvt_pk_bf16(r2, r3);
        *(u32x2*)(mix + v0) = o; }
    __syncthreads();
}

#ifdef DIAG_CUT
__device__ __forceinline__ void diag_phase(const Params& p) {
    const int tid = TID, wave = tid >> 6, lane = tid & 63;
    const bf16_t* HB = (const bf16_t*)(p.ws + WS_HB); const bf16_t* ST = (const bf16_t*)(p.ws + WS_ST); const float* DEC = (const float*)(p.ws + WS_DEC);
    const bf16_t* BIG = (const bf16_t*)(p.ws + WS_BIG);
    for (int row = blockIdx.x * 8 + wave; row < NTOK; row += gridDim.x * 8) {
        float* orow = p.out + (size_t)row * DM;
        for (int i = 0; i < 16; ++i) { const int col = i * 64 + lane; float v = 0.f;
#if DIAG_MODE == 1
            for (int t = 0; t < 3; ++t) v += bf2f((short)BIG[(size_t)row * DINP + col + 1024 * t]);
            if (col < 768) v += bf2f((short)BIG[(size_t)row * DINP + 3072 + col]);
#elif DIAG_MODE == 2
            v = bf2f((short)ST[(size_t)row * 1024 + col]) + DEC[((size_t)row * 8 + (col & 7)) % (32 * 64 * 128)];
#elif DIAG_MODE == 5
            v = DEC[((size_t)row * 8 + (col & 7)) % (32 * 64 * 128)];
#elif DIAG_MODE == 6
            v = bf2f((short)ST[(size_t)row * 1024 + col]);
#elif DIAG_MODE == 4
            v = bf2f((short)HB[(size_t)row * DM + col]);
#endif
            if (!(fabsf(v) < 1e30f)) v = 12345.f;
            orow[col] = v; }
    }
}
#endif
#define XB_TMO      128
#define XB_XCNT(j)  (256  + 64 * (j))
#define XB_XSUB(j)  (1280 + 64 * (j))
#define XB_XGEN(j)  (2304 + 64 * (j))
#define XB_TOP      3328
#define XB_TOPGEN   3392
#define XCD_BAR_WORDS 3456
#define XB_SPIN_CAP (1u << 21)

__device__ __forceinline__ unsigned xb_ld(unsigned* p)              { return __hip_atomic_load(p, __ATOMIC_RELAXED, __HIP_MEMORY_SCOPE_AGENT); }
__device__ __forceinline__ unsigned xb_add(unsigned* p, unsigned v) { return __hip_atomic_fetch_add(p, v, __ATOMIC_RELAXED, __HIP_MEMORY_SCOPE_AGENT); }
__device__ __forceinline__ unsigned xb_xcc_id() { return (unsigned)__builtin_amdgcn_s_getreg((3 << 11) | 20) & 0xFu; }
#define XB_SPIN(cond, bar) do { unsigned _sp = 0; while (cond) { __builtin_amdgcn_s_sleep(1); \
    if ((++_sp & 255u) == 0u) { if (xb_ld(&(bar)[XB_TMO])) break; if (_sp > XB_SPIN_CAP) { atomicAdd(&(bar)[XB_TMO], 1u); break; } } } } while (0)

struct XcdBarrier {
    unsigned* bar; unsigned x;
    volatile LAS unsigned* st;
};

__device__ __forceinline__ XcdBarrier xcd_barrier_post(unsigned* bar, volatile LAS unsigned* st) {
    XcdBarrier b; b.bar = bar; b.x = xb_xcc_id(); b.st = st;
    if (threadIdx.x == 0) (void)xb_add(&bar[XB_XCNT(b.x)], 1u);
    return b;
}
__device__ __forceinline__ void xcd_barrier_complete(unsigned* bar, unsigned x, unsigned& nloc, unsigned& nx) {
    const unsigned G = gridDim.x * gridDim.y * gridDim.z;
    unsigned sum, cnt, mine, sp = 0u;
    for (;;) {
        sum = 0u; cnt = 0u; mine = 0u;
#pragma unroll
        for (unsigned j = 0; j < 16; ++j) { const unsigned c = xb_ld(&bar[XB_XCNT(j)]); sum += c; cnt += (c > 0u) ? 1u : 0u; mine = (j == x) ? c : mine; }
        if (sum == G) break;
        __builtin_amdgcn_s_sleep(1);
        if ((++sp & 255u) == 0u) { if (xb_ld(&bar[XB_TMO])) break; if (sp > XB_SPIN_CAP) { atomicAdd(&bar[XB_TMO], 1u); break; } }
    }
    nloc = mine > 0u ? mine : 1u; nx = cnt > 0u ? cnt : 1u;
}

__device__ __forceinline__ void xcd_barrier(const XcdBarrier& b) {
    asm volatile("s_waitcnt vmcnt(0)" ::: "memory");
    __syncthreads();
    if (threadIdx.x == 0) {
        unsigned* bar = b.bar;
        __builtin_amdgcn_s_waitcnt(0);
        unsigned nloc = b.st[0], nx = b.st[1];
        if (nloc == 0u) { xcd_barrier_complete(bar, b.x, nloc, nx); b.st[0] = nloc; b.st[1] = nx; }
        const unsigned old = xb_add(&bar[XB_XSUB(b.x)], 1u);
        const unsigned gen = old / nloc;
        if (old + 1u == (gen + 1u) * nloc) {
            __builtin_amdgcn_fence(__ATOMIC_RELEASE, "agent");
            asm volatile("s_waitcnt vmcnt(0)" ::: "memory");
            const unsigned og = xb_add(&bar[XB_TOP], 1u);
            const unsigned tg = og / nx;
            if (og + 1u == (tg + 1u) * nx) xb_add(&bar[XB_TOPGEN], 1u);
            else XB_SPIN(xb_ld(&bar[XB_TOPGEN]) == tg, bar);
            __builtin_amdgcn_fence(__ATOMIC_ACQUIRE, "agent");
            xb_add(&bar[XB_XGEN(b.x)], 1u);
            asm volatile("s_waitcnt vmcnt(0)" ::: "memory");
        } else {
            XB_SPIN(xb_ld(&bar[XB_XGEN(b.x)]) == gen, bar);
            __builtin_amdgcn_fence(__ATOMIC_ACQUIRE, "agent");
            asm volatile("s_waitcnt vmcnt(0)" ::: "memory");
        }
    }
    __syncthreads();
}


template <class Epi>
__device__ __forceinline__ void run_gemm(LAS unsigned char* lds, const bf16_t* A, const bf16_t* Bt, int M, int N, int K, const Epi& E) {
    pg8::Gemm g; g.A = A; g.Bt = Bt; g.M = M; g.N = N; g.K = K;
    pg8::StaticOrder S; S.init(M, N, (int)gridDim.x, (int)blockIdx.x);
    pg8::gemm_phase<Epi, pg8::StaticOrder, true, true>(lds, g, S, E);
}

constexpr int NPHASE = 2 + 9 * DEPTH;
#define GRID_SYNC() do { if (pin.ph_lo < 0) grid.sync(); xcd_barrier(xb); } while (0)

__global__ void __launch_bounds__(NTHREADS, 2) fwd_megakernel(Params pin) {
    extern __shared__ __attribute__((aligned(16))) unsigned char lds_raw[];
    LAS unsigned char* lds = (LAS unsigned char*)lds_raw;
    cg::grid_group grid = cg::this_grid();
    volatile LAS unsigned* xst = (volatile LAS unsigned*)(lds + 131072);
    if (threadIdx.x == 0) { xst[0] = 0u; xst[1] = 0u; }
    __syncthreads();
    XcdBarrier xb = xcd_barrier_post((unsigned*)(pin.ws + WS_BAR), xst);
    const int G = (int)gridDim.x, blk = (int)blockIdx.x;
    for (int ph = pin.ph_lo; ph < pin.ph_hi; ++ph) {
        Params p = pin;
        { size_t zoff = 0; asm volatile("" : "+s"(zoff));
            p.ws = pin.ws + zoff; p.out = pin.out + zoff; p.x = pin.x + zoff; }
        bf16_t* WIN = (bf16_t*)(p.ws + WS_WIN); bf16_t* WOUT = (bf16_t*)(p.ws + WS_WOUT); bf16_t* W1B = (bf16_t*)(p.ws + WS_W1); bf16_t* W2B = (bf16_t*)(p.ws + WS_W2);
        const float* MOD = (const float*)(p.ws + WS_MOD);
        bf16_t* BIG = (bf16_t*)(p.ws + WS_BIG); bf16_t* HB = (bf16_t*)(p.ws + WS_HB);
        if (ph == 0) {
          for (int rep_ = 0; rep_ < REP_PRO; ++rep_) {
            cvt_kind(p.w_in, WIN, DM, DIN, DINP, (LAS float*)lds);
            cvt_kind(p.w_out, WOUT, DM, DM, DM, (LAS float*)lds);
            cvt_kind(p.w1, W1B, DM, DFF, DFF, (LAS float*)lds);
            cvt_kind(p.w2, W2B, DFF, DM, DM, (LAS float*)lds);
            mod_phase(p, (LAS float*)lds);
            lb_phase(p);
          }
        } else if (ph == NPHASE - 1) {
            final_norm(p.out, p.final_w);
        } else {
            const int l = (ph - 1) / 9, s = (ph - 1) % 9;
            const float* modl = MOD + (size_t)l * NB * 6144;
            const float* xcur = (l == 0) ? p.x : p.out;
            if (s == 0) {
                for (int rep_ = 0; rep_ < REP_NORM; ++rep_) rmsnorm_mod(xcur, p.norm_mix_w + l * DM, modl, 0, 1024, HB);
            } else if (s == 1) {
                pg8::EpiBf16<0> E; E.O = BIG; E.ldc = DINP;
                for (int rep_ = 0; rep_ < REP_GEMM; ++rep_) run_gemm(lds, HB, WIN + (size_t)l * DINP * DM, NTOK, DINP, DM, E);
            } else if (s == 2) {
              for (int rep2_ = 0; rep2_ < REP_S2; ++rep2_) {
#ifndef DIAG_NOTHR
                for (int v = blk; v < 2048; v += G) { const int itp = v >> 8, rem = v & 255, b = rem & 7, jj = rem >> 3; const int qt = itp * 32 + ((itp & 1) ? 31 - jj : jj); for (int rep_ = 0; rep_ < REP_THR; ++rep_) thr_item(p, b, qt, lds); }
#endif
                for (int v = blk; v < 2048; v += G) { const int c = v & 63, bh = v >> 6; hgrn_A_item(p, l, bh >> 2, bh & 3, c, lds); }
                for (int v = blk; v < 1024; v += G) conv_item(p, l, v >> 7, v & 127, lds);
                for (int v = blk; v < 512; v += G) vt_item(p, v >> 6, v & 63, lds);
              }
            } else if (s == 3) {
                hgrn_scan(p);
                for (int v = blk; v < 512; v += G) { const int itp = v >> 8, rem = v & 255, b = rem & 7, jj = rem >> 3; const int qb = itp ? 63 - jj : jj; for (int rep_ = 0; rep_ < REP_ATTN; ++rep_) attn_item(p, b, qb, lds); }
            } else if (s == 4) {
                for (int rep_ = 0; rep_ < REP_HO; ++rep_) for (int v = blk; v < 2048; v += G) { const int c = v & 63, bh = v >> 6; hgrn_C_item(p, l, bh >> 2, bh & 3, c, lds); }
            } else if (s == 5) {
                pg8::EpiResid E; E.xs = xcur; E.xd = p.out; E.gate = modl + 2048;
                run_gemm(lds, HB, WOUT + (size_t)l * DM * DM, NTOK, DM, DM, E);
            } else if (s == 6) {
                for (int rep_ = 0; rep_ < REP_NORM; ++rep_) rmsnorm_mod(p.out, p.norm_mlp_w + l * DM, modl, 3072, 4096, HB);
            } else if (s == 7) {
                pg8::EpiBf16<1> E; E.O = BIG; E.ldc = DFF;
                for (int rep_ = 0; rep_ < REP_GEMM; ++rep_) run_gemm(lds, HB, W1B + (size_t)l * DFF * DM, NTOK, DFF, DM, E);
            } else {
                pg8::EpiResid E; E.xs = p.out; E.xd = p.out; E.gate = modl + 5120;
                run_gemm(lds, BIG, W2B + (size_t)l * DM * DFF, NTOK, DM, DFF, E);
            }
        }
        if (ph + 1 < pin.ph_hi) { GRID_SYNC(); }
    }
#ifdef DIAG_CUT
    { const int ph = 1; GRID_SYNC(); } diag_phase(pin);
#endif
}

extern "C" void kernel_launch(void* const* d_in, const int* in_sizes, int n_in, void* d_out, int out_size, void* d_ws, size_t ws_size, hipStream_t stream) {
    static int grid_blocks = 0;
    if (grid_blocks == 0) {
        if (n_in != 17 || out_size != NTOK * DM || ws_size < WS_END) { fprintf(stderr, "kernel_launch: unexpected shapes (n_in %d out %d ws %zu need %zu)\n", n_in, out_size, ws_size, (size_t)WS_END); grid_blocks = -1; return; }
        int dev = 0, cus = 0, per_cu = 0;
        hipGetDevice(&dev);
        hipDeviceGetAttribute(&cus, hipDeviceAttributeMultiprocessorCount, dev);
        if (hipFuncSetAttribute((const void*)fwd_megakernel, hipFuncAttributeMaxDynamicSharedMemorySize, LDS_BYTES) != hipSuccess) { fprintf(stderr, "kernel_launch: hipFuncSetAttribute failed\n"); grid_blocks = -1; return; }
        if (hipOccupancyMaxActiveBlocksPerMultiprocessor(&per_cu, (const void*)fwd_megakernel, NTHREADS, LDS_BYTES) != hipSuccess || per_cu < 1) { fprintf(stderr, "kernel_launch: occupancy query says %d blocks/CU\n", per_cu); per_cu = 1; }
        (void)hipGetLastError();
        grid_blocks = cus * (per_cu > 1 ? 1 : per_cu);
    }
    if (grid_blocks < 0) return;
    Params p{};
    p.x = (const float*)d_in[0]; p.c = (const float*)d_in[1]; p.ada_w = (const float*)d_in[2]; p.ada_b = (const float*)d_in[3];
    p.norm_mix_w = (const float*)d_in[4]; p.norm_mlp_w = (const float*)d_in[5]; p.w_in = (const float*)d_in[6]; p.lb_logits = (const float*)d_in[7];
    p.onorm_w = (const float*)d_in[8]; p.cv_w = (const float*)d_in[9]; p.cv_b = (const float*)d_in[10]; p.cv_ln_w = (const float*)d_in[11]; p.cv_ln_b = (const float*)d_in[12];
    p.w_out = (const float*)d_in[13]; p.w1 = (const float*)d_in[14]; p.w2 = (const float*)d_in[15]; p.final_w = (const float*)d_in[16];
    p.out = (float*)d_out; p.ws = (unsigned char*)d_ws; p.ph_lo = 0; p.ph_hi = NPHASE;
#ifdef DIAG_CUT
    p.ph_hi = DIAG_CUT;
#endif
    if (hipMemsetAsync((char*)d_ws + WS_BAR, 0, 16384, stream) != hipSuccess) { fprintf(stderr, "kernel_launch: hipMemsetAsync failed\n"); return; }
    void* args[] = {&p};
    hipError_t e = hipLaunchCooperativeKernel((const void*)fwd_megakernel, dim3(grid_blocks), dim3(NTHREADS), args, LDS_BYTES, stream);
    if (e != hipSuccess) fprintf(stderr, "kernel_launch: cooperative launch failed: %s (grid %d)\n", hipGetErrorString(e), grid_blocks);
}
```

```cpp
#include <hip/hip_runtime.h>
#include <hip/hip_cooperative_groups.h>
#include <cstdio>
#include <cstdint>
namespace cg = cooperative_groups;

#define LAS __attribute__((address_space(3)))
typedef unsigned short bf16_t;
typedef short bf16x8 __attribute__((ext_vector_type(8)));
typedef float f32x4 __attribute__((ext_vector_type(4)));
typedef unsigned u32x4 __attribute__((ext_vector_type(4)));
typedef unsigned u32x2 __attribute__((ext_vector_type(2)));

constexpr int DM = 1024, NB = 8, SEQ = 4096, DEPTH = 4, NTOK = NB * SEQ;
constexpr int DIN = 3624, DINP = 3840, DFF = 4096;
constexpr int OFF_HQ = 0, OFF_HF = 512, OFF_HI = 1024, OFF_HG = 1536, OFF_SQ = 2048, OFF_SK = 2304, OFF_SV = 2560, OFF_IQ = 2816, OFF_IK = 3072, OFF_IW = 3104, OFF_CU = 3112;
constexpr int TOPK = 256;
constexpr float EPS = 1e-6f;
constexpr int NTHREADS = 512;
constexpr int LDS_BYTES = 131072 + 64;

constexpr size_t WS_WIN = 0;
constexpr size_t WS_WOUT = WS_WIN + (size_t)DEPTH * DINP * DM * 2;
constexpr size_t WS_W1 = WS_WOUT + (size_t)DEPTH * DM * DM * 2;
constexpr size_t WS_W2 = WS_W1 + (size_t)DEPTH * DFF * DM * 2;
constexpr size_t WS_MOD = WS_W2 + (size_t)DEPTH * DM * DFF * 2;
constexpr size_t WS_LB = WS_MOD + (size_t)DEPTH * NB * 6 * DM * 4;
constexpr size_t WS_BIG = WS_LB + (size_t)DEPTH * 512 * 4;
constexpr size_t WS_MASK = WS_BIG + (size_t)NTOK * DINP * 2;
static_assert((size_t)NTOK * DINP * 2 + (size_t)NTOK * 128 * 4 <= (size_t)NTOK * DFF * 2, "mask overlay");
constexpr size_t WS_HB = WS_BIG + (size_t)NTOK * DFF * 2;
constexpr size_t WS_ST = WS_HB + (size_t)NTOK * DM * 2;
constexpr size_t WS_DEC = WS_ST + (size_t)32 * 64 * 16384 * 2;
constexpr size_t WS_VT = WS_DEC + (size_t)32 * 64 * 128 * 4;
constexpr size_t WS_THRT = WS_VT + (size_t)NB * 4 * 64 * SEQ * 2;
constexpr size_t WS_THRC = WS_THRT + (size_t)NTOK * 4;
constexpr size_t WS_BAR = WS_THRC + (size_t)NTOK * 4;
constexpr size_t WS_END = WS_BAR + 16384;
static_assert(WS_END <= (size_t)512 * 1024 * 1024, "workspace map exceeds 512 MiB");

struct Params {
    const float* x; const float* c; const float* ada_w; const float* ada_b; const float* norm_mix_w; const float* norm_mlp_w;
    const float* w_in; const float* lb_logits; const float* onorm_w; const float* cv_w; const float* cv_b; const float* cv_ln_w; const float* cv_ln_b;
    const float* w_out; const float* w1; const float* w2; const float* final_w;
    float* out; unsigned char* ws;
    int ph_lo, ph_hi;
};

typedef float f32x2_t __attribute__((ext_vector_type(2)));
typedef __bf16 bf16x2_t __attribute__((ext_vector_type(2)));
__device__ __forceinline__ unsigned cvt_pk_bf16(float lo, float hi) { const f32x2_t v = {lo, hi}; return __builtin_bit_cast(unsigned, __builtin_convertvector(v, bf16x2_t)); }
__device__ __forceinline__ float bf2f(short h) { return __uint_as_float(((unsigned)(unsigned short)h) << 16); }
__device__ __forceinline__ float bflo(unsigned w) { return __uint_as_float(w << 16); }
__device__ __forceinline__ float bfhi(unsigned w) { return __uint_as_float(w & 0xffff0000u); }
__device__ __forceinline__ bf16_t f2bf(float f) { return (bf16_t)(cvt_pk_bf16(f, 0.f) & 0xffffu); }
__device__ __forceinline__ float wave_sum(float v) {
    v += __shfl_xor(v, 32); v += __shfl_xor(v, 16); v += __shfl_xor(v, 8); v += __shfl_xor(v, 4); v += __shfl_xor(v, 2); v += __shfl_xor(v, 1); return v;
}
__device__ __forceinline__ float xrow16_max(float x) {
    auto s = __builtin_amdgcn_permlane16_swap(__float_as_uint(x), __float_as_uint(x), false, false);
    x = fmaxf(__uint_as_float(s[0]), __uint_as_float(s[1]));
    auto t = __builtin_amdgcn_permlane32_swap(__float_as_uint(x), __float_as_uint(x), false, false);
    return fmaxf(__uint_as_float(t[0]), __uint_as_float(t[1]));
}
__device__ __forceinline__ float xrow16_sum(float x) {
    auto s = __builtin_amdgcn_permlane16_swap(__float_as_uint(x), __float_as_uint(x), false, false);
    x = __uint_as_float(s[0]) + __uint_as_float(s[1]);
    auto t = __builtin_amdgcn_permlane32_swap(__float_as_uint(x), __float_as_uint(x), false, false);
    return __uint_as_float(t[0]) + __uint_as_float(t[1]);
}
__device__ __forceinline__ float sigmoidf_(float x) { return __builtin_amdgcn_rcpf(1.f + __expf(-x)); }
__device__ __forceinline__ float siluf_(float x) { return x * __builtin_amdgcn_rcpf(1.f + __expf(-x)); }
__device__ __forceinline__ unsigned sortable(float f) { unsigned b = __float_as_uint(f); return b ^ ((b & 0x80000000u) ? 0xffffffffu : 0x80000000u); }
__device__ __forceinline__ f32x4 mfma16(bf16x8 a, bf16x8 b, f32x4 c) { return __builtin_amdgcn_mfma_f32_16x16x32_bf16(a, b, c, 0, 0, 0); }

namespace pg8 {
#define PG8_LAS __attribute__((address_space(3)))
constexpr int BM = 256, BK = 64, HALF = 128, HTB = HALF * BK * 2, STAGE_BYTES = 8 * HTB, NXCD = 8, WGM = 8;
__host__ __device__ __forceinline__ int lds_byte(int r, int c) { const int st = (r >> 4) * 2 + (c >> 5), rr = r & 15, cc = c & 31, ob = rr * 64 + cc * 2; return st * 1024 + (ob ^ (((ob >> 9) & 1) << 5)); }
__host__ __device__ __forceinline__ void stage_rc(int b, int& R, int& C) { const int st = b / 1024, sb = b % 1024, swz = sb ^ (((sb >> 9) & 1) << 5); R = (st >> 1) * 16 + swz / 64; C = (st & 1) * 32 + (swz % 64) / 2; }
__host__ __device__ __forceinline__ int perm32(int rho) { const int n = rho >> 4, i = rho & 15; return 8 * (i >> 2) + 4 * n + (i & 3); }
struct Unit { int pm, pn; };
struct Gemm { const bf16_t* A; const bf16_t* Bt; int M, N, K; };
struct StaticOrder {
    int nM, nN, nwg, G, c;
    __host__ __device__ void init(int M, int N, int G_, int c_) { nM = M / BM; nN = N / BM; nwg = nM * nN; G = G_; c = c_; }
    __host__ __device__ bool next(int i, Unit& u) const {
        const long L = (long)i * G + c; if (L >= nwg) return false;
        int wgid = (int)L; { const int q = nwg / NXCD, r = nwg % NXCD, xcd = wgid % NXCD, off = wgid / NXCD; wgid = (xcd < r ? xcd * (q + 1) : r * (q + 1) + (xcd - r) * q) + off; }
        const int nig = WGM * nN, gid = wgid / nig, fm = gid * WGM, gsz = (nM - fm) < WGM ? (nM - fm) : WGM;
        u.pm = fm + ((wgid % nig) % gsz); u.pn = (wgid % nig) / gsz; return true;
    }
    __device__ __forceinline__ void a_ready(const Unit&) const {}
    __device__ __forceinline__ void done(const Unit&) const {}
};

template <int ACT  > struct EpiBf16 {
    static constexpr bool PERM = true, AFTER_DRAIN = false;
    bf16_t* O; int ldc;
    __device__ __forceinline__ void operator()(const f32x4 (&acc)[2][2][4][2], const Unit& u, int wr, int wc, int fr, int fq) const {
        const int row0 = u.pm * BM + wr * 64 + fr, col0 = u.pn * BM + wc * 32 + 8 * fq;
#pragma unroll
        for (int ai = 0; ai < 2; ++ai)
#pragma unroll
            for (int m = 0; m < 4; ++m) { bf16_t* rowp = O + (size_t)(row0 + ai * HALF + m * 16) * ldc + col0;
#pragma unroll
                for (int bj = 0; bj < 2; ++bj) { f32x4 v0 = acc[ai][bj][m][0], v1 = acc[ai][bj][m][1];
                    if (ACT == 1) {
#pragma unroll
                        for (int j = 0; j < 4; ++j) { const float a = fmaxf(v0[j], 0.f), b = fmaxf(v1[j], 0.f); v0[j] = a * a; v1[j] = b * b; } }
                    u32x4 w; w.x = cvt_pk_bf16(v0[0], v0[1]); w.y = cvt_pk_bf16(v0[2], v0[3]); w.z = cvt_pk_bf16(v1[0], v1[1]); w.w = cvt_pk_bf16(v1[2], v1[3]);
                    __builtin_nontemporal_store(w, (u32x4*)(rowp + bj * HALF)); } }
    }
};
struct EpiResid {
    static constexpr bool PERM = true, AFTER_DRAIN = false;
    const float* xs; float* xd; const float* gate;
    __device__ __forceinline__ void operator()(const f32x4 (&acc)[2][2][4][2], const Unit& u, int wr, int wc, int fr, int fq) const {
        const int row0 = u.pm * BM + wr * 64 + fr, col0 = u.pn * BM + wc * 32 + 8 * fq;
        const float* gp = gate + (size_t)((u.pm * BM) >> 12) * 6144 + col0;
        f32x4 gv[2][2];
#pragma unroll
        for (int bj = 0; bj < 2; ++bj)
#pragma unroll
            for (int n = 0; n < 2; ++n) gv[bj][n] = *(const f32x4*)(gp + bj * HALF + 4 * n);
#pragma unroll
        for (int ai = 0; ai < 2; ++ai)
#pragma unroll
            for (int m = 0; m < 4; ++m) { const size_t off = (size_t)(row0 + ai * HALF + m * 16) * DM + col0;
#pragma unroll
                for (int bj = 0; bj < 2; ++bj)
#pragma unroll
                    for (int n = 0; n < 2; ++n) { const f32x4 xv = *(const f32x4*)(xs + off + bj * HALF + 4 * n);
                        *(f32x4*)(xd + off + bj * HALF + 4 * n) = xv + gv[bj][n] * acc[ai][bj][m][n]; } }
    }
};
template <class Epi, class Sched, bool ALIGN_EPI = false, bool SP2 = false>
__device__ __forceinline__ void gemm_phase(PG8_LAS unsigned char* lds, const Gemm g, const Sched& S, const Epi& E) {
    int tid_ = threadIdx.x; asm volatile("" : "+v"(tid_)); const int tid = tid_, wid = __builtin_amdgcn_readfirstlane(tid >> 6), lane = tid & 63, wr = wid >> 2, wc = wid & 3, fr = lane & 15, fq = lane >> 4;
    const int K = g.K, nt = K / BK;
    unsigned voffA[2], voffB[2];
#pragma unroll
    for (int i = 0; i < 2; ++i) { int R, C; stage_rc(tid * 16 + i * 8192, R, C); const int Rb = Epi::PERM ? ((R & ~31) + perm32(R & 31)) : R;
        voffA[i] = (unsigned)(R * K + C) * 2u; voffB[i] = (unsigned)(Rb * K + C) * 2u; }
    const size_t kstep = (size_t)(BK * 2);
    const size_t hstep = (size_t)HALF * K * 2;
    const size_t tstep = 2 * hstep;
    const unsigned ldsw = (unsigned)wid * 1024u;
    const int aoff = lds_byte(wr * 64 + fr, fq * 8), boff = lds_byte(wc * 32 + fr, fq * 8);
#define PG8_SA(b, h) (((b) * 2 + (h)) * HTB)
#define PG8_SB(b, h) ((4 + (b) * 2 + (h)) * HTB)
#define PG8_STAGE(bufoff, gbase, voff) do { _Pragma("unroll") for (int _i = 0; _i < 2; ++_i) \
        __builtin_amdgcn_global_load_lds((const unsigned*)((const char*)(gbase) + (voff)[_i]), (PG8_LAS unsigned*)(lds + (bufoff) + ldsw + _i * 8192), 16, 0, 0); } while (0)
#define PG8_LDA(dst, b, h) do { _Pragma("unroll") for (int m = 0; m < 4; ++m) _Pragma("unroll") for (int k = 0; k < 2; ++k) dst[m][k] = *(const PG8_LAS bf16x8*)(lds + PG8_SA(b, h) + aoff + m * 2048 + k * 1024); } while (0)
#define PG8_LDB(dst, b, h) do { _Pragma("unroll") for (int n = 0; n < 2; ++n) _Pragma("unroll") for (int k = 0; k < 2; ++k) dst[n][k] = *(const PG8_LAS bf16x8*)(lds + PG8_SB(b, h) + boff + n * 2048 + k * 1024); } while (0)
#define PG8_MMA(ai, bj, At, Bt) do { __builtin_amdgcn_s_setprio(1); _Pragma("unroll") for (int m = 0; m < 4; ++m) _Pragma("unroll") for (int n = 0; n < 2; ++n) _Pragma("unroll") for (int k = 0; k < 2; ++k) \
        acc[ai][bj][m][n] = __builtin_amdgcn_mfma_f32_16x16x32_bf16(Bt[n][k], At[m][k], acc[ai][bj][m][n], 0, 0, 0); __builtin_amdgcn_s_setprio(0); } while (0)
#define PG8_WAIT_V(n) asm volatile("s_waitcnt vmcnt(" #n ")" ::: "memory")
#define PG8_WAIT_L(n) asm volatile("s_waitcnt lgkmcnt(" #n ")" ::: "memory")
#define PG8_BAR __builtin_amdgcn_s_barrier()
#define PG8_SCHED __builtin_amdgcn_sched_barrier(0)
    Unit cur, nxt; int ui = 0;
    if (!S.next(0, cur)) return;
    f32x4 acc[2][2][4][2];
#pragma unroll
    for (int a = 0; a < 2; ++a)
#pragma unroll
        for (int b = 0; b < 2; ++b)
#pragma unroll
            for (int m = 0; m < 4; ++m)
#pragma unroll
                for (int n = 0; n < 2; ++n) acc[a][b][m][n] = (f32x4){0.f, 0.f, 0.f, 0.f};
    bf16x8 At[4][2], B0[2][2], B1[2][2];
    const char* cA = (const char*)g.A + (size_t)cur.pm * tstep; const char* cB = (const char*)g.Bt + (size_t)cur.pn * tstep;
    S.a_ready(cur);
    if constexpr (SP2) {
        PG8_STAGE(PG8_SB(0, 0), cB, voffB); PG8_STAGE(PG8_SB(0, 1), cB + hstep, voffB); PG8_STAGE(PG8_SA(0, 0), cA, voffA); PG8_STAGE(PG8_SA(0, 1), cA + hstep, voffA);
        if (wr == 1) PG8_BAR;
        PG8_WAIT_V(2); PG8_BAR;
        PG8_STAGE(PG8_SB(1, 0), cB + kstep, voffB); PG8_STAGE(PG8_SA(1, 0), cA + kstep, voffA); PG8_STAGE(PG8_SB(1, 1), cB + hstep + kstep, voffB);
        PG8_WAIT_V(6); PG8_BAR;
    } else {
        PG8_STAGE(PG8_SB(0, 0), cB, voffB); PG8_STAGE(PG8_SA(0, 0), cA, voffA); PG8_STAGE(PG8_SB(0, 1), cB + hstep, voffB); PG8_STAGE(PG8_SA(0, 1), cA + hstep, voffA);
        if (wr == 1) PG8_BAR;
        PG8_WAIT_V(4); PG8_BAR;
        PG8_STAGE(PG8_SB(1, 0), cB + kstep, voffB); PG8_STAGE(PG8_SA(1, 0), cA + kstep, voffA); PG8_STAGE(PG8_SB(1, 1), cB + hstep + kstep, voffB);
        PG8_WAIT_V(6); PG8_BAR;
    }
    for (;;) {
        const bool has_next = S.next(ui + 1, nxt);
        const char* nA = has_next ? (const char*)g.A + (size_t)nxt.pm * tstep : cA; const char* nB = has_next ? (const char*)g.Bt + (size_t)nxt.pn * tstep : cB;
        for (int t = 0; t < nt; t += 2) {
            const bool last = (t == nt - 2);
            const char* a1 = cA + (size_t)(t + 1) * kstep;
            const char* a2 = last ? nA : cA + (size_t)(t + 2) * kstep; const char* b2 = last ? nB : cB + (size_t)(t + 2) * kstep;
            const char* a3 = a2 + kstep; const char* b3 = b2 + kstep;
            if (last && has_next) S.a_ready(nxt);
            if constexpr (SP2) {
            PG8_LDB(B0, 0, 0); PG8_LDB(B1, 0, 1); PG8_SCHED; PG8_LDA(At, 0, 0); PG8_STAGE(PG8_SA(1, 1), a1 + hstep, voffA);
            PG8_WAIT_V(8); PG8_WAIT_L(0); PG8_BAR; PG8_MMA(0, 0, At, B0); PG8_MMA(0, 1, At, B1); PG8_BAR; PG8_SCHED;
            PG8_LDA(At, 0, 1); PG8_STAGE(PG8_SB(0, 0), b2, voffB); PG8_STAGE(PG8_SB(0, 1), b2 + hstep, voffB); PG8_STAGE(PG8_SA(0, 0), a2, voffA);
            PG8_WAIT_V(8); PG8_WAIT_L(0); PG8_BAR; PG8_MMA(1, 0, At, B0); PG8_MMA(1, 1, At, B1); PG8_BAR; PG8_SCHED;
            PG8_LDB(B0, 1, 0); PG8_LDB(B1, 1, 1); PG8_SCHED; PG8_LDA(At, 1, 0); PG8_STAGE(PG8_SA(0, 1), a2 + hstep, voffA);
            PG8_WAIT_V(8); PG8_WAIT_L(0); PG8_BAR; PG8_MMA(0, 0, At, B0); PG8_MMA(0, 1, At, B1); PG8_BAR; PG8_SCHED;
            PG8_LDA(At, 1, 1); PG8_STAGE(PG8_SB(1, 0), b3, voffB); PG8_STAGE(PG8_SB(1, 1), b3 + hstep, voffB); PG8_STAGE(PG8_SA(1, 0), a3, voffA);
            PG8_WAIT_V(8); PG8_WAIT_L(0); PG8_BAR; PG8_MMA(1, 0, At, B0); PG8_MMA(1, 1, At, B1); PG8_BAR; PG8_SCHED;
            } else {
            PG8_LDB(B0, 0, 0); PG8_SCHED; PG8_LDA(At, 0, 0); PG8_STAGE(PG8_SA(1, 1), a1 + hstep, voffA);
            PG8_WAIT_L(8); PG8_BAR; PG8_WAIT_L(0); PG8_MMA(0, 0, At, B0); PG8_BAR; PG8_SCHED;
            PG8_LDB(B1, 0, 1); PG8_STAGE(PG8_SB(0, 0), b2, voffB);
            PG8_BAR; PG8_WAIT_L(0); PG8_MMA(0, 1, At, B1); PG8_BAR;
            PG8_LDA(At, 0, 1); PG8_STAGE(PG8_SA(0, 0), a2, voffA);
            PG8_BAR; PG8_WAIT_L(0); PG8_MMA(1, 0, At, B0); PG8_BAR; PG8_SCHED;
            PG8_STAGE(PG8_SB(0, 1), b2 + hstep, voffB);
            PG8_WAIT_V(6); PG8_BAR; PG8_MMA(1, 1, At, B1); PG8_BAR;
            PG8_LDB(B0, 1, 0); PG8_SCHED; PG8_LDA(At, 1, 0); PG8_STAGE(PG8_SA(0, 1), a2 + hstep, voffA);
            PG8_WAIT_L(8); PG8_BAR; PG8_WAIT_L(0); PG8_MMA(0, 0, At, B0); PG8_BAR; PG8_SCHED;
            PG8_LDB(B1, 1, 1); PG8_STAGE(PG8_SB(1, 0), b3, voffB);
            PG8_BAR; PG8_WAIT_L(0); PG8_MMA(0, 1, At, B1); PG8_BAR;
            PG8_LDA(At, 1, 1); PG8_STAGE(PG8_SA(1, 0), a3, voffA);
            PG8_BAR; PG8_WAIT_L(0); PG8_MMA(1, 0, At, B0); PG8_BAR; PG8_SCHED;
            PG8_STAGE(PG8_SB(1, 1), b3 + hstep, voffB);
            PG8_WAIT_V(6); PG8_BAR; PG8_MMA(1, 1, At, B1); PG8_BAR;
            }
        }
        if constexpr (ALIGN_EPI) { if (wr == 0) PG8_BAR; }
        if constexpr (!Epi::AFTER_DRAIN) { E(acc, cur, wr, wc, fr, fq); S.done(cur); }
        if (!has_next) break;
#pragma unroll
        for (int a = 0; a < 2; ++a)
#pragma unroll
            for (int b = 0; b < 2; ++b)
#pragma unroll
                for (int m = 0; m < 4; ++m)
#pragma unroll
                    for (int n = 0; n < 2; ++n) acc[a][b][m][n] = (f32x4){0.f, 0.f, 0.f, 0.f};
        cur = nxt; cA = nA; cB = nB; ++ui;
        if constexpr (ALIGN_EPI) { if (wr == 1) PG8_BAR; }
    }
    PG8_WAIT_V(0);
    if constexpr (!ALIGN_EPI) { if (wr == 0) PG8_BAR; }
    PG8_BAR;
    if constexpr (Epi::AFTER_DRAIN) { E.fused(acc, cur, wr, wc, fr, fq, lds, wid, lane); S.done(cur); }
#undef PG8_SA
#undef PG8_SB
#undef PG8_STAGE
#undef PG8_LDA
#undef PG8_LDB
#undef PG8_MMA
#undef PG8_WAIT_V
#undef PG8_WAIT_L
#undef PG8_BAR
#undef PG8_SCHED
}
}

#ifndef REP_THR
#define REP_THR 1
#endif
#ifndef REP_NORM
#define REP_NORM 1
#endif
#ifndef REP_PRO
#define REP_PRO 1
#endif
#ifndef REP_ATTN
#define REP_ATTN 1
#endif
#ifndef REP_S2
#define REP_S2 1
#endif
#ifndef REP_GEMM
#define REP_GEMM 1
#endif
#ifndef REP_HO
#define REP_HO 1
#endif
__device__ __forceinline__ int ltid() { int t = threadIdx.x; asm volatile("" : "+v"(t)); return t; }
#define TID ltid()

__device__ __forceinline__ void cvt_kind(const float* __restrict__ src, bf16_t* __restrict__ dst, int K, int N, int Npad, LAS float* tl) {
    const int tid = TID, nk = K / 64, nn = Npad / 64, per = nk * nn, total = DEPTH * per;
    for (int t = blockIdx.x; t < total; t += gridDim.x) {
        const int l = t / per, r = t % per, kt = r / nn, nt = r % nn;
        const float* s = src + (size_t)l * K * N; bf16_t* d = dst + (size_t)l * Npad * K;
#pragma unroll
        for (int i = 0; i < 2; ++i) { const int kr = (tid >> 4) + 32 * i, nc = (tid & 15) * 4, n = nt * 64 + nc;
            f32x4 v = (f32x4){0.f, 0.f, 0.f, 0.f};
            if (n < N) v = *(const f32x4*)(s + (size_t)(kt * 64 + kr) * N + n);
            tl[kr * 65 + nc + 0] = v[0]; tl[kr * 65 + nc + 1] = v[1]; tl[kr * 65 + nc + 2] = v[2]; tl[kr * 65 + nc + 3] = v[3]; }
        __syncthreads();
        { const int n = tid >> 3, k8 = (tid & 7) * 8; u32x4 w;
            w.x = cvt_pk_bf16(tl[(k8 + 0) * 65 + n], tl[(k8 + 1) * 65 + n]); w.y = cvt_pk_bf16(tl[(k8 + 2) * 65 + n], tl[(k8 + 3) * 65 + n]);
            w.z = cvt_pk_bf16(tl[(k8 + 4) * 65 + n], tl[(k8 + 5) * 65 + n]); w.w = cvt_pk_bf16(tl[(k8 + 6) * 65 + n], tl[(k8 + 7) * 65 + n]);
            *(u32x4*)(d + (size_t)(nt * 64 + n) * K + kt * 64 + k8) = w; }
        __syncthreads();
    }
}

__device__ __forceinline__ void mod_phase(const Params& p, LAS float* sm) {
    const int tid = TID;
    LAS float* cact = sm; LAS float* red = sm + 8192;
    for (int i = tid; i < NB * DM; i += NTHREADS) cact[i] = siluf_(p.c[i]);
    __syncthreads();
    float* MOD = (float*)(p.ws + WS_MOD);
    for (int it = blockIdx.x; it < DEPTH * 96; it += gridDim.x) {
        const int l = it / 96, j0 = (it % 96) * 64, col = tid & 63, seg = tid >> 6;
        const float* w = p.ada_w + (size_t)l * DM * 6144 + j0 + col;
        float a0 = 0.f, a1 = 0.f, a2 = 0.f, a3 = 0.f, a4 = 0.f, a5 = 0.f, a6 = 0.f, a7 = 0.f;
#pragma unroll 8
        for (int k = seg * 128; k < seg * 128 + 128; ++k) { const float wv = w[(size_t)k * 6144];
            a0 += cact[0 * DM + k] * wv; a1 += cact[1 * DM + k] * wv; a2 += cact[2 * DM + k] * wv; a3 += cact[3 * DM + k] * wv;
            a4 += cact[4 * DM + k] * wv; a5 += cact[5 * DM + k] * wv; a6 += cact[6 * DM + k] * wv; a7 += cact[7 * DM + k] * wv; }
        red[(seg * 8 + 0) * 64 + col] = a0; red[(seg * 8 + 1) * 64 + col] = a1; red[(seg * 8 + 2) * 64 + col] = a2; red[(seg * 8 + 3) * 64 + col] = a3;
        red[(seg * 8 + 4) * 64 + col] = a4; red[(seg * 8 + 5) * 64 + col] = a5; red[(seg * 8 + 6) * 64 + col] = a6; red[(seg * 8 + 7) * 64 + col] = a7;
        __syncthreads();
        { const int b = tid >> 6; float s = p.ada_b[l * 6144 + j0 + col];
#pragma unroll
            for (int sg = 0; sg < 8; ++sg) s += red[(sg * 8 + b) * 64 + col];
            MOD[(size_t)(l * NB + b) * 6144 + j0 + col] = s; }
        __syncthreads();
    }
}

__device__ __forceinline__ void lb_phase(const Params& p) {
    if (blockIdx.x != 0) return;
    const int k = TID; float* LB = (float*)(p.ws + WS_LB);
    const float v0 = p.lb_logits[k], v1 = p.lb_logits[512 + k], v2 = p.lb_logits[1024 + k], v3 = p.lb_logits[1536 + k];
    const float mx = fmaxf(fmaxf(v0, v1), fmaxf(v2, v3));
    const float e0 = expf(v0 - mx), e1 = expf(v1 - mx), e2 = expf(v2 - mx), e3 = expf(v3 - mx), inv = 1.f / (e0 + e1 + e2 + e3);
    const float p0 = e0 * inv, p1 = e1 * inv, p2 = e2 * inv, p3 = e3 * inv;
    LB[k] = p0 - p0; LB[512 + k] = (p0 + p1) - p0; LB[1024 + k] = ((p0 + p1) + p2) - p0; LB[1536 + k] = (((p0 + p1) + p2) + p3) - p0;
}

__device__ __forceinline__ void rmsnorm_mod(const float* __restrict__ xs, const float* __restrict__ w, const float* __restrict__ mod, int sh_off, int sc_off, bf16_t* __restrict__ dst) {
    const int tid = TID, wave = tid >> 6, lane = tid & 63;
    const int row0 = blockIdx.x * 8 + wave, rstep = gridDim.x * 8;
    f32x4 v[4], nv[4];
    if (row0 < NTOK) {
#pragma unroll
        for (int i = 0; i < 4; ++i) nv[i] = *(const f32x4*)(xs + (size_t)row0 * DM + i * 256 + lane * 4); }
    for (int row = row0; row < NTOK; row += rstep) {
        float ss = 0.f;
#pragma unroll
        for (int i = 0; i < 4; ++i) { v[i] = nv[i]; ss += v[i][0] * v[i][0] + v[i][1] * v[i][1] + v[i][2] * v[i][2] + v[i][3] * v[i][3]; }
        if (row + rstep < NTOK) {
#pragma unroll
            for (int i = 0; i < 4; ++i) nv[i] = *(const f32x4*)(xs + (size_t)(row + rstep) * DM + i * 256 + lane * 4); }
        ss = wave_sum(ss);
        const float rstd = rsqrtf(ss * (1.f / DM) + EPS);
        const float* mb = mod + (size_t)(row >> 12) * 6144;
#pragma unroll
        for (int i = 0; i < 4; ++i) { const int col = i * 256 + lane * 4;
            const f32x4 ww = *(const f32x4*)(w + col), sc = *(const f32x4*)(mb + sc_off + col), sh = *(const f32x4*)(mb + sh_off + col);
            const f32x4 h = (v[i] * rstd * ww) * (sc + 1.f) + sh;
            u32x2 o; o.x = cvt_pk_bf16(h[0], h[1]); o.y = cvt_pk_bf16(h[2], h[3]);
            *(u32x2*)(dst + (size_t)row * DM + col) = o; }
    }
}
__device__ __forceinline__ void final_norm(float* __restrict__ x, const float* __restrict__ w) {
    const int tid = TID, wave = tid >> 6, lane = tid & 63;
    for (int row = blockIdx.x * 8 + wave; row < NTOK; row += gridDim.x * 8) {
        float* xr = x + (size_t)row * DM; f32x4 v[4]; float ss = 0.f;
#pragma unroll
        for (int i = 0; i < 4; ++i) { v[i] = *(const f32x4*)(xr + i * 256 + lane * 4); ss += v[i][0] * v[i][0] + v[i][1] * v[i][1] + v[i][2] * v[i][2] + v[i][3] * v[i][3]; }
        ss = wave_sum(ss);
        const float rstd = rsqrtf(ss * (1.f / DM) + EPS);
#pragma unroll
        for (int i = 0; i < 4; ++i) { const int col = i * 256 + lane * 4; const f32x4 ww = *(const f32x4*)(w + col); *(f32x4*)(xr + col) = v[i] * rstd * ww; }
    }
}

__device__ __forceinline__ void vt_item(const Params& p, int b, int tt, LAS unsigned char* sm) {
    const int tid = TID; LAS bf16_t* vb = (LAS bf16_t*)sm;
    const bf16_t* proj = (const bf16_t*)(p.ws + WS_BIG) + (size_t)(b * SEQ + tt * 64) * DINP + OFF_SV;
#pragma unroll
    for (int i = 0; i < 4; ++i) { const int idx = tid + NTHREADS * i, row = idx >> 5, c8 = (idx & 31) * 8;
        *(LAS bf16x8*)(vb + row * 264 + c8) = *(const bf16x8*)(proj + (size_t)row * DINP + c8); }
    __syncthreads();
    { const int col = tid >> 1, half = tid & 1;
        bf16_t* dst = (bf16_t*)(p.ws + WS_VT) + ((size_t)(b * 4 + (col >> 6)) * 64 + (col & 63)) * SEQ + tt * 64 + half * 32;
#pragma unroll
        for (int i = 0; i < 4; ++i) { bf16x8 o;
#pragma unroll
            for (int e = 0; e < 8; ++e) o[e] = (short)vb[(half * 32 + i * 8 + e) * 264 + col];
            *(bf16x8*)(dst + i * 8) = o; } }
    __syncthreads();
}

__device__ __forceinline__ void conv_item(const Params& p, int l, int b, int tt, LAS unsigned char* sm) {
    const int tid = TID; LAS float* hb = (LAS float*)sm;
    LAS float* ob = (LAS float*)(sm + 62 * 256 * 4);
    const int t0 = tt * 32;
    const bf16_t* proj = (const bf16_t*)(p.ws + WS_BIG) + (size_t)b * SEQ * DINP + OFF_CU;
#pragma unroll
    for (int i = 0; i < 4; ++i) { const int idx = tid + NTHREADS * i;
        if (idx < 62 * 32) { const int row = idx >> 5, c8 = (idx & 31) * 8, t = t0 - 30 + row;
            f32x4 h0 = (f32x4){0.f, 0.f, 0.f, 0.f}, h1 = h0;
            if (t >= 0) { const bf16x8 a = *(const bf16x8*)(proj + (size_t)t * DINP + c8), g = *(const bf16x8*)(proj + (size_t)t * DINP + 256 + c8);
#pragma unroll
                for (int j = 0; j < 4; ++j) { h0[j] = bf2f(a[j]) * sigmoidf_(bf2f(g[j])); h1[j] = bf2f(a[4 + j]) * sigmoidf_(bf2f(g[4 + j])); } }
            *(LAS f32x4*)(hb + row * 256 + c8) = h0; *(LAS f32x4*)(hb + row * 256 + c8 + 4) = h1; } }
    __syncthreads();
    { const int ch = tid & 255, half = tid >> 8;
        float w[31];
#pragma unroll
        for (int j = 0; j < 31; ++j) w[j] = p.cv_w[(size_t)(l * 31 + j) * 256 + ch];
        const float bias = p.cv_b[l * 256 + ch];
        float o[16];
#pragma unroll
        for (int i = 0; i < 16; ++i) o[i] = bias;
#pragma unroll
        for (int r = 0; r < 46; ++r) { const float hv = hb[(half * 16 + r) * 256 + ch];
#pragma unroll
            for (int i = 0; i < 16; ++i) { const int j = r - i; if (j >= 0 && j <= 30) o[i] = fmaf(hv, w[j], o[i]); } }
#pragma unroll
        for (int i = 0; i < 16; ++i) ob[(half * 16 + i) * 256 + ch] = o[i]; }
    __syncthreads();
    { const int wave = tid >> 6, lane = tid & 63;
        const f32x4 lw = *(const f32x4*)(p.cv_ln_w + l * 256 + lane * 4), lbv = *(const f32x4*)(p.cv_ln_b + l * 256 + lane * 4);
        bf16_t* mix = (bf16_t*)(p.ws + WS_HB);
#pragma unroll
        for (int i = 0; i < 4; ++i) { const int tl = wave * 4 + i;
            const f32x4 xv = *(LAS f32x4*)(ob + tl * 256 + lane * 4);
            const float mu = wave_sum(xv[0] + xv[1] + xv[2] + xv[3]) * (1.f / 256.f);
            const f32x4 dv = xv - mu;
            const float var = wave_sum(dv[0] * dv[0] + dv[1] * dv[1] + dv[2] * dv[2] + dv[3] * dv[3]) * (1.f / 256.f);
            const float rs = rsqrtf(var + EPS);
            const f32x4 y = dv * rs * lw + lbv;
            u32x2 o2; o2.x = cvt_pk_bf16(siluf_(y[0]), siluf_(y[1])); o2.y = cvt_pk_bf16(siluf_(y[2]), siluf_(y[3]));
            *(u32x2*)(mix + (size_t)(b * SEQ + t0 + tl) * DM + 768 + lane * 4) = o2; } }
    __syncthreads();
}

constexpr float IDX_WSCALE = 0.35355339059327373f * 0.17677669529663687f;
__device__ __forceinline__ f32x4 idx_scores(const bf16x8 ka, const bf16x8 (&qi)[8], const float (&wq)[8]) {
    f32x4 s = (f32x4){0.f, 0.f, 0.f, 0.f};
#pragma unroll
    for (int h = 0; h < 8; ++h) { const f32x4 d = mfma16(ka, qi[h], (f32x4){0.f, 0.f, 0.f, 0.f});
#pragma unroll
        for (int r = 0; r < 4; ++r) s[r] = __builtin_fmaf(wq[h], fmaxf(d[r], 0.f), s[r]); }
    return s;
}

__device__ __forceinline__ void cnt_ge(int& cn, unsigned a, unsigned b) { asm("v_cmp_ge_u32 vcc, %1, %2\n\tv_addc_co_u32 %0, vcc, 0, %0, vcc" : "+v"(cn) : "v"(a), "v"(b) : "vcc"); }
__device__ __forceinline__ void cnt_ge16(int& cn, const unsigned (&A)[4], const unsigned (&B)[4], const unsigned (&C)[4], const unsigned (&D)[4], unsigned b) {
#define CG_(n) "v_cmp_ge_u32 vcc, %" #n ", %17\n\tv_addc_co_u32 %0, vcc, 0, %0, vcc\n\t"
    asm(CG_(1) CG_(2) CG_(3) CG_(4) CG_(5) CG_(6) CG_(7) CG_(8) CG_(9) CG_(10) CG_(11) CG_(12) CG_(13) CG_(14) CG_(15) CG_(16)
        : "+v"(cn) : "v"(A[0]), "v"(A[1]), "v"(A[2]), "v"(A[3]), "v"(B[0]), "v"(B[1]), "v"(B[2]), "v"(B[3]), "v"(C[0]), "v"(C[1]), "v"(C[2]), "v"(C[3]), "v"(D[0]), "v"(D[1]), "v"(D[2]), "v"(D[3]), "v"(b) : "vcc");
#undef CG_
}
constexpr int TH_ROW = 40, TH_BUF = 1024 * TH_ROW * 2, TH_CNT = TH_BUF;
__device__ __forceinline__ void thr_item(const Params& p, int b, int qt, LAS unsigned char* sm) {
    const int tid = TID, w = __builtin_amdgcn_readfirstlane(tid >> 6), l = tid & 63, c16 = l & 15, g = l >> 4;
    LAS unsigned* cnt = (LAS unsigned*)(sm + TH_CNT);
    const bf16_t* proj = (const bf16_t*)(p.ws + WS_BIG) + (size_t)b * SEQ * DINP;
    const int q = qt * 16 + c16;
    const bf16_t* qrow = proj + (size_t)q * DINP;
    bf16x8 qi[8]; float wq[8];
#pragma unroll
    for (int h = 0; h < 8; ++h) qi[h] = *(const bf16x8*)(qrow + OFF_IQ + h * 32 + g * 8);
    { const bf16x8 wv = *(const bf16x8*)(qrow + OFF_IW);
#pragma unroll
        for (int h = 0; h < 8; ++h) wq[h] = bf2f(wv[h]) * IDX_WSCALE; }
    unsigned sc[32][4];
    const int ni = (qt >= w) ? ((qt - w) >> 3) + 1 : 0;
    const int nchunk = (qt >> 6) + 1;
    const bf16_t* gsrc = proj + (size_t)(tid >> 2) * DINP + OFF_IK + (tid & 3) * 8;
    const int ldst = (tid >> 2) * TH_ROW + (tid & 3) * 8;
    bf16x8 stg[8];
#define TH_LOAD(ck_) do { const bf16_t* s_ = gsrc + (size_t)(ck_) * 1024 * DINP; _Pragma("unroll") for (int m_ = 0; m_ < 8; ++m_) stg[m_] = *(const bf16x8*)(s_ + (size_t)(128 * m_) * DINP); } while (0)
#define TH_STORE() do { LAS bf16_t* d_ = (LAS bf16_t*)sm + ldst; _Pragma("unroll") for (int m_ = 0; m_ < 8; ++m_) *(LAS bf16x8*)(d_ + 128 * m_ * TH_ROW) = stg[m_]; } while (0)
    TH_LOAD(0);
    for (int i = tid; i < 48 * 16; i += NTHREADS) cnt[i] = 0u;
#pragma unroll
    for (int ck = 0; ck < 4; ++ck) {
        if (ck < nchunk) {
            TH_STORE();
            __syncthreads();
            if (ck + 1 < nchunk) TH_LOAD(ck + 1);
            LAS bf16_t* B = (LAS bf16_t*)sm;
#pragma unroll
            for (int j = 0; j < 8; ++j) { const int i = ck * 8 + j, kt = w + 8 * i;
                if (kt <= qt) { const bf16x8 ka = *(LAS bf16x8*)(B + ((j * 8 + w) * 16 + c16) * TH_ROW + g * 8);
                    const f32x4 s = idx_scores(ka, qi, wq);
#pragma unroll
                    for (int r = 0; r < 4; ++r) { const int key = kt * 16 + 4 * g + r; sc[i][r] = (key <= q) ? sortable(s[r]) : 0u; }
                } else { sc[i][0] = 0u; sc[i][1] = 0u; sc[i][2] = 0u; sc[i][3] = 0u; } }
            if (ck + 1 < nchunk) __syncthreads();
        } else {
#pragma unroll
            for (int j = 0; j < 8; ++j) { sc[ck * 8 + j][0] = 0u; sc[ck * 8 + j][1] = 0u; sc[ck * 8 + j][2] = 0u; sc[ck * 8 + j][3] = 0u; }
        }
    }
#undef TH_LOAD
#undef TH_STORE
#define TH_XCHG(tot_) do { __hip_atomic_fetch_add(&cnt[it * 16 + c16], (unsigned)cn, __ATOMIC_RELAXED, __HIP_MEMORY_SCOPE_WORKGROUP); __syncthreads(); tot_ = (int)cnt[it * 16 + c16]; } while (0)
    unsigned T = 0u; bool done = false; int it = 0;
    for (; it < 32; ++it) {
        const unsigned cand = T | (1u << (31 - it)); int cn = 0;
#pragma unroll
        for (int gi = 0; gi < 4; ++gi) if (ni > 8 * gi) {
#pragma unroll
            for (int i = 8 * gi; i < 8 * gi + 8; i += 4) cnt_ge16(cn, sc[i], sc[i + 1], sc[i + 2], sc[i + 3], cand); }
        int tot; TH_XCHG(tot);
        if (!done) { if (tot >= TOPK) T = cand; if (tot == TOPK) done = true; }
        if (__all(done)) { ++it; break; }
    }
    unsigned ceq = 4095u; bool tied = false;
    const bool open = !done && (T != 0u);
    if (!__all(!open)) {
        int ngt = 0, nge = 0;
        for (int e = 0; e < 2; ++e, ++it) {
            const unsigned cand = (e == 0) ? T + 1u : T; int cn = 0;
#pragma unroll
            for (int gi = 0; gi < 4; ++gi) if (ni > 8 * gi) {
#pragma unroll
            for (int i = 8 * gi; i < 8 * gi + 8; ++i) { cnt_ge(cn, sc[i][0], cand); cnt_ge(cn, sc[i][1], cand); cnt_ge(cn, sc[i][2], cand); cnt_ge(cn, sc[i][3], cand); } }
            int tot; TH_XCHG(tot);
            if (e == 0) ngt = tot; else nge = tot;
        }
        const int need = TOPK - ngt; const bool excess = open && (nge - ngt > need);
#pragma unroll
        for (int i = 0; i < 32; ++i)
#pragma unroll
            for (int r = 0; r < 4; ++r) sc[i][r] = (sc[i][r] == T) ? (unsigned)((w + 8 * i) * 16 + 4 * g + r) : (sc[i][r] > T ? 0xfffffffeu : 0xffffffffu);
        unsigned c = 0u;
        for (int s = 0; s < 12; ++s, ++it) {
            const unsigned cand = c | (1u << (11 - s)); int cn = 0;
#pragma unroll
            for (int gi = 0; gi < 4; ++gi) if (ni > 8 * gi) {
#pragma unroll
                for (int i = 8 * gi; i < 8 * gi + 8; ++i) { cnt_ge(cn, cand - 1u, sc[i][0]); cnt_ge(cn, cand - 1u, sc[i][1]); cnt_ge(cn, cand - 1u, sc[i][2]); cnt_ge(cn, cand - 1u, sc[i][3]); } }
            int tot; TH_XCHG(tot);
            if (tot < need) c = cand;
        }
        if (excess) ceq = c;
        tied = true;
    }
#undef TH_XCHG
    LAS unsigned* lm = (LAS unsigned*)sm;
    __syncthreads();
    for (int i = tid; i < 2048; i += NTHREADS) lm[i] = 0u;
    __syncthreads();
    { const unsigned Tm = T > 1u ? T : 1u; const bool allow_eq = (T != 0u);
#pragma unroll
        for (int gi = 0; gi < 4; ++gi) if (ni > 8 * gi) {
#pragma unroll
            for (int i = 8 * gi; i < 8 * gi + 8; ++i) { unsigned nib = 0u;
#pragma unroll
                for (int r = 0; r < 4; ++r) { const unsigned v = sc[i][r];
                    const bool s_ = tied ? ((v == 0xfffffffeu) || (allow_eq && v <= ceq)) : (v >= Tm);
                    nib |= s_ ? (1u << r) : 0u; }
                const int kt = w + 8 * i;
                if (nib) __hip_atomic_fetch_or(&lm[c16 * 128 + (kt >> 1)], nib << (4 * g + 16 * (kt & 1)), __ATOMIC_RELAXED, __HIP_MEMORY_SCOPE_WORKGROUP); } }
    }
    __syncthreads();
    { unsigned* gm = (unsigned*)(p.ws + WS_MASK) + (size_t)(b * SEQ + qt * 16) * 128;
        *(u32x4*)(gm + tid * 4) = *(LAS u32x4*)(lm + tid * 4); }
    __syncthreads();
}

constexpr int AT_KROW = 264, AT_IROW = 40, AT_VROW = 40;
constexpr int AT_OFFI = 32 * AT_KROW * 2, AT_OFFV = AT_OFFI + 32 * AT_IROW * 2, AT_BUF = AT_OFFV + 256 * AT_VROW * 2;
__device__ __forceinline__ int at_row(int r) { return (r & 3) + 4 * ((r >> 3) & 3) + 16 * ((r >> 2) & 1); }
__device__ __forceinline__ void attn_item(const Params& p, int b, int qb, LAS unsigned char* sm) {
    const int tid = TID, w = __builtin_amdgcn_readfirstlane(tid >> 6), l = tid & 63, c16 = l & 15, g = l >> 4, qs = w & 3, hp = w >> 2;
    const bf16_t* proj = (const bf16_t*)(p.ws + WS_BIG) + (size_t)b * SEQ * DINP;
    const bf16_t* vt = (const bf16_t*)(p.ws + WS_VT) + (size_t)b * 4 * 64 * SEQ;
    const int q = qb * 64 + qs * 16 + c16;
    const bf16_t* qrow = proj + (size_t)q * DINP;
    const unsigned* mrow = (const unsigned*)(p.ws + WS_MASK) + (size_t)(b * SEQ + q) * 128;
    bf16x8 Qb[2][2];
#pragma unroll
    for (int hh = 0; hh < 2; ++hh)
#pragma unroll
        for (int kk = 0; kk < 2; ++kk) { const bf16x8 raw = *(const bf16x8*)(qrow + OFF_SQ + (2 * hp + hh) * 64 + kk * 32 + g * 8); bf16x8 o;
#pragma unroll
            for (int e = 0; e < 8; ++e) o[e] = (short)f2bf(bf2f(raw[e]) * 0.125f);
            Qb[hh][kk] = o; }
    f32x4 O[2][4];
#pragma unroll
    for (int hh = 0; hh < 2; ++hh)
#pragma unroll
        for (int dt = 0; dt < 4; ++dt) O[hh][dt] = (f32x4){0.f, 0.f, 0.f, 0.f};
    float mrun[2] = {-1e30f, -1e30f}, lrun[2] = {0.f, 0.f};
    const int nt = 2 * qb + 2, my_nt = (qb * 64 + qs * 16 + 15) / 32 + 1;
    const int kr0 = tid >> 5, kc = (tid & 31) * 8, vr0 = tid >> 2, vc = (tid & 3) * 8;
    const bf16_t* gK = proj + (size_t)kr0 * DINP + OFF_SK + kc;
    const bf16_t* gV = vt + (size_t)vr0 * SEQ + vc;
    const int lK0 = at_row(kr0) * AT_KROW + kc, lK1 = at_row(kr0 + 16) * AT_KROW + kc;
    const int lV0 = AT_OFFV / 2 + vr0 * AT_VROW + vc, lV1 = AT_OFFV / 2 + (vr0 + 128) * AT_VROW + vc;
    bf16x8 sA[4], sB[4]; unsigned mw = 0u, mwA = 0u, mwB = 0u;
#define AT_LOAD(S_, M_, k0_) do { S_[0] = *(const bf16x8*)(gK + (size_t)(k0_) * DINP); S_[1] = *(const bf16x8*)(gK + (size_t)((k0_) + 16) * DINP); \
        M_ = mrow[(k0_) >> 5]; S_[2] = *(const bf16x8*)(gV + (k0_)); S_[3] = *(const bf16x8*)(gV + (size_t)128 * SEQ + (k0_)); } while (0)
#define AT_STORE(S_, buf_) do { LAS bf16_t* B_ = (LAS bf16_t*)(sm + (buf_) * AT_BUF); *(LAS bf16x8*)(B_ + lK0) = S_[0]; *(LAS bf16x8*)(B_ + lK1) = S_[1]; \
        *(LAS bf16x8*)(B_ + lV0) = S_[2]; *(LAS bf16x8*)(B_ + lV1) = S_[3]; } while (0)
    AT_LOAD(sA, mwA, 0); AT_STORE(sA, 0); mw = mwA;
    AT_LOAD(sB, mwB, 32);
    __syncthreads();
    for (int t2 = 0; t2 < nt; t2 += 2) {
#pragma unroll
      for (int par = 0; par < 2; ++par) {
        const int t = t2 + par, k0 = t * 32;
        if (t + 2 < nt) { if (par == 0) AT_LOAD(sA, mwA, k0 + 64); else AT_LOAD(sB, mwB, k0 + 64); }
        if (t < my_nt) {
            LAS bf16_t* Bk = (LAS bf16_t*)(sm + par * AT_BUF); LAS bf16_t* Bv = Bk + AT_OFFV / 2;
            bool sel[2][4]; float lg[2][2][4];
#pragma unroll
            for (int s = 0; s < 2; ++s) {
                const int lrow = 16 * s + c16;
#pragma unroll
                for (int r = 0; r < 4; ++r) sel[s][r] = ((mw >> (8 * g + 4 * s + r)) & 1u) != 0u;
#pragma unroll
                for (int hh = 0; hh < 2; ++hh) { f32x4 S = (f32x4){0.f, 0.f, 0.f, 0.f};
#pragma unroll
                    for (int kk = 0; kk < 2; ++kk) { const bf16x8 kf = *(LAS bf16x8*)(Bk + lrow * AT_KROW + (2 * hp + hh) * 64 + kk * 32 + g * 8); S = mfma16(kf, Qb[hh][kk], S); }
#pragma unroll
                    for (int r = 0; r < 4; ++r) lg[hh][s][r] = S[r]; }
            }
#pragma unroll
            for (int hh = 0; hh < 2; ++hh) {
                float lm_[8];
#pragma unroll
                for (int s = 0; s < 2; ++s)
#pragma unroll
                    for (int r = 0; r < 4; ++r) lm_[s * 4 + r] = sel[s][r] ? lg[hh][s][r] : -1e30f;
                float mx = fmaxf(fmaxf(fmaxf(lm_[0], lm_[1]), fmaxf(lm_[2], lm_[3])), fmaxf(fmaxf(lm_[4], lm_[5]), fmaxf(lm_[6], lm_[7])));
                mx = xrow16_max(mx);
                const float mn = fmaxf(mrun[hh], mx), alpha = __expf(mrun[hh] - mn), mn2 = mn * 1.4426950408889634f;
                mrun[hh] = mn;
                float pv[8]; float ps = 0.f;
#pragma unroll
                for (int e = 0; e < 8; ++e) { pv[e] = (mn > -1e29f) ? __builtin_amdgcn_exp2f(__builtin_fmaf(lm_[e], 1.4426950408889634f, -mn2)) : 0.f; ps += pv[e]; }
                lrun[hh] = lrun[hh] * alpha + ps;
                union { bf16x8 v; unsigned u[4]; } pb;
                pb.u[0] = cvt_pk_bf16(pv[0], pv[1]); pb.u[1] = cvt_pk_bf16(pv[2], pv[3]); pb.u[2] = cvt_pk_bf16(pv[4], pv[5]); pb.u[3] = cvt_pk_bf16(pv[6], pv[7]);
                if (__any(alpha != 1.f)) {
#pragma unroll
                    for (int dt = 0; dt < 4; ++dt) O[hh][dt] = O[hh][dt] * alpha; }
                bf16x8 va4[4];
#pragma unroll
                for (int dt = 0; dt < 4; ++dt) va4[dt] = *(LAS bf16x8*)(Bv + ((2 * hp + hh) * 64 + dt * 16 + c16) * AT_VROW + g * 8);
                __builtin_amdgcn_s_setprio(1);
#pragma unroll
                for (int dt = 0; dt < 4; ++dt) O[hh][dt] = mfma16(va4[dt], pb.v, O[hh][dt]);
                __builtin_amdgcn_s_setprio(0);
            }
        }
        if (t + 1 < nt) { if (par == 0) { AT_STORE(sB, 1); mw = mwB; } else { AT_STORE(sA, 0); mw = mwA; } }
        __syncthreads();
      }
    }
#undef AT_LOAD
#undef AT_STORE
    bf16_t* mix = (bf16_t*)(p.ws + WS_HB) + (size_t)(b * SEQ + q) * DM + 512;
#pragma unroll
    for (int hh = 0; hh < 2; ++hh) { const float tot = xrow16_sum(lrun[hh]);
        const float inv = 1.f / tot;
#pragma unroll
        for (int dt = 0; dt < 4; ++dt) { const f32x4 o = O[hh][dt] * inv; u32x2 o2; o2.x = cvt_pk_bf16(o[0], o[1]); o2.y = cvt_pk_bf16(o[2], o[3]);
            *(u32x2*)(mix + (2 * hp + hh) * 64 + dt * 16 + 4 * g) = o2; } }
}

__device__ __forceinline__ void hgrn_G(const bf16x8 (&fv)[2], const float* lb, LAS float* Gs, LAS float* segtot) {
    const int tid = TID;
#pragma unroll
    for (int i = 0; i < 2; ++i) { const int row = (tid >> 4) + 32 * i, c8 = (tid & 15) * 8;
        const bf16x8 v = fv[i];
#pragma unroll
        for (int j = 0; j < 8; ++j) { const float fr = bf2f(v[j]), lbv = lb[c8 + j]; const float f = lbv + (1.f - lbv) * sigmoidf_(fr);
            Gs[row * 129 + c8 + j] = __logf(fmaxf(f, 1e-30f)); } }
    __syncthreads();
    const int col = tid & 127, seg = tid >> 7;
    { float run = 0.f;
#pragma unroll
        for (int r = 0; r < 16; ++r) { const int idx = (seg * 16 + r) * 129 + col; run += Gs[idx]; Gs[idx] = run; }
        segtot[seg * 128 + col] = run; }
    __syncthreads();
    { float off = 0.f;
#pragma unroll
        for (int s = 0; s < 3; ++s) if (s < seg) off += segtot[s * 128 + col];
        if (seg > 0) {
#pragma unroll
            for (int r = 0; r < 16; ++r) Gs[(seg * 16 + r) * 129 + col] += off; } }
    __syncthreads();
}

__device__ __forceinline__ void hgrn_A_item(const Params& p, int l, int b, int h, int c, LAS unsigned char* sm) {
    const int tid = TID, w = __builtin_amdgcn_readfirstlane(tid >> 6), ln = tid & 63, c16 = ln & 15, g = ln >> 4;
    LAS float* Gs = (LAS float*)sm; LAS float* segtot = (LAS float*)(sm + 33024);
    LAS bf16_t* KgT = (LAS bf16_t*)(sm + 35072); LAS bf16_t* vT = (LAS bf16_t*)(sm + 53504);
    LAS bf16_t* qt_ = (LAS bf16_t*)(sm + 71936); LAS bf16_t* kt_ = (LAS bf16_t*)(sm + 89344); LAS bf16_t* Am = (LAS bf16_t*)(sm + 106752);
    bf16_t* prow0 = (bf16_t*)(p.ws + WS_BIG) + (size_t)(b * SEQ + c * 64) * DINP;
    const float* lb = (const float*)(p.ws + WS_LB) + l * 512 + h * 128;
    bf16x8 fG[2], qG[2];
#pragma unroll
    for (int i = 0; i < 2; ++i) { const bf16_t* rq = prow0 + (size_t)((tid >> 4) + 32 * i) * DINP + h * 128 + (tid & 15) * 8; fG[i] = *(const bf16x8*)(rq + OFF_HF); qG[i] = *(const bf16x8*)(rq + OFF_HQ); }
    const bf16_t* rp = prow0 + (size_t)(tid & 63) * DINP + h * 128 + (tid >> 6) * 16;
    const bf16x8 f0 = *(const bf16x8*)(rp + OFF_HF), f1 = *(const bf16x8*)(rp + OFF_HF + 8), v0 = *(const bf16x8*)(rp + OFF_HI), v1 = *(const bf16x8*)(rp + OFF_HI + 8);
    hgrn_G(fG, lb, Gs, segtot);
#pragma unroll
    for (int i = 0; i < 2; ++i) { const int row = (tid >> 4) + 32 * i, c8 = (tid & 15) * 8;
        const bf16x8 qv8 = qG[i], fv8 = fG[i];
        float a[8], bq[8], cq[8];
#pragma unroll
        for (int j = 0; j < 8; ++j) { const int k = c8 + j; const float G = Gs[row * 129 + k], Gm = Gs[31 * 129 + k], lbv = lb[k];
            const float qv = siluf_(bf2f(qv8[j])) * 0.08838834764831845f, kval = (1.f - lbv) * sigmoidf_(-bf2f(fv8[j]));
            a[j] = qv * __expf(fminf(G - Gm, 80.f)); bq[j] = kval * __expf(fminf(Gm - G, 80.f)); cq[j] = qv * __expf(G); }
        u32x4 o;
        o.x = cvt_pk_bf16(a[0], a[1]); o.y = cvt_pk_bf16(a[2], a[3]); o.z = cvt_pk_bf16(a[4], a[5]); o.w = cvt_pk_bf16(a[6], a[7]); *(LAS u32x4*)(qt_ + row * 136 + c8) = o;
        o.x = cvt_pk_bf16(bq[0], bq[1]); o.y = cvt_pk_bf16(bq[2], bq[3]); o.z = cvt_pk_bf16(bq[4], bq[5]); o.w = cvt_pk_bf16(bq[6], bq[7]); *(LAS u32x4*)(kt_ + row * 136 + c8) = o;
        o.x = cvt_pk_bf16(cq[0], cq[1]); o.y = cvt_pk_bf16(cq[2], cq[3]); o.z = cvt_pk_bf16(cq[4], cq[5]); o.w = cvt_pk_bf16(cq[6], cq[7]);
        *(u32x4*)(prow0 + (size_t)row * DINP + OFF_HQ + h * 128 + c8) = o; }
    { const int j = tid & 63, kg = tid >> 6;
#pragma unroll
        for (int e = 0; e < 16; ++e) { const int k = kg * 16 + e; const float fr = bf2f(e < 8 ? f0[e & 7] : f1[e & 7]), lbv = lb[k];
            const float kval = (1.f - lbv) * sigmoidf_(-fr);
            KgT[k * 72 + j] = f2bf(kval * __expf(Gs[63 * 129 + k] - Gs[j * 129 + k]));
            vT[k * 72 + j] = (bf16_t)(e < 8 ? v0[e & 7] : v1[e & 7]); } }
    const size_t bhc = (size_t)((b * 4 + h) * 64 + c);
    if (tid < 128) ((float*)(p.ws + WS_DEC))[bhc * 128 + tid] = __expf(Gs[63 * 129 + tid]);
    __syncthreads();
    { f32x4 acc[8];
#pragma unroll
        for (int vt = 0; vt < 8; ++vt) acc[vt] = (f32x4){0.f, 0.f, 0.f, 0.f};
#pragma unroll
        for (int kk = 0; kk < 2; ++kk) { const bf16x8 a = *(LAS bf16x8*)(KgT + (w * 16 + c16) * 72 + kk * 32 + g * 8);
#pragma unroll
            for (int vt = 0; vt < 8; ++vt) { const bf16x8 bb = *(LAS bf16x8*)(vT + (vt * 16 + c16) * 72 + kk * 32 + g * 8); acc[vt] = mfma16(a, bb, acc[vt]); } }
        bf16_t* st = (bf16_t*)(p.ws + WS_ST) + bhc * 16384;
#pragma unroll
        for (int vt = 0; vt < 8; ++vt) { u32x2 o; o.x = cvt_pk_bf16(acc[vt][0], acc[vt][1]); o.y = cvt_pk_bf16(acc[vt][2], acc[vt][3]);
            *(u32x2*)(st + (size_t)(vt * 16 + c16) * 128 + w * 16 + 4 * g) = o; } }
#pragma unroll
    for (int s = 0; s < 2; ++s) { const int tI = w * 2 + s, itile = tI >> 2, jt = tI & 3;
        f32x4 d = (f32x4){0.f, 0.f, 0.f, 0.f};
        if (jt <= itile) {
#pragma unroll
            for (int kk = 0; kk < 4; ++kk) { const bf16x8 a = *(LAS bf16x8*)(kt_ + (jt * 16 + c16) * 136 + kk * 32 + g * 8), bb = *(LAS bf16x8*)(qt_ + (itile * 16 + c16) * 136 + kk * 32 + g * 8);
                d = mfma16(a, bb, d); } }
        const int i = itile * 16 + c16, j0 = jt * 16 + 4 * g;
        u32x2 o; o.x = cvt_pk_bf16((j0 + 0 <= i) ? d[0] : 0.f, (j0 + 1 <= i) ? d[1] : 0.f); o.y = cvt_pk_bf16((j0 + 2 <= i) ? d[2] : 0.f, (j0 + 3 <= i) ? d[3] : 0.f);
        *(LAS u32x2*)(Am + i * 72 + j0) = o; }
    __syncthreads();
    { const int itile = w & 3, vh = w >> 2;
        f32x4 acc[4];
#pragma unroll
        for (int vt = 0; vt < 4; ++vt) acc[vt] = (f32x4){0.f, 0.f, 0.f, 0.f};
#pragma unroll
        for (int kk = 0; kk < 2; ++kk) { const bf16x8 bb = *(LAS bf16x8*)(Am + (itile * 16 + c16) * 72 + kk * 32 + g * 8);
#pragma unroll
            for (int vt = 0; vt < 4; ++vt) { const bf16x8 a = *(LAS bf16x8*)(vT + ((vh * 4 + vt) * 16 + c16) * 72 + kk * 32 + g * 8); acc[vt] = mfma16(a, bb, acc[vt]); } }
        bf16_t* mix = (bf16_t*)(p.ws + WS_HB) + (size_t)(b * SEQ + c * 64 + itile * 16 + c16) * DM + h * 128;
#pragma unroll
        for (int vt = 0; vt < 4; ++vt) { u32x2 o; o.x = cvt_pk_bf16(acc[vt][0], acc[vt][1]); o.y = cvt_pk_bf16(acc[vt][2], acc[vt][3]);
            *(u32x2*)(mix + (vh * 4 + vt) * 16 + 4 * g) = o; } }
    __syncthreads();
}

__device__ __forceinline__ void hgrn_scan(const Params& p) {
    bf16_t* ST = (bf16_t*)(p.ws + WS_ST); const float* DEC = (const float*)(p.ws + WS_DEC);
    for (int e = blockIdx.x * NTHREADS + TID; e < 32 * 4096; e += gridDim.x * NTHREADS) {
        const int bh = e >> 12, idx4 = (e & 4095) * 4, k = idx4 & 127;
        bf16_t* base = ST + (size_t)bh * 64 * 16384 + idx4; const float* dec = DEC + (size_t)bh * 64 * 128 + k;
        f32x4 S = (f32x4){0.f, 0.f, 0.f, 0.f};
#pragma unroll 16
        for (int c = 0; c < 64; ++c) { const u32x2 loc = *(const u32x2*)(base + (size_t)c * 16384); const f32x4 d = *(const f32x4*)(dec + c * 128);
            u32x2 o; o.x = cvt_pk_bf16(S[0], S[1]); o.y = cvt_pk_bf16(S[2], S[3]);
            *(u32x2*)(base + (size_t)c * 16384) = o;
            S[0] = d[0] * S[0] + bflo(loc.x); S[1] = d[1] * S[1] + bfhi(loc.x); S[2] = d[2] * S[2] + bflo(loc.y); S[3] = d[3] * S[3] + bfhi(loc.y); }
    }
}

__device__ __forceinline__ void hgrn_C_item(const Params& p, int l, int b, int h, int c, LAS unsigned char* sm) {
    const int tid = TID, w = __builtin_amdgcn_readfirstlane(tid >> 6), ln = tid & 63, c16 = ln & 15, g = ln >> 4;
    LAS float* ssq = (LAS float*)sm;
    const int itile = w & 3, vh = w >> 2, i = itile * 16 + c16;
    const bf16_t* prow = (const bf16_t*)(p.ws + WS_BIG) + (size_t)(b * SEQ + c * 64 + i) * DINP;
    bf16_t* mix = (bf16_t*)(p.ws + WS_HB) + (size_t)(b * SEQ + c * 64 + i) * DM + h * 128;
    const bf16_t* st_ = (const bf16_t*)(p.ws + WS_ST) + (size_t)((b * 4 + h) * 64 + c) * 16384;
    bf16x8 qgF[4], stG[4][4]; u32x2 grG[4], oi[4];
#pragma unroll
    for (int kk = 0; kk < 4; ++kk) qgF[kk] = *(const bf16x8*)(prow + OFF_HQ + h * 128 + kk * 32 + g * 8);
#pragma unroll
    for (int kk = 0; kk < 4; ++kk)
#pragma unroll
        for (int vt = 0; vt < 4; ++vt) stG[kk][vt] = *(const bf16x8*)(st_ + (size_t)((vh * 4 + vt) * 16 + c16) * 128 + kk * 32 + g * 8);
#pragma unroll
    for (int vt = 0; vt < 4; ++vt) { const int v0 = (vh * 4 + vt) * 16 + 4 * g; grG[vt] = *(const u32x2*)(prow + OFF_HG + h * 128 + v0); oi[vt] = *(const u32x2*)(mix + v0); }
    f32x4 acc[4];
#pragma unroll
    for (int vt = 0; vt < 4; ++vt) acc[vt] = (f32x4){bflo(oi[vt].x), bfhi(oi[vt].x), bflo(oi[vt].y), bfhi(oi[vt].y)};
#pragma unroll
    for (int kk = 0; kk < 4; ++kk)
#pragma unroll
        for (int vt = 0; vt < 4; ++vt) acc[vt] = mfma16(stG[kk][vt], qgF[kk], acc[vt]);
    float ss = 0.f;
#pragma unroll
    for (int vt = 0; vt < 4; ++vt) ss += acc[vt][0] * acc[vt][0] + acc[vt][1] * acc[vt][1] + acc[vt][2] * acc[vt][2] + acc[vt][3] * acc[vt][3];
    ss = xrow16_sum(ss);
    if (g == 0) ssq[vh * 64 + i] = ss;
    __syncthreads();
    const float rstd = rsqrtf((ssq[i] + ssq[64 + i]) * (1.f / 128.f) + EPS);
#pragma unroll
    for (int vt = 0; vt < 4; ++vt) { const int v0 = (vh * 4 + vt) * 16 + 4 * g;
        const u32x2 gr = grG[vt]; const f32x4 ow = *(const f32x4*)(p.onorm_w + l * 512 + h * 128 + v0);
        const float r0 = acc[vt][0] * rstd * ow[0] * siluf_(bflo(gr.x)), r1 = acc[vt][1] * rstd * ow[1] * siluf_(bfhi(gr.x));
        const float r2 = acc[vt][2] * rstd * ow[2] * siluf_(bflo(gr.y)), r3 = acc[vt][3] * rstd * ow[3] * siluf_(bfhi(gr.y));
        u32x2 o; o.x = cvt_pk_bf16(r0, r1); o.y = cvt_pk_bf16(r2, r3);
        *(u32x2*)(mix + v0) = o; }
    __syncthreads();
}

#ifdef DIAG_CUT
__device__ __forceinline__ void diag_phase(const Params& p) {
    const int tid = TID, wave = tid >> 6, lane = tid & 63;
    const bf16_t* HB = (const bf16_t*)(p.ws + WS_HB); const bf16_t* ST = (const bf16_t*)(p.ws + WS_ST); const float* DEC = (const float*)(p.ws + WS_DEC);
    const bf16_t* BIG = (const bf16_t*)(p.ws + WS_BIG);
    for (int row = blockIdx.x * 8 + wave; row < NTOK; row += gridDim.x * 8) {
        float* orow = p.out + (size_t)row * DM;
        for (int i = 0; i < 16; ++i) { const int col = i * 64 + lane; float v = 0.f;
#if DIAG_MODE == 1
            for (int t = 0; t < 3; ++t) v += bf2f((short)BIG[(size_t)row * DINP + col + 1024 * t]);
            if (col < 768) v += bf2f((short)BIG[(size_t)row * DINP + 3072 + col]);
#elif DIAG_MODE == 2
            v = bf2f((short)ST[(size_t)row * 1024 + col]) + DEC[((size_t)row * 8 + (col & 7)) % (32 * 64 * 128)];
#elif DIAG_MODE == 5
            v = DEC[((size_t)row * 8 + (col & 7)) % (32 * 64 * 128)];
#elif DIAG_MODE == 6
            v = bf2f((short)ST[(size_t)row * 1024 + col]);
#elif DIAG_MODE == 4
            v = bf2f((short)HB[(size_t)row * DM + col]);
#endif
            if (!(fabsf(v) < 1e30f)) v = 12345.f;
            orow[col] = v; }
    }
}
#endif
#define XB_TMO      128
#define XB_XCNT(j)  (256  + 64 * (j))
#define XB_XSUB(j)  (1280 + 64 * (j))
#define XB_XGEN(j)  (2304 + 64 * (j))
#define XB_TOP      3328
#define XB_TOPGEN   3392
#define XCD_BAR_WORDS 3456
#define XB_SPIN_CAP (1u << 21)

__device__ __forceinline__ unsigned xb_ld(unsigned* p)              { return __hip_atomic_load(p, __ATOMIC_RELAXED, __HIP_MEMORY_SCOPE_AGENT); }
__device__ __forceinline__ unsigned xb_add(unsigned* p, unsigned v) { return __hip_atomic_fetch_add(p, v, __ATOMIC_RELAXED, __HIP_MEMORY_SCOPE_AGENT); }
__device__ __forceinline__ unsigned xb_xcc_id() { return (unsigned)__builtin_amdgcn_s_getreg((3 << 11) | 20) & 0xFu; }
#define XB_SPIN(cond, bar) do { unsigned _sp = 0; while (cond) { __builtin_amdgcn_s_sleep(1); \
    if ((++_sp & 255u) == 0u) { if (xb_ld(&(bar)[XB_TMO])) break; if (_sp > XB_SPIN_CAP) { atomicAdd(&(bar)[XB_TMO], 1u); break; } } } } while (0)

struct XcdBarrier {
    unsigned* bar; unsigned x;
    volatile LAS unsigned* st;
};

__device__ __forceinline__ XcdBarrier xcd_barrier_post(unsigned* bar, volatile LAS unsigned* st) {
    XcdBarrier b; b.bar = bar; b.x = xb_xcc_id(); b.st = st;
    if (threadIdx.x == 0) (void)xb_add(&bar[XB_XCNT(b.x)], 1u);
    return b;
}
__device__ __forceinline__ void xcd_barrier_complete(unsigned* bar, unsigned x, unsigned& nloc, unsigned& nx) {
    const unsigned G = gridDim.x * gridDim.y * gridDim.z;
    unsigned sum, cnt, mine, sp = 0u;
    for (;;) {
        sum = 0u; cnt = 0u; mine = 0u;
#pragma unroll
        for (unsigned j = 0; j < 16; ++j) { const unsigned c = xb_ld(&bar[XB_XCNT(j)]); sum += c; cnt += (c > 0u) ? 1u : 0u; mine = (j == x) ? c : mine; }
        if (sum == G) break;
        __builtin_amdgcn_s_sleep(1);
        if ((++sp & 255u) == 0u) { if (xb_ld(&bar[XB_TMO])) break; if (sp > XB_SPIN_CAP) { atomicAdd(&bar[XB_TMO], 1u); break; } }
    }
    nloc = mine > 0u ? mine : 1u; nx = cnt > 0u ? cnt : 1u;
}

__device__ __forceinline__ void xcd_barrier(const XcdBarrier& b) {
    asm volatile("s_waitcnt vmcnt(0)" ::: "memory");
    __syncthreads();
    if (threadIdx.x == 0) {
        unsigned* bar = b.bar;
        __builtin_amdgcn_s_waitcnt(0);
        unsigned nloc = b.st[0], nx = b.st[1];
        if (nloc == 0u) { xcd_barrier_complete(bar, b.x, nloc, nx); b.st[0] = nloc; b.st[1] = nx; }
        const unsigned old = xb_add(&bar[XB_XSUB(b.x)], 1u);
        const unsigned gen = old / nloc;
        if (old + 1u == (gen + 1u) * nloc) {
            __builtin_amdgcn_fence(__ATOMIC_RELEASE, "agent");
            asm volatile("s_waitcnt vmcnt(0)" ::: "memory");
            const unsigned og = xb_add(&bar[XB_TOP], 1u);
            const unsigned tg = og / nx;
            if (og + 1u == (tg + 1u) * nx) xb_add(&bar[XB_TOPGEN], 1u);
            else XB_SPIN(xb_ld(&bar[XB_TOPGEN]) == tg, bar);
            __builtin_amdgcn_fence(__ATOMIC_ACQUIRE, "agent");
            xb_add(&bar[XB_XGEN(b.x)], 1u);
            asm volatile("s_waitcnt vmcnt(0)" ::: "memory");
        } else {
            XB_SPIN(xb_ld(&bar[XB_XGEN(b.x)]) == gen, bar);
            __builtin_amdgcn_fence(__ATOMIC_ACQUIRE, "agent");
            asm volatile("s_waitcnt vmcnt(0)" ::: "memory");
        }
    }
    __syncthreads();
}


template <class Epi>
__device__ __forceinline__ void run_gemm(LAS unsigned char* lds, const bf16_t* A, const bf16_t* Bt, int M, int N, int K, const Epi& E) {
    pg8::Gemm g; g.A = A; g.Bt = Bt; g.M = M; g.N = N; g.K = K;
    pg8::StaticOrder S; S.init(M, N, (int)gridDim.x, (int)blockIdx.x);
    pg8::gemm_phase<Epi, pg8::StaticOrder, true, true>(lds, g, S, E);
}

constexpr int NPHASE = 2 + 9 * DEPTH;
#define GRID_SYNC() do { if (pin.ph_lo < 0) grid.sync(); xcd_barrier(xb); } while (0)

__global__ void __launch_bounds__(NTHREADS, 2) fwd_megakernel(Params pin) {
    extern __shared__ __attribute__((aligned(16))) unsigned char lds_raw[];
    LAS unsigned char* lds = (LAS unsigned char*)lds_raw;
    cg::grid_group grid = cg::this_grid();
    volatile LAS unsigned* xst = (volatile LAS unsigned*)(lds + 131072);
    if (threadIdx.x == 0) { xst[0] = 0u; xst[1] = 0u; }
    __syncthreads();
    XcdBarrier xb = xcd_barrier_post((unsigned*)(pin.ws + WS_BAR), xst);
    const int G = (int)gridDim.x, blk = (int)blockIdx.x;
    for (int ph = pin.ph_lo; ph < pin.ph_hi; ++ph) {
        Params p = pin;
        { size_t zoff = 0; asm volatile("" : "+s"(zoff));
            p.ws = pin.ws + zoff; p.out = pin.out + zoff; p.x = pin.x + zoff; }
        bf16_t* WIN = (bf16_t*)(p.ws + WS_WIN); bf16_t* WOUT = (bf16_t*)(p.ws + WS_WOUT); bf16_t* W1B = (bf16_t*)(p.ws + WS_W1); bf16_t* W2B = (bf16_t*)(p.ws + WS_W2);
        const float* MOD = (const float*)(p.ws + WS_MOD);
        bf16_t* BIG = (bf16_t*)(p.ws + WS_BIG); bf16_t* HB = (bf16_t*)(p.ws + WS_HB);
        if (ph == 0) {
          for (int rep_ = 0; rep_ < REP_PRO; ++rep_) {
            cvt_kind(p.w_in, WIN, DM, DIN, DINP, (LAS float*)lds);
            cvt_kind(p.w_out, WOUT, DM, DM, DM, (LAS float*)lds);
            cvt_kind(p.w1, W1B, DM, DFF, DFF, (LAS float*)lds);
            cvt_kind(p.w2, W2B, DFF, DM, DM, (LAS float*)lds);
            mod_phase(p, (LAS float*)lds);
            lb_phase(p);
          }
        } else if (ph == NPHASE - 1) {
            final_norm(p.out, p.final_w);
        } else {
            const int l = (ph - 1) / 9, s = (ph - 1) % 9;
            const float* modl = MOD + (size_t)l * NB * 6144;
            const float* xcur = (l == 0) ? p.x : p.out;
            if (s == 0) {
                for (int rep_ = 0; rep_ < REP_NORM; ++rep_) rmsnorm_mod(xcur, p.norm_mix_w + l * DM, modl, 0, 1024, HB);
            } else if (s == 1) {
                pg8::EpiBf16<0> E; E.O = BIG; E.ldc = DINP;
                for (int rep_ = 0; rep_ < REP_GEMM; ++rep_) run_gemm(lds, HB, WIN + (size_t)l * DINP * DM, NTOK, DINP, DM, E);
            } else if (s == 2) {
              for (int rep2_ = 0; rep2_ < REP_S2; ++rep2_) {
#ifndef DIAG_NOTHR
                for (int v = blk; v < 2048; v += G) { const int itp = v >> 8, rem = v & 255, b = rem & 7, jj = rem >> 3; const int qt = itp * 32 + ((itp & 1) ? 31 - jj : jj); for (int rep_ = 0; rep_ < REP_THR; ++rep_) thr_item(p, b, qt, lds); }
#endif
                for (int v = blk; v < 2048; v += G) { const int c = v & 63, bh = v >> 6; hgrn_A_item(p, l, bh >> 2, bh & 3, c, lds); }
                for (int v = blk; v < 1024; v += G) conv_item(p, l, v >> 7, v & 127, lds);
                for (int v = blk; v < 512; v += G) vt_item(p, v >> 6, v & 63, lds);
              }
            } else if (s == 3) {
                hgrn_scan(p);
                for (int v = blk; v < 512; v += G) { const int itp = v >> 8, rem = v & 255, b = rem & 7, jj = rem >> 3; const int qb = itp ? 63 - jj : jj; for (int rep_ = 0; rep_ < REP_ATTN; ++rep_) attn_item(p, b, qb, lds); }
            } else if (s == 4) {
                for (int rep_ = 0; rep_ < REP_HO; ++rep_) for (int v = blk; v < 2048; v += G) { const int c = v & 63, bh = v >> 6; hgrn_C_item(p, l, bh >> 2, bh & 3, c, lds); }
            } else if (s == 5) {
                pg8::EpiResid E; E.xs = xcur; E.xd = p.out; E.gate = modl + 2048;
                run_gemm(lds, HB, WOUT + (size_t)l * DM * DM, NTOK, DM, DM, E);
            } else if (s == 6) {
                for (int rep_ = 0; rep_ < REP_NORM; ++rep_) rmsnorm_mod(p.out, p.norm_mlp_w + l * DM, modl, 3072, 4096, HB);
            } else if (s == 7) {
                pg8::EpiBf16<1> E; E.O = BIG; E.ldc = DFF;
                for (int rep_ = 0; rep_ < REP_GEMM; ++rep_) run_gemm(lds, HB, W1B + (size_t)l * DFF * DM, NTOK, DFF, DM, E);
            } else {
                pg8::EpiResid E; E.xs = p.out; E.xd = p.out; E.gate = modl + 5120;
                run_gemm(lds, BIG, W2B + (size_t)l * DM * DFF, NTOK, DM, DFF, E);
            }
        }
        if (ph + 1 < pin.ph_hi) { GRID_SYNC(); }
    }
#ifdef DIAG_CUT
    { const int ph = 1; GRID_SYNC(); } diag_phase(pin);
#endif
}

extern "C" void kernel_launch(void* const* d_in, const int* in_sizes, int n_in, void* d_out, int out_size, void* d_ws, size_t ws_size, hipStream_t stream) {
    static int grid_blocks = 0;
    if (grid_blocks == 0) {
        if (n_in != 17 || out_size != NTOK * DM || ws_size < WS_END) { fprintf(stderr, "kernel_launch: unexpected shapes (n_in %d out %d ws %zu need %zu)\n", n_in, out_size, ws_size, (size_t)WS_END); grid_blocks = -1; return; }
        int dev = 0, cus = 0, per_cu = 0;
        hipGetDevice(&dev);
        hipDeviceGetAttribute(&cus, hipDeviceAttributeMultiprocessorCount, dev);
        if (hipFuncSetAttribute((const void*)fwd_megakernel, hipFuncAttributeMaxDynamicSharedMemorySize, LDS_BYTES) != hipSuccess) { fprintf(stderr, "kernel_launch: hipFuncSetAttribute failed\n"); grid_blocks = -1; return; }
        if (hipOccupancyMaxActiveBlocksPerMultiprocessor(&per_cu, (const void*)fwd_megakernel, NTHREADS, LDS_BYTES) != hipSuccess || per_cu < 1) { fprintf(stderr, "kernel_launch: occupancy query says %d blocks/CU\n", per_cu); per_cu = 1; }
        (void)hipGetLastError();
        grid_blocks = cus * (per_cu > 1 ? 1 : per_cu);
    }
    if (grid_blocks < 0) return;
    Params p{};
    p.x = (const float*)d_in[0]; p.c = (const float*)d_in[1]; p.ada_w = (const float*)d_in[2]; p.ada_b = (const float*)d_in[3];
    p.norm_mix_w = (const float*)d_in[4]; p.norm_mlp_w = (const float*)d_in[5]; p.w_in = (const float*)d_in[6]; p.lb_logits = (const float*)d_in[7];
    p.onorm_w = (const float*)d_in[8]; p.cv_w = (const float*)d_in[9]; p.cv_b = (const float*)d_in[10]; p.cv_ln_w = (const float*)d_in[11]; p.cv_ln_b = (const float*)d_in[12];
    p.w_out = (const float*)d_in[13]; p.w1 = (const float*)d_in[14]; p.w2 = (const float*)d_in[15]; p.final_w = (const float*)d_in[16];
    p.out = (float*)d_out; p.ws = (unsigned char*)d_ws; p.ph_lo = 0; p.ph_hi = NPHASE;
#ifdef DIAG_CUT
    p.ph_hi = DIAG_CUT;
#endif
    if (hipMemsetAsync((char*)d_ws + WS_BAR, 0, 16384, stream) != hipSuccess) { fprintf(stderr, "kernel_launch: hipMemsetAsync failed\n"); return; }
    void* args[] = {&p};
    hipError_t e = hipLaunchCooperativeKernel((const void*)fwd_megakernel, dim3(grid_blocks), dim3(NTHREADS), args, LDS_BYTES, stream);
    if (e != hipSuccess) fprintf(stderr, "kernel_launch: cooperative launch failed: %s (grid %d)\n", hipGetErrorString(e), grid_blocks);
}
```

```cpp
#include <hip/hip_runtime.h>
#include <hip/hip_cooperative_groups.h>
#include <cstdio>
#include <cstdint>
namespace cg = cooperative_groups;

#define LAS __attribute__((address_space(3)))
typedef unsigned short bf16_t;
typedef short bf16x8 __attribute__((ext_vector_type(8)));
typedef float f32x4 __attribute__((ext_vector_type(4)));
typedef unsigned u32x4 __attribute__((ext_vector_type(4)));
typedef unsigned u32x2 __attribute__((ext_vector_type(2)));

constexpr int DM = 1024, NB = 8, SEQ = 4096, DEPTH = 4, NTOK = NB * SEQ;
constexpr int DIN = 3624, DINP = 3840, DFF = 4096;
constexpr int OFF_HQ = 0, OFF_HF = 512, OFF_HI = 1024, OFF_HG = 1536, OFF_SQ = 2048, OFF_SK = 2304, OFF_SV = 2560, OFF_IQ = 2816, OFF_IK = 3072, OFF_IW = 3104, OFF_CU = 3112;
constexpr int TOPK = 256;
constexpr float EPS = 1e-6f;
constexpr int NTHREADS = 512;
constexpr int LDS_BYTES = 131072 + 64;

constexpr size_t WS_WIN = 0;
constexpr size_t WS_WOUT = WS_WIN + (size_t)DEPTH * DINP * DM * 2;
constexpr size_t WS_W1 = WS_WOUT + (size_t)DEPTH * DM * DM * 2;
constexpr size_t WS_W2 = WS_W1 + (size_t)DEPTH * DFF * DM * 2;
constexpr size_t WS_MOD = WS_W2 + (size_t)DEPTH * DM * DFF * 2;
constexpr size_t WS_LB = WS_MOD + (size_t)DEPTH * NB * 6 * DM * 4;
constexpr size_t WS_BIG = WS_LB + (size_t)DEPTH * 512 * 4;
constexpr size_t WS_MASK = WS_BIG + (size_t)NTOK * DINP * 2;
static_assert((size_t)NTOK * DINP * 2 + (size_t)NTOK * 128 * 4 <= (size_t)NTOK * DFF * 2, "mask overlay");
constexpr size_t WS_HB = WS_BIG + (size_t)NTOK * DFF * 2;
constexpr size_t WS_ST = WS_HB + (size_t)NTOK * DM * 2;
constexpr size_t WS_DEC = WS_ST + (size_t)32 * 64 * 16384 * 2;
constexpr size_t WS_VT = WS_DEC + (size_t)32 * 64 * 128 * 4;
constexpr size_t WS_THRT = WS_VT + (size_t)NB * 4 * 64 * SEQ * 2;
constexpr size_t WS_THRC = WS_THRT + (size_t)NTOK * 4;
constexpr size_t WS_BAR = WS_THRC + (size_t)NTOK * 4;
constexpr size_t WS_END = WS_BAR + 16384;
static_assert(WS_END <= (size_t)512 * 1024 * 1024, "workspace map exceeds 512 MiB");

struct Params {
    const float* x; const float* c; const float* ada_w; const float* ada_b; const float* norm_mix_w; const float* norm_mlp_w;
    const float* w_in; const float* lb_logits; const float* onorm_w; const float* cv_w; const float* cv_b; const float* cv_ln_w; const float* cv_ln_b;
    const float* w_out; const float* w1; const float* w2; const float* final_w;
    float* out; unsigned char* ws;
    int ph_lo, ph_hi;
};

typedef float f32x2_t __attribute__((ext_vector_type(2)));
typedef __bf16 bf16x2_t __attribute__((ext_vector_type(2)));
__device__ __forceinline__ unsigned cvt_pk_bf16(float lo, float hi) { const f32x2_t v = {lo, hi}; return __builtin_bit_cast(unsigned, __builtin_convertvector(v, bf16x2_t)); }
__device__ __forceinline__ float bf2f(short h) { return __uint_as_float(((unsigned)(unsigned short)h) << 16); }
__device__ __forceinline__ float bflo(unsigned w) { return __uint_as_float(w << 16); }
__device__ __forceinline__ float bfhi(unsigned w) { return __uint_as_float(w & 0xffff0000u); }
__device__ __forceinline__ bf16_t f2bf(float f) { return (bf16_t)(cvt_pk_bf16(f, 0.f) & 0xffffu); }
__device__ __forceinline__ float wave_sum(float v) {
    v += __shfl_xor(v, 32); v += __shfl_xor(v, 16); v += __shfl_xor(v, 8); v += __shfl_xor(v, 4); v += __shfl_xor(v, 2); v += __shfl_xor(v, 1); return v;
}
__device__ __forceinline__ float xrow16_max(float x) {
    auto s = __builtin_amdgcn_permlane16_swap(__float_as_uint(x), __float_as_uint(x), false, false);
    x = fmaxf(__uint_as_float(s[0]), __uint_as_float(s[1]));
    auto t = __builtin_amdgcn_permlane32_swap(__float_as_uint(x), __float_as_uint(x), false, false);
    return fmaxf(__uint_as_float(t[0]), __uint_as_float(t[1]));
}
__device__ __forceinline__ float xrow16_sum(float x) {
    auto s = __builtin_amdgcn_permlane16_swap(__float_as_uint(x), __float_as_uint(x), false, false);
    x = __uint_as_float(s[0]) + __uint_as_float(s[1]);
    auto t = __builtin_amdgcn_permlane32_swap(__float_as_uint(x), __float_as_uint(x), false, false);
    return __uint_as_float(t[0]) + __uint_as_float(t[1]);
}
__device__ __forceinline__ float sigmoidf_(float x) { return __builtin_amdgcn_rcpf(1.f + __expf(-x)); }
__device__ __forceinline__ float siluf_(float x) { return x * __builtin_amdgcn_rcpf(1.f + __expf(-x)); }
__device__ __forceinline__ unsigned sortable(float f) { unsigned b = __float_as_uint(f); return b ^ ((b & 0x80000000u) ? 0xffffffffu : 0x80000000u); }
__device__ __forceinline__ f32x4 mfma16(bf16x8 a, bf16x8 b, f32x4 c) { return __builtin_amdgcn_mfma_f32_16x16x32_bf16(a, b, c, 0, 0, 0); }

namespace pg8 {
#define PG8_LAS __attribute__((address_space(3)))
constexpr int BM = 256, BK = 64, HALF = 128, HTB = HALF * BK * 2, STAGE_BYTES = 8 * HTB, NXCD = 8, WGM = 8;
__host__ __device__ __forceinline__ int lds_byte(int r, int c) { const int st = (r >> 4) * 2 + (c >> 5), rr = r & 15, cc = c & 31, ob = rr * 64 + cc * 2; return st * 1024 + (ob ^ (((ob >> 9) & 1) << 5)); }
__host__ __device__ __forceinline__ void stage_rc(int b, int& R, int& C) { const int st = b / 1024, sb = b % 1024, swz = sb ^ (((sb >> 9) & 1) << 5); R = (st >> 1) * 16 + swz / 64; C = (st & 1) * 32 + (swz % 64) / 2; }
__host__ __device__ __forceinline__ int perm32(int rho) { const int n = rho >> 4, i = rho & 15; return 8 * (i >> 2) + 4 * n + (i & 3); }
struct Unit { int pm, pn; };
struct Gemm { const bf16_t* A; const bf16_t* Bt; int M, N, K; };
struct StaticOrder {
    int nM, nN, nwg, G, c;
    __host__ __device__ void init(int M, int N, int G_, int c_) { nM = M / BM; nN = N / BM; nwg = nM * nN; G = G_; c = c_; }
    __host__ __device__ bool next(int i, Unit& u) const {
        const long L = (long)i * G + c; if (L >= nwg) return false;
        int wgid = (int)L; { const int q = nwg / NXCD, r = nwg % NXCD, xcd = wgid % NXCD, off = wgid / NXCD; wgid = (xcd < r ? xcd * (q + 1) : r * (q + 1) + (xcd - r) * q) + off; }
        const int nig = WGM * nN, gid = wgid / nig, fm = gid * WGM, gsz = (nM - fm) < WGM ? (nM - fm) : WGM;
        u.pm = fm + ((wgid % nig) % gsz); u.pn = (wgid % nig) / gsz; return true;
    }
    __device__ __forceinline__ void a_ready(const Unit&) const {}
    __device__ __forceinline__ void done(const Unit&) const {}
};

template <int ACT  > struct EpiBf16 {
    static constexpr bool PERM = true, AFTER_DRAIN = false;
    bf16_t* O; int ldc;
    __device__ __forceinline__ void operator()(const f32x4 (&acc)[2][2][4][2], const Unit& u, int wr, int wc, int fr, int fq) const {
        const int row0 = u.pm * BM + wr * 64 + fr, col0 = u.pn * BM + wc * 32 + 8 * fq;
#pragma unroll
        for (int ai = 0; ai < 2; ++ai)
#pragma unroll
            for (int m = 0; m < 4; ++m) { bf16_t* rowp = O + (size_t)(row0 + ai * HALF + m * 16) * ldc + col0;
#pragma unroll
                for (int bj = 0; bj < 2; ++bj) { f32x4 v0 = acc[ai][bj][m][0], v1 = acc[ai][bj][m][1];
                    if (ACT == 1) {
#pragma unroll
                        for (int j = 0; j < 4; ++j) { const float a = fmaxf(v0[j], 0.f), b = fmaxf(v1[j], 0.f); v0[j] = a * a; v1[j] = b * b; } }
                    u32x4 w; w.x = cvt_pk_bf16(v0[0], v0[1]); w.y = cvt_pk_bf16(v0[2], v0[3]); w.z = cvt_pk_bf16(v1[0], v1[1]); w.w = cvt_pk_bf16(v1[2], v1[3]);
                    __builtin_nontemporal_store(w, (u32x4*)(rowp + bj * HALF)); } }
    }
};
struct EpiResid {
    static constexpr bool PERM = true, AFTER_DRAIN = false;
    const float* xs; float* xd; const float* gate;
    __device__ __forceinline__ void operator()(const f32x4 (&acc)[2][2][4][2], const Unit& u, int wr, int wc, int fr, int fq) const {
        const int row0 = u.pm * BM + wr * 64 + fr, col0 = u.pn * BM + wc * 32 + 8 * fq;
        const float* gp = gate + (size_t)((u.pm * BM) >> 12) * 6144 + col0;
        f32x4 gv[2][2];
#pragma unroll
        for (int bj = 0; bj < 2; ++bj)
#pragma unroll
            for (int n = 0; n < 2; ++n) gv[bj][n] = *(const f32x4*)(gp + bj * HALF + 4 * n);
#pragma unroll
        for (int ai = 0; ai < 2; ++ai)
#pragma unroll
            for (int m = 0; m < 4; ++m) { const size_t off = (size_t)(row0 + ai * HALF + m * 16) * DM + col0;
#pragma unroll
                for (int bj = 0; bj < 2; ++bj)
#pragma unroll
                    for (int n = 0; n < 2; ++n) { const f32x4 xv = *(const f32x4*)(xs + off + bj * HALF + 4 * n);
                        *(f32x4*)(xd + off + bj * HALF + 4 * n) = xv + gv[bj][n] * acc[ai][bj][m][n]; } }
    }
};
template <class Epi, class Sched, bool ALIGN_EPI = false, bool SP2 = false>
__device__ __forceinline__ void gemm_phase(PG8_LAS unsigned char* lds, const Gemm g, const Sched& S, const Epi& E) {
    int tid_ = threadIdx.x; asm volatile("" : "+v"(tid_)); const int tid = tid_, wid = __builtin_amdgcn_readfirstlane(tid >> 6), lane = tid & 63, wr = wid >> 2, wc = wid & 3, fr = lane & 15, fq = lane >> 4;
    const int K = g.K, nt = K / BK;
    unsigned voffA[2], voffB[2];
#pragma unroll
    for (int i = 0; i < 2; ++i) { int R, C; stage_rc(tid * 16 + i * 8192, R, C); const int Rb = Epi::PERM ? ((R & ~31) + perm32(R & 31)) : R;
        voffA[i] = (unsigned)(R * K + C) * 2u; voffB[i] = (unsigned)(Rb * K + C) * 2u; }
    const size_t kstep = (size_t)(BK * 2);
    const size_t hstep = (size_t)HALF * K * 2;
    const size_t tstep = 2 * hstep;
    const unsigned ldsw = (unsigned)wid * 1024u;
    const int aoff = lds_byte(wr * 64 + fr, fq * 8), boff = lds_byte(wc * 32 + fr, fq * 8);
#define PG8_SA(b, h) (((b) * 2 + (h)) * HTB)
#define PG8_SB(b, h) ((4 + (b) * 2 + (h)) * HTB)
#define PG8_STAGE(bufoff, gbase, voff) do { _Pragma("unroll") for (int _i = 0; _i < 2; ++_i) \
        __builtin_amdgcn_global_load_lds((const unsigned*)((const char*)(gbase) + (voff)[_i]), (PG8_LAS unsigned*)(lds + (bufoff) + ldsw + _i * 8192), 16, 0, 0); } while (0)
#define PG8_LDA(dst, b, h) do { _Pragma("unroll") for (int m = 0; m < 4; ++m) _Pragma("unroll") for (int k = 0; k < 2; ++k) dst[m][k] = *(const PG8_LAS bf16x8*)(lds + PG8_SA(b, h) + aoff + m * 2048 + k * 1024); } while (0)
#define PG8_LDB(dst, b, h) do { _Pragma("unroll") for (int n = 0; n < 2; ++n) _Pragma("unroll") for (int k = 0; k < 2; ++k) dst[n][k] = *(const PG8_LAS bf16x8*)(lds + PG8_SB(b, h) + boff + n * 2048 + k * 1024); } while (0)
#define PG8_MMA(ai, bj, At, Bt) do { __builtin_amdgcn_s_setprio(1); _Pragma("unroll") for (int m = 0; m < 4; ++m) _Pragma("unroll") for (int n = 0; n < 2; ++n) _Pragma("unroll") for (int k = 0; k < 2; ++k) \
        acc[ai][bj][m][n] = __builtin_amdgcn_mfma_f32_16x16x32_bf16(Bt[n][k], At[m][k], acc[ai][bj][m][n], 0, 0, 0); __builtin_amdgcn_s_setprio(0); } while (0)
#define PG8_WAIT_V(n) asm volatile("s_waitcnt vmcnt(" #n ")" ::: "memory")
#define PG8_WAIT_L(n) asm volatile("s_waitcnt lgkmcnt(" #n ")" ::: "memory")
#define PG8_BAR __builtin_amdgcn_s_barrier()
#define PG8_SCHED __builtin_amdgcn_sched_barrier(0)
    Unit cur, nxt; int ui = 0;
    if (!S.next(0, cur)) return;
    f32x4 acc[2][2][4][2];
#pragma unroll
    for (int a = 0; a < 2; ++a)
#pragma unroll
        for (int b = 0; b < 2; ++b)
#pragma unroll
            for (int m = 0; m < 4; ++m)
#pragma unroll
                for (int n = 0; n < 2; ++n) acc[a][b][m][n] = (f32x4){0.f, 0.f, 0.f, 0.f};
    bf16x8 At[4][2], B0[2][2], B1[2][2];
    const char* cA = (const char*)g.A + (size_t)cur.pm * tstep; const char* cB = (const char*)g.Bt + (size_t)cur.pn * tstep;
    S.a_ready(cur);
    if constexpr (SP2) {
        PG8_STAGE(PG8_SB(0, 0), cB, voffB); PG8_STAGE(PG8_SB(0, 1), cB + hstep, voffB); PG8_STAGE(PG8_SA(0, 0), cA, voffA); PG8_STAGE(PG8_SA(0, 1), cA + hstep, voffA);
        if (wr == 1) PG8_BAR;
        PG8_WAIT_V(2); PG8_BAR;
        PG8_STAGE(PG8_SB(1, 0), cB + kstep, voffB); PG8_STAGE(PG8_SA(1, 0), cA + kstep, voffA); PG8_STAGE(PG8_SB(1, 1), cB + hstep + kstep, voffB);
        PG8_WAIT_V(6); PG8_BAR;
    } else {
        PG8_STAGE(PG8_SB(0, 0), cB, voffB); PG8_STAGE(PG8_SA(0, 0), cA, voffA); PG8_STAGE(PG8_SB(0, 1), cB + hstep, voffB); PG8_STAGE(PG8_SA(0, 1), cA + hstep, voffA);
        if (wr == 1) PG8_BAR;
        PG8_WAIT_V(4); PG8_BAR;
        PG8_STAGE(PG8_SB(1, 0), cB + kstep, voffB); PG8_STAGE(PG8_SA(1, 0), cA + kstep, voffA); PG8_STAGE(PG8_SB(1, 1), cB + hstep + kstep, voffB);
        PG8_WAIT_V(6); PG8_BAR;
    }
    for (;;) {
        const bool has_next = S.next(ui + 1, nxt);
        const char* nA = has_next ? (const char*)g.A + (size_t)nxt.pm * tstep : cA; const char* nB = has_next ? (const char*)g.Bt + (size_t)nxt.pn * tstep : cB;
        for (int t = 0; t < nt; t += 2) {
            const bool last = (t == nt - 2);
            const char* a1 = cA + (size_t)(t + 1) * kstep;
            const char* a2 = last ? nA : cA + (size_t)(t + 2) * kstep; const char* b2 = last ? nB : cB + (size_t)(t + 2) * kstep;
            const char* a3 = a2 + kstep; const char* b3 = b2 + kstep;
            if (last && has_next) S.a_ready(nxt);
            if constexpr (SP2) {
            PG8_LDB(B0, 0, 0); PG8_LDB(B1, 0, 1); PG8_SCHED; PG8_LDA(At, 0, 0); PG8_STAGE(PG8_SA(1, 1), a1 + hstep, voffA);
            PG8_WAIT_V(8); PG8_WAIT_L(0); PG8_BAR; PG8_MMA(0, 0, At, B0); PG8_MMA(0, 1, At, B1); PG8_BAR; PG8_SCHED;
            PG8_LDA(At, 0, 1); PG8_STAGE(PG8_SB(0, 0), b2, voffB); PG8_STAGE(PG8_SB(0, 1), b2 + hstep, voffB); PG8_STAGE(PG8_SA(0, 0), a2, voffA);
            PG8_WAIT_V(8); PG8_WAIT_L(0); PG8_BAR; PG8_MMA(1, 0, At, B0); PG8_MMA(1, 1, At, B1); PG8_BAR; PG8_SCHED;
            PG8_LDB(B0, 1, 0); PG8_LDB(B1, 1, 1); PG8_SCHED; PG8_LDA(At, 1, 0); PG8_STAGE(PG8_SA(0, 1), a2 + hstep, voffA);
            PG8_WAIT_V(8); PG8_WAIT_L(0); PG8_BAR; PG8_MMA(0, 0, At, B0); PG8_MMA(0, 1, At, B1); PG8_BAR; PG8_SCHED;
            PG8_LDA(At, 1, 1); PG8_STAGE(PG8_SB(1, 0), b3, voffB); PG8_STAGE(PG8_SB(1, 1), b3 + hstep, voffB); PG8_STAGE(PG8_SA(1, 0), a3, voffA);
            PG8_WAIT_V(8); PG8_WAIT_L(0); PG8_BAR; PG8_MMA(1, 0, At, B0); PG8_MMA(1, 1, At, B1); PG8_BAR; PG8_SCHED;
            } else {
            PG8_LDB(B0, 0, 0); PG8_SCHED; PG8_LDA(At, 0, 0); PG8_STAGE(PG8_SA(1, 1), a1 + hstep, voffA);
            PG8_WAIT_L(8); PG8_BAR; PG8_WAIT_L(0); PG8_MMA(0, 0, At, B0); PG8_BAR; PG8_SCHED;
            PG8_LDB(B1, 0, 1); PG8_STAGE(PG8_SB(0, 0), b2, voffB);
            PG8_BAR; PG8_WAIT_L(0); PG8_MMA(0, 1, At, B1); PG8_BAR;
            PG8_LDA(At, 0, 1); PG8_STAGE(PG8_SA(0, 0), a2, voffA);
            PG8_BAR; PG8_WAIT_L(0); PG8_MMA(1, 0, At, B0); PG8_BAR; PG8_SCHED;
            PG8_STAGE(PG8_SB(0, 1), b2 + hstep, voffB);
            PG8_WAIT_V(6); PG8_BAR; PG8_MMA(1, 1, At, B1); PG8_BAR;
            PG8_LDB(B0, 1, 0); PG8_SCHED; PG8_LDA(At, 1, 0); PG8_STAGE(PG8_SA(0, 1), a2 + hstep, voffA);
            PG8_WAIT_L(8); PG8_BAR; PG8_WAIT_L(0); PG8_MMA(0, 0, At, B0); PG8_BAR; PG8_SCHED;
            PG8_LDB(B1, 1, 1); PG8_STAGE(PG8_SB(1, 0), b3, voffB);
            PG8_BAR; PG8_WAIT_L(0); PG8_MMA(0, 1, At, B1); PG8_BAR;
            PG8_LDA(At, 1, 1); PG8_STAGE(PG8_SA(1, 0), a3, voffA);
            PG8_BAR; PG8_WAIT_L(0); PG8_MMA(1, 0, At, B0); PG8_BAR; PG8_SCHED;
            PG8_STAGE(PG8_SB(1, 1), b3 + hstep, voffB);
            PG8_WAIT_V(6); PG8_BAR; PG8_MMA(1, 1, At, B1); PG8_BAR;
            }
        }
        if constexpr (ALIGN_EPI) { if (wr == 0) PG8_BAR; }
        if constexpr (!Epi::AFTER_DRAIN) { E(acc, cur, wr, wc, fr, fq); S.done(cur); }
        if (!has_next) break;
#pragma unroll
        for (int a = 0; a < 2; ++a)
#pragma unroll
            for (int b = 0; b < 2; ++b)
#pragma unroll
                for (int m = 0; m < 4; ++m)
#pragma unroll
                    for (int n = 0; n < 2; ++n) acc[a][b][m][n] = (f32x4){0.f, 0.f, 0.f, 0.f};
        cur = nxt; cA = nA; cB = nB; ++ui;
        if constexpr (ALIGN_EPI) { if (wr == 1) PG8_BAR; }
    }
    PG8_WAIT_V(0);
    if constexpr (!ALIGN_EPI) { if (wr == 0) PG8_BAR; }
    PG8_BAR;
    if constexpr (Epi::AFTER_DRAIN) { E.fused(acc, cur, wr, wc, fr, fq, lds, wid, lane); S.done(cur); }
#undef PG8_SA
#undef PG8_SB
#undef PG8_STAGE
#undef PG8_LDA
#undef PG8_LDB
#undef PG8_MMA
#undef PG8_WAIT_V
#undef PG8_WAIT_L
#undef PG8_BAR
#undef PG8_SCHED
}
}

#ifndef REP_THR
#define REP_THR 1
#endif
#ifndef REP_NORM
#define REP_NORM 1
#endif
#ifndef REP_PRO
#define REP_PRO 1
#endif
#ifndef REP_ATTN
#define REP_ATTN 1
#endif
#ifndef REP_S2
#define REP_S2 1
#endif
#ifndef REP_GEMM
#define REP_GEMM 1
#endif
#ifndef REP_HO
#define REP_HO 1
#endif
__device__ __forceinline__ int ltid() { int t = threadIdx.x; asm volatile("" : "+v"(t)); return t; }
#define TID ltid()

__device__ __forceinline__ void cvt_kind(const float* __restrict__ src, bf16_t* __restrict__ dst, int K, int N, int Npad, LAS float* tl) {
    const int tid = TID, nk = K / 64, nn = Npad / 64, per = nk * nn, total = DEPTH * per;
    for (int t = blockIdx.x; t < total; t += gridDim.x) {
        const int l = t / per, r = t % per, kt = r / nn, nt = r % nn;
        const float* s = src + (size_t)l * K * N; bf16_t* d = dst + (size_t)l * Npad * K;
#pragma unroll
        for (int i = 0; i < 2; ++i) { const int kr = (tid >> 4) + 32 * i, nc = (tid & 15) * 4, n = nt * 64 + nc;
            f32x4 v = (f32x4){0.f, 0.f, 0.f, 0.f};
            if (n < N) v = *(const f32x4*)(s + (size_t)(kt * 64 + kr) * N + n);
            tl[kr * 65 + nc + 0] = v[0]; tl[kr * 65 + nc + 1] = v[1]; tl[kr * 65 + nc + 2] = v[2]; tl[kr * 65 + nc + 3] = v[3]; }
        __syncthreads();
        { const int n = tid >> 3, k8 = (tid & 7) * 8; u32x4 w;
            w.x = cvt_pk_bf16(tl[(k8 + 0) * 65 + n], tl[(k8 + 1) * 65 + n]); w.y = cvt_pk_bf16(tl[(k8 + 2) * 65 + n], tl[(k8 + 3) * 65 + n]);
            w.z = cvt_pk_bf16(tl[(k8 + 4) * 65 + n], tl[(k8 + 5) * 65 + n]); w.w = cvt_pk_bf16(tl[(k8 + 6) * 65 + n], tl[(k8 + 7) * 65 + n]);
            *(u32x4*)(d + (size_t)(nt * 64 + n) * K + kt * 64 + k8) = w; }
        __syncthreads();
    }
}

__device__ __forceinline__ void mod_phase(const Params& p, LAS float* sm) {
    const int tid = TID;
    LAS float* cact = sm; LAS float* red = sm + 8192;
    for (int i = tid; i < NB * DM; i += NTHREADS) cact[i] = siluf_(p.c[i]);
    __syncthreads();
    float* MOD = (float*)(p.ws + WS_MOD);
    for (int it = blockIdx.x; it < DEPTH * 96; it += gridDim.x) {
        const int l = it / 96, j0 = (it % 96) * 64, col = tid & 63, seg = tid >> 6;
        const float* w = p.ada_w + (size_t)l * DM * 6144 + j0 + col;
        float a0 = 0.f, a1 = 0.f, a2 = 0.f, a3 = 0.f, a4 = 0.f, a5 = 0.f, a6 = 0.f, a7 = 0.f;
#pragma unroll 8
        for (int k = seg * 128; k < seg * 128 + 128; ++k) { const float wv = w[(size_t)k * 6144];
            a0 += cact[0 * DM + k] * wv; a1 += cact[1 * DM + k] * wv; a2 += cact[2 * DM + k] * wv; a3 += cact[3 * DM + k] * wv;
            a4 += cact[4 * DM + k] * wv; a5 += cact[5 * DM + k] * wv; a6 += cact[6 * DM + k] * wv; a7 += cact[7 * DM + k] * wv; }
        red[(seg * 8 + 0) * 64 + col] = a0; red[(seg * 8 + 1) * 64 + col] = a1; red[(seg * 8 + 2) * 64 + col] = a2; red[(seg * 8 + 3) * 64 + col] = a3;
        red[(seg * 8 + 4) * 64 + col] = a4; red[(seg * 8 + 5) * 64 + col] = a5; red[(seg * 8 + 6) * 64 + col] = a6; red[(seg * 8 + 7) * 64 + col] = a7;
        __syncthreads();
        { const int b = tid >> 6; float s = p.ada_b[l * 6144 + j0 + col];
#pragma unroll
            for (int sg = 0; sg < 8; ++sg) s += red[(sg * 8 + b) * 64 + col];
            MOD[(size_t)(l * NB + b) * 6144 + j0 + col] = s; }
        __syncthreads();
    }
}

__device__ __forceinline__ void lb_phase(const Params& p) {
    if (blockIdx.x != 0) return;
    const int k = TID; float* LB = (float*)(p.ws + WS_LB);
    const float v0 = p.lb_logits[k], v1 = p.lb_logits[512 + k], v2 = p.lb_logits[1024 + k], v3 = p.lb_logits[1536 + k];
    const float mx = fmaxf(fmaxf(v0, v1), fmaxf(v2, v3));
    const float e0 = expf(v0 - mx), e1 = expf(v1 - mx), e2 = expf(v2 - mx), e3 = expf(v3 - mx), inv = 1.f / (e0 + e1 + e2 + e3);
    const float p0 = e0 * inv, p1 = e1 * inv, p2 = e2 * inv, p3 = e3 * inv;
    LB[k] = p0 - p0; LB[512 + k] = (p0 + p1) - p0; LB[1024 + k] = ((p0 + p1) + p2) - p0; LB[1536 + k] = (((p0 + p1) + p2) + p3) - p0;
}

__device__ __forceinline__ void rmsnorm_mod(const float* __restrict__ xs, const float* __restrict__ w, const float* __restrict__ mod, int sh_off, int sc_off, bf16_t* __restrict__ dst) {
    const int tid = TID, wave = tid >> 6, lane = tid & 63;
    const int row0 = blockIdx.x * 8 + wave, rstep = gridDim.x * 8;
    f32x4 v[4], nv[4];
    if (row0 < NTOK) {
#pragma unroll
        for (int i = 0; i < 4; ++i) nv[i] = *(const f32x4*)(xs + (size_t)row0 * DM + i * 256 + lane * 4); }
    for (int row = row0; row < NTOK; row += rstep) {
        float ss = 0.f;
#pragma unroll
        for (int i = 0; i < 4; ++i) { v[i] = nv[i]; ss += v[i][0] * v[i][0] + v[i][1] * v[i][1] + v[i][2] * v[i][2] + v[i][3] * v[i][3]; }
        if (row + rstep < NTOK) {
#pragma unroll
            for (int i = 0; i < 4; ++i) nv[i] = *(const f32x4*)(xs + (size_t)(row + rstep) * DM + i * 256 + lane * 4); }
        ss = wave_sum(ss);
        const float rstd = rsqrtf(ss * (1.f / DM) + EPS);
        const float* mb = mod + (size_t)(row >> 12) * 6144;
#pragma unroll
        for (int i = 0; i < 4; ++i) { const int col = i * 256 + lane * 4;
            const f32x4 ww = *(const f32x4*)(w + col), sc = *(const f32x4*)(mb + sc_off + col), sh = *(const f32x4*)(mb + sh_off + col);
            const f32x4 h = (v[i] * rstd * ww) * (sc + 1.f) + sh;
            u32x2 o; o.x = cvt_pk_bf16(h[0], h[1]); o.y = cvt_pk_bf16(h[2], h[3]);
            *(u32x2*)(dst + (size_t)row * DM + col) = o; }
    }
}
__device__ __forceinline__ void final_norm(float* __restrict__ x, const float* __restrict__ w) {
    const int tid = TID, wave = tid >> 6, lane = tid & 63;
    for (int row = blockIdx.x * 8 + wave; row < NTOK; row += gridDim.x * 8) {
        float* xr = x + (size_t)row * DM; f32x4 v[4]; float ss = 0.f;
#pragma unroll
        for (int i = 0; i < 4; ++i) { v[i] = *(const f32x4*)(xr + i * 256 + lane * 4); ss += v[i][0] * v[i][0] + v[i][1] * v[i][1] + v[i][2] * v[i][2] + v[i][3] * v[i][3]; }
        ss = wave_sum(ss);
        const float rstd = rsqrtf(ss * (1.f / DM) + EPS);
#pragma unroll
        for (int i = 0; i < 4; ++i) { const int col = i * 256 + lane * 4; const f32x4 ww = *(const f32x4*)(w + col); *(f32x4*)(xr + col) = v[i] * rstd * ww; }
    }
}

__device__ __forceinline__ void vt_item(const Params& p, int b, int tt, LAS unsigned char* sm) {
    const int tid = TID; LAS bf16_t* vb = (LAS bf16_t*)sm;
    const bf16_t* proj = (const bf16_t*)(p.ws + WS_BIG) + (size_t)(b * SEQ + tt * 64) * DINP + OFF_SV;
#pragma unroll
    for (int i = 0; i < 4; ++i) { const int idx = tid + NTHREADS * i, row = idx >> 5, c8 = (idx & 31) * 8;
        *(LAS bf16x8*)(vb + row * 264 + c8) = *(const bf16x8*)(proj + (size_t)row * DINP + c8); }
    __syncthreads();
    { const int col = tid >> 1, half = tid & 1;
        bf16_t* dst = (bf16_t*)(p.ws + WS_VT) + ((size_t)(b * 4 + (col >> 6)) * 64 + (col & 63)) * SEQ + tt * 64 + half * 32;
#pragma unroll
        for (int i = 0; i < 4; ++i) { bf16x8 o;
#pragma unroll
            for (int e = 0; e < 8; ++e) o[e] = (short)vb[(half * 32 + i * 8 + e) * 264 + col];
            *(bf16x8*)(dst + i * 8) = o; } }
    __syncthreads();
}

__device__ __forceinline__ void conv_item(const Params& p, int l, int b, int tt, LAS unsigned char* sm) {
    const int tid = TID; LAS float* hb = (LAS float*)sm;
    LAS float* ob = (LAS float*)(sm + 62 * 256 * 4);
    const int t0 = tt * 32;
    const bf16_t* proj = (const bf16_t*)(p.ws + WS_BIG) + (size_t)b * SEQ * DINP + OFF_CU;
#pragma unroll
    for (int i = 0; i < 4; ++i) { const int idx = tid + NTHREADS * i;
        if (idx < 62 * 32) { const int row = idx >> 5, c8 = (idx & 31) * 8, t = t0 - 30 + row;
            f32x4 h0 = (f32x4){0.f, 0.f, 0.f, 0.f}, h1 = h0;
            if (t >= 0) { const bf16x8 a = *(const bf16x8*)(proj + (size_t)t * DINP + c8), g = *(const bf16x8*)(proj + (size_t)t * DINP + 256 + c8);
#pragma unroll
                for (int j = 0; j < 4; ++j) { h0[j] = bf2f(a[j]) * sigmoidf_(bf2f(g[j])); h1[j] = bf2f(a[4 + j]) * sigmoidf_(bf2f(g[4 + j])); } }
            *(LAS f32x4*)(hb + row * 256 + c8) = h0; *(LAS f32x4*)(hb + row * 256 + c8 + 4) = h1; } }
    __syncthreads();
    { const int ch = tid & 255, half = tid >> 8;
        float w[31];
#pragma unroll
        for (int j = 0; j < 31; ++j) w[j] = p.cv_w[(size_t)(l * 31 + j) * 256 + ch];
        const float bias = p.cv_b[l * 256 + ch];
        float o[16];
#pragma unroll
        for (int i = 0; i < 16; ++i) o[i] = bias;
#pragma unroll
        for (int r = 0; r < 46; ++r) { const float hv = hb[(half * 16 + r) * 256 + ch];
#pragma unroll
            for (int i = 0; i < 16; ++i) { const int j = r - i; if (j >= 0 && j <= 30) o[i] = fmaf(hv, w[j], o[i]); } }
#pragma unroll
        for (int i = 0; i < 16; ++i) ob[(half * 16 + i) * 256 + ch] = o[i]; }
    __syncthreads();
    { const int wave = tid >> 6, lane = tid & 63;
        const f32x4 lw = *(const f32x4*)(p.cv_ln_w + l * 256 + lane * 4), lbv = *(const f32x4*)(p.cv_ln_b + l * 256 + lane * 4);
        bf16_t* mix = (bf16_t*)(p.ws + WS_HB);
#pragma unroll
        for (int i = 0; i < 4; ++i) { const int tl = wave * 4 + i;
            const f32x4 xv = *(LAS f32x4*)(ob + tl * 256 + lane * 4);
            const float mu = wave_sum(xv[0] + xv[1] + xv[2] + xv[3]) * (1.f / 256.f);
            const f32x4 dv = xv - mu;
            const float var = wave_sum(dv[0] * dv[0] + dv[1] * dv[1] + dv[2] * dv[2] + dv[3] * dv[3]) * (1.f / 256.f);
            const float rs = rsqrtf(var + EPS);
            const f32x4 y = dv * rs * lw + lbv;
            u32x2 o2; o2.x = cvt_pk_bf16(siluf_(y[0]), siluf_(y[1])); o2.y = cvt_pk_bf16(siluf_(y[2]), siluf_(y[3]));
            *(u32x2*)(mix + (size_t)(b * SEQ + t0 + tl) * DM + 768 + lane * 4) = o2; } }
    __syncthreads();
}

constexpr float IDX_WSCALE = 0.35355339059327373f * 0.17677669529663687f;
__device__ __forceinline__ f32x4 idx_scores(const bf16x8 ka, const bf16x8 (&qi)[8], const float (&wq)[8]) {
    f32x4 s = (f32x4){0.f, 0.f, 0.f, 0.f};
#pragma unroll
    for (int h = 0; h < 8; ++h) { const f32x4 d = mfma16(ka, qi[h], (f32x4){0.f, 0.f, 0.f, 0.f});
#pragma unroll
        for (int r = 0; r < 4; ++r) s[r] = __builtin_fmaf(wq[h], fmaxf(d[r], 0.f), s[r]); }
    return s;
}

__device__ __forceinline__ void cnt_ge(int& cn, unsigned a, unsigned b) { asm("v_cmp_ge_u32 vcc, %1, %2\n\tv_addc_co_u32 %0, vcc, 0, %0, vcc" : "+v"(cn) : "v"(a), "v"(b) : "vcc"); }
__device__ __forceinline__ void cnt_ge16(int& cn, const unsigned (&A)[4], const unsigned (&B)[4], const unsigned (&C)[4], const unsigned (&D)[4], unsigned b) {
#define CG_(n) "v_cmp_ge_u32 vcc, %" #n ", %17\n\tv_addc_co_u32 %0, vcc, 0, %0, vcc\n\t"
    asm(CG_(1) CG_(2) CG_(3) CG_(4) CG_(5) CG_(6) CG_(7) CG_(8) CG_(9) CG_(10) CG_(11) CG_(12) CG_(13) CG_(14) CG_(15) CG_(16)
        : "+v"(cn) : "v"(A[0]), "v"(A[1]), "v"(A[2]), "v"(A[3]), "v"(B[0]), "v"(B[1]), "v"(B[2]), "v"(B[3]), "v"(C[0]), "v"(C[1]), "v"(C[2]), "v"(C[3]), "v"(D[0]), "v"(D[1]), "v"(D[2]), "v"(D[3]), "v"(b) : "vcc");
#undef CG_
}
constexpr int TH_ROW = 40, TH_BUF = 1024 * TH_ROW * 2, TH_CNT = TH_BUF;
__device__ __forceinline__ void thr_item(const Params& p, int b, int qt, LAS unsigned char* sm) {
    const int tid = TID, w = __builtin_amdgcn_readfirstlane(tid >> 6), l = tid & 63, c16 = l & 15, g = l >> 4;
    LAS unsigned* cnt = (LAS unsigned*)(sm + TH_CNT);
    const bf16_t* proj = (const bf16_t*)(p.ws + WS_BIG) + (size_t)b * SEQ * DINP;
    const int q = qt * 16 + c16;
    const bf16_t* qrow = proj + (size_t)q * DINP;
    bf16x8 qi[8]; float wq[8];
#pragma unroll
    for (int h = 0; h < 8; ++h) qi[h] = *(const bf16x8*)(qrow + OFF_IQ + h * 32 + g * 8);
    { const bf16x8 wv = *(const bf16x8*)(qrow + OFF_IW);
#pragma unroll
        for (int h = 0; h < 8; ++h) wq[h] = bf2f(wv[h]) * IDX_WSCALE; }
    unsigned sc[32][4];
    const int ni = (qt >= w) ? ((qt - w) >> 3) + 1 : 0;
    const int nchunk = (qt >> 6) + 1;
    const bf16_t* gsrc = proj + (size_t)(tid >> 2) * DINP + OFF_IK + (tid & 3) * 8;
    const int ldst = (tid >> 2) * TH_ROW + (tid & 3) * 8;
    bf16x8 stg[8];
#define TH_LOAD(ck_) do { const bf16_t* s_ = gsrc + (size_t)(ck_) * 1024 * DINP; _Pragma("unroll") for (int m_ = 0; m_ < 8; ++m_) stg[m_] = *(const bf16x8*)(s_ + (size_t)(128 * m_) * DINP); } while (0)
#define TH_STORE() do { LAS bf16_t* d_ = (LAS bf16_t*)sm + ldst; _Pragma("unroll") for (int m_ = 0; m_ < 8; ++m_) *(LAS bf16x8*)(d_ + 128 * m_ * TH_ROW) = stg[m_]; } while (0)
    TH_LOAD(0);
    for (int i = tid; i < 48 * 16; i += NTHREADS) cnt[i] = 0u;
#pragma unroll
    for (int ck = 0; ck < 4; ++ck) {
        if (ck < nchunk) {
            TH_STORE();
            __syncthreads();
            if (ck + 1 < nchunk) TH_LOAD(ck + 1);
            LAS bf16_t* B = (LAS bf16_t*)sm;
#pragma unroll
            for (int j = 0; j < 8; ++j) { const int i = ck * 8 + j, kt = w + 8 * i;
                if (kt <= qt) { const bf16x8 ka = *(LAS bf16x8*)(B + ((j * 8 + w) * 16 + c16) * TH_ROW + g * 8);
                    const f32x4 s = idx_scores(ka, qi, wq);
#pragma unroll
                    for (int r = 0; r < 4; ++r) { const int key = kt * 16 + 4 * g + r; sc[i][r] = (key <= q) ? sortable(s[r]) : 0u; }
                } else { sc[i][0] = 0u; sc[i][1] = 0u; sc[i][2] = 0u; sc[i][3] = 0u; } }
            if (ck + 1 < nchunk) __syncthreads();
        } else {
#pragma unroll
            for (int j = 0; j < 8; ++j) { sc[ck * 8 + j][0] = 0u; sc[ck * 8 + j][1] = 0u; sc[ck * 8 + j][2] = 0u; sc[ck * 8 + j][3] = 0u; }
        }
    }
#undef TH_LOAD
#undef TH_STORE
#define TH_XCHG(tot_) do { __hip_atomic_fetch_add(&cnt[it * 16 + c16], (unsigned)cn, __ATOMIC_RELAXED, __HIP_MEMORY_SCOPE_WORKGROUP); __syncthreads(); tot_ = (int)cnt[it * 16 + c16]; } while (0)
    unsigned T = 0u; bool done = false; int it = 0;
    for (; it < 32; ++it) {
        const unsigned cand = T | (1u << (31 - it)); int cn = 0;
#pragma unroll
        for (int gi = 0; gi < 4; ++gi) if (ni > 8 * gi) {
#pragma unroll
            for (int i = 8 * gi; i < 8 * gi + 8; i += 4) cnt_ge16(cn, sc[i], sc[i + 1], sc[i + 2], sc[i + 3], cand); }
        int tot; TH_XCHG(tot);
        if (!done) { if (tot >= TOPK) T = cand; if (tot == TOPK) done = true; }
        if (__all(done)) { ++it; break; }
    }
    unsigned ceq = 4095u; bool tied = false;
    const bool open = !done && (T != 0u);
    if (!__all(!open)) {
        int ngt = 0, nge = 0;
        for (int e = 0; e < 2; ++e, ++it) {
            const unsigned cand = (e == 0) ? T + 1u : T; int cn = 0;
#pragma unroll
            for (int gi = 0; gi < 4; ++gi) if (ni > 8 * gi) {
#pragma unroll
            for (int i = 8 * gi; i < 8 * gi + 8; ++i) { cnt_ge(cn, sc[i][0], cand); cnt_ge(cn, sc[i][1], cand); cnt_ge(cn, sc[i][2], cand); cnt_ge(cn, sc[i][3], cand); } }
            int tot; TH_XCHG(tot);
            if (e == 0) ngt = tot; else nge = tot;
        }
        const int need = TOPK - ngt; const bool excess = open && (nge - ngt > need);
#pragma unroll
        for (int i = 0; i < 32; ++i)
#pragma unroll
            for (int r = 0; r < 4; ++r) sc[i][r] = (sc[i][r] == T) ? (unsigned)((w + 8 * i) * 16 + 4 * g + r) : (sc[i][r] > T ? 0xfffffffeu : 0xffffffffu);
        unsigned c = 0u;
        for (int s = 0; s < 12; ++s, ++it) {
            const unsigned cand = c | (1u << (11 - s)); int cn = 0;
#pragma unroll
            for (int gi = 0; gi < 4; ++gi) if (ni > 8 * gi) {
#pragma unroll
                for (int i = 8 * gi; i < 8 * gi + 8; ++i) { cnt_ge(cn, cand - 1u, sc[i][0]); cnt_ge(cn, cand - 1u, sc[i][1]); cnt_ge(cn, cand - 1u, sc[i][2]); cnt_ge(cn, cand - 1u, sc[i][3]); } }
            int tot; TH_XCHG(tot);
            if (tot < need) c = cand;
        }
        if (excess) ceq = c;
        tied = true;
    }
#undef TH_XCHG
    LAS unsigned* lm = (LAS unsigned*)sm;
    __syncthreads();
    for (int i = tid; i < 2048; i += NTHREADS) lm[i] = 0u;
    __syncthreads();
    { const unsigned Tm = T > 1u ? T : 1u; const bool allow_eq = (T != 0u);
#pragma unroll
        for (int gi = 0; gi < 4; ++gi) if (ni > 8 * gi) {
#pragma unroll
            for (int i = 8 * gi; i < 8 * gi + 8; ++i) { unsigned nib = 0u;
#pragma unroll
                for (int r = 0; r < 4; ++r) { const unsigned v = sc[i][r];
                    const bool s_ = tied ? ((v == 0xfffffffeu) || (allow_eq && v <= ceq)) : (v >= Tm);
                    nib |= s_ ? (1u << r) : 0u; }
                const int kt = w + 8 * i;
                if (nib) __hip_atomic_fetch_or(&lm[c16 * 128 + (kt >> 1)], nib << (4 * g + 16 * (kt & 1)), __ATOMIC_RELAXED, __HIP_MEMORY_SCOPE_WORKGROUP); } }
    }
    __syncthreads();
    { unsigned* gm = (unsigned*)(p.ws + WS_MASK) + (size_t)(b * SEQ + qt * 16) * 128;
        *(u32x4*)(gm + tid * 4) = *(LAS u32x4*)(lm + tid * 4); }
    __syncthreads();
}

constexpr int AT_KROW = 264, AT_IROW = 40, AT_VROW = 40;
constexpr int AT_OFFI = 32 * AT_KROW * 2, AT_OFFV = AT_OFFI + 32 * AT_IROW * 2, AT_BUF = AT_OFFV + 256 * AT_VROW * 2;
__device__ __forceinline__ int at_row(int r) { return (r & 3) + 4 * ((r >> 3) & 3) + 16 * ((r >> 2) & 1); }
__device__ __forceinline__ void attn_item(const Params& p, int b, int qb, LAS unsigned char* sm) {
    const int tid = TID, w = __builtin_amdgcn_readfirstlane(tid >> 6), l = tid & 63, c16 = l & 15, g = l >> 4, qs = w & 3, hp = w >> 2;
    const bf16_t* proj = (const bf16_t*)(p.ws + WS_BIG) + (size_t)b * SEQ * DINP;
    const bf16_t* vt = (const bf16_t*)(p.ws + WS_VT) + (size_t)b * 4 * 64 * SEQ;
    const int q = qb * 64 + qs * 16 + c16;
    const bf16_t* qrow = proj + (size_t)q * DINP;
    const unsigned* mrow = (const unsigned*)(p.ws + WS_MASK) + (size_t)(b * SEQ + q) * 128;
    bf16x8 Qb[2][2];
#pragma unroll
    for (int hh = 0; hh < 2; ++hh)
#pragma unroll
        for (int kk = 0; kk < 2; ++kk) { const bf16x8 raw = *(const bf16x8*)(qrow + OFF_SQ + (2 * hp + hh) * 64 + kk * 32 + g * 8); bf16x8 o;
#pragma unroll
            for (int e = 0; e < 8; ++e) o[e] = (short)f2bf(bf2f(raw[e]) * 0.125f);
            Qb[hh][kk] = o; }
    f32x4 O[2][4];
#pragma unroll
    for (int hh = 0; hh < 2; ++hh)
#pragma unroll
        for (int dt = 0; dt < 4; ++dt) O[hh][dt] = (f32x4){0.f, 0.f, 0.f, 0.f};
    float mrun[2] = {-1e30f, -1e30f}, lrun[2] = {0.f, 0.f};
    const int nt = 2 * qb + 2, my_nt = (qb * 64 + qs * 16 + 15) / 32 + 1;
    const int kr0 = tid >> 5, kc = (tid & 31) * 8, vr0 = tid >> 2, vc = (tid & 3) * 8;
    const bf16_t* gK = proj + (size_t)kr0 * DINP + OFF_SK + kc;
    const bf16_t* gV = vt + (size_t)vr0 * SEQ + vc;
    const int lK0 = at_row(kr0) * AT_KROW + kc, lK1 = at_row(kr0 + 16) * AT_KROW + kc;
    const int lV0 = AT_OFFV / 2 + vr0 * AT_VROW + vc, lV1 = AT_OFFV / 2 + (vr0 + 128) * AT_VROW + vc;
    bf16x8 sA[4], sB[4]; unsigned mw = 0u, mwA = 0u, mwB = 0u;
#define AT_LOAD(S_, M_, k0_) do { S_[0] = *(const bf16x8*)(gK + (size_t)(k0_) * DINP); S_[1] = *(const bf16x8*)(gK + (size_t)((k0_) + 16) * DINP); \
        M_ = mrow[(k0_) >> 5]; S_[2] = *(const bf16x8*)(gV + (k0_)); S_[3] = *(const bf16x8*)(gV + (size_t)128 * SEQ + (k0_)); } while (0)
#define AT_STORE(S_, buf_) do { LAS bf16_t* B_ = (LAS bf16_t*)(sm + (buf_) * AT_BUF); *(LAS bf16x8*)(B_ + lK0) = S_[0]; *(LAS bf16x8*)(B_ + lK1) = S_[1]; \
        *(LAS bf16x8*)(B_ + lV0) = S_[2]; *(LAS bf16x8*)(B_ + lV1) = S_[3]; } while (0)
    AT_LOAD(sA, mwA, 0); AT_STORE(sA, 0); mw = mwA;
    AT_LOAD(sB, mwB, 32);
    __syncthreads();
    for (int t2 = 0; t2 < nt; t2 += 2) {
#pragma unroll
      for (int par = 0; par < 2; ++par) {
        const int t = t2 + par, k0 = t * 32;
        if (t + 2 < nt) { if (par == 0) AT_LOAD(sA, mwA, k0 + 64); else AT_LOAD(sB, mwB, k0 + 64); }
        if (t < my_nt) {
            LAS bf16_t* Bk = (LAS bf16_t*)(sm + par * AT_BUF); LAS bf16_t* Bv = Bk + AT_OFFV / 2;
            bool sel[2][4]; float lg[2][2][4];
#pragma unroll
            for (int s = 0; s < 2; ++s) {
                const int lrow = 16 * s + c16;
#pragma unroll
                for (int r = 0; r < 4; ++r) sel[s][r] = ((mw >> (8 * g + 4 * s + r)) & 1u) != 0u;
#pragma unroll
                for (int hh = 0; hh < 2; ++hh) { f32x4 S = (f32x4){0.f, 0.f, 0.f, 0.f};
#pragma unroll
                    for (int kk = 0; kk < 2; ++kk) { const bf16x8 kf = *(LAS bf16x8*)(Bk + lrow * AT_KROW + (2 * hp + hh) * 64 + kk * 32 + g * 8); S = mfma16(kf, Qb[hh][kk], S); }
#pragma unroll
                    for (int r = 0; r < 4; ++r) lg[hh][s][r] = S[r]; }
            }
#pragma unroll
            for (int hh = 0; hh < 2; ++hh) {
                float lm_[8];
#pragma unroll
                for (int s = 0; s < 2; ++s)
#pragma unroll
                    for (int r = 0; r < 4; ++r) lm_[s * 4 + r] = sel[s][r] ? lg[hh][s][r] : -1e30f;
                float mx = fmaxf(fmaxf(fmaxf(lm_[0], lm_[1]), fmaxf(lm_[2], lm_[3])), fmaxf(fmaxf(lm_[4], lm_[5]), fmaxf(lm_[6], lm_[7])));
                mx = xrow16_max(mx);
                const float mn = fmaxf(mrun[hh], mx), alpha = __expf(mrun[hh] - mn), mn2 = mn * 1.4426950408889634f;
                mrun[hh] = mn;
                float pv[8]; float ps = 0.f;
#pragma unroll
                for (int e = 0; e < 8; ++e) { pv[e] = (mn > -1e29f) ? __builtin_amdgcn_exp2f(__builtin_fmaf(lm_[e], 1.4426950408889634f, -mn2)) : 0.f; ps += pv[e]; }
                lrun[hh] = lrun[hh] * alpha + ps;
                union { bf16x8 v; unsigned u[4]; } pb;
                pb.u[0] = cvt_pk_bf16(pv[0], pv[1]); pb.u[1] = cvt_pk_bf16(pv[2], pv[3]); pb.u[2] = cvt_pk_bf16(pv[4], pv[5]); pb.u[3] = cvt_pk_bf16(pv[6], pv[7]);
                if (__any(alpha != 1.f)) {
#pragma unroll
                    for (int dt = 0; dt < 4; ++dt) O[hh][dt] = O[hh][dt] * alpha; }
                bf16x8 va4[4];
#pragma unroll
                for (int dt = 0; dt < 4; ++dt) va4[dt] = *(LAS bf16x8*)(Bv + ((2 * hp + hh) * 64 + dt * 16 + c16) * AT_VROW + g * 8);
                __builtin_amdgcn_s_setprio(1);
#pragma unroll
                for (int dt = 0; dt < 4; ++dt) O[hh][dt] = mfma16(va4[dt], pb.v, O[hh][dt]);
                __builtin_amdgcn_s_setprio(0);
            }
        }
        if (t + 1 < nt) { if (par == 0) { AT_STORE(sB, 1); mw = mwB; } else { AT_STORE(sA, 0); mw = mwA; } }
        __syncthreads();
      }
    }
#undef AT_LOAD
#undef AT_STORE
    bf16_t* mix = (bf16_t*)(p.ws + WS_HB) + (size_t)(b * SEQ + q) * DM + 512;
#pragma unroll
    for (int hh = 0; hh < 2; ++hh) { const float tot = xrow16_sum(lrun[hh]);
        const float inv = 1.f / tot;
#pragma unroll
        for (int dt = 0; dt < 4; ++dt) { const f32x4 o = O[hh][dt] * inv; u32x2 o2; o2.x = cvt_pk_bf16(o[0], o[1]); o2.y = cvt_pk_bf16(o[2], o[3]);
            *(u32x2*)(mix + (2 * hp + hh) * 64 + dt * 16 + 4 * g) = o2; } }
}

__device__ __forceinline__ void hgrn_G(const bf16x8 (&fv)[2], const float* lb, LAS float* Gs, LAS float* segtot) {
    const int tid = TID;
#pragma unroll
    for (int i = 0; i < 2; ++i) { const int row = (tid >> 4) + 32 * i, c8 = (tid & 15) * 8;
        const bf16x8 v = fv[i];
#pragma unroll
        for (int j = 0; j < 8; ++j) { const float fr = bf2f(v[j]), lbv = lb[c8 + j]; const float f = lbv + (1.f - lbv) * sigmoidf_(fr);
            Gs[row * 129 + c8 + j] = __builtin_amdgcn_logf(fmaxf(f, 1e-30f)); } }
    __syncthreads();
    const int col = tid & 127, seg = tid >> 7;
    { float run = 0.f;
#pragma unroll
        for (int r = 0; r < 16; ++r) { const int idx = (seg * 16 + r) * 129 + col; run += Gs[idx]; Gs[idx] = run; }
        segtot[seg * 128 + col] = run; }
    __syncthreads();
    { float off = 0.f;
#pragma unroll
        for (int s = 0; s < 3; ++s) if (s < seg) off += segtot[s * 128 + col];
        if (seg > 0) {
#pragma unroll
            for (int r = 0; r < 16; ++r) Gs[(seg * 16 + r) * 129 + col] += off; } }
    __syncthreads();
}

__device__ __forceinline__ void hgrn_A_item(const Params& p, int l, int b, int h, int c, LAS unsigned char* sm) {
    const int tid = TID, w = __builtin_amdgcn_readfirstlane(tid >> 6), ln = tid & 63, c16 = ln & 15, g = ln >> 4;
    LAS float* Gs = (LAS float*)sm; LAS float* segtot = (LAS float*)(sm + 33024);
    LAS bf16_t* KgT = (LAS bf16_t*)(sm + 35072); LAS bf16_t* vT = (LAS bf16_t*)(sm + 53504);
    LAS bf16_t* qt_ = (LAS bf16_t*)(sm + 71936); LAS bf16_t* kt_ = (LAS bf16_t*)(sm + 89344); LAS bf16_t* Am = (LAS bf16_t*)(sm + 106752);
    bf16_t* prow0 = (bf16_t*)(p.ws + WS_BIG) + (size_t)(b * SEQ + c * 64) * DINP;
    const float* lb = (const float*)(p.ws + WS_LB) + l * 512 + h * 128;
    bf16x8 fG[2], qG[2];
#pragma unroll
    for (int i = 0; i < 2; ++i) { const bf16_t* rq = prow0 + (size_t)((tid >> 4) + 32 * i) * DINP + h * 128 + (tid & 15) * 8; fG[i] = *(const bf16x8*)(rq + OFF_HF); qG[i] = *(const bf16x8*)(rq + OFF_HQ); }
    const bf16_t* rp = prow0 + (size_t)(tid & 63) * DINP + h * 128 + (tid >> 6) * 16;
    const bf16x8 f0 = *(const bf16x8*)(rp + OFF_HF), f1 = *(const bf16x8*)(rp + OFF_HF + 8), v0 = *(const bf16x8*)(rp + OFF_HI), v1 = *(const bf16x8*)(rp + OFF_HI + 8);
    hgrn_G(fG, lb, Gs, segtot);
#pragma unroll
    for (int i = 0; i < 2; ++i) { const int row = (tid >> 4) + 32 * i, c8 = (tid & 15) * 8;
        const bf16x8 qv8 = qG[i], fv8 = fG[i];
        float a[8], bq[8], cq[8];
#pragma unroll
        for (int j = 0; j < 8; ++j) { const int k = c8 + j; const float G = Gs[row * 129 + k], Gm = Gs[31 * 129 + k], lbv = lb[k];
            const float qv = siluf_(bf2f(qv8[j])) * 0.08838834764831845f, kval = (1.f - lbv) * sigmoidf_(-bf2f(fv8[j]));
            a[j] = qv * __builtin_amdgcn_exp2f(fminf(G - Gm, 115.f)); bq[j] = kval * __builtin_amdgcn_exp2f(fminf(Gm - G, 115.f)); cq[j] = qv * __builtin_amdgcn_exp2f(G); }
        u32x4 o;
        o.x = cvt_pk_bf16(a[0], a[1]); o.y = cvt_pk_bf16(a[2], a[3]); o.z = cvt_pk_bf16(a[4], a[5]); o.w = cvt_pk_bf16(a[6], a[7]); *(LAS u32x4*)(qt_ + row * 136 + c8) = o;
        o.x = cvt_pk_bf16(bq[0], bq[1]); o.y = cvt_pk_bf16(bq[2], bq[3]); o.z = cvt_pk_bf16(bq[4], bq[5]); o.w = cvt_pk_bf16(bq[6], bq[7]); *(LAS u32x4*)(kt_ + row * 136 + c8) = o;
        o.x = cvt_pk_bf16(cq[0], cq[1]); o.y = cvt_pk_bf16(cq[2], cq[3]); o.z = cvt_pk_bf16(cq[4], cq[5]); o.w = cvt_pk_bf16(cq[6], cq[7]);
        *(u32x4*)(prow0 + (size_t)row * DINP + OFF_HQ + h * 128 + c8) = o; }
    { const int j = tid & 63, kg = tid >> 6;
#pragma unroll
        for (int e = 0; e < 16; ++e) { const int k = kg * 16 + e; const float fr = bf2f(e < 8 ? f0[e & 7] : f1[e & 7]), lbv = lb[k];
            const float kval = (1.f - lbv) * sigmoidf_(-fr);
            KgT[k * 72 + j] = f2bf(kval * __builtin_amdgcn_exp2f(Gs[63 * 129 + k] - Gs[j * 129 + k]));
            vT[k * 72 + j] = (bf16_t)(e < 8 ? v0[e & 7] : v1[e & 7]); } }
    const size_t bhc = (size_t)((b * 4 + h) * 64 + c);
    if (tid < 128) ((float*)(p.ws + WS_DEC))[bhc * 128 + tid] = __builtin_amdgcn_exp2f(Gs[63 * 129 + tid]);
    __syncthreads();
    { f32x4 acc[8];
#pragma unroll
        for (int vt = 0; vt < 8; ++vt) acc[vt] = (f32x4){0.f, 0.f, 0.f, 0.f};
#pragma unroll
        for (int kk = 0; kk < 2; ++kk) { const bf16x8 a = *(LAS bf16x8*)(KgT + (w * 16 + c16) * 72 + kk * 32 + g * 8);
#pragma unroll
            for (int vt = 0; vt < 8; ++vt) { const bf16x8 bb = *(LAS bf16x8*)(vT + (vt * 16 + c16) * 72 + kk * 32 + g * 8); acc[vt] = mfma16(a, bb, acc[vt]); } }
        bf16_t* st = (bf16_t*)(p.ws + WS_ST) + bhc * 16384;
#pragma unroll
        for (int vt = 0; vt < 8; ++vt) { u32x2 o; o.x = cvt_pk_bf16(acc[vt][0], acc[vt][1]); o.y = cvt_pk_bf16(acc[vt][2], acc[vt][3]);
            *(u32x2*)(st + (size_t)(vt * 16 + c16) * 128 + w * 16 + 4 * g) = o; } }
#pragma unroll
    for (int s = 0; s < 2; ++s) { const int tI = w * 2 + s, itile = tI >> 2, jt = tI & 3;
        f32x4 d = (f32x4){0.f, 0.f, 0.f, 0.f};
        if (jt <= itile) {
#pragma unroll
            for (int kk = 0; kk < 4; ++kk) { const bf16x8 a = *(LAS bf16x8*)(kt_ + (jt * 16 + c16) * 136 + kk * 32 + g * 8), bb = *(LAS bf16x8*)(qt_ + (itile * 16 + c16) * 136 + kk * 32 + g * 8);
                d = mfma16(a, bb, d); } }
        const int i = itile * 16 + c16, j0 = jt * 16 + 4 * g;
        u32x2 o; o.x = cvt_pk_bf16((j0 + 0 <= i) ? d[0] : 0.f, (j0 + 1 <= i) ? d[1] : 0.f); o.y = cvt_pk_bf16((j0 + 2 <= i) ? d[2] : 0.f, (j0 + 3 <= i) ? d[3] : 0.f);
        *(LAS u32x2*)(Am + i * 72 + j0) = o; }
    __syncthreads();
    { const int itile = w & 3, vh = w >> 2;
        f32x4 acc[4];
#pragma unroll
        for (int vt = 0; vt < 4; ++vt) acc[vt] = (f32x4){0.f, 0.f, 0.f, 0.f};
#pragma unroll
        for (int kk = 0; kk < 2; ++kk) { const bf16x8 bb = *(LAS bf16x8*)(Am + (itile * 16 + c16) * 72 + kk * 32 + g * 8);
#pragma unroll
            for (int vt = 0; vt < 4; ++vt) { const bf16x8 a = *(LAS bf16x8*)(vT + ((vh * 4 + vt) * 16 + c16) * 72 + kk * 32 + g * 8); acc[vt] = mfma16(a, bb, acc[vt]); } }
        bf16_t* mix = (bf16_t*)(p.ws + WS_HB) + (size_t)(b * SEQ + c * 64 + itile * 16 + c16) * DM + h * 128;
#pragma unroll
        for (int vt = 0; vt < 4; ++vt) { u32x2 o; o.x = cvt_pk_bf16(acc[vt][0], acc[vt][1]); o.y = cvt_pk_bf16(acc[vt][2], acc[vt][3]);
            *(u32x2*)(mix + (vh * 4 + vt) * 16 + 4 * g) = o; } }
    __syncthreads();
}

__device__ __forceinline__ void hgrn_scan(const Params& p) {
    bf16_t* ST = (bf16_t*)(p.ws + WS_ST); const float* DEC = (const float*)(p.ws + WS_DEC);
    for (int e = blockIdx.x * NTHREADS + TID; e < 32 * 4096; e += gridDim.x * NTHREADS) {
        const int bh = e >> 12, idx4 = (e & 4095) * 4, k = idx4 & 127;
        bf16_t* base = ST + (size_t)bh * 64 * 16384 + idx4; const float* dec = DEC + (size_t)bh * 64 * 128 + k;
        f32x4 S = (f32x4){0.f, 0.f, 0.f, 0.f};
#pragma unroll 16
        for (int c = 0; c < 64; ++c) { const u32x2 loc = *(const u32x2*)(base + (size_t)c * 16384); const f32x4 d = *(const f32x4*)(dec + c * 128);
            u32x2 o; o.x = cvt_pk_bf16(S[0], S[1]); o.y = cvt_pk_bf16(S[2], S[3]);
            *(u32x2*)(base + (size_t)c * 16384) = o;
            S[0] = d[0] * S[0] + bflo(loc.x); S[1] = d[1] * S[1] + bfhi(loc.x); S[2] = d[2] * S[2] + bflo(loc.y); S[3] = d[3] * S[3] + bfhi(loc.y); }
    }
}

__device__ __forceinline__ void hgrn_C_item(const Params& p, int l, int b, int h, int c, LAS unsigned char* sm) {
    const int tid = TID, w = __builtin_amdgcn_readfirstlane(tid >> 6), ln = tid & 63, c16 = ln & 15, g = ln >> 4;
    LAS float* ssq = (LAS float*)sm;
    const int itile = w & 3, vh = w >> 2, i = itile * 16 + c16;
    const bf16_t* prow = (const bf16_t*)(p.ws + WS_BIG) + (size_t)(b * SEQ + c * 64 + i) * DINP;
    bf16_t* mix = (bf16_t*)(p.ws + WS_HB) + (size_t)(b * SEQ + c * 64 + i) * DM + h * 128;
    const bf16_t* st_ = (const bf16_t*)(p.ws + WS_ST) + (size_t)((b * 4 + h) * 64 + c) * 16384;
    bf16x8 qgF[4], stG[4][4]; u32x2 grG[4], oi[4];
#pragma unroll
    for (int kk = 0; kk < 4; ++kk) qgF[kk] = *(const bf16x8*)(prow + OFF_HQ + h * 128 + kk * 32 + g * 8);
#pragma unroll
    for (int kk = 0; kk < 4; ++kk)
#pragma unroll
        for (int vt = 0; vt < 4; ++vt) stG[kk][vt] = *(const bf16x8*)(st_ + (size_t)((vh * 4 + vt) * 16 + c16) * 128 + kk * 32 + g * 8);
#pragma unroll
    for (int vt = 0; vt < 4; ++vt) { const int v0 = (vh * 4 + vt) * 16 + 4 * g; grG[vt] = *(const u32x2*)(prow + OFF_HG + h * 128 + v0); oi[vt] = *(const u32x2*)(mix + v0); }
    f32x4 acc[4];
#pragma unroll
    for (int vt = 0; vt < 4; ++vt) acc[vt] = (f32x4){bflo(oi[vt].x), bfhi(oi[vt].x), bflo(oi[vt].y), bfhi(oi[vt].y)};
#pragma unroll
    for (int kk = 0; kk < 4; ++kk)
#pragma unroll
        for (int vt = 0; vt < 4; ++vt) acc[vt] = mfma16(stG[kk][vt], qgF[kk], acc[vt]);
    float ss = 0.f;
#pragma unroll
    for (int vt = 0; vt < 4; ++vt) ss += acc[vt][0] * acc[vt][0] + acc[vt][1] * acc[vt][1] + acc[vt][2] * acc[vt][2] + acc[vt][3] * acc[vt][3];
    ss = xrow16_sum(ss);
    if (g == 0) ssq[vh * 64 + i] = ss;
    __syncthreads();
    const float rstd = rsqrtf((ssq[i] + ssq[64 + i]) * (1.f / 128.f) + EPS);
#pragma unroll
    for (int vt = 0; vt < 4; ++vt) { const int v0 = (vh * 4 + vt) * 16 + 4 * g;
        const u32x2 gr = grG[vt]; const f32x4 ow = *(const f32x4*)(p.onorm_w + l * 512 + h * 128 + v0);
        const float r0 = acc[vt][0] * rstd * ow[0] * siluf_(bflo(gr.x)), r1 = acc[vt][1] * rstd * ow[1] * siluf_(bfhi(gr.x));
        const float r2 = acc[vt][2] * rstd * ow[2] * siluf_(bflo(gr.y)), r3 = acc[vt][3] * rstd * ow[3] * siluf_(bfhi(gr.y));
        u32x2 o; o.x = cvt_pk_bf16(r0, r1); o.y = cvt_pk_bf16(r2, r3);
        *(u32x2*)(mix + v0) = o; }
    __syncthreads();
}

#ifdef DIAG_CUT
__device__ __forceinline__ void diag_phase(const Params& p) {
    const int tid = TID, wave = tid >> 6, lane = tid & 63;
    const bf16_t* HB = (const bf16_t*)(p.ws + WS_HB); const bf16_t* ST = (const bf16_t*)(p.ws + WS_ST); const float* DEC = (const float*)(p.ws + WS_DEC);
    const bf16_t* BIG = (const bf16_t*)(p.ws + WS_BIG);
    for (int row = blockIdx.x * 8 + wave; row < NTOK; row += gridDim.x * 8) {
        float* orow = p.out + (size_t)row * DM;
        for (int i = 0; i < 16; ++i) { const int col = i * 64 + lane; float v = 0.f;
#if DIAG_MODE == 1
            for (int t = 0; t < 3; ++t) v += bf2f((short)BIG[(size_t)row * DINP + col + 1024 * t]);
            if (col < 768) v += bf2f((short)BIG[(size_t)row * DINP + 3072 + col]);
#elif DIAG_MODE == 2
            v = bf2f((short)ST[(size_t)row * 1024 + col]) + DEC[((size_t)row * 8 + (col & 7)) % (32 * 64 * 128)];
#elif DIAG_MODE == 5
            v = DEC[((size_t)row * 8 + (col & 7)) % (32 * 64 * 128)];
#elif DIAG_MODE == 6
            v = bf2f((short)ST[(size_t)row * 1024 + col]);
#elif DIAG_MODE == 4
            v = bf2f((short)HB[(size_t)row * DM + col]);
#endif
            if (!(fabsf(v) < 1e30f)) v = 12345.f;
            orow[col] = v; }
    }
}
#endif
#define XB_TMO      128
#define XB_XCNT(j)  (256  + 64 * (j))
#define XB_XSUB(j)  (1280 + 64 * (j))
#define XB_XGEN(j)  (2304 + 64 * (j))
#define XB_TOP      3328
#define XB_TOPGEN   3392
#define XCD_BAR_WORDS 3456
#define XB_SPIN_CAP (1u << 21)

__device__ __forceinline__ unsigned xb_ld(unsigned* p)              { return __hip_atomic_load(p, __ATOMIC_RELAXED, __HIP_MEMORY_SCOPE_AGENT); }
__device__ __forceinline__ unsigned xb_add(unsigned* p, unsigned v) { return __hip_atomic_fetch_add(p, v, __ATOMIC_RELAXED, __HIP_MEMORY_SCOPE_AGENT); }
__device__ __forceinline__ unsigned xb_xcc_id() { return (unsigned)__builtin_amdgcn_s_getreg((3 << 11) | 20) & 0xFu; }
#define XB_SPIN(cond, bar) do { unsigned _sp = 0; while (cond) { __builtin_amdgcn_s_sleep(1); \
    if ((++_sp & 255u) == 0u) { if (xb_ld(&(bar)[XB_TMO])) break; if (_sp > XB_SPIN_CAP) { atomicAdd(&(bar)[XB_TMO], 1u); break; } } } } while (0)

struct XcdBarrier {
    unsigned* bar; unsigned x;
    volatile LAS unsigned* st;
};

__device__ __forceinline__ XcdBarrier xcd_barrier_post(unsigned* bar, volatile LAS unsigned* st) {
    XcdBarrier b; b.bar = bar; b.x = xb_xcc_id(); b.st = st;
    if (threadIdx.x == 0) (void)xb_add(&bar[XB_XCNT(b.x)], 1u);
    return b;
}
__device__ __forceinline__ void xcd_barrier_complete(unsigned* bar, unsigned x, unsigned& nloc, unsigned& nx) {
    const unsigned G = gridDim.x * gridDim.y * gridDim.z;
    unsigned sum, cnt, mine, sp = 0u;
    for (;;) {
        sum = 0u; cnt = 0u; mine = 0u;
#pragma unroll
        for (unsigned j = 0; j < 16; ++j) { const unsigned c = xb_ld(&bar[XB_XCNT(j)]); sum += c; cnt += (c > 0u) ? 1u : 0u; mine = (j == x) ? c : mine; }
        if (sum == G) break;
        __builtin_amdgcn_s_sleep(1);
        if ((++sp & 255u) == 0u) { if (xb_ld(&bar[XB_TMO])) break; if (sp > XB_SPIN_CAP) { atomicAdd(&bar[XB_TMO], 1u); break; } }
    }
    nloc = mine > 0u ? mine : 1u; nx = cnt > 0u ? cnt : 1u;
}

__device__ __forceinline__ void xcd_barrier(const XcdBarrier& b) {
    asm volatile("s_waitcnt vmcnt(0)" ::: "memory");
    __syncthreads();
    if (threadIdx.x == 0) {
        unsigned* bar = b.bar;
        __builtin_amdgcn_s_waitcnt(0);
        unsigned nloc = b.st[0], nx = b.st[1];
        if (nloc == 0u) { xcd_barrier_complete(bar, b.x, nloc, nx); b.st[0] = nloc; b.st[1] = nx; }
        const unsigned old = xb_add(&bar[XB_XSUB(b.x)], 1u);
        const unsigned gen = old / nloc;
        if (old + 1u == (gen + 1u) * nloc) {
            __builtin_amdgcn_fence(__ATOMIC_RELEASE, "agent");
            asm volatile("s_waitcnt vmcnt(0)" ::: "memory");
            const unsigned og = xb_add(&bar[XB_TOP], 1u);
            const unsigned tg = og / nx;
            if (og + 1u == (tg + 1u) * nx) xb_add(&bar[XB_TOPGEN], 1u);
            else XB_SPIN(xb_ld(&bar[XB_TOPGEN]) == tg, bar);
            __builtin_amdgcn_fence(__ATOMIC_ACQUIRE, "agent");
            xb_add(&bar[XB_XGEN(b.x)], 1u);
            asm volatile("s_waitcnt vmcnt(0)" ::: "memory");
        } else {
            XB_SPIN(xb_ld(&bar[XB_XGEN(b.x)]) == gen, bar);
            __builtin_amdgcn_fence(__ATOMIC_ACQUIRE, "agent");
            asm volatile("s_waitcnt vmcnt(0)" ::: "memory");
        }
    }
    __syncthreads();
}


template <class Epi>
__device__ __forceinline__ void run_gemm(LAS unsigned char* lds, const bf16_t* A, const bf16_t* Bt, int M, int N, int K, const Epi& E) {
    pg8::Gemm g; g.A = A; g.Bt = Bt; g.M = M; g.N = N; g.K = K;
    pg8::StaticOrder S; S.init(M, N, (int)gridDim.x, (int)blockIdx.x);
    pg8::gemm_phase<Epi, pg8::StaticOrder, true, true>(lds, g, S, E);
}

constexpr int NPHASE = 2 + 9 * DEPTH;
#define GRID_SYNC() do { if (pin.ph_lo < 0) grid.sync(); xcd_barrier(xb); } while (0)

__global__ void __launch_bounds__(NTHREADS, 2) fwd_megakernel(Params pin) {
    extern __shared__ __attribute__((aligned(16))) unsigned char lds_raw[];
    LAS unsigned char* lds = (LAS unsigned char*)lds_raw;
    cg::grid_group grid = cg::this_grid();
    volatile LAS unsigned* xst = (volatile LAS unsigned*)(lds + 131072);
    if (threadIdx.x == 0) { xst[0] = 0u; xst[1] = 0u; }
    __syncthreads();
    XcdBarrier xb = xcd_barrier_post((unsigned*)(pin.ws + WS_BAR), xst);
    const int G = (int)gridDim.x, blk = (int)blockIdx.x;
    for (int ph = pin.ph_lo; ph < pin.ph_hi; ++ph) {
        Params p = pin;
        { size_t zoff = 0; asm volatile("" : "+s"(zoff));
            p.ws = pin.ws + zoff; p.out = pin.out + zoff; p.x = pin.x + zoff; }
        bf16_t* WIN = (bf16_t*)(p.ws + WS_WIN); bf16_t* WOUT = (bf16_t*)(p.ws + WS_WOUT); bf16_t* W1B = (bf16_t*)(p.ws + WS_W1); bf16_t* W2B = (bf16_t*)(p.ws + WS_W2);
        const float* MOD = (const float*)(p.ws + WS_MOD);
        bf16_t* BIG = (bf16_t*)(p.ws + WS_BIG); bf16_t* HB = (bf16_t*)(p.ws + WS_HB);
        if (ph == 0) {
          for (int rep_ = 0; rep_ < REP_PRO; ++rep_) {
            cvt_kind(p.w_in, WIN, DM, DIN, DINP, (LAS float*)lds);
            cvt_kind(p.w_out, WOUT, DM, DM, DM, (LAS float*)lds);
            cvt_kind(p.w1, W1B, DM, DFF, DFF, (LAS float*)lds);
            cvt_kind(p.w2, W2B, DFF, DM, DM, (LAS float*)lds);
            mod_phase(p, (LAS float*)lds);
            lb_phase(p);
          }
        } else if (ph == NPHASE - 1) {
            final_norm(p.out, p.final_w);
        } else {
            const int l = (ph - 1) / 9, s = (ph - 1) % 9;
            const float* modl = MOD + (size_t)l * NB * 6144;
            const float* xcur = (l == 0) ? p.x : p.out;
            if (s == 0) {
                for (int rep_ = 0; rep_ < REP_NORM; ++rep_) rmsnorm_mod(xcur, p.norm_mix_w + l * DM, modl, 0, 1024, HB);
            } else if (s == 1) {
                pg8::EpiBf16<0> E; E.O = BIG; E.ldc = DINP;
                for (int rep_ = 0; rep_ < REP_GEMM; ++rep_) run_gemm(lds, HB, WIN + (size_t)l * DINP * DM, NTOK, DINP, DM, E);
            } else if (s == 2) {
              for (int rep2_ = 0; rep2_ < REP_S2; ++rep2_) {
#ifndef DIAG_NOTHR
                for (int v = blk; v < 2048; v += G) { const int itp = v >> 8, rem = v & 255, b = rem & 7, jj = rem >> 3; const int qt = itp * 32 + ((itp & 1) ? 31 - jj : jj); for (int rep_ = 0; rep_ < REP_THR; ++rep_) thr_item(p, b, qt, lds); }
#endif
                for (int v = blk; v < 2048; v += G) { const int c = v & 63, bh = v >> 6; hgrn_A_item(p, l, bh >> 2, bh & 3, c, lds); }
                for (int v = blk; v < 1024; v += G) conv_item(p, l, v >> 7, v & 127, lds);
                for (int v = blk; v < 512; v += G) vt_item(p, v >> 6, v & 63, lds);
              }
            } else if (s == 3) {
                hgrn_scan(p);
                for (int v = blk; v < 512; v += G) { const int itp = v >> 8, rem = v & 255, b = rem & 7, jj = rem >> 3; const int qb = itp ? 63 - jj : jj; for (int rep_ = 0; rep_ < REP_ATTN; ++rep_) attn_item(p, b, qb, lds); }
            } else if (s == 4) {
                for (int rep_ = 0; rep_ < REP_HO; ++rep_) for (int v = blk; v < 2048; v += G) { const int c = v & 63, bh = v >> 6; hgrn_C_item(p, l, bh >> 2, bh & 3, c, lds); }
            } else if (s == 5) {
                pg8::EpiResid E; E.xs = xcur; E.xd = p.out; E.gate = modl + 2048;
                run_gemm(lds, HB, WOUT + (size_t)l * DM * DM, NTOK, DM, DM, E);
            } else if (s == 6) {
                for (int rep_ = 0; rep_ < REP_NORM; ++rep_) rmsnorm_mod(p.out, p.norm_mlp_w + l * DM, modl, 3072, 4096, HB);
            } else if (s == 7) {
                pg8::EpiBf16<1> E; E.O = BIG; E.ldc = DFF;
                for (int rep_ = 0; rep_ < REP_GEMM; ++rep_) run_gemm(lds, HB, W1B + (size_t)l * DFF * DM, NTOK, DFF, DM, E);
            } else {
                pg8::EpiResid E; E.xs = p.out; E.xd = p.out; E.gate = modl + 5120;
                run_gemm(lds, BIG, W2B + (size_t)l * DM * DFF, NTOK, DM, DFF, E);
            }
        }
        if (ph + 1 < pin.ph_hi) { GRID_SYNC(); }
    }
#ifdef DIAG_CUT
    { const int ph = 1; GRID_SYNC(); } diag_phase(pin);
#endif
}

extern "C" void kernel_launch(void* const* d_in, const int* in_sizes, int n_in, void* d_out, int out_size, void* d_ws, size_t ws_size, hipStream_t stream) {
    static int grid_blocks = 0;
    if (grid_blocks == 0) {
        if (n_in != 17 || out_size != NTOK * DM || ws_size < WS_END) { fprintf(stderr, "kernel_launch: unexpected shapes (n_in %d out %d ws %zu need %zu)\n", n_in, out_size, ws_size, (size_t)WS_END); grid_blocks = -1; return; }
        int dev = 0, cus = 0, per_cu = 0;
        hipGetDevice(&dev);
        hipDeviceGetAttribute(&cus, hipDeviceAttributeMultiprocessorCount, dev);
        if (hipFuncSetAttribute((const void*)fwd_megakernel, hipFuncAttributeMaxDynamicSharedMemorySize, LDS_BYTES) != hipSuccess) { fprintf(stderr, "kernel_launch: hipFuncSetAttribute failed\n"); grid_blocks = -1; return; }
        if (hipOccupancyMaxActiveBlocksPerMultiprocessor(&per_cu, (const void*)fwd_megakernel, NTHREADS, LDS_BYTES) != hipSuccess || per_cu < 1) { fprintf(stderr, "kernel_launch: occupancy query says %d blocks/CU\n", per_cu); per_cu = 1; }
        (void)hipGetLastError();
        grid_blocks = cus * (per_cu > 1 ? 1 : per_cu);
    }
    if (grid_blocks < 0) return;
    Params p{};
    p.x = (const float*)d_in[0]; p.c = (const float*)d_in[1]; p.ada_w = (const float*)d_in[2]; p.ada_b = (const float*)d_in[3];
    p.norm_mix_w = (const float*)d_in[4]; p.norm_mlp_w = (const float*)d_in[5]; p.w_in = (const float*)d_in[6]; p.lb_logits = (const float*)d_in[7];
    p.onorm_w = (const float*)d_in[8]; p.cv_w = (const float*)d_in[9]; p.cv_b = (const float*)d_in[10]; p.cv_ln_w = (const float*)d_in[11]; p.cv_ln_b = (const float*)d_in[12];
    p.w_out = (const float*)d_in[13]; p.w1 = (const float*)d_in[14]; p.w2 = (const float*)d_in[15]; p.final_w = (const float*)d_in[16];
    p.out = (float*)d_out; p.ws = (unsigned char*)d_ws; p.ph_lo = 0; p.ph_hi = NPHASE;
#ifdef DIAG_CUT
    p.ph_hi = DIAG_CUT;
#endif
    if (hipMemsetAsync((char*)d_ws + WS_BAR, 0, 16384, stream) != hipSuccess) { fprintf(stderr, "kernel_launch: hipMemsetAsync failed\n"); return; }
    void* args[] = {&p};
    hipError_t e = hipLaunchCooperativeKernel((const void*)fwd_megakernel, dim3(grid_blocks), dim3(NTHREADS), args, LDS_BYTES, stream);
    if (e != hipSuccess) fprintf(stderr, "kernel_launch: cooperative launch failed: %s (grid %d)\n", hipGetErrorString(e), grid_blocks);
}
```

```cpp
#include <hip/hip_runtime.h>
#include <hip/hip_cooperative_groups.h>
#include <cstdio>
#include <cstdint>
namespace cg = cooperative_groups;

#define LAS __attribute__((address_space(3)))
typedef unsigned short bf16_t;
typedef short bf16x8 __attribute__((ext_vector_type(8)));
typedef float f32x4 __attribute__((ext_vector_type(4)));
typedef unsigned u32x4 __attribute__((ext_vector_type(4)));
typedef unsigned u32x2 __attribute__((ext_vector_type(2)));

constexpr int DM = 1024, NB = 8, SEQ = 4096, DEPTH = 4, NTOK = NB * SEQ;
constexpr int DIN = 3624, DINP = 3840, DFF = 4096;
constexpr int OFF_HQ = 0, OFF_HF = 512, OFF_HI = 1024, OFF_HG = 1536, OFF_SQ = 2048, OFF_SK = 2304, OFF_SV = 2560, OFF_IQ = 2816, OFF_IK = 3072, OFF_IW = 3104, OFF_CU = 3112;
constexpr int TOPK = 256;
constexpr float EPS = 1e-6f;
constexpr int NTHREADS = 512;
constexpr int LDS_BYTES = 131072 + 64;

constexpr size_t WS_WIN = 0;
constexpr size_t WS_WOUT = WS_WIN + (size_t)DEPTH * DINP * DM * 2;
constexpr size_t WS_W1 = WS_WOUT + (size_t)DEPTH * DM * DM * 2;
constexpr size_t WS_W2 = WS_W1 + (size_t)DEPTH * DFF * DM * 2;
constexpr size_t WS_MOD = WS_W2 + (size_t)DEPTH * DM * DFF * 2;
constexpr size_t WS_LB = WS_MOD + (size_t)DEPTH * NB * 6 * DM * 4;
constexpr size_t WS_BIG = WS_LB + (size_t)DEPTH * 512 * 4;
constexpr size_t WS_MASK = WS_BIG + (size_t)NTOK * DINP * 2;
static_assert((size_t)NTOK * DINP * 2 + (size_t)NTOK * 128 * 4 <= (size_t)NTOK * DFF * 2, "mask overlay");
constexpr size_t WS_HB = WS_BIG + (size_t)NTOK * DFF * 2;
constexpr size_t WS_ST = WS_HB + (size_t)NTOK * DM * 2;
constexpr size_t WS_DEC = WS_ST + (size_t)32 * 64 * 16384 * 2;
constexpr size_t WS_VT = WS_DEC + (size_t)32 * 64 * 128 * 4;
constexpr size_t WS_THRT = WS_VT + (size_t)NB * 4 * 64 * SEQ * 2;
constexpr size_t WS_THRC = WS_THRT + (size_t)NTOK * 4;
constexpr size_t WS_BAR = WS_THRC + (size_t)NTOK * 4;
constexpr size_t WS_END = WS_BAR + 16384;
static_assert(WS_END <= (size_t)512 * 1024 * 1024, "workspace map exceeds 512 MiB");

struct Params {
    const float* x; const float* c; const float* ada_w; const float* ada_b; const float* norm_mix_w; const float* norm_mlp_w;
    const float* w_in; const float* lb_logits; const float* onorm_w; const float* cv_w; const float* cv_b; const float* cv_ln_w; const float* cv_ln_b;
    const float* w_out; const float* w1; const float* w2; const float* final_w;
    float* out; unsigned char* ws;
    int ph_lo, ph_hi;
};

typedef float f32x2_t __attribute__((ext_vector_type(2)));
typedef __bf16 bf16x2_t __attribute__((ext_vector_type(2)));
__device__ __forceinline__ unsigned cvt_pk_bf16(float lo, float hi) { const f32x2_t v = {lo, hi}; return __builtin_bit_cast(unsigned, __builtin_convertvector(v, bf16x2_t)); }
__device__ __forceinline__ float bf2f(short h) { return __uint_as_float(((unsigned)(unsigned short)h) << 16); }
__device__ __forceinline__ float bflo(unsigned w) { return __uint_as_float(w << 16); }
__device__ __forceinline__ float bfhi(unsigned w) { return __uint_as_float(w & 0xffff0000u); }
__device__ __forceinline__ bf16_t f2bf(float f) { return (bf16_t)(cvt_pk_bf16(f, 0.f) & 0xffffu); }
__device__ __forceinline__ float wave_sum(float v) {
    v += __shfl_xor(v, 32); v += __shfl_xor(v, 16); v += __shfl_xor(v, 8); v += __shfl_xor(v, 4); v += __shfl_xor(v, 2); v += __shfl_xor(v, 1); return v;
}
__device__ __forceinline__ float xrow16_max(float x) {
    auto s = __builtin_amdgcn_permlane16_swap(__float_as_uint(x), __float_as_uint(x), false, false);
    x = fmaxf(__uint_as_float(s[0]), __uint_as_float(s[1]));
    auto t = __builtin_amdgcn_permlane32_swap(__float_as_uint(x), __float_as_uint(x), false, false);
    return fmaxf(__uint_as_float(t[0]), __uint_as_float(t[1]));
}
__device__ __forceinline__ float xrow16_sum(float x) {
    auto s = __builtin_amdgcn_permlane16_swap(__float_as_uint(x), __float_as_uint(x), false, false);
    x = __uint_as_float(s[0]) + __uint_as_float(s[1]);
    auto t = __builtin_amdgcn_permlane32_swap(__float_as_uint(x), __float_as_uint(x), false, false);
    return __uint_as_float(t[0]) + __uint_as_float(t[1]);
}
__device__ __forceinline__ float sigmoidf_(float x) { return __builtin_amdgcn_rcpf(1.f + __expf(-x)); }
__device__ __forceinline__ float siluf_(float x) { return x * __builtin_amdgcn_rcpf(1.f + __expf(-x)); }
__device__ __forceinline__ unsigned sortable(float f) { unsigned b = __float_as_uint(f); return b ^ ((b & 0x80000000u) ? 0xffffffffu : 0x80000000u); }
__device__ __forceinline__ f32x4 mfma16(bf16x8 a, bf16x8 b, f32x4 c) { return __builtin_amdgcn_mfma_f32_16x16x32_bf16(a, b, c, 0, 0, 0); }

namespace pg8 {
#define PG8_LAS __attribute__((address_space(3)))
constexpr int BM = 256, BK = 64, HALF = 128, HTB = HALF * BK * 2, STAGE_BYTES = 8 * HTB, NXCD = 8, WGM = 4;
__host__ __device__ __forceinline__ int lds_byte(int r, int c) { const int st = (r >> 4) * 2 + (c >> 5), rr = r & 15, cc = c & 31, ob = rr * 64 + cc * 2; return st * 1024 + (ob ^ (((ob >> 9) & 1) << 5)); }
__host__ __device__ __forceinline__ void stage_rc(int b, int& R, int& C) { const int st = b / 1024, sb = b % 1024, swz = sb ^ (((sb >> 9) & 1) << 5); R = (st >> 1) * 16 + swz / 64; C = (st & 1) * 32 + (swz % 64) / 2; }
__host__ __device__ __forceinline__ int perm32(int rho) { const int n = rho >> 4, i = rho & 15; return 8 * (i >> 2) + 4 * n + (i & 3); }
struct Unit { int pm, pn; };
struct Gemm { const bf16_t* A; const bf16_t* Bt; int M, N, K; };
struct StaticOrder {
    int nM, nN, nwg, G, c;
    __host__ __device__ void init(int M, int N, int G_, int c_) { nM = M / BM; nN = N / BM; nwg = nM * nN; G = G_; c = c_; }
    __host__ __device__ bool next(int i, Unit& u) const {
        const long L = (long)i * G + c; if (L >= nwg) return false;
        int wgid = (int)L; { const int q = nwg / NXCD, r = nwg % NXCD, xcd = wgid % NXCD, off = wgid / NXCD; wgid = (xcd < r ? xcd * (q + 1) : r * (q + 1) + (xcd - r) * q) + off; }
        const int nig = WGM * nN, gid = wgid / nig, fm = gid * WGM, gsz = (nM - fm) < WGM ? (nM - fm) : WGM;
        u.pm = fm + ((wgid % nig) % gsz); u.pn = (wgid % nig) / gsz; return true;
    }
    __device__ __forceinline__ void a_ready(const Unit&) const {}
    __device__ __forceinline__ void done(const Unit&) const {}
};

template <int ACT  > struct EpiBf16 {
    static constexpr bool PERM = true, AFTER_DRAIN = false;
    bf16_t* O; int ldc;
    __device__ __forceinline__ void operator()(const f32x4 (&acc)[2][2][4][2], const Unit& u, int wr, int wc, int fr, int fq) const {
        const int row0 = u.pm * BM + wr * 64 + fr, col0 = u.pn * BM + wc * 32 + 8 * fq;
#pragma unroll
        for (int ai = 0; ai < 2; ++ai)
#pragma unroll
            for (int m = 0; m < 4; ++m) { bf16_t* rowp = O + (size_t)(row0 + ai * HALF + m * 16) * ldc + col0;
#pragma unroll
                for (int bj = 0; bj < 2; ++bj) { f32x4 v0 = acc[ai][bj][m][0], v1 = acc[ai][bj][m][1];
                    if (ACT == 1) {
#pragma unroll
                        for (int j = 0; j < 4; ++j) { const float a = fmaxf(v0[j], 0.f), b = fmaxf(v1[j], 0.f); v0[j] = a * a; v1[j] = b * b; } }
                    u32x4 w; w.x = cvt_pk_bf16(v0[0], v0[1]); w.y = cvt_pk_bf16(v0[2], v0[3]); w.z = cvt_pk_bf16(v1[0], v1[1]); w.w = cvt_pk_bf16(v1[2], v1[3]);
                    __builtin_nontemporal_store(w, (u32x4*)(rowp + bj * HALF)); } }
    }
};
struct EpiResid {
    static constexpr bool PERM = true, AFTER_DRAIN = false;
    const float* xs; float* xd; const float* gate;
    __device__ __forceinline__ void operator()(const f32x4 (&acc)[2][2][4][2], const Unit& u, int wr, int wc, int fr, int fq) const {
        const int row0 = u.pm * BM + wr * 64 + fr, col0 = u.pn * BM + wc * 32 + 8 * fq;
        const float* gp = gate + (size_t)((u.pm * BM) >> 12) * 6144 + col0;
        f32x4 gv[2][2];
#pragma unroll
        for (int bj = 0; bj < 2; ++bj)
#pragma unroll
            for (int n = 0; n < 2; ++n) gv[bj][n] = *(const f32x4*)(gp + bj * HALF + 4 * n);
#pragma unroll
        for (int ai = 0; ai < 2; ++ai)
#pragma unroll
            for (int m = 0; m < 4; ++m) { const size_t off = (size_t)(row0 + ai * HALF + m * 16) * DM + col0;
#pragma unroll
                for (int bj = 0; bj < 2; ++bj)
#pragma unroll
                    for (int n = 0; n < 2; ++n) { const f32x4 xv = *(const f32x4*)(xs + off + bj * HALF + 4 * n);
                        *(f32x4*)(xd + off + bj * HALF + 4 * n) = xv + gv[bj][n] * acc[ai][bj][m][n]; } }
    }
};
template <class Epi, class Sched, bool ALIGN_EPI = false, bool SP2 = false>
__device__ __forceinline__ void gemm_phase(PG8_LAS unsigned char* lds, const Gemm g, const Sched& S, const Epi& E) {
    int tid_ = threadIdx.x; asm volatile("" : "+v"(tid_)); const int tid = tid_, wid = __builtin_amdgcn_readfirstlane(tid >> 6), lane = tid & 63, wr = wid >> 2, wc = wid & 3, fr = lane & 15, fq = lane >> 4;
    const int K = g.K, nt = K / BK;
    unsigned voffA[2], voffB[2];
#pragma unroll
    for (int i = 0; i < 2; ++i) { int R, C; stage_rc(tid * 16 + i * 8192, R, C); const int Rb = Epi::PERM ? ((R & ~31) + perm32(R & 31)) : R;
        voffA[i] = (unsigned)(R * K + C) * 2u; voffB[i] = (unsigned)(Rb * K + C) * 2u; }
    const size_t kstep = (size_t)(BK * 2);
    const size_t hstep = (size_t)HALF * K * 2;
    const size_t tstep = 2 * hstep;
    const unsigned ldsw = (unsigned)wid * 1024u;
    const int aoff = lds_byte(wr * 64 + fr, fq * 8), boff = lds_byte(wc * 32 + fr, fq * 8);
#define PG8_SA(b, h) (((b) * 2 + (h)) * HTB)
#define PG8_SB(b, h) ((4 + (b) * 2 + (h)) * HTB)
#define PG8_STAGE(bufoff, gbase, voff) do { _Pragma("unroll") for (int _i = 0; _i < 2; ++_i) \
        __builtin_amdgcn_global_load_lds((const unsigned*)((const char*)(gbase) + (voff)[_i]), (PG8_LAS unsigned*)(lds + (bufoff) + ldsw + _i * 8192), 16, 0, 0); } while (0)
#define PG8_LDA(dst, b, h) do { _Pragma("unroll") for (int m = 0; m < 4; ++m) _Pragma("unroll") for (int k = 0; k < 2; ++k) dst[m][k] = *(const PG8_LAS bf16x8*)(lds + PG8_SA(b, h) + aoff + m * 2048 + k * 1024); } while (0)
#define PG8_LDB(dst, b, h) do { _Pragma("unroll") for (int n = 0; n < 2; ++n) _Pragma("unroll") for (int k = 0; k < 2; ++k) dst[n][k] = *(const PG8_LAS bf16x8*)(lds + PG8_SB(b, h) + boff + n * 2048 + k * 1024); } while (0)
#define PG8_MMA(ai, bj, At, Bt) do { __builtin_amdgcn_s_setprio(1); _Pragma("unroll") for (int m = 0; m < 4; ++m) _Pragma("unroll") for (int n = 0; n < 2; ++n) _Pragma("unroll") for (int k = 0; k < 2; ++k) \
        acc[ai][bj][m][n] = __builtin_amdgcn_mfma_f32_16x16x32_bf16(Bt[n][k], At[m][k], acc[ai][bj][m][n], 0, 0, 0); __builtin_amdgcn_s_setprio(0); } while (0)
#define PG8_WAIT_V(n) asm volatile("s_waitcnt vmcnt(" #n ")" ::: "memory")
#define PG8_WAIT_L(n) asm volatile("s_waitcnt lgkmcnt(" #n ")" ::: "memory")
#define PG8_BAR __builtin_amdgcn_s_barrier()
#define PG8_SCHED __builtin_amdgcn_sched_barrier(0)
    Unit cur, nxt; int ui = 0;
    if (!S.next(0, cur)) return;
    f32x4 acc[2][2][4][2];
#pragma unroll
    for (int a = 0; a < 2; ++a)
#pragma unroll
        for (int b = 0; b < 2; ++b)
#pragma unroll
            for (int m = 0; m < 4; ++m)
#pragma unroll
                for (int n = 0; n < 2; ++n) acc[a][b][m][n] = (f32x4){0.f, 0.f, 0.f, 0.f};
    bf16x8 At[4][2], B0[2][2], B1[2][2];
    const char* cA = (const char*)g.A + (size_t)cur.pm * tstep; const char* cB = (const char*)g.Bt + (size_t)cur.pn * tstep;
    S.a_ready(cur);
    if constexpr (SP2) {
        PG8_STAGE(PG8_SB(0, 0), cB, voffB); PG8_STAGE(PG8_SB(0, 1), cB + hstep, voffB); PG8_STAGE(PG8_SA(0, 0), cA, voffA); PG8_STAGE(PG8_SA(0, 1), cA + hstep, voffA);
        if (wr == 1) PG8_BAR;
        PG8_WAIT_V(2); PG8_BAR;
        PG8_STAGE(PG8_SB(1, 0), cB + kstep, voffB); PG8_STAGE(PG8_SA(1, 0), cA + kstep, voffA); PG8_STAGE(PG8_SB(1, 1), cB + hstep + kstep, voffB);
        PG8_WAIT_V(6); PG8_BAR;
    } else {
        PG8_STAGE(PG8_SB(0, 0), cB, voffB); PG8_STAGE(PG8_SA(0, 0), cA, voffA); PG8_STAGE(PG8_SB(0, 1), cB + hstep, voffB); PG8_STAGE(PG8_SA(0, 1), cA + hstep, voffA);
        if (wr == 1) PG8_BAR;
        PG8_WAIT_V(4); PG8_BAR;
        PG8_STAGE(PG8_SB(1, 0), cB + kstep, voffB); PG8_STAGE(PG8_SA(1, 0), cA + kstep, voffA); PG8_STAGE(PG8_SB(1, 1), cB + hstep + kstep, voffB);
        PG8_WAIT_V(6); PG8_BAR;
    }
    for (;;) {
        const bool has_next = S.next(ui + 1, nxt);
        const char* nA = has_next ? (const char*)g.A + (size_t)nxt.pm * tstep : cA; const char* nB = has_next ? (const char*)g.Bt + (size_t)nxt.pn * tstep : cB;
        for (int t = 0; t < nt; t += 2) {
            const bool last = (t == nt - 2);
            const char* a1 = cA + (size_t)(t + 1) * kstep;
            const char* a2 = last ? nA : cA + (size_t)(t + 2) * kstep; const char* b2 = last ? nB : cB + (size_t)(t + 2) * kstep;
            const char* a3 = a2 + kstep; const char* b3 = b2 + kstep;
            if (last && has_next) S.a_ready(nxt);
            if constexpr (SP2) {
            PG8_LDB(B0, 0, 0); PG8_LDB(B1, 0, 1); PG8_SCHED; PG8_LDA(At, 0, 0); PG8_STAGE(PG8_SA(1, 1), a1 + hstep, voffA);
            PG8_WAIT_V(8); PG8_WAIT_L(0); PG8_BAR; PG8_MMA(0, 0, At, B0); PG8_MMA(0, 1, At, B1); PG8_BAR; PG8_SCHED;
            PG8_LDA(At, 0, 1); PG8_STAGE(PG8_SB(0, 0), b2, voffB); PG8_STAGE(PG8_SB(0, 1), b2 + hstep, voffB); PG8_STAGE(PG8_SA(0, 0), a2, voffA);
            PG8_WAIT_V(8); PG8_WAIT_L(0); PG8_BAR; PG8_MMA(1, 0, At, B0); PG8_MMA(1, 1, At, B1); PG8_BAR; PG8_SCHED;
            PG8_LDB(B0, 1, 0); PG8_LDB(B1, 1, 1); PG8_SCHED; PG8_LDA(At, 1, 0); PG8_STAGE(PG8_SA(0, 1), a2 + hstep, voffA);
            PG8_WAIT_V(8); PG8_WAIT_L(0); PG8_BAR; PG8_MMA(0, 0, At, B0); PG8_MMA(0, 1, At, B1); PG8_BAR; PG8_SCHED;
            PG8_LDA(At, 1, 1); PG8_STAGE(PG8_SB(1, 0), b3, voffB); PG8_STAGE(PG8_SB(1, 1), b3 + hstep, voffB); PG8_STAGE(PG8_SA(1, 0), a3, voffA);
            PG8_WAIT_V(8); PG8_WAIT_L(0); PG8_BAR; PG8_MMA(1, 0, At, B0); PG8_MMA(1, 1, At, B1); PG8_BAR; PG8_SCHED;
            } else {
            PG8_LDB(B0, 0, 0); PG8_SCHED; PG8_LDA(At, 0, 0); PG8_STAGE(PG8_SA(1, 1), a1 + hstep, voffA);
            PG8_WAIT_L(8); PG8_BAR; PG8_WAIT_L(0); PG8_MMA(0, 0, At, B0); PG8_BAR; PG8_SCHED;
            PG8_LDB(B1, 0, 1); PG8_STAGE(PG8_SB(0, 0), b2, voffB);
            PG8_BAR; PG8_WAIT_L(0); PG8_MMA(0, 1, At, B1); PG8_BAR;
            PG8_LDA(At, 0, 1); PG8_STAGE(PG8_SA(0, 0), a2, voffA);
            PG8_BAR; PG8_WAIT_L(0); PG8_MMA(1, 0, At, B0); PG8_BAR; PG8_SCHED;
            PG8_STAGE(PG8_SB(0, 1), b2 + hstep, voffB);
            PG8_WAIT_V(6); PG8_BAR; PG8_MMA(1, 1, At, B1); PG8_BAR;
            PG8_LDB(B0, 1, 0); PG8_SCHED; PG8_LDA(At, 1, 0); PG8_STAGE(PG8_SA(0, 1), a2 + hstep, voffA);
            PG8_WAIT_L(8); PG8_BAR; PG8_WAIT_L(0); PG8_MMA(0, 0, At, B0); PG8_BAR; PG8_SCHED;
            PG8_LDB(B1, 1, 1); PG8_STAGE(PG8_SB(1, 0), b3, voffB);
            PG8_BAR; PG8_WAIT_L(0); PG8_MMA(0, 1, At, B1); PG8_BAR;
            PG8_LDA(At, 1, 1); PG8_STAGE(PG8_SA(1, 0), a3, voffA);
            PG8_BAR; PG8_WAIT_L(0); PG8_MMA(1, 0, At, B0); PG8_BAR; PG8_SCHED;
            PG8_STAGE(PG8_SB(1, 1), b3 + hstep, voffB);
            PG8_WAIT_V(6); PG8_BAR; PG8_MMA(1, 1, At, B1); PG8_BAR;
            }
        }
        if constexpr (ALIGN_EPI) { if (wr == 0) PG8_BAR; }
        if constexpr (!Epi::AFTER_DRAIN) { E(acc, cur, wr, wc, fr, fq); S.done(cur); }
        if (!has_next) break;
#pragma unroll
        for (int a = 0; a < 2; ++a)
#pragma unroll
            for (int b = 0; b < 2; ++b)
#pragma unroll
                for (int m = 0; m < 4; ++m)
#pragma unroll
                    for (int n = 0; n < 2; ++n) acc[a][b][m][n] = (f32x4){0.f, 0.f, 0.f, 0.f};
        cur = nxt; cA = nA; cB = nB; ++ui;
        if constexpr (ALIGN_EPI) { if (wr == 1) PG8_BAR; }
    }
    PG8_WAIT_V(0);
    if constexpr (!ALIGN_EPI) { if (wr == 0) PG8_BAR; }
    PG8_BAR;
    if constexpr (Epi::AFTER_DRAIN) { E.fused(acc, cur, wr, wc, fr, fq, lds, wid, lane); S.done(cur); }
#undef PG8_SA
#undef PG8_SB
#undef PG8_STAGE
#undef PG8_LDA
#undef PG8_LDB
#undef PG8_MMA
#undef PG8_WAIT_V
#undef PG8_WAIT_L
#undef PG8_BAR
#undef PG8_SCHED
}
}

#ifndef REP_THR
#define REP_THR 1
#endif
#ifndef REP_NORM
#define REP_NORM 1
#endif
#ifndef REP_PRO
#define REP_PRO 1
#endif
#ifndef REP_ATTN
#define REP_ATTN 1
#endif
#ifndef REP_S2
#define REP_S2 1
#endif
#ifndef REP_GEMM
#define REP_GEMM 1
#endif
#ifndef REP_HO
#define REP_HO 1
#endif
__device__ __forceinline__ int ltid() { int t = threadIdx.x; asm volatile("" : "+v"(t)); return t; }
#define TID ltid()

__device__ __forceinline__ void cvt_kind(const float* __restrict__ src, bf16_t* __restrict__ dst, int K, int N, int Npad, LAS float* tl) {
    const int tid = TID, nk = K / 64, nn = Npad / 64, per = nk * nn, total = DEPTH * per;
    for (int t = blockIdx.x; t < total; t += gridDim.x) {
        const int l = t / per, r = t % per, kt = r / nn, nt = r % nn;
        const float* s = src + (size_t)l * K * N; bf16_t* d = dst + (size_t)l * Npad * K;
#pragma unroll
        for (int i = 0; i < 2; ++i) { const int kr = (tid >> 4) + 32 * i, nc = (tid & 15) * 4, n = nt * 64 + nc;
            f32x4 v = (f32x4){0.f, 0.f, 0.f, 0.f};
            if (n < N) v = *(const f32x4*)(s + (size_t)(kt * 64 + kr) * N + n);
            tl[kr * 65 + nc + 0] = v[0]; tl[kr * 65 + nc + 1] = v[1]; tl[kr * 65 + nc + 2] = v[2]; tl[kr * 65 + nc + 3] = v[3]; }
        __syncthreads();
        { const int n = tid >> 3, k8 = (tid & 7) * 8; u32x4 w;
            w.x = cvt_pk_bf16(tl[(k8 + 0) * 65 + n], tl[(k8 + 1) * 65 + n]); w.y = cvt_pk_bf16(tl[(k8 + 2) * 65 + n], tl[(k8 + 3) * 65 + n]);
            w.z = cvt_pk_bf16(tl[(k8 + 4) * 65 + n], tl[(k8 + 5) * 65 + n]); w.w = cvt_pk_bf16(tl[(k8 + 6) * 65 + n], tl[(k8 + 7) * 65 + n]);
            *(u32x4*)(d + (size_t)(nt * 64 + n) * K + kt * 64 + k8) = w; }
        __syncthreads();
    }
}

__device__ __forceinline__ void mod_phase(const Params& p, LAS float* sm) {
    const int tid = TID;
    LAS float* cact = sm; LAS float* red = sm + 8192;
    for (int i = tid; i < NB * DM; i += NTHREADS) cact[i] = siluf_(p.c[i]);
    __syncthreads();
    float* MOD = (float*)(p.ws + WS_MOD);
    for (int it = blockIdx.x; it < DEPTH * 96; it += gridDim.x) {
        const int l = it / 96, j0 = (it % 96) * 64, col = tid & 63, seg = tid >> 6;
        const float* w = p.ada_w + (size_t)l * DM * 6144 + j0 + col;
        float a0 = 0.f, a1 = 0.f, a2 = 0.f, a3 = 0.f, a4 = 0.f, a5 = 0.f, a6 = 0.f, a7 = 0.f;
#pragma unroll 8
        for (int k = seg * 128; k < seg * 128 + 128; ++k) { const float wv = w[(size_t)k * 6144];
            a0 += cact[0 * DM + k] * wv; a1 += cact[1 * DM + k] * wv; a2 += cact[2 * DM + k] * wv; a3 += cact[3 * DM + k] * wv;
            a4 += cact[4 * DM + k] * wv; a5 += cact[5 * DM + k] * wv; a6 += cact[6 * DM + k] * wv; a7 += cact[7 * DM + k] * wv; }
        red[(seg * 8 + 0) * 64 + col] = a0; red[(seg * 8 + 1) * 64 + col] = a1; red[(seg * 8 + 2) * 64 + col] = a2; red[(seg * 8 + 3) * 64 + col] = a3;
        red[(seg * 8 + 4) * 64 + col] = a4; red[(seg * 8 + 5) * 64 + col] = a5; red[(seg * 8 + 6) * 64 + col] = a6; red[(seg * 8 + 7) * 64 + col] = a7;
        __syncthreads();
        { const int b = tid >> 6; float s = p.ada_b[l * 6144 + j0 + col];
#pragma unroll
            for (int sg = 0; sg < 8; ++sg) s += red[(sg * 8 + b) * 64 + col];
            MOD[(size_t)(l * NB + b) * 6144 + j0 + col] = s; }
        __syncthreads();
    }
}

__device__ __forceinline__ void lb_phase(const Params& p) {
    if (blockIdx.x != 0) return;
    const int k = TID; float* LB = (float*)(p.ws + WS_LB);
    const float v0 = p.lb_logits[k], v1 = p.lb_logits[512 + k], v2 = p.lb_logits[1024 + k], v3 = p.lb_logits[1536 + k];
    const float mx = fmaxf(fmaxf(v0, v1), fmaxf(v2, v3));
    const float e0 = expf(v0 - mx), e1 = expf(v1 - mx), e2 = expf(v2 - mx), e3 = expf(v3 - mx), inv = 1.f / (e0 + e1 + e2 + e3);
    const float p0 = e0 * inv, p1 = e1 * inv, p2 = e2 * inv, p3 = e3 * inv;
    LB[k] = p0 - p0; LB[512 + k] = (p0 + p1) - p0; LB[1024 + k] = ((p0 + p1) + p2) - p0; LB[1536 + k] = (((p0 + p1) + p2) + p3) - p0;
}

__device__ __forceinline__ void rmsnorm_mod(const float* __restrict__ xs, const float* __restrict__ w, const float* __restrict__ mod, int sh_off, int sc_off, bf16_t* __restrict__ dst) {
    const int tid = TID, wave = tid >> 6, lane = tid & 63;
    const int row0 = blockIdx.x * 8 + wave, rstep = gridDim.x * 8;
    f32x4 v[4], nv[4];
    if (row0 < NTOK) {
#pragma unroll
        for (int i = 0; i < 4; ++i) nv[i] = *(const f32x4*)(xs + (size_t)row0 * DM + i * 256 + lane * 4); }
    for (int row = row0; row < NTOK; row += rstep) {
        float ss = 0.f;
#pragma unroll
        for (int i = 0; i < 4; ++i) { v[i] = nv[i]; ss += v[i][0] * v[i][0] + v[i][1] * v[i][1] + v[i][2] * v[i][2] + v[i][3] * v[i][3]; }
        if (row + rstep < NTOK) {
#pragma unroll
            for (int i = 0; i < 4; ++i) nv[i] = *(const f32x4*)(xs + (size_t)(row + rstep) * DM + i * 256 + lane * 4); }
        ss = wave_sum(ss);
        const float rstd = rsqrtf(ss * (1.f / DM) + EPS);
        const float* mb = mod + (size_t)(row >> 12) * 6144;
#pragma unroll
        for (int i = 0; i < 4; ++i) { const int col = i * 256 + lane * 4;
            const f32x4 ww = *(const f32x4*)(w + col), sc = *(const f32x4*)(mb + sc_off + col), sh = *(const f32x4*)(mb + sh_off + col);
            const f32x4 h = (v[i] * rstd * ww) * (sc + 1.f) + sh;
            u32x2 o; o.x = cvt_pk_bf16(h[0], h[1]); o.y = cvt_pk_bf16(h[2], h[3]);
            *(u32x2*)(dst + (size_t)row * DM + col) = o; }
    }
}
__device__ __forceinline__ void final_norm(float* __restrict__ x, const float* __restrict__ w) {
    const int tid = TID, wave = tid >> 6, lane = tid & 63;
    for (int row = blockIdx.x * 8 + wave; row < NTOK; row += gridDim.x * 8) {
        float* xr = x + (size_t)row * DM; f32x4 v[4]; float ss = 0.f;
#pragma unroll
        for (int i = 0; i < 4; ++i) { v[i] = *(const f32x4*)(xr + i * 256 + lane * 4); ss += v[i][0] * v[i][0] + v[i][1] * v[i][1] + v[i][2] * v[i][2] + v[i][3] * v[i][3]; }
        ss = wave_sum(ss);
        const float rstd = rsqrtf(ss * (1.f / DM) + EPS);
#pragma unroll
        for (int i = 0; i < 4; ++i) { const int col = i * 256 + lane * 4; const f32x4 ww = *(const f32x4*)(w + col); *(f32x4*)(xr + col) = v[i] * rstd * ww; }
    }
}

__device__ __forceinline__ void vt_item(const Params& p, int b, int tt, LAS unsigned char* sm) {
    const int tid = TID; LAS bf16_t* vb = (LAS bf16_t*)sm;
    const bf16_t* proj = (const bf16_t*)(p.ws + WS_BIG) + (size_t)(b * SEQ + tt * 64) * DINP + OFF_SV;
#pragma unroll
    for (int i = 0; i < 4; ++i) { const int idx = tid + NTHREADS * i, row = idx >> 5, c8 = (idx & 31) * 8;
        *(LAS bf16x8*)(vb + row * 264 + c8) = *(const bf16x8*)(proj + (size_t)row * DINP + c8); }
    __syncthreads();
    { const int col = tid >> 1, half = tid & 1;
        bf16_t* dst = (bf16_t*)(p.ws + WS_VT) + ((size_t)(b * 4 + (col >> 6)) * 64 + (col & 63)) * SEQ + tt * 64 + half * 32;
#pragma unroll
        for (int i = 0; i < 4; ++i) { bf16x8 o;
#pragma unroll
            for (int e = 0; e < 8; ++e) o[e] = (short)vb[(half * 32 + i * 8 + e) * 264 + col];
            *(bf16x8*)(dst + i * 8) = o; } }
    __syncthreads();
}

__device__ __forceinline__ void conv_item(const Params& p, int l, int b, int tt, LAS unsigned char* sm) {
    const int tid = TID; LAS float* hb = (LAS float*)sm;
    LAS float* ob = (LAS float*)(sm + 62 * 256 * 4);
    const int t0 = tt * 32;
    const bf16_t* proj = (const bf16_t*)(p.ws + WS_BIG) + (size_t)b * SEQ * DINP + OFF_CU;
#pragma unroll
    for (int i = 0; i < 4; ++i) { const int idx = tid + NTHREADS * i;
        if (idx < 62 * 32) { const int row = idx >> 5, c8 = (idx & 31) * 8, t = t0 - 30 + row;
            f32x4 h0 = (f32x4){0.f, 0.f, 0.f, 0.f}, h1 = h0;
            if (t >= 0) { const bf16x8 a = *(const bf16x8*)(proj + (size_t)t * DINP + c8), g = *(const bf16x8*)(proj + (size_t)t * DINP + 256 + c8);
#pragma unroll
                for (int j = 0; j < 4; ++j) { h0[j] = bf2f(a[j]) * sigmoidf_(bf2f(g[j])); h1[j] = bf2f(a[4 + j]) * sigmoidf_(bf2f(g[4 + j])); } }
            *(LAS f32x4*)(hb + row * 256 + c8) = h0; *(LAS f32x4*)(hb + row * 256 + c8 + 4) = h1; } }
    __syncthreads();
    { const int ch = tid & 255, half = tid >> 8;
        float w[31];
#pragma unroll
        for (int j = 0; j < 31; ++j) w[j] = p.cv_w[(size_t)(l * 31 + j) * 256 + ch];
        const float bias = p.cv_b[l * 256 + ch];
        float o[16];
#pragma unroll
        for (int i = 0; i < 16; ++i) o[i] = bias;
#pragma unroll
        for (int r = 0; r < 46; ++r) { const float hv = hb[(half * 16 + r) * 256 + ch];
#pragma unroll
            for (int i = 0; i < 16; ++i) { const int j = r - i; if (j >= 0 && j <= 30) o[i] = fmaf(hv, w[j], o[i]); } }
#pragma unroll
        for (int i = 0; i < 16; ++i) ob[(half * 16 + i) * 256 + ch] = o[i]; }
    __syncthreads();
    { const int wave = tid >> 6, lane = tid & 63;
        const f32x4 lw = *(const f32x4*)(p.cv_ln_w + l * 256 + lane * 4), lbv = *(const f32x4*)(p.cv_ln_b + l * 256 + lane * 4);
        bf16_t* mix = (bf16_t*)(p.ws + WS_HB);
#pragma unroll
        for (int i = 0; i < 4; ++i) { const int tl = wave * 4 + i;
            const f32x4 xv = *(LAS f32x4*)(ob + tl * 256 + lane * 4);
            const float mu = wave_sum(xv[0] + xv[1] + xv[2] + xv[3]) * (1.f / 256.f);
            const f32x4 dv = xv - mu;
            const float var = wave_sum(dv[0] * dv[0] + dv[1] * dv[1] + dv[2] * dv[2] + dv[3] * dv[3]) * (1.f / 256.f);
            const float rs = rsqrtf(var + EPS);
            const f32x4 y = dv * rs * lw + lbv;
            u32x2 o2; o2.x = cvt_pk_bf16(siluf_(y[0]), siluf_(y[1])); o2.y = cvt_pk_bf16(siluf_(y[2]), siluf_(y[3]));
            *(u32x2*)(mix + (size_t)(b * SEQ + t0 + tl) * DM + 768 + lane * 4) = o2; } }
    __syncthreads();
}

constexpr float IDX_WSCALE = 0.35355339059327373f * 0.17677669529663687f;
__device__ __forceinline__ f32x4 idx_scores(const bf16x8 ka, const bf16x8 (&qi)[8], const float (&wq)[8]) {
    f32x4 s = (f32x4){0.f, 0.f, 0.f, 0.f};
#pragma unroll
    for (int h = 0; h < 8; ++h) { const f32x4 d = mfma16(ka, qi[h], (f32x4){0.f, 0.f, 0.f, 0.f});
#pragma unroll
        for (int r = 0; r < 4; ++r) s[r] = __builtin_fmaf(wq[h], fmaxf(d[r], 0.f), s[r]); }
    return s;
}

__device__ __forceinline__ void cnt_ge(int& cn, unsigned a, unsigned b) { asm("v_cmp_ge_u32 vcc, %1, %2\n\tv_addc_co_u32 %0, vcc, 0, %0, vcc" : "+v"(cn) : "v"(a), "v"(b) : "vcc"); }
__device__ __forceinline__ void cnt_ge16(int& cn, const unsigned (&A)[4], const unsigned (&B)[4], const unsigned (&C)[4], const unsigned (&D)[4], unsigned b) {
#define CG_(n) "v_cmp_ge_u32 vcc, %" #n ", %17\n\tv_addc_co_u32 %0, vcc, 0, %0, vcc\n\t"
    asm(CG_(1) CG_(2) CG_(3) CG_(4) CG_(5) CG_(6) CG_(7) CG_(8) CG_(9) CG_(10) CG_(11) CG_(12) CG_(13) CG_(14) CG_(15) CG_(16)
        : "+v"(cn) : "v"(A[0]), "v"(A[1]), "v"(A[2]), "v"(A[3]), "v"(B[0]), "v"(B[1]), "v"(B[2]), "v"(B[3]), "v"(C[0]), "v"(C[1]), "v"(C[2]), "v"(C[3]), "v"(D[0]), "v"(D[1]), "v"(D[2]), "v"(D[3]), "v"(b) : "vcc");
#undef CG_
}
constexpr int TH_ROW = 40, TH_BUF = 1024 * TH_ROW * 2, TH_CNT = TH_BUF;
__device__ __forceinline__ void thr_item(const Params& p, int b, int qt, LAS unsigned char* sm) {
    const int tid = TID, w = __builtin_amdgcn_readfirstlane(tid >> 6), l = tid & 63, c16 = l & 15, g = l >> 4;
    LAS unsigned* cnt = (LAS unsigned*)(sm + TH_CNT);
    const bf16_t* proj = (const bf16_t*)(p.ws + WS_BIG) + (size_t)b * SEQ * DINP;
    const int q = qt * 16 + c16;
    const bf16_t* qrow = proj + (size_t)q * DINP;
    bf16x8 qi[8]; float wq[8];
#pragma unroll
    for (int h = 0; h < 8; ++h) qi[h] = *(const bf16x8*)(qrow + OFF_IQ + h * 32 + g * 8);
    { const bf16x8 wv = *(const bf16x8*)(qrow + OFF_IW);
#pragma unroll
        for (int h = 0; h < 8; ++h) wq[h] = bf2f(wv[h]) * IDX_WSCALE; }
    unsigned sc[32][4];
    const int ni = (qt >= w) ? ((qt - w) >> 3) + 1 : 0;
    const int nchunk = (qt >> 6) + 1;
    const bf16_t* gsrc = proj + (size_t)(tid >> 2) * DINP + OFF_IK + (tid & 3) * 8;
    const int ldst = (tid >> 2) * TH_ROW + (tid & 3) * 8;
    bf16x8 stg[8];
#define TH_LOAD(ck_) do { const bf16_t* s_ = gsrc + (size_t)(ck_) * 1024 * DINP; _Pragma("unroll") for (int m_ = 0; m_ < 8; ++m_) stg[m_] = *(const bf16x8*)(s_ + (size_t)(128 * m_) * DINP); } while (0)
#define TH_STORE() do { LAS bf16_t* d_ = (LAS bf16_t*)sm + ldst; _Pragma("unroll") for (int m_ = 0; m_ < 8; ++m_) *(LAS bf16x8*)(d_ + 128 * m_ * TH_ROW) = stg[m_]; } while (0)
    TH_LOAD(0);
    for (int i = tid; i < 48 * 16; i += NTHREADS) cnt[i] = 0u;
#pragma unroll
    for (int ck = 0; ck < 4; ++ck) {
        if (ck < nchunk) {
            TH_STORE();
            __syncthreads();
            if (ck + 1 < nchunk) TH_LOAD(ck + 1);
            LAS bf16_t* B = (LAS bf16_t*)sm;
#pragma unroll
            for (int j = 0; j < 8; ++j) { const int i = ck * 8 + j, kt = w + 8 * i;
                if (kt <= qt) { const bf16x8 ka = *(LAS bf16x8*)(B + ((j * 8 + w) * 16 + c16) * TH_ROW + g * 8);
                    const f32x4 s = idx_scores(ka, qi, wq);
#pragma unroll
                    for (int r = 0; r < 4; ++r) { const int key = kt * 16 + 4 * g + r; sc[i][r] = (key <= q) ? sortable(s[r]) : 0u; }
                } else { sc[i][0] = 0u; sc[i][1] = 0u; sc[i][2] = 0u; sc[i][3] = 0u; } }
            if (ck + 1 < nchunk) __syncthreads();
        } else {
#pragma unroll
            for (int j = 0; j < 8; ++j) { sc[ck * 8 + j][0] = 0u; sc[ck * 8 + j][1] = 0u; sc[ck * 8 + j][2] = 0u; sc[ck * 8 + j][3] = 0u; }
        }
    }
#undef TH_LOAD
#undef TH_STORE
#define TH_XCHG(tot_) do { __hip_atomic_fetch_add(&cnt[it * 16 + c16], (unsigned)cn, __ATOMIC_RELAXED, __HIP_MEMORY_SCOPE_WORKGROUP); __syncthreads(); tot_ = (int)cnt[it * 16 + c16]; } while (0)
    unsigned T = 0u; bool done = false; int it = 0;
    for (; it < 32; ++it) {
        const unsigned cand = T | (1u << (31 - it)); int cn = 0;
#pragma unroll
        for (int gi = 0; gi < 4; ++gi) if (ni > 8 * gi) {
#pragma unroll
            for (int i = 8 * gi; i < 8 * gi + 8; i += 4) cnt_ge16(cn, sc[i], sc[i + 1], sc[i + 2], sc[i + 3], cand); }
        int tot; TH_XCHG(tot);
        if (!done) { if (tot >= TOPK) T = cand; if (tot == TOPK) done = true; }
        if (__all(done)) { ++it; break; }
    }
    unsigned ceq = 4095u; bool tied = false;
    const bool open = !done && (T != 0u);
    if (!__all(!open)) {
        int ngt = 0, nge = 0;
        for (int e = 0; e < 2; ++e, ++it) {
            const unsigned cand = (e == 0) ? T + 1u : T; int cn = 0;
#pragma unroll
            for (int gi = 0; gi < 4; ++gi) if (ni > 8 * gi) {
#pragma unroll
            for (int i = 8 * gi; i < 8 * gi + 8; ++i) { cnt_ge(cn, sc[i][0], cand); cnt_ge(cn, sc[i][1], cand); cnt_ge(cn, sc[i][2], cand); cnt_ge(cn, sc[i][3], cand); } }
            int tot; TH_XCHG(tot);
            if (e == 0) ngt = tot; else nge = tot;
        }
        const int need = TOPK - ngt; const bool excess = open && (nge - ngt > need);
#pragma unroll
        for (int i = 0; i < 32; ++i)
#pragma unroll
            for (int r = 0; r < 4; ++r) sc[i][r] = (sc[i][r] == T) ? (unsigned)((w + 8 * i) * 16 + 4 * g + r) : (sc[i][r] > T ? 0xfffffffeu : 0xffffffffu);
        unsigned c = 0u;
        for (int s = 0; s < 12; ++s, ++it) {
            const unsigned cand = c | (1u << (11 - s)); int cn = 0;
#pragma unroll
            for (int gi = 0; gi < 4; ++gi) if (ni > 8 * gi) {
#pragma unroll
                for (int i = 8 * gi; i < 8 * gi + 8; ++i) { cnt_ge(cn, cand - 1u, sc[i][0]); cnt_ge(cn, cand - 1u, sc[i][1]); cnt_ge(cn, cand - 1u, sc[i][2]); cnt_ge(cn, cand - 1u, sc[i][3]); } }
            int tot; TH_XCHG(tot);
            if (tot < need) c = cand;
        }
        if (excess) ceq = c;
        tied = true;
    }
#undef TH_XCHG
    LAS unsigned* lm = (LAS unsigned*)sm;
    __syncthreads();
    for (int i = tid; i < 2048; i += NTHREADS) lm[i] = 0u;
    __syncthreads();
    { const unsigned Tm = T > 1u ? T : 1u; const bool allow_eq = (T != 0u);
#pragma unroll
        for (int gi = 0; gi < 4; ++gi) if (ni > 8 * gi) {
#pragma unroll
            for (int i = 8 * gi; i < 8 * gi + 8; ++i) { unsigned nib = 0u;
#pragma unroll
                for (int r = 0; r < 4; ++r) { const unsigned v = sc[i][r];
                    const bool s_ = tied ? ((v == 0xfffffffeu) || (allow_eq && v <= ceq)) : (v >= Tm);
                    nib |= s_ ? (1u << r) : 0u; }
                const int kt = w + 8 * i;
                if (nib) __hip_atomic_fetch_or(&lm[c16 * 128 + (kt >> 1)], nib << (4 * g + 16 * (kt & 1)), __ATOMIC_RELAXED, __HIP_MEMORY_SCOPE_WORKGROUP); } }
    }
    __syncthreads();
    { unsigned* gm = (unsigned*)(p.ws + WS_MASK) + (size_t)(b * SEQ + qt * 16) * 128;
        *(u32x4*)(gm + tid * 4) = *(LAS u32x4*)(lm + tid * 4); }
    __syncthreads();
}

constexpr int AT_KROW = 264, AT_IROW = 40, AT_VROW = 40;
constexpr int AT_OFFI = 32 * AT_KROW * 2, AT_OFFV = AT_OFFI + 32 * AT_IROW * 2, AT_BUF = AT_OFFV + 256 * AT_VROW * 2;
__device__ __forceinline__ int at_row(int r) { return (r & 3) + 4 * ((r >> 3) & 3) + 16 * ((r >> 2) & 1); }
__device__ __forceinline__ void attn_item(const Params& p, int b, int qb, LAS unsigned char* sm) {
    const int tid = TID, w = __builtin_amdgcn_readfirstlane(tid >> 6), l = tid & 63, c16 = l & 15, g = l >> 4, qs = w & 3, hp = w >> 2;
    const bf16_t* proj = (const bf16_t*)(p.ws + WS_BIG) + (size_t)b * SEQ * DINP;
    const bf16_t* vt = (const bf16_t*)(p.ws + WS_VT) + (size_t)b * 4 * 64 * SEQ;
    const int q = qb * 64 + qs * 16 + c16;
    const bf16_t* qrow = proj + (size_t)q * DINP;
    const unsigned* mrow = (const unsigned*)(p.ws + WS_MASK) + (size_t)(b * SEQ + q) * 128;
    bf16x8 Qb[2][2];
#pragma unroll
    for (int hh = 0; hh < 2; ++hh)
#pragma unroll
        for (int kk = 0; kk < 2; ++kk) { const bf16x8 raw = *(const bf16x8*)(qrow + OFF_SQ + (2 * hp + hh) * 64 + kk * 32 + g * 8); bf16x8 o;
#pragma unroll
            for (int e = 0; e < 8; ++e) o[e] = (short)f2bf(bf2f(raw[e]) * 0.125f);
            Qb[hh][kk] = o; }
    f32x4 O[2][4];
#pragma unroll
    for (int hh = 0; hh < 2; ++hh)
#pragma unroll
        for (int dt = 0; dt < 4; ++dt) O[hh][dt] = (f32x4){0.f, 0.f, 0.f, 0.f};
    float mrun[2] = {-1e30f, -1e30f}, lrun[2] = {0.f, 0.f};
    const int nt = 2 * qb + 2, my_nt = (qb * 64 + qs * 16 + 15) / 32 + 1;
    const int kr0 = tid >> 5, kc = (tid & 31) * 8, vr0 = tid >> 2, vc = (tid & 3) * 8;
    const bf16_t* gK = proj + (size_t)kr0 * DINP + OFF_SK + kc;
    const bf16_t* gV = vt + (size_t)vr0 * SEQ + vc;
    const int lK0 = at_row(kr0) * AT_KROW + kc, lK1 = at_row(kr0 + 16) * AT_KROW + kc;
    const int lV0 = AT_OFFV / 2 + vr0 * AT_VROW + vc, lV1 = AT_OFFV / 2 + (vr0 + 128) * AT_VROW + vc;
    bf16x8 sA[4], sB[4]; unsigned mw = 0u, mwA = 0u, mwB = 0u;
#define AT_LOAD(S_, M_, k0_) do { S_[0] = *(const bf16x8*)(gK + (size_t)(k0_) * DINP); S_[1] = *(const bf16x8*)(gK + (size_t)((k0_) + 16) * DINP); \
        M_ = mrow[(k0_) >> 5]; S_[2] = *(const bf16x8*)(gV + (k0_)); S_[3] = *(const bf16x8*)(gV + (size_t)128 * SEQ + (k0_)); } while (0)
#define AT_STORE(S_, buf_) do { LAS bf16_t* B_ = (LAS bf16_t*)(sm + (buf_) * AT_BUF); *(LAS bf16x8*)(B_ + lK0) = S_[0]; *(LAS bf16x8*)(B_ + lK1) = S_[1]; \
        *(LAS bf16x8*)(B_ + lV0) = S_[2]; *(LAS bf16x8*)(B_ + lV1) = S_[3]; } while (0)
    AT_LOAD(sA, mwA, 0); AT_STORE(sA, 0); mw = mwA;
    AT_LOAD(sB, mwB, 32);
    __syncthreads();
    for (int t2 = 0; t2 < nt; t2 += 2) {
#pragma unroll
      for (int par = 0; par < 2; ++par) {
        const int t = t2 + par, k0 = t * 32;
        if (t + 2 < nt) { if (par == 0) AT_LOAD(sA, mwA, k0 + 64); else AT_LOAD(sB, mwB, k0 + 64); }
        if (t < my_nt) {
            LAS bf16_t* Bk = (LAS bf16_t*)(sm + par * AT_BUF); LAS bf16_t* Bv = Bk + AT_OFFV / 2;
            bool sel[2][4]; float lg[2][2][4];
#pragma unroll
            for (int s = 0; s < 2; ++s) {
                const int lrow = 16 * s + c16;
#pragma unroll
                for (int r = 0; r < 4; ++r) sel[s][r] = ((mw >> (8 * g + 4 * s + r)) & 1u) != 0u;
#pragma unroll
                for (int hh = 0; hh < 2; ++hh) { f32x4 S = (f32x4){0.f, 0.f, 0.f, 0.f};
#pragma unroll
                    for (int kk = 0; kk < 2; ++kk) { const bf16x8 kf = *(LAS bf16x8*)(Bk + lrow * AT_KROW + (2 * hp + hh) * 64 + kk * 32 + g * 8); S = mfma16(kf, Qb[hh][kk], S); }
#pragma unroll
                    for (int r = 0; r < 4; ++r) lg[hh][s][r] = S[r]; }
            }
#pragma unroll
            for (int hh = 0; hh < 2; ++hh) {
                float lm_[8];
#pragma unroll
                for (int s = 0; s < 2; ++s)
#pragma unroll
                    for (int r = 0; r < 4; ++r) lm_[s * 4 + r] = sel[s][r] ? lg[hh][s][r] : -1e30f;
                float mx = fmaxf(fmaxf(fmaxf(lm_[0], lm_[1]), fmaxf(lm_[2], lm_[3])), fmaxf(fmaxf(lm_[4], lm_[5]), fmaxf(lm_[6], lm_[7])));
                mx = xrow16_max(mx);
                const float mn = fmaxf(mrun[hh], mx), alpha = __expf(mrun[hh] - mn), mn2 = mn * 1.4426950408889634f;
                mrun[hh] = mn;
                float pv[8]; float ps = 0.f;
#pragma unroll
                for (int e = 0; e < 8; ++e) { pv[e] = (mn > -1e29f) ? __builtin_amdgcn_exp2f(__builtin_fmaf(lm_[e], 1.4426950408889634f, -mn2)) : 0.f; ps += pv[e]; }
                lrun[hh] = lrun[hh] * alpha + ps;
                union { bf16x8 v; unsigned u[4]; } pb;
                pb.u[0] = cvt_pk_bf16(pv[0], pv[1]); pb.u[1] = cvt_pk_bf16(pv[2], pv[3]); pb.u[2] = cvt_pk_bf16(pv[4], pv[5]); pb.u[3] = cvt_pk_bf16(pv[6], pv[7]);
                if (__any(alpha != 1.f)) {
#pragma unroll
                    for (int dt = 0; dt < 4; ++dt) O[hh][dt] = O[hh][dt] * alpha; }
                bf16x8 va4[4];
#pragma unroll
                for (int dt = 0; dt < 4; ++dt) va4[dt] = *(LAS bf16x8*)(Bv + ((2 * hp + hh) * 64 + dt * 16 + c16) * AT_VROW + g * 8);
                __builtin_amdgcn_s_setprio(1);
#pragma unroll
                for (int dt = 0; dt < 4; ++dt) O[hh][dt] = mfma16(va4[dt], pb.v, O[hh][dt]);
                __builtin_amdgcn_s_setprio(0);
            }
        }
        if (t + 1 < nt) { if (par == 0) { AT_STORE(sB, 1); mw = mwB; } else { AT_STORE(sA, 0); mw = mwA; } }
        __syncthreads();
      }
    }
#undef AT_LOAD
#undef AT_STORE
    bf16_t* mix = (bf16_t*)(p.ws + WS_HB) + (size_t)(b * SEQ + q) * DM + 512;
#pragma unroll
    for (int hh = 0; hh < 2; ++hh) { const float tot = xrow16_sum(lrun[hh]);
        const float inv = 1.f / tot;
#pragma unroll
        for (int dt = 0; dt < 4; ++dt) { const f32x4 o = O[hh][dt] * inv; u32x2 o2; o2.x = cvt_pk_bf16(o[0], o[1]); o2.y = cvt_pk_bf16(o[2], o[3]);
            *(u32x2*)(mix + (2 * hp + hh) * 64 + dt * 16 + 4 * g) = o2; } }
}

__device__ __forceinline__ void hgrn_G(const bf16x8 (&fv)[2], const float* lb, LAS float* Gs, LAS float* segtot) {
    const int tid = TID;
#pragma unroll
    for (int i = 0; i < 2; ++i) { const int row = (tid >> 4) + 32 * i, c8 = (tid & 15) * 8;
        const bf16x8 v = fv[i];
#pragma unroll
        for (int j = 0; j < 8; ++j) { const float fr = bf2f(v[j]), lbv = lb[c8 + j]; const float f = lbv + (1.f - lbv) * sigmoidf_(fr);
            Gs[row * 129 + c8 + j] = __builtin_amdgcn_logf(fmaxf(f, 1e-30f)); } }
    __syncthreads();
    const int col = tid & 127, seg = tid >> 7;
    { float run = 0.f;
#pragma unroll
        for (int r = 0; r < 16; ++r) { const int idx = (seg * 16 + r) * 129 + col; run += Gs[idx]; Gs[idx] = run; }
        segtot[seg * 128 + col] = run; }
    __syncthreads();
    { float off = 0.f;
#pragma unroll
        for (int s = 0; s < 3; ++s) if (s < seg) off += segtot[s * 128 + col];
        if (seg > 0) {
#pragma unroll
            for (int r = 0; r < 16; ++r) Gs[(seg * 16 + r) * 129 + col] += off; } }
    __syncthreads();
}

__device__ __forceinline__ void hgrn_A_item(const Params& p, int l, int b, int h, int c, LAS unsigned char* sm) {
    const int tid = TID, w = __builtin_amdgcn_readfirstlane(tid >> 6), ln = tid & 63, c16 = ln & 15, g = ln >> 4;
    LAS float* Gs = (LAS float*)sm; LAS float* segtot = (LAS float*)(sm + 33024);
    LAS bf16_t* KgT = (LAS bf16_t*)(sm + 35072); LAS bf16_t* vT = (LAS bf16_t*)(sm + 53504);
    LAS bf16_t* qt_ = (LAS bf16_t*)(sm + 71936); LAS bf16_t* kt_ = (LAS bf16_t*)(sm + 89344); LAS bf16_t* Am = (LAS bf16_t*)(sm + 106752);
    bf16_t* prow0 = (bf16_t*)(p.ws + WS_BIG) + (size_t)(b * SEQ + c * 64) * DINP;
    const float* lb = (const float*)(p.ws + WS_LB) + l * 512 + h * 128;
    bf16x8 fG[2], qG[2];
#pragma unroll
    for (int i = 0; i < 2; ++i) { const bf16_t* rq = prow0 + (size_t)((tid >> 4) + 32 * i) * DINP + h * 128 + (tid & 15) * 8; fG[i] = *(const bf16x8*)(rq + OFF_HF); qG[i] = *(const bf16x8*)(rq + OFF_HQ); }
    const bf16_t* rp = prow0 + (size_t)(tid & 63) * DINP + h * 128 + (tid >> 6) * 16;
    const bf16x8 f0 = *(const bf16x8*)(rp + OFF_HF), f1 = *(const bf16x8*)(rp + OFF_HF + 8), v0 = *(const bf16x8*)(rp + OFF_HI), v1 = *(const bf16x8*)(rp + OFF_HI + 8);
    hgrn_G(fG, lb, Gs, segtot);
#pragma unroll
    for (int i = 0; i < 2; ++i) { const int row = (tid >> 4) + 32 * i, c8 = (tid & 15) * 8;
        const bf16x8 qv8 = qG[i], fv8 = fG[i];
        float a[8], bq[8], cq[8];
#pragma unroll
        for (int j = 0; j < 8; ++j) { const int k = c8 + j; const float G = Gs[row * 129 + k], Gm = Gs[31 * 129 + k], lbv = lb[k];
            const float qv = siluf_(bf2f(qv8[j])) * 0.08838834764831845f, kval = (1.f - lbv) * sigmoidf_(-bf2f(fv8[j]));
            a[j] = qv * __builtin_amdgcn_exp2f(fminf(G - Gm, 115.f)); bq[j] = kval * __builtin_amdgcn_exp2f(fminf(Gm - G, 115.f)); cq[j] = qv * __builtin_amdgcn_exp2f(G); }
        u32x4 o;
        o.x = cvt_pk_bf16(a[0], a[1]); o.y = cvt_pk_bf16(a[2], a[3]); o.z = cvt_pk_bf16(a[4], a[5]); o.w = cvt_pk_bf16(a[6], a[7]); *(LAS u32x4*)(qt_ + row * 136 + c8) = o;
        o.x = cvt_pk_bf16(bq[0], bq[1]); o.y = cvt_pk_bf16(bq[2], bq[3]); o.z = cvt_pk_bf16(bq[4], bq[5]); o.w = cvt_pk_bf16(bq[6], bq[7]); *(LAS u32x4*)(kt_ + row * 136 + c8) = o;
        o.x = cvt_pk_bf16(cq[0], cq[1]); o.y = cvt_pk_bf16(cq[2], cq[3]); o.z = cvt_pk_bf16(cq[4], cq[5]); o.w = cvt_pk_bf16(cq[6], cq[7]);
        *(u32x4*)(prow0 + (size_t)row * DINP + OFF_HQ + h * 128 + c8) = o; }
    { const int j = tid & 63, kg = tid >> 6;
#pragma unroll
        for (int e = 0; e < 16; ++e) { const int k = kg * 16 + e; const float fr = bf2f(e < 8 ? f0[e & 7] : f1[e & 7]), lbv = lb[k];
            const float kval = (1.f - lbv) * sigmoidf_(-fr);
            KgT[k * 72 + j] = f2bf(kval * __builtin_amdgcn_exp2f(Gs[63 * 129 + k] - Gs[j * 129 + k]));
            vT[k * 72 + j] = (bf16_t)(e < 8 ? v0[e & 7] : v1[e & 7]); } }
    const size_t bhc = (size_t)((b * 4 + h) * 64 + c);
    if (tid < 128) ((float*)(p.ws + WS_DEC))[bhc * 128 + tid] = __builtin_amdgcn_exp2f(Gs[63 * 129 + tid]);
    __syncthreads();
    { f32x4 acc[8];
#pragma unroll
        for (int vt = 0; vt < 8; ++vt) acc[vt] = (f32x4){0.f, 0.f, 0.f, 0.f};
#pragma unroll
        for (int kk = 0; kk < 2; ++kk) { const bf16x8 a = *(LAS bf16x8*)(KgT + (w * 16 + c16) * 72 + kk * 32 + g * 8);
#pragma unroll
            for (int vt = 0; vt < 8; ++vt) { const bf16x8 bb = *(LAS bf16x8*)(vT + (vt * 16 + c16) * 72 + kk * 32 + g * 8); acc[vt] = mfma16(a, bb, acc[vt]); } }
        bf16_t* st = (bf16_t*)(p.ws + WS_ST) + bhc * 16384;
#pragma unroll
        for (int vt = 0; vt < 8; ++vt) { u32x2 o; o.x = cvt_pk_bf16(acc[vt][0], acc[vt][1]); o.y = cvt_pk_bf16(acc[vt][2], acc[vt][3]);
            *(u32x2*)(st + (size_t)(vt * 16 + c16) * 128 + w * 16 + 4 * g) = o; } }
#pragma unroll
    for (int s = 0; s < 2; ++s) { const int tI = w * 2 + s, itile = tI >> 2, jt = tI & 3;
        f32x4 d = (f32x4){0.f, 0.f, 0.f, 0.f};
        if (jt <= itile) {
#pragma unroll
            for (int kk = 0; kk < 4; ++kk) { const bf16x8 a = *(LAS bf16x8*)(kt_ + (jt * 16 + c16) * 136 + kk * 32 + g * 8), bb = *(LAS bf16x8*)(qt_ + (itile * 16 + c16) * 136 + kk * 32 + g * 8);
                d = mfma16(a, bb, d); } }
        const int i = itile * 16 + c16, j0 = jt * 16 + 4 * g;
        u32x2 o; o.x = cvt_pk_bf16((j0 + 0 <= i) ? d[0] : 0.f, (j0 + 1 <= i) ? d[1] : 0.f); o.y = cvt_pk_bf16((j0 + 2 <= i) ? d[2] : 0.f, (j0 + 3 <= i) ? d[3] : 0.f);
        *(LAS u32x2*)(Am + i * 72 + j0) = o; }
    __syncthreads();
    { const int itile = w & 3, vh = w >> 2;
        f32x4 acc[4];
#pragma unroll
        for (int vt = 0; vt < 4; ++vt) acc[vt] = (f32x4){0.f, 0.f, 0.f, 0.f};
#pragma unroll
        for (int kk = 0; kk < 2; ++kk) { const bf16x8 bb = *(LAS bf16x8*)(Am + (itile * 16 + c16) * 72 + kk * 32 + g * 8);
#pragma unroll
            for (int vt = 0; vt < 4; ++vt) { const bf16x8 a = *(LAS bf16x8*)(vT + ((vh * 4 + vt) * 16 + c16) * 72 + kk * 32 + g * 8); acc[vt] = mfma16(a, bb, acc[vt]); } }
        bf16_t* mix = (bf16_t*)(p.ws + WS_HB) + (size_t)(b * SEQ + c * 64 + itile * 16 + c16) * DM + h * 128;
#pragma unroll
        for (int vt = 0; vt < 4; ++vt) { u32x2 o; o.x = cvt_pk_bf16(acc[vt][0], acc[vt][1]); o.y = cvt_pk_bf16(acc[vt][2], acc[vt][3]);
            *(u32x2*)(mix + (vh * 4 + vt) * 16 + 4 * g) = o; } }
    __syncthreads();
}

__device__ __forceinline__ void hgrn_scan(const Params& p) {
    bf16_t* ST = (bf16_t*)(p.ws + WS_ST); const float* DEC = (const float*)(p.ws + WS_DEC);
    for (int e = blockIdx.x * NTHREADS + TID; e < 32 * 4096; e += gridDim.x * NTHREADS) {
        const int bh = e >> 12, idx4 = (e & 4095) * 4, k = idx4 & 127;
        bf16_t* base = ST + (size_t)bh * 64 * 16384 + idx4; const float* dec = DEC + (size_t)bh * 64 * 128 + k;
        f32x4 S = (f32x4){0.f, 0.f, 0.f, 0.f};
#pragma unroll 16
        for (int c = 0; c < 64; ++c) { const u32x2 loc = *(const u32x2*)(base + (size_t)c * 16384); const f32x4 d = *(const f32x4*)(dec + c * 128);
            u32x2 o; o.x = cvt_pk_bf16(S[0], S[1]); o.y = cvt_pk_bf16(S[2], S[3]);
            *(u32x2*)(base + (size_t)c * 16384) = o;
            S[0] = d[0] * S[0] + bflo(loc.x); S[1] = d[1] * S[1] + bfhi(loc.x); S[2] = d[2] * S[2] + bflo(loc.y); S[3] = d[3] * S[3] + bfhi(loc.y); }
    }
}

__device__ __forceinline__ void hgrn_C_item(const Params& p, int l, int b, int h, int c, LAS unsigned char* sm) {
    const int tid = TID, w = __builtin_amdgcn_readfirstlane(tid >> 6), ln = tid & 63, c16 = ln & 15, g = ln >> 4;
    LAS float* ssq = (LAS float*)sm;
    const int itile = w & 3, vh = w >> 2, i = itile * 16 + c16;
    const bf16_t* prow = (const bf16_t*)(p.ws + WS_BIG) + (size_t)(b * SEQ + c * 64 + i) * DINP;
    bf16_t* mix = (bf16_t*)(p.ws + WS_HB) + (size_t)(b * SEQ + c * 64 + i) * DM + h * 128;
    const bf16_t* st_ = (const bf16_t*)(p.ws + WS_ST) + (size_t)((b * 4 + h) * 64 + c) * 16384;
    bf16x8 qgF[4], stG[4][4]; u32x2 grG[4], oi[4];
#pragma unroll
    for (int kk = 0; kk < 4; ++kk) qgF[kk] = *(const bf16x8*)(prow + OFF_HQ + h * 128 + kk * 32 + g * 8);
#pragma unroll
    for (int kk = 0; kk < 4; ++kk)
#pragma unroll
        for (int vt = 0; vt < 4; ++vt) stG[kk][vt] = *(const bf16x8*)(st_ + (size_t)((vh * 4 + vt) * 16 + c16) * 128 + kk * 32 + g * 8);
#pragma unroll
    for (int vt = 0; vt < 4; ++vt) { const int v0 = (vh * 4 + vt) * 16 + 4 * g; grG[vt] = *(const u32x2*)(prow + OFF_HG + h * 128 + v0); oi[vt] = *(const u32x2*)(mix + v0); }
    f32x4 acc[4];
#pragma unroll
    for (int vt = 0; vt < 4; ++vt) acc[vt] = (f32x4){bflo(oi[vt].x), bfhi(oi[vt].x), bflo(oi[vt].y), bfhi(oi[vt].y)};
#pragma unroll
    for (int kk = 0; kk < 4; ++kk)
#pragma unroll
        for (int vt = 0; vt < 4; ++vt) acc[vt] = mfma16(stG[kk][vt], qgF[kk], acc[vt]);
    float ss = 0.f;
#pragma unroll
    for (int vt = 0; vt < 4; ++vt) ss += acc[vt][0] * acc[vt][0] + acc[vt][1] * acc[vt][1] + acc[vt][2] * acc[vt][2] + acc[vt][3] * acc[vt][3];
    ss = xrow16_sum(ss);
    if (g == 0) ssq[vh * 64 + i] = ss;
    __syncthreads();
    const float rstd = rsqrtf((ssq[i] + ssq[64 + i]) * (1.f / 128.f) + EPS);
#pragma unroll
    for (int vt = 0; vt < 4; ++vt) { const int v0 = (vh * 4 + vt) * 16 + 4 * g;
        const u32x2 gr = grG[vt]; const f32x4 ow = *(const f32x4*)(p.onorm_w + l * 512 + h * 128 + v0);
        const float r0 = acc[vt][0] * rstd * ow[0] * siluf_(bflo(gr.x)), r1 = acc[vt][1] * rstd * ow[1] * siluf_(bfhi(gr.x));
        const float r2 = acc[vt][2] * rstd * ow[2] * siluf_(bflo(gr.y)), r3 = acc[vt][3] * rstd * ow[3] * siluf_(bfhi(gr.y));
        u32x2 o; o.x = cvt_pk_bf16(r0, r1); o.y = cvt_pk_bf16(r2, r3);
        *(u32x2*)(mix + v0) = o; }
    __syncthreads();
}

#ifdef DIAG_CUT
__device__ __forceinline__ void diag_phase(const Params& p) {
    const int tid = TID, wave = tid >> 6, lane = tid & 63;
    const bf16_t* HB = (const bf16_t*)(p.ws + WS_HB); const bf16_t* ST = (const bf16_t*)(p.ws + WS_ST); const float* DEC = (const float*)(p.ws + WS_DEC);
    const bf16_t* BIG = (const bf16_t*)(p.ws + WS_BIG);
    for (int row = blockIdx.x * 8 + wave; row < NTOK; row += gridDim.x * 8) {
        float* orow = p.out + (size_t)row * DM;
        for (int i = 0; i < 16; ++i) { const int col = i * 64 + lane; float v = 0.f;
#if DIAG_MODE == 1
            for (int t = 0; t < 3; ++t) v += bf2f((short)BIG[(size_t)row * DINP + col + 1024 * t]);
            if (col < 768) v += bf2f((short)BIG[(size_t)row * DINP + 3072 + col]);
#elif DIAG_MODE == 2
            v = bf2f((short)ST[(size_t)row * 1024 + col]) + DEC[((size_t)row * 8 + (col & 7)) % (32 * 64 * 128)];
#elif DIAG_MODE == 5
            v = DEC[((size_t)row * 8 + (col & 7)) % (32 * 64 * 128)];
#elif DIAG_MODE == 6
            v = bf2f((short)ST[(size_t)row * 1024 + col]);
#elif DIAG_MODE == 4
            v = bf2f((short)HB[(size_t)row * DM + col]);
#endif
            if (!(fabsf(v) < 1e30f)) v = 12345.f;
            orow[col] = v; }
    }
}
#endif
#define XB_TMO      128
#define XB_XCNT(j)  (256  + 64 * (j))
#define XB_XSUB(j)  (1280 + 64 * (j))
#define XB_XGEN(j)  (2304 + 64 * (j))
#define XB_TOP      3328
#define XB_TOPGEN   3392
#define XCD_BAR_WORDS 3456
#define XB_SPIN_CAP (1u << 21)

__device__ __forceinline__ unsigned xb_ld(unsigned* p)              { return __hip_atomic_load(p, __ATOMIC_RELAXED, __HIP_MEMORY_SCOPE_AGENT); }
__device__ __forceinline__ unsigned xb_add(unsigned* p, unsigned v) { return __hip_atomic_fetch_add(p, v, __ATOMIC_RELAXED, __HIP_MEMORY_SCOPE_AGENT); }
__device__ __forceinline__ unsigned xb_xcc_id() { return (unsigned)__builtin_amdgcn_s_getreg((3 << 11) | 20) & 0xFu; }
#define XB_SPIN(cond, bar) do { unsigned _sp = 0; while (cond) { __builtin_amdgcn_s_sleep(1); \
    if ((++_sp & 255u) == 0u) { if (xb_ld(&(bar)[XB_TMO])) break; if (_sp > XB_SPIN_CAP) { atomicAdd(&(bar)[XB_TMO], 1u); break; } } } } while (0)

struct XcdBarrier {
    unsigned* bar; unsigned x;
    volatile LAS unsigned* st;
};

__device__ __forceinline__ XcdBarrier xcd_barrier_post(unsigned* bar, volatile LAS unsigned* st) {
    XcdBarrier b; b.bar = bar; b.x = xb_xcc_id(); b.st = st;
    if (threadIdx.x == 0) (void)xb_add(&bar[XB_XCNT(b.x)], 1u);
    return b;
}
__device__ __forceinline__ void xcd_barrier_complete(unsigned* bar, unsigned x, unsigned& nloc, unsigned& nx) {
    const unsigned G = gridDim.x * gridDim.y * gridDim.z;
    unsigned sum, cnt, mine, sp = 0u;
    for (;;) {
        sum = 0u; cnt = 0u; mine = 0u;
#pragma unroll
        for (unsigned j = 0; j < 16; ++j) { const unsigned c = xb_ld(&bar[XB_XCNT(j)]); sum += c; cnt += (c > 0u) ? 1u : 0u; mine = (j == x) ? c : mine; }
        if (sum == G) break;
        __builtin_amdgcn_s_sleep(1);
        if ((++sp & 255u) == 0u) { if (xb_ld(&bar[XB_TMO])) break; if (sp > XB_SPIN_CAP) { atomicAdd(&bar[XB_TMO], 1u); break; } }
    }
    nloc = mine > 0u ? mine : 1u; nx = cnt > 0u ? cnt : 1u;
}

__device__ __forceinline__ void xcd_barrier(const XcdBarrier& b) {
    asm volatile("s_waitcnt vmcnt(0)" ::: "memory");
    __syncthreads();
    if (threadIdx.x == 0) {
        unsigned* bar = b.bar;
        __builtin_amdgcn_s_waitcnt(0);
        unsigned nloc = b.st[0], nx = b.st[1];
        if (nloc == 0u) { xcd_barrier_complete(bar, b.x, nloc, nx); b.st[0] = nloc; b.st[1] = nx; }
        const unsigned old = xb_add(&bar[XB_XSUB(b.x)], 1u);
        const unsigned gen = old / nloc;
        if (old + 1u == (gen + 1u) * nloc) {
            __builtin_amdgcn_fence(__ATOMIC_RELEASE, "agent");
            asm volatile("s_waitcnt vmcnt(0)" ::: "memory");
            const unsigned og = xb_add(&bar[XB_TOP], 1u);
            const unsigned tg = og / nx;
            if (og + 1u == (tg + 1u) * nx) xb_add(&bar[XB_TOPGEN], 1u);
            else XB_SPIN(xb_ld(&bar[XB_TOPGEN]) == tg, bar);
            __builtin_amdgcn_fence(__ATOMIC_ACQUIRE, "agent");
            xb_add(&bar[XB_XGEN(b.x)], 1u);
            asm volatile("s_waitcnt vmcnt(0)" ::: "memory");
        } else {
            XB_SPIN(xb_ld(&bar[XB_XGEN(b.x)]) == gen, bar);
            __builtin_amdgcn_fence(__ATOMIC_ACQUIRE, "agent");
            asm volatile("s_waitcnt vmcnt(0)" ::: "memory");
        }
    }
    __syncthreads();
}


template <class Epi>
__device__ __forceinline__ void run_gemm(LAS unsigned char* lds, const bf16_t* A, const bf16_t* Bt, int M, int N, int K, const Epi& E) {
    pg8::Gemm g; g.A = A; g.Bt = Bt; g.M = M; g.N = N; g.K = K;
    pg8::StaticOrder S; S.init(M, N, (int)gridDim.x, (int)blockIdx.x);
    pg8::gemm_phase<Epi, pg8::StaticOrder, true, true>(lds, g, S, E);
}

constexpr int NPHASE = 2 + 9 * DEPTH;
#define GRID_SYNC() do { if (pin.ph_lo < 0) grid.sync(); xcd_barrier(xb); } while (0)

__global__ void __launch_bounds__(NTHREADS, 2) fwd_megakernel(Params pin) {
    extern __shared__ __attribute__((aligned(16))) unsigned char lds_raw[];
    LAS unsigned char* lds = (LAS unsigned char*)lds_raw;
    cg::grid_group grid = cg::this_grid();
    volatile LAS unsigned* xst = (volatile LAS unsigned*)(lds + 131072);
    if (threadIdx.x == 0) { xst[0] = 0u; xst[1] = 0u; }
    __syncthreads();
    XcdBarrier xb = xcd_barrier_post((unsigned*)(pin.ws + WS_BAR), xst);
    const int G = (int)gridDim.x, blk = (int)blockIdx.x;
    for (int ph = pin.ph_lo; ph < pin.ph_hi; ++ph) {
        Params p = pin;
        { size_t zoff = 0; asm volatile("" : "+s"(zoff));
            p.ws = pin.ws + zoff; p.out = pin.out + zoff; p.x = pin.x + zoff; }
        bf16_t* WIN = (bf16_t*)(p.ws + WS_WIN); bf16_t* WOUT = (bf16_t*)(p.ws + WS_WOUT); bf16_t* W1B = (bf16_t*)(p.ws + WS_W1); bf16_t* W2B = (bf16_t*)(p.ws + WS_W2);
        const float* MOD = (const float*)(p.ws + WS_MOD);
        bf16_t* BIG = (bf16_t*)(p.ws + WS_BIG); bf16_t* HB = (bf16_t*)(p.ws + WS_HB);
        if (ph == 0) {
          for (int rep_ = 0; rep_ < REP_PRO; ++rep_) {
            cvt_kind(p.w_in, WIN, DM, DIN, DINP, (LAS float*)lds);
            cvt_kind(p.w_out, WOUT, DM, DM, DM, (LAS float*)lds);
            cvt_kind(p.w1, W1B, DM, DFF, DFF, (LAS float*)lds);
            cvt_kind(p.w2, W2B, DFF, DM, DM, (LAS float*)lds);
            mod_phase(p, (LAS float*)lds);
            lb_phase(p);
          }
        } else if (ph == NPHASE - 1) {
            final_norm(p.out, p.final_w);
        } else {
            const int l = (ph - 1) / 9, s = (ph - 1) % 9;
            const float* modl = MOD + (size_t)l * NB * 6144;
            const float* xcur = (l == 0) ? p.x : p.out;
            if (s == 0) {
                for (int rep_ = 0; rep_ < REP_NORM; ++rep_) rmsnorm_mod(xcur, p.norm_mix_w + l * DM, modl, 0, 1024, HB);
            } else if (s == 1) {
                pg8::EpiBf16<0> E; E.O = BIG; E.ldc = DINP;
                for (int rep_ = 0; rep_ < REP_GEMM; ++rep_) run_gemm(lds, HB, WIN + (size_t)l * DINP * DM, NTOK, DINP, DM, E);
            } else if (s == 2) {
              for (int rep2_ = 0; rep2_ < REP_S2; ++rep2_) {
#ifndef DIAG_NOTHR
                for (int v = blk; v < 2048; v += G) { const int itp = v >> 8, rem = v & 255, b = rem & 7, jj = rem >> 3; const int qt = itp * 32 + ((itp & 1) ? 31 - jj : jj); for (int rep_ = 0; rep_ < REP_THR; ++rep_) thr_item(p, b, qt, lds); }
#endif
                for (int v = blk; v < 2048; v += G) { const int c = v & 63, bh = v >> 6; hgrn_A_item(p, l, bh >> 2, bh & 3, c, lds); }
                for (int v = blk; v < 1024; v += G) conv_item(p, l, v >> 7, v & 127, lds);
                for (int v = blk; v < 512; v += G) vt_item(p, v >> 6, v & 63, lds);
              }
            } else if (s == 3) {
                hgrn_scan(p);
                for (int v = blk; v < 512; v += G) { const int itp = v >> 8, rem = v & 255, b = rem & 7, jj = rem >> 3; const int qb = itp ? 63 - jj : jj; for (int rep_ = 0; rep_ < REP_ATTN; ++rep_) attn_item(p, b, qb, lds); }
            } else if (s == 4) {
                for (int rep_ = 0; rep_ < REP_HO; ++rep_) for (int v = blk; v < 2048; v += G) { const int c = v & 63, bh = v >> 6; hgrn_C_item(p, l, bh >> 2, bh & 3, c, lds); }
            } else if (s == 5) {
                pg8::EpiResid E; E.xs = xcur; E.xd = p.out; E.gate = modl + 2048;
                run_gemm(lds, HB, WOUT + (size_t)l * DM * DM, NTOK, DM, DM, E);
            } else if (s == 6) {
                for (int rep_ = 0; rep_ < REP_NORM; ++rep_) rmsnorm_mod(p.out, p.norm_mlp_w + l * DM, modl, 3072, 4096, HB);
            } else if (s == 7) {
                pg8::EpiBf16<1> E; E.O = BIG; E.ldc = DFF;
                for (int rep_ = 0; rep_ < REP_GEMM; ++rep_) run_gemm(lds, HB, W1B + (size_t)l * DFF * DM, NTOK, DFF, DM, E);
            } else {
                pg8::EpiResid E; E.xs = p.out; E.xd = p.out; E.gate = modl + 5120;
                run_gemm(lds, BIG, W2B + (size_t)l * DM * DFF, NTOK, DM, DFF, E);
            }
        }
        if (ph + 1 < pin.ph_hi) { GRID_SYNC(); }
    }
#ifdef DIAG_CUT
    { const int ph = 1; GRID_SYNC(); } diag_phase(pin);
#endif
}

extern "C" void kernel_launch(void* const* d_in, const int* in_sizes, int n_in, void* d_out, int out_size, void* d_ws, size_t ws_size, hipStream_t stream) {
    static int grid_blocks = 0;
    if (grid_blocks == 0) {
        if (n_in != 17 || out_size != NTOK * DM || ws_size < WS_END) { fprintf(stderr, "kernel_launch: unexpected shapes (n_in %d out %d ws %zu need %zu)\n", n_in, out_size, ws_size, (size_t)WS_END); grid_blocks = -1; return; }
        int dev = 0, cus = 0, per_cu = 0;
        hipGetDevice(&dev);
        hipDeviceGetAttribute(&cus, hipDeviceAttributeMultiprocessorCount, dev);
        if (hipFuncSetAttribute((const void*)fwd_megakernel, hipFuncAttributeMaxDynamicSharedMemorySize, LDS_BYTES) != hipSuccess) { fprintf(stderr, "kernel_launch: hipFuncSetAttribute failed\n"); grid_blocks = -1; return; }
        if (hipOccupancyMaxActiveBlocksPerMultiprocessor(&per_cu, (const void*)fwd_megakernel, NTHREADS, LDS_BYTES) != hipSuccess || per_cu < 1) { fprintf(stderr, "kernel_launch: occupancy query says %d blocks/CU\n", per_cu); per_cu = 1; }
        (void)hipGetLastError();
        grid_blocks = cus * (per_cu > 1 ? 1 : per_cu);
    }
    if (grid_blocks < 0) return;
    Params p{};
    p.x = (const float*)d_in[0]; p.c = (const float*)d_in[1]; p.ada_w = (const float*)d_in[2]; p.ada_b = (const float*)d_in[3];
    p.norm_mix_w = (const float*)d_in[4]; p.norm_mlp_w = (const float*)d_in[5]; p.w_in = (const float*)d_in[6]; p.lb_logits = (const float*)d_in[7];
    p.onorm_w = (const float*)d_in[8]; p.cv_w = (const float*)d_in[9]; p.cv_b = (const float*)d_in[10]; p.cv_ln_w = (const float*)d_in[11]; p.cv_ln_b = (const float*)d_in[12];
    p.w_out = (const float*)d_in[13]; p.w1 = (const float*)d_in[14]; p.w2 = (const float*)d_in[15]; p.final_w = (const float*)d_in[16];
    p.out = (float*)d_out; p.ws = (unsigned char*)d_ws; p.ph_lo = 0; p.ph_hi = NPHASE;
#ifdef DIAG_CUT
    p.ph_hi = DIAG_CUT;
#endif
    if (hipMemsetAsync((char*)d_ws + WS_BAR, 0, 16384, stream) != hipSuccess) { fprintf(stderr, "kernel_launch: hipMemsetAsync failed\n"); return; }
    void* args[] = {&p};
    hipError_t e = hipLaunchCooperativeKernel((const void*)fwd_megakernel, dim3(grid_blocks), dim3(NTHREADS), args, LDS_BYTES, stream);
    if (e != hipSuccess) fprintf(stderr, "kernel_launch: cooperative launch failed: %s (grid %d)\n", hipGetErrorString(e), grid_blocks);
}
```

```cpp
#include <hip/hip_runtime.h>
#include <hip/hip_cooperative_groups.h>
#include <cstdio>
#include <cstdint>
namespace cg = cooperative_groups;

#define LAS __attribute__((address_space(3)))
typedef unsigned short bf16_t;
typedef short bf16x8 __attribute__((ext_vector_type(8)));
typedef float f32x4 __attribute__((ext_vector_type(4)));
typedef unsigned u32x4 __attribute__((ext_vector_type(4)));
typedef unsigned u32x2 __attribute__((ext_vector_type(2)));

constexpr int DM = 1024, NB = 8, SEQ = 4096, DEPTH = 4, NTOK = NB * SEQ;
constexpr int DIN = 3624, DINP = 3840, DFF = 4096;
constexpr int OFF_HQ = 0, OFF_HF = 512, OFF_HI = 1024, OFF_HG = 1536, OFF_SQ = 2048, OFF_SK = 2304, OFF_SV = 2560, OFF_IQ = 2816, OFF_IK = 3072, OFF_IW = 3104, OFF_CU = 3112;
constexpr int TOPK = 256;
constexpr float EPS = 1e-6f;
constexpr int NTHREADS = 512;
constexpr int LDS_BYTES = 131072 + 64;

constexpr size_t WS_WIN = 0;
constexpr size_t WS_WOUT = WS_WIN + (size_t)DEPTH * DINP * DM * 2;
constexpr size_t WS_W1 = WS_WOUT + (size_t)DEPTH * DM * DM * 2;
constexpr size_t WS_W2 = WS_W1 + (size_t)DEPTH * DFF * DM * 2;
constexpr size_t WS_MOD = WS_W2 + (size_t)DEPTH * DM * DFF * 2;
constexpr size_t WS_LB = WS_MOD + (size_t)DEPTH * NB * 6 * DM * 4;
constexpr size_t WS_BIG = WS_LB + (size_t)DEPTH * 512 * 4;
constexpr size_t WS_MASK = WS_BIG + (size_t)NTOK * DINP * 2;
static_assert((size_t)NTOK * DINP * 2 + (size_t)NTOK * 128 * 4 <= (size_t)NTOK * DFF * 2, "mask overlay");
constexpr size_t WS_HB = WS_BIG + (size_t)NTOK * DFF * 2;
constexpr size_t WS_ST = WS_HB + (size_t)NTOK * DM * 2;
constexpr size_t WS_DEC = WS_ST + (size_t)32 * 64 * 16384 * 2;
constexpr size_t WS_VT = WS_DEC + (size_t)32 * 64 * 128 * 4;
constexpr size_t WS_THRT = WS_VT + (size_t)NB * 4 * 64 * SEQ * 2;
constexpr size_t WS_THRC = WS_THRT + (size_t)NTOK * 4;
constexpr size_t WS_BAR = WS_THRC + (size_t)NTOK * 4;
constexpr size_t WS_END = WS_BAR + 16384;
static_assert(WS_END <= (size_t)512 * 1024 * 1024, "workspace map exceeds 512 MiB");

struct Params {
    const float* x; const float* c; const float* ada_w; const float* ada_b; const float* norm_mix_w; const float* norm_mlp_w;
    const float* w_in; const float* lb_logits; const float* onorm_w; const float* cv_w; const float* cv_b; const float* cv_ln_w; const float* cv_ln_b;
    const float* w_out; const float* w1; const float* w2; const float* final_w;
    float* out; unsigned char* ws;
    int ph_lo, ph_hi;
};

typedef float f32x2_t __attribute__((ext_vector_type(2)));
typedef __bf16 bf16x2_t __attribute__((ext_vector_type(2)));
__device__ __forceinline__ unsigned cvt_pk_bf16(float lo, float hi) { const f32x2_t v = {lo, hi}; return __builtin_bit_cast(unsigned, __builtin_convertvector(v, bf16x2_t)); }
__device__ __forceinline__ float bf2f(short h) { return __uint_as_float(((unsigned)(unsigned short)h) << 16); }
__device__ __forceinline__ float bflo(unsigned w) { return __uint_as_float(w << 16); }
__device__ __forceinline__ float bfhi(unsigned w) { return __uint_as_float(w & 0xffff0000u); }
__device__ __forceinline__ bf16_t f2bf(float f) { return (bf16_t)(cvt_pk_bf16(f, 0.f) & 0xffffu); }
__device__ __forceinline__ float wave_sum(float v) {
    v += __shfl_xor(v, 32); v += __shfl_xor(v, 16); v += __shfl_xor(v, 8); v += __shfl_xor(v, 4); v += __shfl_xor(v, 2); v += __shfl_xor(v, 1); return v;
}
__device__ __forceinline__ float xrow16_max(float x) {
    auto s = __builtin_amdgcn_permlane16_swap(__float_as_uint(x), __float_as_uint(x), false, false);
    x = fmaxf(__uint_as_float(s[0]), __uint_as_float(s[1]));
    auto t = __builtin_amdgcn_permlane32_swap(__float_as_uint(x), __float_as_uint(x), false, false);
    return fmaxf(__uint_as_float(t[0]), __uint_as_float(t[1]));
}
__device__ __forceinline__ float xrow16_sum(float x) {
    auto s = __builtin_amdgcn_permlane16_swap(__float_as_uint(x), __float_as_uint(x), false, false);
    x = __uint_as_float(s[0]) + __uint_as_float(s[1]);
    auto t = __builtin_amdgcn_permlane32_swap(__float_as_uint(x), __float_as_uint(x), false, false);
    return __uint_as_float(t[0]) + __uint_as_float(t[1]);
}
__device__ __forceinline__ float sigmoidf_(float x) { return __builtin_amdgcn_rcpf(1.f + __expf(-x)); }
__device__ __forceinline__ float siluf_(float x) { return x * __builtin_amdgcn_rcpf(1.f + __expf(-x)); }
__device__ __forceinline__ unsigned sortable(float f) { unsigned b = __float_as_uint(f); return b ^ ((b & 0x80000000u) ? 0xffffffffu : 0x80000000u); }
__device__ __forceinline__ f32x4 mfma16(bf16x8 a, bf16x8 b, f32x4 c) { return __builtin_amdgcn_mfma_f32_16x16x32_bf16(a, b, c, 0, 0, 0); }

namespace pg8 {
#define PG8_LAS __attribute__((address_space(3)))
constexpr int BM = 256, BK = 64, HALF = 128, HTB = HALF * BK * 2, STAGE_BYTES = 8 * HTB, NXCD = 8, WGM = 2;
__host__ __device__ __forceinline__ int lds_byte(int r, int c) { const int st = (r >> 4) * 2 + (c >> 5), rr = r & 15, cc = c & 31, ob = rr * 64 + cc * 2; return st * 1024 + (ob ^ (((ob >> 9) & 1) << 5)); }
__host__ __device__ __forceinline__ void stage_rc(int b, int& R, int& C) { const int st = b / 1024, sb = b % 1024, swz = sb ^ (((sb >> 9) & 1) << 5); R = (st >> 1) * 16 + swz / 64; C = (st & 1) * 32 + (swz % 64) / 2; }
__host__ __device__ __forceinline__ int perm32(int rho) { const int n = rho >> 4, i = rho & 15; return 8 * (i >> 2) + 4 * n + (i & 3); }
struct Unit { int pm, pn; };
struct Gemm { const bf16_t* A; const bf16_t* Bt; int M, N, K; };
struct StaticOrder {
    int nM, nN, nwg, G, c;
    __host__ __device__ void init(int M, int N, int G_, int c_) { nM = M / BM; nN = N / BM; nwg = nM * nN; G = G_; c = c_; }
    __host__ __device__ bool next(int i, Unit& u) const {
        const long L = (long)i * G + c; if (L >= nwg) return false;
        int wgid = (int)L; { const int q = nwg / NXCD, r = nwg % NXCD, xcd = wgid % NXCD, off = wgid / NXCD; wgid = (xcd < r ? xcd * (q + 1) : r * (q + 1) + (xcd - r) * q) + off; }
        const int nig = WGM * nN, gid = wgid / nig, fm = gid * WGM, gsz = (nM - fm) < WGM ? (nM - fm) : WGM;
        u.pm = fm + ((wgid % nig) % gsz); u.pn = (wgid % nig) / gsz; return true;
    }
    __device__ __forceinline__ void a_ready(const Unit&) const {}
    __device__ __forceinline__ void done(const Unit&) const {}
};

template <int ACT  > struct EpiBf16 {
    static constexpr bool PERM = true, AFTER_DRAIN = false;
    bf16_t* O; int ldc;
    __device__ __forceinline__ void operator()(const f32x4 (&acc)[2][2][4][2], const Unit& u, int wr, int wc, int fr, int fq) const {
        const int row0 = u.pm * BM + wr * 64 + fr, col0 = u.pn * BM + wc * 32 + 8 * fq;
#pragma unroll
        for (int ai = 0; ai < 2; ++ai)
#pragma unroll
            for (int m = 0; m < 4; ++m) { bf16_t* rowp = O + (size_t)(row0 + ai * HALF + m * 16) * ldc + col0;
#pragma unroll
                for (int bj = 0; bj < 2; ++bj) { f32x4 v0 = acc[ai][bj][m][0], v1 = acc[ai][bj][m][1];
                    if (ACT == 1) {
#pragma unroll
                        for (int j = 0; j < 4; ++j) { const float a = fmaxf(v0[j], 0.f), b = fmaxf(v1[j], 0.f); v0[j] = a * a; v1[j] = b * b; } }
                    u32x4 w; w.x = cvt_pk_bf16(v0[0], v0[1]); w.y = cvt_pk_bf16(v0[2], v0[3]); w.z = cvt_pk_bf16(v1[0], v1[1]); w.w = cvt_pk_bf16(v1[2], v1[3]);
                    __builtin_nontemporal_store(w, (u32x4*)(rowp + bj * HALF)); } }
    }
};
struct EpiResid {
    static constexpr bool PERM = true, AFTER_DRAIN = false;
    const float* xs; float* xd; const float* gate;
    __device__ __forceinline__ void operator()(const f32x4 (&acc)[2][2][4][2], const Unit& u, int wr, int wc, int fr, int fq) const {
        const int row0 = u.pm * BM + wr * 64 + fr, col0 = u.pn * BM + wc * 32 + 8 * fq;
        const float* gp = gate + (size_t)((u.pm * BM) >> 12) * 6144 + col0;
        f32x4 gv[2][2];
#pragma unroll
        for (int bj = 0; bj < 2; ++bj)
#pragma unroll
            for (int n = 0; n < 2; ++n) gv[bj][n] = *(const f32x4*)(gp + bj * HALF + 4 * n);
#pragma unroll
        for (int ai = 0; ai < 2; ++ai)
#pragma unroll
            for (int m = 0; m < 4; ++m) { const size_t off = (size_t)(row0 + ai * HALF + m * 16) * DM + col0;
#pragma unroll
                for (int bj = 0; bj < 2; ++bj)
#pragma unroll
                    for (int n = 0; n < 2; ++n) { const f32x4 xv = *(const f32x4*)(xs + off + bj * HALF + 4 * n);
                        *(f32x4*)(xd + off + bj * HALF + 4 * n) = xv + gv[bj][n] * acc[ai][bj][m][n]; } }
    }
};
template <class Epi, class Sched, bool ALIGN_EPI = false, bool SP2 = false>
__device__ __forceinline__ void gemm_phase(PG8_LAS unsigned char* lds, const Gemm g, const Sched& S, const Epi& E) {
    int tid_ = threadIdx.x; asm volatile("" : "+v"(tid_)); const int tid = tid_, wid = __builtin_amdgcn_readfirstlane(tid >> 6), lane = tid & 63, wr = wid >> 2, wc = wid & 3, fr = lane & 15, fq = lane >> 4;
    const int K = g.K, nt = K / BK;
    unsigned voffA[2], voffB[2];
#pragma unroll
    for (int i = 0; i < 2; ++i) { int R, C; stage_rc(tid * 16 + i * 8192, R, C); const int Rb = Epi::PERM ? ((R & ~31) + perm32(R & 31)) : R;
        voffA[i] = (unsigned)(R * K + C) * 2u; voffB[i] = (unsigned)(Rb * K + C) * 2u; }
    const size_t kstep = (size_t)(BK * 2);
    const size_t hstep = (size_t)HALF * K * 2;
    const size_t tstep = 2 * hstep;
    const unsigned ldsw = (unsigned)wid * 1024u;
    const int aoff = lds_byte(wr * 64 + fr, fq * 8), boff = lds_byte(wc * 32 + fr, fq * 8);
#define PG8_SA(b, h) (((b) * 2 + (h)) * HTB)
#define PG8_SB(b, h) ((4 + (b) * 2 + (h)) * HTB)
#define PG8_STAGE(bufoff, gbase, voff) do { _Pragma("unroll") for (int _i = 0; _i < 2; ++_i) \
        __builtin_amdgcn_global_load_lds((const unsigned*)((const char*)(gbase) + (voff)[_i]), (PG8_LAS unsigned*)(lds + (bufoff) + ldsw + _i * 8192), 16, 0, 0); } while (0)
#define PG8_LDA(dst, b, h) do { _Pragma("unroll") for (int m = 0; m < 4; ++m) _Pragma("unroll") for (int k = 0; k < 2; ++k) dst[m][k] = *(const PG8_LAS bf16x8*)(lds + PG8_SA(b, h) + aoff + m * 2048 + k * 1024); } while (0)
#define PG8_LDB(dst, b, h) do { _Pragma("unroll") for (int n = 0; n < 2; ++n) _Pragma("unroll") for (int k = 0; k < 2; ++k) dst[n][k] = *(const PG8_LAS bf16x8*)(lds + PG8_SB(b, h) + boff + n * 2048 + k * 1024); } while (0)
#define PG8_MMA(ai, bj, At, Bt) do { __builtin_amdgcn_s_setprio(1); _Pragma("unroll") for (int m = 0; m < 4; ++m) _Pragma("unroll") for (int n = 0; n < 2; ++n) _Pragma("unroll") for (int k = 0; k < 2; ++k) \
        acc[ai][bj][m][n] = __builtin_amdgcn_mfma_f32_16x16x32_bf16(Bt[n][k], At[m][k], acc[ai][bj][m][n], 0, 0, 0); __builtin_amdgcn_s_setprio(0); } while (0)
#define PG8_WAIT_V(n) asm volatile("s_waitcnt vmcnt(" #n ")" ::: "memory")
#define PG8_WAIT_L(n) asm volatile("s_waitcnt lgkmcnt(" #n ")" ::: "memory")
#define PG8_BAR __builtin_amdgcn_s_barrier()
#define PG8_SCHED __builtin_amdgcn_sched_barrier(0)
    Unit cur, nxt; int ui = 0;
    if (!S.next(0, cur)) return;
    f32x4 acc[2][2][4][2];
#pragma unroll
    for (int a = 0; a < 2; ++a)
#pragma unroll
        for (int b = 0; b < 2; ++b)
#pragma unroll
            for (int m = 0; m < 4; ++m)
#pragma unroll
                for (int n = 0; n < 2; ++n) acc[a][b][m][n] = (f32x4){0.f, 0.f, 0.f, 0.f};
    bf16x8 At[4][2], B0[2][2], B1[2][2];
    const char* cA = (const char*)g.A + (size_t)cur.pm * tstep; const char* cB = (const char*)g.Bt + (size_t)cur.pn * tstep;
    S.a_ready(cur);
    if constexpr (SP2) {
        PG8_STAGE(PG8_SB(0, 0), cB, voffB); PG8_STAGE(PG8_SB(0, 1), cB + hstep, voffB); PG8_STAGE(PG8_SA(0, 0), cA, voffA); PG8_STAGE(PG8_SA(0, 1), cA + hstep, voffA);
        if (wr == 1) PG8_BAR;
        PG8_WAIT_V(2); PG8_BAR;
        PG8_STAGE(PG8_SB(1, 0), cB + kstep, voffB); PG8_STAGE(PG8_SA(1, 0), cA + kstep, voffA); PG8_STAGE(PG8_SB(1, 1), cB + hstep + kstep, voffB);
        PG8_WAIT_V(6); PG8_BAR;
    } else {
        PG8_STAGE(PG8_SB(0, 0), cB, voffB); PG8_STAGE(PG8_SA(0, 0), cA, voffA); PG8_STAGE(PG8_SB(0, 1), cB + hstep, voffB); PG8_STAGE(PG8_SA(0, 1), cA + hstep, voffA);
        if (wr == 1) PG8_BAR;
        PG8_WAIT_V(4); PG8_BAR;
        PG8_STAGE(PG8_SB(1, 0), cB + kstep, voffB); PG8_STAGE(PG8_SA(1, 0), cA + kstep, voffA); PG8_STAGE(PG8_SB(1, 1), cB + hstep + kstep, voffB);
        PG8_WAIT_V(6); PG8_BAR;
    }
    for (;;) {
        const bool has_next = S.next(ui + 1, nxt);
        const char* nA = has_next ? (const char*)g.A + (size_t)nxt.pm * tstep : cA; const char* nB = has_next ? (const char*)g.Bt + (size_t)nxt.pn * tstep : cB;
        for (int t = 0; t < nt; t += 2) {
            const bool last = (t == nt - 2);
            const char* a1 = cA + (size_t)(t + 1) * kstep;
            const char* a2 = last ? nA : cA + (size_t)(t + 2) * kstep; const char* b2 = last ? nB : cB + (size_t)(t + 2) * kstep;
            const char* a3 = a2 + kstep; const char* b3 = b2 + kstep;
            if (last && has_next) S.a_ready(nxt);
            if constexpr (SP2) {
            PG8_LDB(B0, 0, 0); PG8_LDB(B1, 0, 1); PG8_SCHED; PG8_LDA(At, 0, 0); PG8_STAGE(PG8_SA(1, 1), a1 + hstep, voffA);
            PG8_WAIT_V(8); PG8_WAIT_L(0); PG8_BAR; PG8_MMA(0, 0, At, B0); PG8_MMA(0, 1, At, B1); PG8_BAR; PG8_SCHED;
            PG8_LDA(At, 0, 1); PG8_STAGE(PG8_SB(0, 0), b2, voffB); PG8_STAGE(PG8_SB(0, 1), b2 + hstep, voffB); PG8_STAGE(PG8_SA(0, 0), a2, voffA);
            PG8_WAIT_V(8); PG8_WAIT_L(0); PG8_BAR; PG8_MMA(1, 0, At, B0); PG8_MMA(1, 1, At, B1); PG8_BAR; PG8_SCHED;
            PG8_LDB(B0, 1, 0); PG8_LDB(B1, 1, 1); PG8_SCHED; PG8_LDA(At, 1, 0); PG8_STAGE(PG8_SA(0, 1), a2 + hstep, voffA);
            PG8_WAIT_V(8); PG8_WAIT_L(0); PG8_BAR; PG8_MMA(0, 0, At, B0); PG8_MMA(0, 1, At, B1); PG8_BAR; PG8_SCHED;
            PG8_LDA(At, 1, 1); PG8_STAGE(PG8_SB(1, 0), b3, voffB); PG8_STAGE(PG8_SB(1, 1), b3 + hstep, voffB); PG8_STAGE(PG8_SA(1, 0), a3, voffA);
            PG8_WAIT_V(8); PG8_WAIT_L(0); PG8_BAR; PG8_MMA(1, 0, At, B0); PG8_MMA(1, 1, At, B1); PG8_BAR; PG8_SCHED;
            } else {
            PG8_LDB(B0, 0, 0); PG8_SCHED; PG8_LDA(At, 0, 0); PG8_STAGE(PG8_SA(1, 1), a1 + hstep, voffA);
            PG8_WAIT_L(8); PG8_BAR; PG8_WAIT_L(0); PG8_MMA(0, 0, At, B0); PG8_BAR; PG8_SCHED;
            PG8_LDB(B1, 0, 1); PG8_STAGE(PG8_SB(0, 0), b2, voffB);
            PG8_BAR; PG8_WAIT_L(0); PG8_MMA(0, 1, At, B1); PG8_BAR;
            PG8_LDA(At, 0, 1); PG8_STAGE(PG8_SA(0, 0), a2, voffA);
            PG8_BAR; PG8_WAIT_L(0); PG8_MMA(1, 0, At, B0); PG8_BAR; PG8_SCHED;
            PG8_STAGE(PG8_SB(0, 1), b2 + hstep, voffB);
            PG8_WAIT_V(6); PG8_BAR; PG8_MMA(1, 1, At, B1); PG8_BAR;
            PG8_LDB(B0, 1, 0); PG8_SCHED; PG8_LDA(At, 1, 0); PG8_STAGE(PG8_SA(0, 1), a2 + hstep, voffA);
            PG8_WAIT_L(8); PG8_BAR; PG8_WAIT_L(0); PG8_MMA(0, 0, At, B0); PG8_BAR; PG8_SCHED;
            PG8_LDB(B1, 1, 1); PG8_STAGE(PG8_SB(1, 0), b3, voffB);
            PG8_BAR; PG8_WAIT_L(0); PG8_MMA(0, 1, At, B1); PG8_BAR;
            PG8_LDA(At, 1, 1); PG8_STAGE(PG8_SA(1, 0), a3, voffA);
            PG8_BAR; PG8_WAIT_L(0); PG8_MMA(1, 0, At, B0); PG8_BAR; PG8_SCHED;
            PG8_STAGE(PG8_SB(1, 1), b3 + hstep, voffB);
            PG8_WAIT_V(6); PG8_BAR; PG8_MMA(1, 1, At, B1); PG8_BAR;
            }
        }
        if constexpr (ALIGN_EPI) { if (wr == 0) PG8_BAR; }
        if constexpr (!Epi::AFTER_DRAIN) { E(acc, cur, wr, wc, fr, fq); S.done(cur); }
        if (!has_next) break;
#pragma unroll
        for (int a = 0; a < 2; ++a)
#pragma unroll
            for (int b = 0; b < 2; ++b)
#pragma unroll
                for (int m = 0; m < 4; ++m)
#pragma unroll
                    for (int n = 0; n < 2; ++n) acc[a][b][m][n] = (f32x4){0.f, 0.f, 0.f, 0.f};
        cur = nxt; cA = nA; cB = nB; ++ui;
        if constexpr (ALIGN_EPI) { if (wr == 1) PG8_BAR; }
    }
    PG8_WAIT_V(0);
    if constexpr (!ALIGN_EPI) { if (wr == 0) PG8_BAR; }
    PG8_BAR;
    if constexpr (Epi::AFTER_DRAIN) { E.fused(acc, cur, wr, wc, fr, fq, lds, wid, lane); S.done(cur); }
#undef PG8_SA
#undef PG8_SB
#undef PG8_STAGE
#undef PG8_LDA
#undef PG8_LDB
#undef PG8_MMA
#undef PG8_WAIT_V
#undef PG8_WAIT_L
#undef PG8_BAR
#undef PG8_SCHED
}
}

#ifndef REP_THR
#define REP_THR 1
#endif
#ifndef REP_NORM
#define REP_NORM 1
#endif
#ifndef REP_PRO
#define REP_PRO 1
#endif
#ifndef REP_ATTN
#define REP_ATTN 1
#endif
#ifndef REP_S2
#define REP_S2 1
#endif
#ifndef REP_GEMM
#define REP_GEMM 1
#endif
#ifndef REP_HO
#define REP_HO 1
#endif
__device__ __forceinline__ int ltid() { int t = threadIdx.x; asm volatile("" : "+v"(t)); return t; }
#define TID ltid()

__device__ __forceinline__ void cvt_kind(const float* __restrict__ src, bf16_t* __restrict__ dst, int K, int N, int Npad, LAS float* tl) {
    const int tid = TID, nk = K / 64, nn = Npad / 64, per = nk * nn, total = DEPTH * per;
    for (int t = blockIdx.x; t < total; t += gridDim.x) {
        const int l = t / per, r = t % per, kt = r / nn, nt = r % nn;
        const float* s = src + (size_t)l * K * N; bf16_t* d = dst + (size_t)l * Npad * K;
#pragma unroll
        for (int i = 0; i < 2; ++i) { const int kr = (tid >> 4) + 32 * i, nc = (tid & 15) * 4, n = nt * 64 + nc;
            f32x4 v = (f32x4){0.f, 0.f, 0.f, 0.f};
            if (n < N) v = *(const f32x4*)(s + (size_t)(kt * 64 + kr) * N + n);
            tl[kr * 65 + nc + 0] = v[0]; tl[kr * 65 + nc + 1] = v[1]; tl[kr * 65 + nc + 2] = v[2]; tl[kr * 65 + nc + 3] = v[3]; }
        __syncthreads();
        { const int n = tid >> 3, k8 = (tid & 7) * 8; u32x4 w;
            w.x = cvt_pk_bf16(tl[(k8 + 0) * 65 + n], tl[(k8 + 1) * 65 + n]); w.y = cvt_pk_bf16(tl[(k8 + 2) * 65 + n], tl[(k8 + 3) * 65 + n]);
            w.z = cvt_pk_bf16(tl[(k8 + 4) * 65 + n], tl[(k8 + 5) * 65 + n]); w.w = cvt_pk_bf16(tl[(k8 + 6) * 65 + n], tl[(k8 + 7) * 65 + n]);
            *(u32x4*)(d + (size_t)(nt * 64 + n) * K + kt * 64 + k8) = w; }
        __syncthreads();
    }
}

__device__ __forceinline__ void mod_phase(const Params& p, LAS float* sm) {
    const int tid = TID;
    LAS float* cact = sm; LAS float* red = sm + 8192;
    for (int i = tid; i < NB * DM; i += NTHREADS) cact[i] = siluf_(p.c[i]);
    __syncthreads();
    float* MOD = (float*)(p.ws + WS_MOD);
    for (int it = blockIdx.x; it < DEPTH * 96; it += gridDim.x) {
        const int l = it / 96, j0 = (it % 96) * 64, col = tid & 63, seg = tid >> 6;
        const float* w = p.ada_w + (size_t)l * DM * 6144 + j0 + col;
        float a0 = 0.f, a1 = 0.f, a2 = 0.f, a3 = 0.f, a4 = 0.f, a5 = 0.f, a6 = 0.f, a7 = 0.f;
#pragma unroll 8
        for (int k = seg * 128; k < seg * 128 + 128; ++k) { const float wv = w[(size_t)k * 6144];
            a0 += cact[0 * DM + k] * wv; a1 += cact[1 * DM + k] * wv; a2 += cact[2 * DM + k] * wv; a3 += cact[3 * DM + k] * wv;
            a4 += cact[4 * DM + k] * wv; a5 += cact[5 * DM + k] * wv; a6 += cact[6 * DM + k] * wv; a7 += cact[7 * DM + k] * wv; }
        red[(seg * 8 + 0) * 64 + col] = a0; red[(seg * 8 + 1) * 64 + col] = a1; red[(seg * 8 + 2) * 64 + col] = a2; red[(seg * 8 + 3) * 64 + col] = a3;
        red[(seg * 8 + 4) * 64 + col] = a4; red[(seg * 8 + 5) * 64 + col] = a5; red[(seg * 8 + 6) * 64 + col] = a6; red[(seg * 8 + 7) * 64 + col] = a7;
        __syncthreads();
        { const int b = tid >> 6; float s = p.ada_b[l * 6144 + j0 + col];
#pragma unroll
            for (int sg = 0; sg < 8; ++sg) s += red[(sg * 8 + b) * 64 + col];
            MOD[(size_t)(l * NB + b) * 6144 + j0 + col] = s; }
        __syncthreads();
    }
}

__device__ __forceinline__ void lb_phase(const Params& p) {
    if (blockIdx.x != 0) return;
    const int k = TID; float* LB = (float*)(p.ws + WS_LB);
    const float v0 = p.lb_logits[k], v1 = p.lb_logits[512 + k], v2 = p.lb_logits[1024 + k], v3 = p.lb_logits[1536 + k];
    const float mx = fmaxf(fmaxf(v0, v1), fmaxf(v2, v3));
    const float e0 = expf(v0 - mx), e1 = expf(v1 - mx), e2 = expf(v2 - mx), e3 = expf(v3 - mx), inv = 1.f / (e0 + e1 + e2 + e3);
    const float p0 = e0 * inv, p1 = e1 * inv, p2 = e2 * inv, p3 = e3 * inv;
    LB[k] = p0 - p0; LB[512 + k] = (p0 + p1) - p0; LB[1024 + k] = ((p0 + p1) + p2) - p0; LB[1536 + k] = (((p0 + p1) + p2) + p3) - p0;
}

__device__ __forceinline__ void rmsnorm_mod(const float* __restrict__ xs, const float* __restrict__ w, const float* __restrict__ mod, int sh_off, int sc_off, bf16_t* __restrict__ dst) {
    const int tid = TID, wave = tid >> 6, lane = tid & 63;
    const int row0 = blockIdx.x * 8 + wave, rstep = gridDim.x * 8;
    f32x4 v[4], nv[4];
    if (row0 < NTOK) {
#pragma unroll
        for (int i = 0; i < 4; ++i) nv[i] = *(const f32x4*)(xs + (size_t)row0 * DM + i * 256 + lane * 4); }
    for (int row = row0; row < NTOK; row += rstep) {
        float ss = 0.f;
#pragma unroll
        for (int i = 0; i < 4; ++i) { v[i] = nv[i]; ss += v[i][0] * v[i][0] + v[i][1] * v[i][1] + v[i][2] * v[i][2] + v[i][3] * v[i][3]; }
        if (row + rstep < NTOK) {
#pragma unroll
            for (int i = 0; i < 4; ++i) nv[i] = *(const f32x4*)(xs + (size_t)(row + rstep) * DM + i * 256 + lane * 4); }
        ss = wave_sum(ss);
        const float rstd = rsqrtf(ss * (1.f / DM) + EPS);
        const float* mb = mod + (size_t)(row >> 12) * 6144;
#pragma unroll
        for (int i = 0; i < 4; ++i) { const int col = i * 256 + lane * 4;
            const f32x4 ww = *(const f32x4*)(w + col), sc = *(const f32x4*)(mb + sc_off + col), sh = *(const f32x4*)(mb + sh_off + col);
            const f32x4 h = (v[i] * rstd * ww) * (sc + 1.f) + sh;
            u32x2 o; o.x = cvt_pk_bf16(h[0], h[1]); o.y = cvt_pk_bf16(h[2], h[3]);
            *(u32x2*)(dst + (size_t)row * DM + col) = o; }
    }
}
__device__ __forceinline__ void final_norm(float* __restrict__ x, const float* __restrict__ w) {
    const int tid = TID, wave = tid >> 6, lane = tid & 63;
    for (int row = blockIdx.x * 8 + wave; row < NTOK; row += gridDim.x * 8) {
        float* xr = x + (size_t)row * DM; f32x4 v[4]; float ss = 0.f;
#pragma unroll
        for (int i = 0; i < 4; ++i) { v[i] = *(const f32x4*)(xr + i * 256 + lane * 4); ss += v[i][0] * v[i][0] + v[i][1] * v[i][1] + v[i][2] * v[i][2] + v[i][3] * v[i][3]; }
        ss = wave_sum(ss);
        const float rstd = rsqrtf(ss * (1.f / DM) + EPS);
#pragma unroll
        for (int i = 0; i < 4; ++i) { const int col = i * 256 + lane * 4; const f32x4 ww = *(const f32x4*)(w + col); *(f32x4*)(xr + col) = v[i] * rstd * ww; }
    }
}

__device__ __forceinline__ void vt_item(const Params& p, int b, int tt, LAS unsigned char* sm) {
    const int tid = TID; LAS bf16_t* vb = (LAS bf16_t*)sm;
    const bf16_t* proj = (const bf16_t*)(p.ws + WS_BIG) + (size_t)(b * SEQ + tt * 64) * DINP + OFF_SV;
#pragma unroll
    for (int i = 0; i < 4; ++i) { const int idx = tid + NTHREADS * i, row = idx >> 5, c8 = (idx & 31) * 8;
        *(LAS bf16x8*)(vb + row * 264 + c8) = *(const bf16x8*)(proj + (size_t)row * DINP + c8); }
    __syncthreads();
    { const int col = tid >> 1, half = tid & 1;
        bf16_t* dst = (bf16_t*)(p.ws + WS_VT) + ((size_t)(b * 4 + (col >> 6)) * 64 + (col & 63)) * SEQ + tt * 64 + half * 32;
#pragma unroll
        for (int i = 0; i < 4; ++i) { bf16x8 o;
#pragma unroll
            for (int e = 0; e < 8; ++e) o[e] = (short)vb[(half * 32 + i * 8 + e) * 264 + col];
            *(bf16x8*)(dst + i * 8) = o; } }
    __syncthreads();
}

__device__ __forceinline__ void conv_item(const Params& p, int l, int b, int tt, LAS unsigned char* sm) {
    const int tid = TID; LAS float* hb = (LAS float*)sm;
    LAS float* ob = (LAS float*)(sm + 62 * 256 * 4);
    const int t0 = tt * 32;
    const bf16_t* proj = (const bf16_t*)(p.ws + WS_BIG) + (size_t)b * SEQ * DINP + OFF_CU;
#pragma unroll
    for (int i = 0; i < 4; ++i) { const int idx = tid + NTHREADS * i;
        if (idx < 62 * 32) { const int row = idx >> 5, c8 = (idx & 31) * 8, t = t0 - 30 + row;
            f32x4 h0 = (f32x4){0.f, 0.f, 0.f, 0.f}, h1 = h0;
            if (t >= 0) { const bf16x8 a = *(const bf16x8*)(proj + (size_t)t * DINP + c8), g = *(const bf16x8*)(proj + (size_t)t * DINP + 256 + c8);
#pragma unroll
                for (int j = 0; j < 4; ++j) { h0[j] = bf2f(a[j]) * sigmoidf_(bf2f(g[j])); h1[j] = bf2f(a[4 + j]) * sigmoidf_(bf2f(g[4 + j])); } }
            *(LAS f32x4*)(hb + row * 256 + c8) = h0; *(LAS f32x4*)(hb + row * 256 + c8 + 4) = h1; } }
    __syncthreads();
    { const int ch = tid & 255, half = tid >> 8;
        float w[31];
#pragma unroll
        for (int j = 0; j < 31; ++j) w[j] = p.cv_w[(size_t)(l * 31 + j) * 256 + ch];
        const float bias = p.cv_b[l * 256 + ch];
        float o[16];
#pragma unroll
        for (int i = 0; i < 16; ++i) o[i] = bias;
#pragma unroll
        for (int r = 0; r < 46; ++r) { const float hv = hb[(half * 16 + r) * 256 + ch];
#pragma unroll
            for (int i = 0; i < 16; ++i) { const int j = r - i; if (j >= 0 && j <= 30) o[i] = fmaf(hv, w[j], o[i]); } }
#pragma unroll
        for (int i = 0; i < 16; ++i) ob[(half * 16 + i) * 256 + ch] = o[i]; }
    __syncthreads();
    { const int wave = tid >> 6, lane = tid & 63;
        const f32x4 lw = *(const f32x4*)(p.cv_ln_w + l * 256 + lane * 4), lbv = *(const f32x4*)(p.cv_ln_b + l * 256 + lane * 4);
        bf16_t* mix = (bf16_t*)(p.ws + WS_HB);
#pragma unroll
        for (int i = 0; i < 4; ++i) { const int tl = wave * 4 + i;
            const f32x4 xv = *(LAS f32x4*)(ob + tl * 256 + lane * 4);
            const float mu = wave_sum(xv[0] + xv[1] + xv[2] + xv[3]) * (1.f / 256.f);
            const f32x4 dv = xv - mu;
            const float var = wave_sum(dv[0] * dv[0] + dv[1] * dv[1] + dv[2] * dv[2] + dv[3] * dv[3]) * (1.f / 256.f);
            const float rs = rsqrtf(var + EPS);
            const f32x4 y = dv * rs * lw + lbv;
            u32x2 o2; o2.x = cvt_pk_bf16(siluf_(y[0]), siluf_(y[1])); o2.y = cvt_pk_bf16(siluf_(y[2]), siluf_(y[3]));
            *(u32x2*)(mix + (size_t)(b * SEQ + t0 + tl) * DM + 768 + lane * 4) = o2; } }
    __syncthreads();
}

constexpr float IDX_WSCALE = 0.35355339059327373f * 0.17677669529663687f;
__device__ __forceinline__ f32x4 idx_scores(const bf16x8 ka, const bf16x8 (&qi)[8], const float (&wq)[8]) {
    f32x4 s = (f32x4){0.f, 0.f, 0.f, 0.f};
#pragma unroll
    for (int h = 0; h < 8; ++h) { const f32x4 d = mfma16(ka, qi[h], (f32x4){0.f, 0.f, 0.f, 0.f});
#pragma unroll
        for (int r = 0; r < 4; ++r) s[r] = __builtin_fmaf(wq[h], fmaxf(d[r], 0.f), s[r]); }
    return s;
}

__device__ __forceinline__ void cnt_ge(int& cn, unsigned a, unsigned b) { asm("v_cmp_ge_u32 vcc, %1, %2\n\tv_addc_co_u32 %0, vcc, 0, %0, vcc" : "+v"(cn) : "v"(a), "v"(b) : "vcc"); }
__device__ __forceinline__ void cnt_ge16(int& cn, const unsigned (&A)[4], const unsigned (&B)[4], const unsigned (&C)[4], const unsigned (&D)[4], unsigned b) {
#define CG_(n) "v_cmp_ge_u32 vcc, %" #n ", %17\n\tv_addc_co_u32 %0, vcc, 0, %0, vcc\n\t"
    asm(CG_(1) CG_(2) CG_(3) CG_(4) CG_(5) CG_(6) CG_(7) CG_(8) CG_(9) CG_(10) CG_(11) CG_(12) CG_(13) CG_(14) CG_(15) CG_(16)
        : "+v"(cn) : "v"(A[0]), "v"(A[1]), "v"(A[2]), "v"(A[3]), "v"(B[0]), "v"(B[1]), "v"(B[2]), "v"(B[3]), "v"(C[0]), "v"(C[1]), "v"(C[2]), "v"(C[3]), "v"(D[0]), "v"(D[1]), "v"(D[2]), "v"(D[3]), "v"(b) : "vcc");
#undef CG_
}
constexpr int TH_ROW = 40, TH_BUF = 1024 * TH_ROW * 2, TH_CNT = TH_BUF;
__device__ __forceinline__ void thr_item(const Params& p, int b, int qt, LAS unsigned char* sm) {
    const int tid = TID, w = __builtin_amdgcn_readfirstlane(tid >> 6), l = tid & 63, c16 = l & 15, g = l >> 4;
    LAS unsigned* cnt = (LAS unsigned*)(sm + TH_CNT);
    const bf16_t* proj = (const bf16_t*)(p.ws + WS_BIG) + (size_t)b * SEQ * DINP;
    const int q = qt * 16 + c16;
    const bf16_t* qrow = proj + (size_t)q * DINP;
    bf16x8 qi[8]; float wq[8];
#pragma unroll
    for (int h = 0; h < 8; ++h) qi[h] = *(const bf16x8*)(qrow + OFF_IQ + h * 32 + g * 8);
    { const bf16x8 wv = *(const bf16x8*)(qrow + OFF_IW);
#pragma unroll
        for (int h = 0; h < 8; ++h) wq[h] = bf2f(wv[h]) * IDX_WSCALE; }
    unsigned sc[32][4];
    const int ni = (qt >= w) ? ((qt - w) >> 3) + 1 : 0;
    const int nchunk = (qt >> 6) + 1;
    const bf16_t* gsrc = proj + (size_t)(tid >> 2) * DINP + OFF_IK + (tid & 3) * 8;
    const int ldst = (tid >> 2) * TH_ROW + (tid & 3) * 8;
    bf16x8 stg[8];
#define TH_LOAD(ck_) do { const bf16_t* s_ = gsrc + (size_t)(ck_) * 1024 * DINP; _Pragma("unroll") for (int m_ = 0; m_ < 8; ++m_) stg[m_] = *(const bf16x8*)(s_ + (size_t)(128 * m_) * DINP); } while (0)
#define TH_STORE() do { LAS bf16_t* d_ = (LAS bf16_t*)sm + ldst; _Pragma("unroll") for (int m_ = 0; m_ < 8; ++m_) *(LAS bf16x8*)(d_ + 128 * m_ * TH_ROW) = stg[m_]; } while (0)
    TH_LOAD(0);
    for (int i = tid; i < 48 * 16; i += NTHREADS) cnt[i] = 0u;
#pragma unroll
    for (int ck = 0; ck < 4; ++ck) {
        if (ck < nchunk) {
            TH_STORE();
            __syncthreads();
            if (ck + 1 < nchunk) TH_LOAD(ck + 1);
            LAS bf16_t* B = (LAS bf16_t*)sm;
#pragma unroll
            for (int j = 0; j < 8; ++j) { const int i = ck * 8 + j, kt = w + 8 * i;
                if (kt <= qt) { const bf16x8 ka = *(LAS bf16x8*)(B + ((j * 8 + w) * 16 + c16) * TH_ROW + g * 8);
                    const f32x4 s = idx_scores(ka, qi, wq);
#pragma unroll
                    for (int r = 0; r < 4; ++r) { const int key = kt * 16 + 4 * g + r; sc[i][r] = (key <= q) ? sortable(s[r]) : 0u; }
                } else { sc[i][0] = 0u; sc[i][1] = 0u; sc[i][2] = 0u; sc[i][3] = 0u; } }
            if (ck + 1 < nchunk) __syncthreads();
        } else {
#pragma unroll
            for (int j = 0; j < 8; ++j) { sc[ck * 8 + j][0] = 0u; sc[ck * 8 + j][1] = 0u; sc[ck * 8 + j][2] = 0u; sc[ck * 8 + j][3] = 0u; }
        }
    }
#undef TH_LOAD
#undef TH_STORE
#define TH_XCHG(tot_) do { __hip_atomic_fetch_add(&cnt[it * 16 + c16], (unsigned)cn, __ATOMIC_RELAXED, __HIP_MEMORY_SCOPE_WORKGROUP); __syncthreads(); tot_ = (int)cnt[it * 16 + c16]; } while (0)
    unsigned T = 0u; bool done = false; int it = 0;
    for (; it < 32; ++it) {
        const unsigned cand = T | (1u << (31 - it)); int cn = 0;
#pragma unroll
        for (int gi = 0; gi < 4; ++gi) if (ni > 8 * gi) {
#pragma unroll
            for (int i = 8 * gi; i < 8 * gi + 8; i += 4) cnt_ge16(cn, sc[i], sc[i + 1], sc[i + 2], sc[i + 3], cand); }
        int tot; TH_XCHG(tot);
        if (!done) { if (tot >= TOPK) T = cand; if (tot == TOPK) done = true; }
        if (__all(done)) { ++it; break; }
    }
    unsigned ceq = 4095u; bool tied = false;
    const bool open = !done && (T != 0u);
    if (!__all(!open)) {
        int ngt = 0, nge = 0;
        for (int e = 0; e < 2; ++e, ++it) {
            const unsigned cand = (e == 0) ? T + 1u : T; int cn = 0;
#pragma unroll
            for (int gi = 0; gi < 4; ++gi) if (ni > 8 * gi) {
#pragma unroll
            for (int i = 8 * gi; i < 8 * gi + 8; ++i) { cnt_ge(cn, sc[i][0], cand); cnt_ge(cn, sc[i][1], cand); cnt_ge(cn, sc[i][2], cand); cnt_ge(cn, sc[i][3], cand); } }
            int tot; TH_XCHG(tot);
            if (e == 0) ngt = tot; else nge = tot;
        }
        const int need = TOPK - ngt; const bool excess = open && (nge - ngt > need);
#pragma unroll
        for (int i = 0; i < 32; ++i)
#pragma unroll
            for (int r = 0; r < 4; ++r) sc[i][r] = (sc[i][r] == T) ? (unsigned)((w + 8 * i) * 16 + 4 * g + r) : (sc[i][r] > T ? 0xfffffffeu : 0xffffffffu);
        unsigned c = 0u;
        for (int s = 0; s < 12; ++s, ++it) {
            const unsigned cand = c | (1u << (11 - s)); int cn = 0;
#pragma unroll
            for (int gi = 0; gi < 4; ++gi) if (ni > 8 * gi) {
#pragma unroll
                for (int i = 8 * gi; i < 8 * gi + 8; ++i) { cnt_ge(cn, cand - 1u, sc[i][0]); cnt_ge(cn, cand - 1u, sc[i][1]); cnt_ge(cn, cand - 1u, sc[i][2]); cnt_ge(cn, cand - 1u, sc[i][3]); } }
            int tot; TH_XCHG(tot);
            if (tot < need) c = cand;
        }
        if (excess) ceq = c;
        tied = true;
    }
#undef TH_XCHG
    LAS unsigned* lm = (LAS unsigned*)sm;
    __syncthreads();
    for (int i = tid; i < 2048; i += NTHREADS) lm[i] = 0u;
    __syncthreads();
    { const unsigned Tm = T > 1u ? T : 1u; const bool allow_eq = (T != 0u);
#pragma unroll
        for (int gi = 0; gi < 4; ++gi) if (ni > 8 * gi) {
#pragma unroll
            for (int i = 8 * gi; i < 8 * gi + 8; ++i) { unsigned nib = 0u;
#pragma unroll
                for (int r = 0; r < 4; ++r) { const unsigned v = sc[i][r];
                    const bool s_ = tied ? ((v == 0xfffffffeu) || (allow_eq && v <= ceq)) : (v >= Tm);
                    nib |= s_ ? (1u << r) : 0u; }
                const int kt = w + 8 * i;
                if (nib) __hip_atomic_fetch_or(&lm[c16 * 128 + (kt >> 1)], nib << (4 * g + 16 * (kt & 1)), __ATOMIC_RELAXED, __HIP_MEMORY_SCOPE_WORKGROUP); } }
    }
    __syncthreads();
    { unsigned* gm = (unsigned*)(p.ws + WS_MASK) + (size_t)(b * SEQ + qt * 16) * 128;
        *(u32x4*)(gm + tid * 4) = *(LAS u32x4*)(lm + tid * 4); }
    __syncthreads();
}

constexpr int AT_KROW = 264, AT_IROW = 40, AT_VROW = 40;
constexpr int AT_OFFI = 32 * AT_KROW * 2, AT_OFFV = AT_OFFI + 32 * AT_IROW * 2, AT_BUF = AT_OFFV + 256 * AT_VROW * 2;
__device__ __forceinline__ int at_row(int r) { return (r & 3) + 4 * ((r >> 3) & 3) + 16 * ((r >> 2) & 1); }
__device__ __forceinline__ void attn_item(const Params& p, int b, int qb, LAS unsigned char* sm) {
    const int tid = TID, w = __builtin_amdgcn_readfirstlane(tid >> 6), l = tid & 63, c16 = l & 15, g = l >> 4, qs = w & 3, hp = w >> 2;
    const bf16_t* proj = (const bf16_t*)(p.ws + WS_BIG) + (size_t)b * SEQ * DINP;
    const bf16_t* vt = (const bf16_t*)(p.ws + WS_VT) + (size_t)b * 4 * 64 * SEQ;
    const int q = qb * 64 + qs * 16 + c16;
    const bf16_t* qrow = proj + (size_t)q * DINP;
    const unsigned* mrow = (const unsigned*)(p.ws + WS_MASK) + (size_t)(b * SEQ + q) * 128;
    bf16x8 Qb[2][2];
#pragma unroll
    for (int hh = 0; hh < 2; ++hh)
#pragma unroll
        for (int kk = 0; kk < 2; ++kk) { const bf16x8 raw = *(const bf16x8*)(qrow + OFF_SQ + (2 * hp + hh) * 64 + kk * 32 + g * 8); bf16x8 o;
#pragma unroll
            for (int e = 0; e < 8; ++e) o[e] = (short)f2bf(bf2f(raw[e]) * 0.125f);
            Qb[hh][kk] = o; }
    f32x4 O[2][4];
#pragma unroll
    for (int hh = 0; hh < 2; ++hh)
#pragma unroll
        for (int dt = 0; dt < 4; ++dt) O[hh][dt] = (f32x4){0.f, 0.f, 0.f, 0.f};
    float mrun[2] = {-1e30f, -1e30f}, lrun[2] = {0.f, 0.f};
    const int nt = 2 * qb + 2, my_nt = (qb * 64 + qs * 16 + 15) / 32 + 1;
    const int kr0 = tid >> 5, kc = (tid & 31) * 8, vr0 = tid >> 2, vc = (tid & 3) * 8;
    const bf16_t* gK = proj + (size_t)kr0 * DINP + OFF_SK + kc;
    const bf16_t* gV = vt + (size_t)vr0 * SEQ + vc;
    const int lK0 = at_row(kr0) * AT_KROW + kc, lK1 = at_row(kr0 + 16) * AT_KROW + kc;
    const int lV0 = AT_OFFV / 2 + vr0 * AT_VROW + vc, lV1 = AT_OFFV / 2 + (vr0 + 128) * AT_VROW + vc;
    bf16x8 sA[4], sB[4]; unsigned mw = 0u, mwA = 0u, mwB = 0u;
#define AT_LOAD(S_, M_, k0_) do { S_[0] = *(const bf16x8*)(gK + (size_t)(k0_) * DINP); S_[1] = *(const bf16x8*)(gK + (size_t)((k0_) + 16) * DINP); \
        M_ = mrow[(k0_) >> 5]; S_[2] = *(const bf16x8*)(gV + (k0_)); S_[3] = *(const bf16x8*)(gV + (size_t)128 * SEQ + (k0_)); } while (0)
#define AT_STORE(S_, buf_) do { LAS bf16_t* B_ = (LAS bf16_t*)(sm + (buf_) * AT_BUF); *(LAS bf16x8*)(B_ + lK0) = S_[0]; *(LAS bf16x8*)(B_ + lK1) = S_[1]; \
        *(LAS bf16x8*)(B_ + lV0) = S_[2]; *(LAS bf16x8*)(B_ + lV1) = S_[3]; } while (0)
    AT_LOAD(sA, mwA, 0); AT_STORE(sA, 0); mw = mwA;
    AT_LOAD(sB, mwB, 32);
    __syncthreads();
    for (int t2 = 0; t2 < nt; t2 += 2) {
#pragma unroll
      for (int par = 0; par < 2; ++par) {
        const int t = t2 + par, k0 = t * 32;
        if (t + 2 < nt) { if (par == 0) AT_LOAD(sA, mwA, k0 + 64); else AT_LOAD(sB, mwB, k0 + 64); }
        if (t < my_nt) {
            LAS bf16_t* Bk = (LAS bf16_t*)(sm + par * AT_BUF); LAS bf16_t* Bv = Bk + AT_OFFV / 2;
            bool sel[2][4]; float lg[2][2][4];
#pragma unroll
            for (int s = 0; s < 2; ++s) {
                const int lrow = 16 * s + c16;
#pragma unroll
                for (int r = 0; r < 4; ++r) sel[s][r] = ((mw >> (8 * g + 4 * s + r)) & 1u) != 0u;
#pragma unroll
                for (int hh = 0; hh < 2; ++hh) { f32x4 S = (f32x4){0.f, 0.f, 0.f, 0.f};
#pragma unroll
                    for (int kk = 0; kk < 2; ++kk) { const bf16x8 kf = *(LAS bf16x8*)(Bk + lrow * AT_KROW + (2 * hp + hh) * 64 + kk * 32 + g * 8); S = mfma16(kf, Qb[hh][kk], S); }
#pragma unroll
                    for (int r = 0; r < 4; ++r) lg[hh][s][r] = S[r]; }
            }
#pragma unroll
            for (int hh = 0; hh < 2; ++hh) {
                float lm_[8];
#pragma unroll
                for (int s = 0; s < 2; ++s)
#pragma unroll
                    for (int r = 0; r < 4; ++r) lm_[s * 4 + r] = sel[s][r] ? lg[hh][s][r] : -1e30f;
                float mx = fmaxf(fmaxf(fmaxf(lm_[0], lm_[1]), fmaxf(lm_[2], lm_[3])), fmaxf(fmaxf(lm_[4], lm_[5]), fmaxf(lm_[6], lm_[7])));
                mx = xrow16_max(mx);
                const float mn = fmaxf(mrun[hh], mx), alpha = __expf(mrun[hh] - mn), mn2 = mn * 1.4426950408889634f;
                mrun[hh] = mn;
                float pv[8]; float ps = 0.f;
#pragma unroll
                for (int e = 0; e < 8; ++e) { pv[e] = (mn > -1e29f) ? __builtin_amdgcn_exp2f(__builtin_fmaf(lm_[e], 1.4426950408889634f, -mn2)) : 0.f; ps += pv[e]; }
                lrun[hh] = lrun[hh] * alpha + ps;
                union { bf16x8 v; unsigned u[4]; } pb;
                pb.u[0] = cvt_pk_bf16(pv[0], pv[1]); pb.u[1] = cvt_pk_bf16(pv[2], pv[3]); pb.u[2] = cvt_pk_bf16(pv[4], pv[5]); pb.u[3] = cvt_pk_bf16(pv[6], pv[7]);
                if (__any(alpha != 1.f)) {
#pragma unroll
                    for (int dt = 0; dt < 4; ++dt) O[hh][dt] = O[hh][dt] * alpha; }
                bf16x8 va4[4];
#pragma unroll
                for (int dt = 0; dt < 4; ++dt) va4[dt] = *(LAS bf16x8*)(Bv + ((2 * hp + hh) * 64 + dt * 16 + c16) * AT_VROW + g * 8);
                __builtin_amdgcn_s_setprio(1);
#pragma unroll
                for (int dt = 0; dt < 4; ++dt) O[hh][dt] = mfma16(va4[dt], pb.v, O[hh][dt]);
                __builtin_amdgcn_s_setprio(0);
            }
        }
        if (t + 1 < nt) { if (par == 0) { AT_STORE(sB, 1); mw = mwB; } else { AT_STORE(sA, 0); mw = mwA; } }
        __syncthreads();
      }
    }
#undef AT_LOAD
#undef AT_STORE
    bf16_t* mix = (bf16_t*)(p.ws + WS_HB) + (size_t)(b * SEQ + q) * DM + 512;
#pragma unroll
    for (int hh = 0; hh < 2; ++hh) { const float tot = xrow16_sum(lrun[hh]);
        const float inv = 1.f / tot;
#pragma unroll
        for (int dt = 0; dt < 4; ++dt) { const f32x4 o = O[hh][dt] * inv; u32x2 o2; o2.x = cvt_pk_bf16(o[0], o[1]); o2.y = cvt_pk_bf16(o[2], o[3]);
            *(u32x2*)(mix + (2 * hp + hh) * 64 + dt * 16 + 4 * g) = o2; } }
}

__device__ __forceinline__ void hgrn_G(const bf16x8 (&fv)[2], const float* lb, LAS float* Gs, LAS float* segtot) {
    const int tid = TID;
#pragma unroll
    for (int i = 0; i < 2; ++i) { const int row = (tid >> 4) + 32 * i, c8 = (tid & 15) * 8;
        const bf16x8 v = fv[i];
#pragma unroll
        for (int j = 0; j < 8; ++j) { const float fr = bf2f(v[j]), lbv = lb[c8 + j]; const float f = lbv + (1.f - lbv) * sigmoidf_(fr);
            Gs[row * 129 + c8 + j] = __builtin_amdgcn_logf(fmaxf(f, 1e-30f)); } }
    __syncthreads();
    const int col = tid & 127, seg = tid >> 7;
    { float run = 0.f;
#pragma unroll
        for (int r = 0; r < 16; ++r) { const int idx = (seg * 16 + r) * 129 + col; run += Gs[idx]; Gs[idx] = run; }
        segtot[seg * 128 + col] = run; }
    __syncthreads();
    { float off = 0.f;
#pragma unroll
        for (int s = 0; s < 3; ++s) if (s < seg) off += segtot[s * 128 + col];
        if (seg > 0) {
#pragma unroll
            for (int r = 0; r < 16; ++r) Gs[(seg * 16 + r) * 129 + col] += off; } }
    __syncthreads();
}

__device__ __forceinline__ void hgrn_A_item(const Params& p, int l, int b, int h, int c, LAS unsigned char* sm) {
    const int tid = TID, w = __builtin_amdgcn_readfirstlane(tid >> 6), ln = tid & 63, c16 = ln & 15, g = ln >> 4;
    LAS float* Gs = (LAS float*)sm; LAS float* segtot = (LAS float*)(sm + 33024);
    LAS bf16_t* KgT = (LAS bf16_t*)(sm + 35072); LAS bf16_t* vT = (LAS bf16_t*)(sm + 53504);
    LAS bf16_t* qt_ = (LAS bf16_t*)(sm + 71936); LAS bf16_t* kt_ = (LAS bf16_t*)(sm + 89344); LAS bf16_t* Am = (LAS bf16_t*)(sm + 106752);
    bf16_t* prow0 = (bf16_t*)(p.ws + WS_BIG) + (size_t)(b * SEQ + c * 64) * DINP;
    const float* lb = (const float*)(p.ws + WS_LB) + l * 512 + h * 128;
    bf16x8 fG[2], qG[2];
#pragma unroll
    for (int i = 0; i < 2; ++i) { const bf16_t* rq = prow0 + (size_t)((tid >> 4) + 32 * i) * DINP + h * 128 + (tid & 15) * 8; fG[i] = *(const bf16x8*)(rq + OFF_HF); qG[i] = *(const bf16x8*)(rq + OFF_HQ); }
    const bf16_t* rp = prow0 + (size_t)(tid & 63) * DINP + h * 128 + (tid >> 6) * 16;
    const bf16x8 f0 = *(const bf16x8*)(rp + OFF_HF), f1 = *(const bf16x8*)(rp + OFF_HF + 8), v0 = *(const bf16x8*)(rp + OFF_HI), v1 = *(const bf16x8*)(rp + OFF_HI + 8);
    hgrn_G(fG, lb, Gs, segtot);
#pragma unroll
    for (int i = 0; i < 2; ++i) { const int row = (tid >> 4) + 32 * i, c8 = (tid & 15) * 8;
        const bf16x8 qv8 = qG[i], fv8 = fG[i];
        float a[8], bq[8], cq[8];
#pragma unroll
        for (int j = 0; j < 8; ++j) { const int k = c8 + j; const float G = Gs[row * 129 + k], Gm = Gs[31 * 129 + k], lbv = lb[k];
            const float qv = siluf_(bf2f(qv8[j])) * 0.08838834764831845f, kval = (1.f - lbv) * sigmoidf_(-bf2f(fv8[j]));
            a[j] = qv * __builtin_amdgcn_exp2f(fminf(G - Gm, 115.f)); bq[j] = kval * __builtin_amdgcn_exp2f(fminf(Gm - G, 115.f)); cq[j] = qv * __builtin_amdgcn_exp2f(G); }
        u32x4 o;
        o.x = cvt_pk_bf16(a[0], a[1]); o.y = cvt_pk_bf16(a[2], a[3]); o.z = cvt_pk_bf16(a[4], a[5]); o.w = cvt_pk_bf16(a[6], a[7]); *(LAS u32x4*)(qt_ + row * 136 + c8) = o;
        o.x = cvt_pk_bf16(bq[0], bq[1]); o.y = cvt_pk_bf16(bq[2], bq[3]); o.z = cvt_pk_bf16(bq[4], bq[5]); o.w = cvt_pk_bf16(bq[6], bq[7]); *(LAS u32x4*)(kt_ + row * 136 + c8) = o;
        o.x = cvt_pk_bf16(cq[0], cq[1]); o.y = cvt_pk_bf16(cq[2], cq[3]); o.z = cvt_pk_bf16(cq[4], cq[5]); o.w = cvt_pk_bf16(cq[6], cq[7]);
        *(u32x4*)(prow0 + (size_t)row * DINP + OFF_HQ + h * 128 + c8) = o; }
    { const int j = tid & 63, kg = tid >> 6;
#pragma unroll
        for (int e = 0; e < 16; ++e) { const int k = kg * 16 + e; const float fr = bf2f(e < 8 ? f0[e & 7] : f1[e & 7]), lbv = lb[k];
            const float kval = (1.f - lbv) * sigmoidf_(-fr);
            KgT[k * 72 + j] = f2bf(kval * __builtin_amdgcn_exp2f(Gs[63 * 129 + k] - Gs[j * 129 + k]));
            vT[k * 72 + j] = (bf16_t)(e < 8 ? v0[e & 7] : v1[e & 7]); } }
    const size_t bhc = (size_t)((b * 4 + h) * 64 + c);
    if (tid < 128) ((float*)(p.ws + WS_DEC))[bhc * 128 + tid] = __builtin_amdgcn_exp2f(Gs[63 * 129 + tid]);
    __syncthreads();
    { f32x4 acc[8];
#pragma unroll
        for (int vt = 0; vt < 8; ++vt) acc[vt] = (f32x4){0.f, 0.f, 0.f, 0.f};
#pragma unroll
        for (int kk = 0; kk < 2; ++kk) { const bf16x8 a = *(LAS bf16x8*)(KgT + (w * 16 + c16) * 72 + kk * 32 + g * 8);
#pragma unroll
            for (int vt = 0; vt < 8; ++vt) { const bf16x8 bb = *(LAS bf16x8*)(vT + (vt * 16 + c16) * 72 + kk * 32 + g * 8); acc[vt] = mfma16(a, bb, acc[vt]); } }
        bf16_t* st = (bf16_t*)(p.ws + WS_ST) + bhc * 16384;
#pragma unroll
        for (int vt = 0; vt < 8; ++vt) { u32x2 o; o.x = cvt_pk_bf16(acc[vt][0], acc[vt][1]); o.y = cvt_pk_bf16(acc[vt][2], acc[vt][3]);
            *(u32x2*)(st + (size_t)(vt * 16 + c16) * 128 + w * 16 + 4 * g) = o; } }
#pragma unroll
    for (int s = 0; s < 2; ++s) { const int tI = w * 2 + s, itile = tI >> 2, jt = tI & 3;
        f32x4 d = (f32x4){0.f, 0.f, 0.f, 0.f};
        if (jt <= itile) {
#pragma unroll
            for (int kk = 0; kk < 4; ++kk) { const bf16x8 a = *(LAS bf16x8*)(kt_ + (jt * 16 + c16) * 136 + kk * 32 + g * 8), bb = *(LAS bf16x8*)(qt_ + (itile * 16 + c16) * 136 + kk * 32 + g * 8);
                d = mfma16(a, bb, d); } }
        const int i = itile * 16 + c16, j0 = jt * 16 + 4 * g;
        u32x2 o; o.x = cvt_pk_bf16((j0 + 0 <= i) ? d[0] : 0.f, (j0 + 1 <= i) ? d[1] : 0.f); o.y = cvt_pk_bf16((j0 + 2 <= i) ? d[2] : 0.f, (j0 + 3 <= i) ? d[3] : 0.f);
        *(LAS u32x2*)(Am + i * 72 + j0) = o; }
    __syncthreads();
    { const int itile = w & 3, vh = w >> 2;
        f32x4 acc[4];
#pragma unroll
        for (int vt = 0; vt < 4; ++vt) acc[vt] = (f32x4){0.f, 0.f, 0.f, 0.f};
#pragma unroll
        for (int kk = 0; kk < 2; ++kk) { const bf16x8 bb = *(LAS bf16x8*)(Am + (itile * 16 + c16) * 72 + kk * 32 + g * 8);
#pragma unroll
            for (int vt = 0; vt < 4; ++vt) { const bf16x8 a = *(LAS bf16x8*)(vT + ((vh * 4 + vt) * 16 + c16) * 72 + kk * 32 + g * 8); acc[vt] = mfma16(a, bb, acc[vt]); } }
        bf16_t* mix = (bf16_t*)(p.ws + WS_HB) + (size_t)(b * SEQ + c * 64 + itile * 16 + c16) * DM + h * 128;
#pragma unroll
        for (int vt = 0; vt < 4; ++vt) { u32x2 o; o.x = cvt_pk_bf16(acc[vt][0], acc[vt][1]); o.y = cvt_pk_bf16(acc[vt][2], acc[vt][3]);
            *(u32x2*)(mix + (vh * 4 + vt) * 16 + 4 * g) = o; } }
    __syncthreads();
}

__device__ __forceinline__ void hgrn_scan(const Params& p) {
    bf16_t* ST = (bf16_t*)(p.ws + WS_ST); const float* DEC = (const float*)(p.ws + WS_DEC);
    for (int e = blockIdx.x * NTHREADS + TID; e < 32 * 4096; e += gridDim.x * NTHREADS) {
        const int bh = e >> 12, idx4 = (e & 4095) * 4, k = idx4 & 127;
        bf16_t* base = ST + (size_t)bh * 64 * 16384 + idx4; const float* dec = DEC + (size_t)bh * 64 * 128 + k;
        f32x4 S = (f32x4){0.f, 0.f, 0.f, 0.f};
#pragma unroll 16
        for (int c = 0; c < 64; ++c) { const u32x2 loc = *(const u32x2*)(base + (size_t)c * 16384); const f32x4 d = *(const f32x4*)(dec + c * 128);
            u32x2 o; o.x = cvt_pk_bf16(S[0], S[1]); o.y = cvt_pk_bf16(S[2], S[3]);
            *(u32x2*)(base + (size_t)c * 16384) = o;
            S[0] = d[0] * S[0] + bflo(loc.x); S[1] = d[1] * S[1] + bfhi(loc.x); S[2] = d[2] * S[2] + bflo(loc.y); S[3] = d[3] * S[3] + bfhi(loc.y); }
    }
}

__device__ __forceinline__ void hgrn_C_item(const Params& p, int l, int b, int h, int c, LAS unsigned char* sm) {
    const int tid = TID, w = __builtin_amdgcn_readfirstlane(tid >> 6), ln = tid & 63, c16 = ln & 15, g = ln >> 4;
    LAS float* ssq = (LAS float*)sm;
    const int itile = w & 3, vh = w >> 2, i = itile * 16 + c16;
    const bf16_t* prow = (const bf16_t*)(p.ws + WS_BIG) + (size_t)(b * SEQ + c * 64 + i) * DINP;
    bf16_t* mix = (bf16_t*)(p.ws + WS_HB) + (size_t)(b * SEQ + c * 64 + i) * DM + h * 128;
    const bf16_t* st_ = (const bf16_t*)(p.ws + WS_ST) + (size_t)((b * 4 + h) * 64 + c) * 16384;
    bf16x8 qgF[4], stG[4][4]; u32x2 grG[4], oi[4];
#pragma unroll
    for (int kk = 0; kk < 4; ++kk) qgF[kk] = *(const bf16x8*)(prow + OFF_HQ + h * 128 + kk * 32 + g * 8);
#pragma unroll
    for (int kk = 0; kk < 4; ++kk)
#pragma unroll
        for (int vt = 0; vt < 4; ++vt) stG[kk][vt] = *(const bf16x8*)(st_ + (size_t)((vh * 4 + vt) * 16 + c16) * 128 + kk * 32 + g * 8);
#pragma unroll
    for (int vt = 0; vt < 4; ++vt) { const int v0 = (vh * 4 + vt) * 16 + 4 * g; grG[vt] = *(const u32x2*)(prow + OFF_HG + h * 128 + v0); oi[vt] = *(const u32x2*)(mix + v0); }
    f32x4 acc[4];
#pragma unroll
    for (int vt = 0; vt < 4; ++vt) acc[vt] = (f32x4){bflo(oi[vt].x), bfhi(oi[vt].x), bflo(oi[vt].y), bfhi(oi[vt].y)};
#pragma unroll
    for (int kk = 0; kk < 4; ++kk)
#pragma unroll
        for (int vt = 0; vt < 4; ++vt) acc[vt] = mfma16(stG[kk][vt], qgF[kk], acc[vt]);
    float ss = 0.f;
#pragma unroll
    for (int vt = 0; vt < 4; ++vt) ss += acc[vt][0] * acc[vt][0] + acc[vt][1] * acc[vt][1] + acc[vt][2] * acc[vt][2] + acc[vt][3] * acc[vt][3];
    ss = xrow16_sum(ss);
    if (g == 0) ssq[vh * 64 + i] = ss;
    __syncthreads();
    const float rstd = rsqrtf((ssq[i] + ssq[64 + i]) * (1.f / 128.f) + EPS);
#pragma unroll
    for (int vt = 0; vt < 4; ++vt) { const int v0 = (vh * 4 + vt) * 16 + 4 * g;
        const u32x2 gr = grG[vt]; const f32x4 ow = *(const f32x4*)(p.onorm_w + l * 512 + h * 128 + v0);
        const float r0 = acc[vt][0] * rstd * ow[0] * siluf_(bflo(gr.x)), r1 = acc[vt][1] * rstd * ow[1] * siluf_(bfhi(gr.x));
        const float r2 = acc[vt][2] * rstd * ow[2] * siluf_(bflo(gr.y)), r3 = acc[vt][3] * rstd * ow[3] * siluf_(bfhi(gr.y));
        u32x2 o; o.x = cvt_pk_bf16(r0, r1); o.y = cvt_pk_bf16(r2, r3);
        *(u32x2*)(mix + v0) = o; }
    __syncthreads();
}

#ifdef DIAG_CUT
__device__ __forceinline__ void diag_phase(const Params& p) {
    const int tid = TID, wave = tid >> 6, lane = tid & 63;
    const bf16_t* HB = (const bf16_t*)(p.ws + WS_HB); const bf16_t* ST = (const bf16_t*)(p.ws + WS_ST); const float* DEC = (const float*)(p.ws + WS_DEC);
    const bf16_t* BIG = (const bf16_t*)(p.ws + WS_BIG);
    for (int row = blockIdx.x * 8 + wave; row < NTOK; row += gridDim.x * 8) {
        float* orow = p.out + (size_t)row * DM;
        for (int i = 0; i < 16; ++i) { const int col = i * 64 + lane; float v = 0.f;
#if DIAG_MODE == 1
            for (int t = 0; t < 3; ++t) v += bf2f((short)BIG[(size_t)row * DINP + col + 1024 * t]);
            if (col < 768) v += bf2f((short)BIG[(size_t)row * DINP + 3072 + col]);
#elif DIAG_MODE == 2
            v = bf2f((short)ST[(size_t)row * 1024 + col]) + DEC[((size_t)row * 8 + (col & 7)) % (32 * 64 * 128)];
#elif DIAG_MODE == 5
            v = DEC[((size_t)row * 8 + (col & 7)) % (32 * 64 * 128)];
#elif DIAG_MODE == 6
            v = bf2f((short)ST[(size_t)row * 1024 + col]);
#elif DIAG_MODE == 4
            v = bf2f((short)HB[(size_t)row * DM + col]);
#endif
            if (!(fabsf(v) < 1e30f)) v = 12345.f;
            orow[col] = v; }
    }
}
#endif
#define XB_TMO      128
#define XB_XCNT(j)  (256  + 64 * (j))
#define XB_XSUB(j)  (1280 + 64 * (j))
#define XB_XGEN(j)  (2304 + 64 * (j))
#define XB_TOP      3328
#define XB_TOPGEN   3392
#define XCD_BAR_WORDS 3456
#define XB_SPIN_CAP (1u << 21)

__device__ __forceinline__ unsigned xb_ld(unsigned* p)              { return __hip_atomic_load(p, __ATOMIC_RELAXED, __HIP_MEMORY_SCOPE_AGENT); }
__device__ __forceinline__ unsigned xb_add(unsigned* p, unsigned v) { return __hip_atomic_fetch_add(p, v, __ATOMIC_RELAXED, __HIP_MEMORY_SCOPE_AGENT); }
__device__ __forceinline__ unsigned xb_xcc_id() { return (unsigned)__builtin_amdgcn_s_getreg((3 << 11) | 20) & 0xFu; }
#define XB_SPIN(cond, bar) do { unsigned _sp = 0; while (cond) { __builtin_amdgcn_s_sleep(1); \
    if ((++_sp & 255u) == 0u) { if (xb_ld(&(bar)[XB_TMO])) break; if (_sp > XB_SPIN_CAP) { atomicAdd(&(bar)[XB_TMO], 1u); break; } } } } while (0)

struct XcdBarrier {
    unsigned* bar; unsigned x;
    volatile LAS unsigned* st;
};

__device__ __forceinline__ XcdBarrier xcd_barrier_post(unsigned* bar, volatile LAS unsigned* st) {
    XcdBarrier b; b.bar = bar; b.x = xb_xcc_id(); b.st = st;
    if (threadIdx.x == 0) (void)xb_add(&bar[XB_XCNT(b.x)], 1u);
    return b;
}
__device__ __forceinline__ void xcd_barrier_complete(unsigned* bar, unsigned x, unsigned& nloc, unsigned& nx) {
    const unsigned G = gridDim.x * gridDim.y * gridDim.z;
    unsigned sum, cnt, mine, sp = 0u;
    for (;;) {
        sum = 0u; cnt = 0u; mine = 0u;
#pragma unroll
        for (unsigned j = 0; j < 16; ++j) { const unsigned c = xb_ld(&bar[XB_XCNT(j)]); sum += c; cnt += (c > 0u) ? 1u : 0u; mine = (j == x) ? c : mine; }
        if (sum == G) break;
        __builtin_amdgcn_s_sleep(1);
        if ((++sp & 255u) == 0u) { if (xb_ld(&bar[XB_TMO])) break; if (sp > XB_SPIN_CAP) { atomicAdd(&bar[XB_TMO], 1u); break; } }
    }
    nloc = mine > 0u ? mine : 1u; nx = cnt > 0u ? cnt : 1u;
}

__device__ __forceinline__ void xcd_barrier(const XcdBarrier& b) {
    asm volatile("s_waitcnt vmcnt(0)" ::: "memory");
    __syncthreads();
    if (threadIdx.x == 0) {
        unsigned* bar = b.bar;
        __builtin_amdgcn_s_waitcnt(0);
        unsigned nloc = b.st[0], nx = b.st[1];
        if (nloc == 0u) { xcd_barrier_complete(bar, b.x, nloc, nx); b.st[0] = nloc; b.st[1] = nx; }
        const unsigned old = xb_add(&bar[XB_XSUB(b.x)], 1u);
        const unsigned gen = old / nloc;
        if (old + 1u == (gen + 1u) * nloc) {
            __builtin_amdgcn_fence(__ATOMIC_RELEASE, "agent");
            asm volatile("s_waitcnt vmcnt(0)" ::: "memory");
            const unsigned og = xb_add(&bar[XB_TOP], 1u);
            const unsigned tg = og / nx;
            if (og + 1u == (tg + 1u) * nx) xb_add(&bar[XB_TOPGEN], 1u);
            else XB_SPIN(xb_ld(&bar[XB_TOPGEN]) == tg, bar);
            __builtin_amdgcn_fence(__ATOMIC_ACQUIRE, "agent");
            xb_add(&bar[XB_XGEN(b.x)], 1u);
            asm volatile("s_waitcnt vmcnt(0)" ::: "memory");
        } else {
            XB_SPIN(xb_ld(&bar[XB_XGEN(b.x)]) == gen, bar);
            __builtin_amdgcn_fence(__ATOMIC_ACQUIRE, "agent");
            asm volatile("s_waitcnt vmcnt(0)" ::: "memory");
        }
    }
    __syncthreads();
}


template <class Epi>
__device__ __forceinline__ void run_gemm(LAS unsigned char* lds, const bf16_t* A, const bf16_t* Bt, int M, int N, int K, const Epi& E) {
    pg8::Gemm g; g.A = A; g.Bt = Bt; g.M = M; g.N = N; g.K = K;
    pg8::StaticOrder S; S.init(M, N, (int)gridDim.x, (int)blockIdx.x);
    pg8::gemm_phase<Epi, pg8::StaticOrder, true, true>(lds, g, S, E);
}

constexpr int NPHASE = 2 + 9 * DEPTH;
#define GRID_SYNC() do { if (pin.ph_lo < 0) grid.sync(); xcd_barrier(xb); } while (0)

__global__ void __launch_bounds__(NTHREADS, 2) fwd_megakernel(Params pin) {
    extern __shared__ __attribute__((aligned(16))) unsigned char lds_raw[];
    LAS unsigned char* lds = (LAS unsigned char*)lds_raw;
    cg::grid_group grid = cg::this_grid();
    volatile LAS unsigned* xst = (volatile LAS unsigned*)(lds + 131072);
    if (threadIdx.x == 0) { xst[0] = 0u; xst[1] = 0u; }
    __syncthreads();
    XcdBarrier xb = xcd_barrier_post((unsigned*)(pin.ws + WS_BAR), xst);
    const int G = (int)gridDim.x, blk = (int)blockIdx.x;
    for (int ph = pin.ph_lo; ph < pin.ph_hi; ++ph) {
        Params p = pin;
        { size_t zoff = 0; asm volatile("" : "+s"(zoff));
            p.ws = pin.ws + zoff; p.out = pin.out + zoff; p.x = pin.x + zoff; }
        bf16_t* WIN = (bf16_t*)(p.ws + WS_WIN); bf16_t* WOUT = (bf16_t*)(p.ws + WS_WOUT); bf16_t* W1B = (bf16_t*)(p.ws + WS_W1); bf16_t* W2B = (bf16_t*)(p.ws + WS_W2);
        const float* MOD = (const float*)(p.ws + WS_MOD);
        bf16_t* BIG = (bf16_t*)(p.ws + WS_BIG); bf16_t* HB = (bf16_t*)(p.ws + WS_HB);
        if (ph == 0) {
          for (int rep_ = 0; rep_ < REP_PRO; ++rep_) {
            cvt_kind(p.w_in, WIN, DM, DIN, DINP, (LAS float*)lds);
            cvt_kind(p.w_out, WOUT, DM, DM, DM, (LAS float*)lds);
            cvt_kind(p.w1, W1B, DM, DFF, DFF, (LAS float*)lds);
            cvt_kind(p.w2, W2B, DFF, DM, DM, (LAS float*)lds);
            mod_phase(p, (LAS float*)lds);
            lb_phase(p);
          }
        } else if (ph == NPHASE - 1) {
            final_norm(p.out, p.final_w);
        } else {
            const int l = (ph - 1) / 9, s = (ph - 1) % 9;
            const float* modl = MOD + (size_t)l * NB * 6144;
            const float* xcur = (l == 0) ? p.x : p.out;
            if (s == 0) {
                for (int rep_ = 0; rep_ < REP_NORM; ++rep_) rmsnorm_mod(xcur, p.norm_mix_w + l * DM, modl, 0, 1024, HB);
            } else if (s == 1) {
                pg8::EpiBf16<0> E; E.O = BIG; E.ldc = DINP;
                for (int rep_ = 0; rep_ < REP_GEMM; ++rep_) run_gemm(lds, HB, WIN + (size_t)l * DINP * DM, NTOK, DINP, DM, E);
            } else if (s == 2) {
              for (int rep2_ = 0; rep2_ < REP_S2; ++rep2_) {
#ifndef DIAG_NOTHR
                for (int v = blk; v < 2048; v += G) { const int itp = v >> 8, rem = v & 255, b = rem & 7, jj = rem >> 3; const int qt = itp * 32 + ((itp & 1) ? 31 - jj : jj); for (int rep_ = 0; rep_ < REP_THR; ++rep_) thr_item(p, b, qt, lds); }
#endif
                for (int v = blk; v < 2048; v += G) { const int c = v & 63, bh = v >> 6; hgrn_A_item(p, l, bh >> 2, bh & 3, c, lds); }
                for (int v = blk; v < 1024; v += G) conv_item(p, l, v >> 7, v & 127, lds);
                for (int v = blk; v < 512; v += G) vt_item(p, v >> 6, v & 63, lds);
              }
            } else if (s == 3) {
                hgrn_scan(p);
                for (int v = blk; v < 512; v += G) { const int itp = v >> 8, rem = v & 255, b = rem & 7, jj = rem >> 3; const int qb = itp ? 63 - jj : jj; for (int rep_ = 0; rep_ < REP_ATTN; ++rep_) attn_item(p, b, qb, lds); }
            } else if (s == 4) {
                for (int rep_ = 0; rep_ < REP_HO; ++rep_) for (int v = blk; v < 2048; v += G) { const int c = v & 63, bh = v >> 6; hgrn_C_item(p, l, bh >> 2, bh & 3, c, lds); }
            } else if (s == 5) {
                pg8::EpiResid E; E.xs = xcur; E.xd = p.out; E.gate = modl + 2048;
                run_gemm(lds, HB, WOUT + (size_t)l * DM * DM, NTOK, DM, DM, E);
            } else if (s == 6) {
                for (int rep_ = 0; rep_ < REP_NORM; ++rep_) rmsnorm_mod(p.out, p.norm_mlp_w + l * DM, modl, 3072, 4096, HB);
            } else if (s == 7) {
                pg8::EpiBf16<1> E; E.O = BIG; E.ldc = DFF;
                for (int rep_ = 0; rep_ < REP_GEMM; ++rep_) run_gemm(lds, HB, W1B + (size_t)l * DFF * DM, NTOK, DFF, DM, E);
            } else {
                pg8::EpiResid E; E.xs = p.out; E.xd = p.out; E.gate = modl + 5120;
                run_gemm(lds, BIG, W2B + (size_t)l * DM * DFF, NTOK, DM, DFF, E);
            }
        }
        if (ph + 1 < pin.ph_hi) { GRID_SYNC(); }
    }
#ifdef DIAG_CUT
    { const int ph = 1; GRID_SYNC(); } diag_phase(pin);
#endif
}

extern "C" void kernel_launch(void* const* d_in, const int* in_sizes, int n_in, void* d_out, int out_size, void* d_ws, size_t ws_size, hipStream_t stream) {
    static int grid_blocks = 0;
    if (grid_blocks == 0) {
        if (n_in != 17 || out_size != NTOK * DM || ws_size < WS_END) { fprintf(stderr, "kernel_launch: unexpected shapes (n_in %d out %d ws %zu need %zu)\n", n_in, out_size, ws_size, (size_t)WS_END); grid_blocks = -1; return; }
        int dev = 0, cus = 0, per_cu = 0;
        hipGetDevice(&dev);
        hipDeviceGetAttribute(&cus, hipDeviceAttributeMultiprocessorCount, dev);
        if (hipFuncSetAttribute((const void*)fwd_megakernel, hipFuncAttributeMaxDynamicSharedMemorySize, LDS_BYTES) != hipSuccess) { fprintf(stderr, "kernel_launch: hipFuncSetAttribute failed\n"); grid_blocks = -1; return; }
        if (hipOccupancyMaxActiveBlocksPerMultiprocessor(&per_cu, (const void*)fwd_megakernel, NTHREADS, LDS_BYTES) != hipSuccess || per_cu < 1) { fprintf(stderr, "kernel_launch: occupancy query says %d blocks/CU\n", per_cu); per_cu = 1; }
        (void)hipGetLastError();
        grid_blocks = cus * (per_cu > 1 ? 1 : per_cu);
    }
    if (grid_blocks < 0) return;
    Params p{};
    p.x = (const float*)d_in[0]; p.c = (const float*)d_in[1]; p.ada_w = (const float*)d_in[2]; p.ada_b = (const float*)d_in[3];
    p.norm_mix_w = (const float*)d_in[4]; p.norm_mlp_w = (const float*)d_in[5]; p.w_in = (const float*)d_in[6]; p.lb_logits = (const float*)d_in[7];
    p.onorm_w = (const float*)d_in[8]; p.cv_w = (const float*)d_in[9]; p.cv_b = (const float*)d_in[10]; p.cv_ln_w = (const float*)d_in[11]; p.cv_ln_b = (const float*)d_in[12];
    p.w_out = (const float*)d_in[13]; p.w1 = (const float*)d_in[14]; p.w2 = (const float*)d_in[15]; p.final_w = (const float*)d_in[16];
    p.out = (float*)d_out; p.ws = (unsigned char*)d_ws; p.ph_lo = 0; p.ph_hi = NPHASE;
#ifdef DIAG_CUT
    p.ph_hi = DIAG_CUT;
#endif
    if (hipMemsetAsync((char*)d_ws + WS_BAR, 0, 16384, stream) != hipSuccess) { fprintf(stderr, "kernel_launch: hipMemsetAsync failed\n"); return; }
    void* args[] = {&p};
    hipError_t e = hipLaunchCooperativeKernel((const void*)fwd_megakernel, dim3(grid_blocks), dim3(NTHREADS), args, LDS_BYTES, stream);
    if (e != hipSuccess) fprintf(stderr, "kernel_launch: cooperative launch failed: %s (grid %d)\n", hipGetErrorString(e), grid_blocks);
}
```
